# Optimizing an MI355X kernel written in HIP

```python
import jax, jax.numpy as jnp
from jax import lax
import numpy as np

D_MODEL = 1024
BATCH = 4
SEQ = 8192
DEPTH = 2

GRID_W = 64
CTX_LEN = 256
N_MOD = 6
NORM_EPS = 1e-6
HEAD_DIM = 64
RWKV_HEADS = 6
RWKV_W = RWKV_HEADS * HEAD_DIM
DECAY_LORA = 64
ICLR_LORA = 64
GATE_LORA = 160
GN_EPS = 64e-5
MLA_HEADS = 6
MLA_NOPE = 64
MLA_ROPE = 32
MLA_V = 64
MLA_W = MLA_HEADS * MLA_V
Q_LORA = 256
KV_LORA = 128
MLA_SCALE = (MLA_NOPE + MLA_ROPE) ** -0.5
ROPE_BASE = 10000.0
Q_BLOCK = 128
FOURIER_GROUPS = 4
FOURIER_CH = 64
FOURIER_W = FOURIER_GROUPS * FOURIER_CH
D_MIX = RWKV_W + MLA_W + FOURIER_W
IN_SIZES = (RWKV_W, RWKV_W, RWKV_W, DECAY_LORA, ICLR_LORA, GATE_LORA, Q_LORA, KV_LORA, MLA_ROPE, FOURIER_W)
D_IN = 3 * RWKV_W + DECAY_LORA + ICLR_LORA + GATE_LORA + Q_LORA + KV_LORA + MLA_ROPE + FOURIER_W
N_EXPERTS = 16
EC_CAPACITY = 2
EXPERT_FF = 1024

kernel_name = "hybrid_rwkv7_mla_fnet_ec_moe_diffusion"


def rmsnorm(x, g):
    xf = x.astype(jnp.float32)
    y = xf * lax.rsqrt(jnp.mean(xf * xf, axis=-1, keepdims=True) + NORM_EPS)
    return (y * g.astype(jnp.float32)).astype(x.dtype)


def split_cols(u):
    return jnp.split(u, np.cumsum(IN_SIZES)[:-1].tolist(), axis=-1)


def rope_1d(x, pos):
    n = x.shape[-1] // 2
    inv = ROPE_BASE ** (-jnp.arange(n, dtype=jnp.float32) / n)
    ang = pos.astype(jnp.float32)[:, None] * inv[None, :]
    cos = jnp.cos(ang)[None, :, None, :]
    sin = jnp.sin(ang)[None, :, None, :]
    xf = x.astype(jnp.float32)
    x1, x2 = xf[..., :n], xf[..., n:]
    return jnp.concatenate([x1 * cos - x2 * sin, x2 * cos + x1 * sin], axis=-1).astype(x.dtype)


def rope_2d(x):
    rows = x.shape[1] // GRID_W
    row = jnp.repeat(jnp.arange(rows), GRID_W)
    col = jnp.tile(jnp.arange(GRID_W), rows)
    half = x.shape[-1] // 2
    return jnp.concatenate([rope_1d(x[..., :half], row), rope_1d(x[..., half:], col)], axis=-1)


def short_conv(u, w):
    up = jnp.pad(u, ((0, 0), (1, 1), (0, 0)))
    return up[:, :-2] * w[0] + up[:, 1:-1] * w[1] + up[:, 2:] * w[2]


def rwkv_scan(r, w, k, v, a_vec, b_vec, s0, reverse):
    def step(S, inp):
        rt, wt, kt, vt, at, bt = inp
        S = (S * wt[:, :, None, :]
             + jnp.einsum("bhvk,bhk->bhv", S, at)[..., None] * bt[:, :, None, :]
             + vt[..., None] * kt[:, :, None, :])
        return S, jnp.einsum("bhvk,bhk->bhv", S, rt)
    xs = tuple(jnp.moveaxis(t, 1, 0) for t in (r, w, k, v, a_vec, b_vec))
    s_final, ys = lax.scan(step, s0, xs, reverse=reverse)
    return jnp.moveaxis(ys, 0, 1), s_final


def rwkv_prep(u, conv_w, w0, w2, a0, a2, g2, k_k, k_a):
    r, k, v, wd, ad, gd = u
    B, L, _ = r.shape
    hd = lambda t: t.reshape(B, L, RWKV_HEADS, HEAD_DIM)
    rkv = short_conv(jnp.concatenate([r, k, v], axis=-1), conv_w).astype(jnp.float32)
    r, k, v = jnp.split(rkv, 3, axis=-1)
    kk = hd(k * k_k)
    kk = kk / jnp.maximum(jnp.sqrt(jnp.sum(kk * kk, axis=-1, keepdims=True)), 1e-12)
    wd_t = jnp.tanh(wd.astype(jnp.float32))
    ad = ad.astype(jnp.float32)
    dirs = []
    for d in range(2):
        wlog = -jax.nn.softplus(-(w0[d] + wd_t @ w2[d])) - 0.5
        decay = jnp.exp(-jnp.exp(wlog))
        a = jax.nn.sigmoid(a0[d] + ad @ a2[d])
        kd = k * (1.0 + (a - 1.0) * k_a)
        dirs.append((hd(decay), hd(kd), -kk, kk * hd(a)))
    g = jax.nn.sigmoid(gd.astype(jnp.float32)) @ g2
    return hd(r), hd(v), dirs, g


def rwkv_post(y, r, v, dirs, g, r_k, lnx_w, lnx_b):
    B, L = y.shape[:2]
    mu = jnp.mean(y, axis=-1, keepdims=True)
    var = jnp.mean(jnp.square(y - mu), axis=-1, keepdims=True)
    yn = (y - mu) * lax.rsqrt(var + GN_EPS) * lnx_w.reshape(RWKV_HEADS, HEAD_DIM) + lnx_b.reshape(RWKV_HEADS, HEAD_DIM)
    bonus = sum(jnp.sum(r * kd * r_k, axis=-1, keepdims=True) * v for (_, kd, _, _) in dirs)
    return (yn + bonus).reshape(B, L, RWKV_W) * g


def rwkv_mixer(uc, ux, conv_w, w0, w2, a0, a2, g2, k_k, k_a, r_k, lnx_w, lnx_b, need_ctx):
    rc, vc, dc, gc = rwkv_prep(uc, conv_w, w0, w2, a0, a2, g2, k_k, k_a)
    rx, vx, dx, gx = rwkv_prep(ux, conv_w, w0, w2, a0, a2, g2, k_k, k_a)
    s0 = jnp.zeros((rx.shape[0], RWKV_HEADS, HEAD_DIM, HEAD_DIM), jnp.float32)
    ycs, yxs = [], []
    for d, rev in enumerate((False, True)):
        wc, kc, ac, bc = dc[d]
        yc_d, s_ctx = rwkv_scan(rc, wc, kc, vc, ac, bc, s0, rev)
        wx, kx, ax, bx = dx[d]
        yx_d, _ = rwkv_scan(rx, wx, kx, vx, ax, bx, s_ctx, rev)
        ycs.append(yc_d)
        yxs.append(yx_d)
    out_x = rwkv_post(yxs[0] + yxs[1], rx, vx, dx, gx, r_k, lnx_w, lnx_b).astype(ux[0].dtype)
    out_c = rwkv_post(ycs[0] + ycs[1], rc, vc, dc, gc, r_k, lnx_w, lnx_b).astype(uc[0].dtype) if need_ctx else None
    return out_c, out_x


def mla_project(qd, kvd, kr, g_q, w_qup, g_kv, w_kvup, rotary):
    B, L, _ = qd.shape
    q = (rmsnorm(qd, g_q) @ w_qup).reshape(B, L, MLA_HEADS, MLA_NOPE + MLA_ROPE)
    kv = (rmsnorm(kvd, g_kv) @ w_kvup).reshape(B, L, MLA_HEADS, MLA_NOPE + MLA_V)
    q_nope, q_rope = q[..., :MLA_NOPE], q[..., MLA_NOPE:]
    k_nope, v = kv[..., :MLA_NOPE], kv[..., MLA_NOPE:]
    k_rope = kr[:, :, None, :]
    if rotary:
        q_rope = rope_2d(q_rope)
        k_rope = rope_2d(k_rope)
    q = jnp.concatenate([q_nope, q_rope], axis=-1)
    k = jnp.concatenate([k_nope, jnp.broadcast_to(k_rope, (B, L, MLA_HEADS, MLA_ROPE))], axis=-1)
    return q, k, v


def attend(q, k, v):
    s = jnp.einsum("bqhd,bkhd->bhqk", q, k).astype(jnp.float32) * MLA_SCALE
    p = jax.nn.softmax(s, axis=-1)
    return jnp.einsum("bhqk,bkhd->bqhd", p.astype(v.dtype), v)


def mla_mixer(uc, ux, g_q, w_qup, g_kv, w_kvup, need_ctx):
    qc, kc, vc = mla_project(*uc, g_q, w_qup, g_kv, w_kvup, False)
    qx, kx, vx = mla_project(*ux, g_q, w_qup, g_kv, w_kvup, True)
    B, L = qx.shape[:2]
    keys = jnp.concatenate([kc, kx], axis=1)
    vals = jnp.concatenate([vc, vx], axis=1)
    nb = L // Q_BLOCK
    qb = jnp.moveaxis(qx.reshape(B, nb, Q_BLOCK, MLA_HEADS, MLA_NOPE + MLA_ROPE), 1, 0)
    ob = lax.map(lambda q_blk: attend(q_blk, keys, vals), qb)
    out_x = jnp.moveaxis(ob, 0, 1).reshape(B, L, MLA_W)
    out_c = attend(qc, kc, vc).reshape(B, qc.shape[1], MLA_W) if need_ctx else None
    return out_c, out_x


def fourier_mixer(u, w_f):
    B, L, _ = u.shape
    z = u.astype(jnp.float32).reshape(B, L, FOURIER_GROUPS, FOURIER_CH)
    z = jnp.fft.fft2(z, axes=(1, 3), norm="ortho").real
    return z.reshape(B, L, FOURIER_W).astype(u.dtype) @ w_f


def ec_moe(h, w_router, w_gate, w_up, w_down):
    B, L, D = h.shape
    cap = max(1, EC_CAPACITY * L // N_EXPERTS)
    aff = jax.nn.softmax((h @ w_router).astype(jnp.float32), axis=-1)
    vals, idx = lax.top_k(jnp.swapaxes(aff, 1, 2), cap)
    xs = jax.vmap(lambda hb, ib: hb[ib])(h, idx)
    hid = jax.nn.silu(jnp.einsum("becd,edf->becf", xs, w_gate)) * jnp.einsum("becd,edf->becf", xs, w_up)
    out = jnp.einsum("becf,efd->becd", hid, w_down) * vals[..., None].astype(h.dtype)
    return jax.vmap(lambda ib, ob: jnp.zeros((L, D), h.dtype).at[ib.reshape(-1)].add(ob.reshape(-1, D)))(idx, out)


def layer(x, h, c, c_ctx, p, last):
    mod_x = (jax.nn.silu(c) @ p["w_mod"] + p["b_mod"])[:, None, :]
    mod_c = jax.nn.silu(c_ctx) @ p["w_mod"] + p["b_mod"]
    sx = jnp.split(mod_x, N_MOD, axis=-1)
    sc = jnp.split(mod_c, N_MOD, axis=-1)

    def mix_in(t, m):
        return rmsnorm(t, p["g_pre_mix"]) * (1.0 + m[1]) + m[0]

    def mix_out(t, parts, m):
        return t + m[2] * rmsnorm(jnp.concatenate(parts, axis=-1) @ p["w_out"], p["g_post_mix"])

    def ffn(t, m):
        tn = rmsnorm(t, p["g_pre_ffn"]) * (1.0 + m[4]) + m[3]
        y = ec_moe(tn, p["w_router"], p["w_expert_gate"], p["w_expert_up"], p["w_expert_down"])
        return t + m[5] * rmsnorm(y, p["g_post_ffn"])

    ux = split_cols(mix_in(x, sx) @ p["w_in"])
    uh = split_cols(mix_in(h, sc) @ p["w_in"])
    need_ctx = not last
    rc, rx = rwkv_mixer(uh[:6], ux[:6], p["conv_rkv"], p["rwkv_w0"], p["rwkv_w2"], p["rwkv_a0"], p["rwkv_a2"],
                        p["rwkv_g2"], p["rwkv_k_k"], p["rwkv_k_a"], p["rwkv_r_k"], p["rwkv_lnx_w"], p["rwkv_lnx_b"],
                        need_ctx)
    mc, mx = mla_mixer(uh[6:9], ux[6:9], p["mla_g_q"], p["mla_w_qup"], p["mla_g_kv"], p["mla_w_kvup"], need_ctx)
    fx = fourier_mixer(ux[9], p["w_fourier"])
    x = ffn(mix_out(x, (rx, mx, fx), sx), sx)
    if need_ctx:
        fc = fourier_mixer(uh[9], p["w_fourier"])
        h = ffn(mix_out(h, (rc, mc, fc), sc), sc)
    return x, h


def setup_inputs(seed: int = 0) -> dict:
    key = jax.random.key(seed)
    ks = iter(jax.random.split(key, 40))
    nrm = lambda shape, s: s * jax.random.normal(next(ks), shape, jnp.float32)
    D = D_MODEL
    return {
        "x": nrm((BATCH, SEQ, D), 1.0),
        "c": nrm((BATCH, D), 1.0),
        "ctx": nrm((BATCH, CTX_LEN, D), 1.0),
        "c_ctx": nrm((D,), 1.0),
        "w_mod": nrm((DEPTH, D, N_MOD * D), 0.5 * D ** -0.5),
        "b_mod": nrm((DEPTH, N_MOD * D), 0.01),
        "g_pre_mix": 1.0 + nrm((DEPTH, D), 0.02),
        "g_post_mix": 1.0 + nrm((DEPTH, D), 0.02),
        "g_pre_ffn": 1.0 + nrm((DEPTH, D), 0.02),
        "g_post_ffn": 1.0 + nrm((DEPTH, D), 0.02),
        "w_in": nrm((DEPTH, D, D_IN), D ** -0.5),
        "w_out": nrm((DEPTH, D_MIX, D), D_MIX ** -0.5),
        "conv_rkv": jnp.array([0.25, 1.0, 0.25], jnp.float32)[None, :, None] + nrm((DEPTH, 3, 3 * RWKV_W), 0.05),
        "rwkv_w0": jax.random.uniform(next(ks), (DEPTH, 2, RWKV_W), jnp.float32, -6.0, -1.0),
        "rwkv_w2": nrm((DEPTH, 2, DECAY_LORA, RWKV_W), 0.1 * DECAY_LORA ** -0.5),
        "rwkv_a0": nrm((DEPTH, 2, RWKV_W), 0.5),
        "rwkv_a2": nrm((DEPTH, 2, ICLR_LORA, RWKV_W), 0.5 * ICLR_LORA ** -0.5),
        "rwkv_g2": nrm((DEPTH, GATE_LORA, RWKV_W), GATE_LORA ** -0.5),
        "rwkv_k_k": 1.0 + nrm((DEPTH, RWKV_W), 0.1),
        "rwkv_k_a": 1.0 + nrm((DEPTH, RWKV_W), 0.1),
        "rwkv_r_k": nrm((DEPTH, RWKV_HEADS, HEAD_DIM), 0.1),
        "rwkv_lnx_w": 1.0 + nrm((DEPTH, RWKV_W), 0.02),
        "rwkv_lnx_b": nrm((DEPTH, RWKV_W), 0.01),
        "mla_g_q": 1.0 + nrm((DEPTH, Q_LORA), 0.02),
        "mla_w_qup": nrm((DEPTH, Q_LORA, MLA_HEADS * (MLA_NOPE + MLA_ROPE)), Q_LORA ** -0.5),
        "mla_g_kv": 1.0 + nrm((DEPTH, KV_LORA), 0.02),
        "mla_w_kvup": nrm((DEPTH, KV_LORA, MLA_HEADS * (MLA_NOPE + MLA_V)), KV_LORA ** -0.5),
        "w_fourier": nrm((DEPTH, FOURIER_W, FOURIER_W), FOURIER_W ** -0.5),
        "w_router": nrm((DEPTH, D, N_EXPERTS), D ** -0.5),
        "w_expert_gate": nrm((DEPTH, N_EXPERTS, D, EXPERT_FF), D ** -0.5),
        "w_expert_up": nrm((DEPTH, N_EXPERTS, D, EXPERT_FF), D ** -0.5),
        "w_expert_down": nrm((DEPTH, N_EXPERTS, EXPERT_FF, D), EXPERT_FF ** -0.5),
    }


def reference(x, c, ctx, c_ctx, w_mod, b_mod, g_pre_mix, g_post_mix, g_pre_ffn, g_post_ffn, w_in, w_out,
              conv_rkv, rwkv_w0, rwkv_w2, rwkv_a0, rwkv_a2, rwkv_g2, rwkv_k_k, rwkv_k_a, rwkv_r_k,
              rwkv_lnx_w, rwkv_lnx_b, mla_g_q, mla_w_qup, mla_g_kv, mla_w_kvup, w_fourier,
              w_router, w_expert_gate, w_expert_up, w_expert_down):
    h = ctx
    for l in range(DEPTH):
        p = {
            "w_mod": w_mod[l], "b_mod": b_mod[l],
            "g_pre_mix": g_pre_mix[l], "g_post_mix": g_post_mix[l],
            "g_pre_ffn": g_pre_ffn[l], "g_post_ffn": g_post_ffn[l],
            "w_in": w_in[l], "w_out": w_out[l], "conv_rkv": conv_rkv[l],
            "rwkv_w0": rwkv_w0[l], "rwkv_w2": rwkv_w2[l], "rwkv_a0": rwkv_a0[l], "rwkv_a2": rwkv_a2[l],
            "rwkv_g2": rwkv_g2[l], "rwkv_k_k": rwkv_k_k[l], "rwkv_k_a": rwkv_k_a[l], "rwkv_r_k": rwkv_r_k[l],
            "rwkv_lnx_w": rwkv_lnx_w[l], "rwkv_lnx_b": rwkv_lnx_b[l],
            "mla_g_q": mla_g_q[l], "mla_w_qup": mla_w_qup[l], "mla_g_kv": mla_g_kv[l], "mla_w_kvup": mla_w_kvup[l],
            "w_fourier": w_fourier[l], "w_router": w_router[l],
            "w_expert_gate": w_expert_gate[l], "w_expert_up": w_expert_up[l], "w_expert_down": w_expert_down[l],
        }
        x, h = layer(x, h, c, c_ctx, p, l == DEPTH - 1)
    return x
```

```cpp
#include <hip/hip_runtime.h>
#include <hip/hip_cooperative_groups.h>
#include <cstdio>
#include <cstdint>
namespace cg = cooperative_groups;

#define LAS __attribute__((address_space(3)))
typedef unsigned short bf16_t;
typedef short bf16x8 __attribute__((ext_vector_type(8)));
typedef float f32x4 __attribute__((ext_vector_type(4)));
typedef float f32x2 __attribute__((ext_vector_type(2)));
typedef float f32x16 __attribute__((ext_vector_type(16)));
typedef unsigned u32x4 __attribute__((ext_vector_type(4)));
typedef unsigned u32x2 __attribute__((ext_vector_type(2)));
typedef __bf16 bf16x2_t __attribute__((ext_vector_type(2)));
#define DI __device__ __forceinline__

constexpr int NB = 4, SEQ = 8192, CTX = 256, PP = SEQ + CTX  , TT = NB * PP  , DM = 1024;
constexpr int UW = 2304;
constexpr int NH = 6;
constexpr int NEXP = 16, RPE = 4352  ;
constexpr float NORM_EPS = 1e-6f, GN_EPS = 64e-5f;
constexpr float QSCALE = 0.10206207261596577f * 1.4426950408889634f;
constexpr int NWAVES = 8, NTHREADS = 512;

DI unsigned cvtpk(float lo, float hi) { f32x2 v = {lo, hi}; bf16x2_t b = __builtin_convertvector(v, bf16x2_t); return __builtin_bit_cast(unsigned, b); }
DI bf16_t f2bf(float f) { return (bf16_t)(cvtpk(f, 0.f) & 0xffffu); }
DI float bf2f(bf16_t b) { return __uint_as_float(((unsigned)b) << 16); }
DI float bflo(unsigned u) { return __uint_as_float(u << 16); }
DI float bfhi(unsigned u) { return __uint_as_float(u & 0xffff0000u); }
DI float wave_sum(float v) {
#pragma unroll
  for (int o = 1; o < 64; o <<= 1) v += __shfl_xor(v, o);
  return v;
}
DI float sigmoidf_(float x) { return 1.f / (1.f + __expf(-x)); }

namespace pg8 {
constexpr int BM = 256, BK = 64, HALF = 128, HTB = HALF * BK * 2, STAGE_BYTES = 8 * HTB, NXCD = 8, WGM = 8;
__host__ __device__ __forceinline__ int lds_byte(int r, int c) { const int st = (r >> 4) * 2 + (c >> 5), rr = r & 15, cc = c & 31, ob = rr * 64 + cc * 2; return st * 1024 + (ob ^ (((ob >> 9) & 1) << 5)); }
__host__ __device__ __forceinline__ void stage_rc(int b, int& R, int& C) { const int st = b / 1024, sb = b % 1024, swz = sb ^ (((sb >> 9) & 1) << 5); R = (st >> 1) * 16 + swz / 64; C = (st & 1) * 32 + (swz % 64) / 2; }
__host__ __device__ __forceinline__ int perm32(int rho) { const int n = rho >> 4, i = rho & 15; return 8 * (i >> 2) + 4 * n + (i & 3); }

struct Unit { int pm, pn; };
struct Gemm { const bf16_t* A; const bf16_t* Bt; int lda; int K; };

struct StaticOrder {
  int nM, nN, nwg, G, c;
  static constexpr bool GATHER = false;
  __device__ void init(int M, int N, int G_, int c_) { nM = M / BM; nN = N / BM; nwg = nM * nN; G = G_; c = c_; }
  __device__ bool next(int i, Unit& u) const {
    const long L = (long)i * G + c; if (L >= nwg) return false;
    int wgid = (int)L; { const int q = nwg / NXCD, r = nwg % NXCD, xcd = wgid % NXCD, off = wgid / NXCD; wgid = (xcd < r ? xcd * (q + 1) : r * (q + 1) + (xcd - r) * q) + off; }
    const int nig = WGM * nN, gid = wgid / nig, fm = gid * WGM, gsz = (nM - fm) < WGM ? (nM - fm) : WGM;
    u.pm = fm + ((wgid % nig) % gsz); u.pn = (wgid % nig) / gsz; return true;
  }
  __device__ int arow(const Unit&, int) const { return 0; }
};

template <class Epi, class Sched>
__device__ __forceinline__ void gemm_phase(LAS unsigned char* lds, const int tid, const Gemm g, const Sched& S, const Epi& E) {
  const int wid = __builtin_amdgcn_readfirstlane(tid >> 6), lane = tid & 63, wr = wid >> 2, wc = wid & 3, fr = lane & 15, fq = lane >> 4;
  int K_ = g.K, lda_ = g.lda; asm volatile("" : "+s"(K_), "+s"(lda_));
  const int K = K_, nt = K / BK, lda = lda_;
  unsigned voffB[2]; int RA[2], CA[2];
#pragma unroll
  for (int i = 0; i < 2; ++i) { int R, C; stage_rc(tid * 16 + i * 8192, R, C); const int Rb = Epi::PERM ? ((R & ~31) + perm32(R & 31)) : R;
    RA[i] = R; CA[i] = C; voffB[i] = (unsigned)(Rb * K + C) * 2u; }
  const size_t kstep = (size_t)(BK * 2);
  const size_t hstepB = (size_t)HALF * K * 2, tstepB = 2 * hstepB;
  const size_t tstepA = (size_t)BM * lda * 2;
  const unsigned ldsw = (unsigned)wid * 1024u;
  const int aoff = lds_byte(wr * 64 + fr, fq * 8), boff = lds_byte(wc * 32 + fr, fq * 8);
#define PG8_SA(b, h) (((b) * 2 + (h)) * HTB)
#define PG8_SB(b, h) ((4 + (b) * 2 + (h)) * HTB)
#define PG8_STAGE(bufoff, gbase, voff) do { _Pragma("unroll") for (int _i = 0; _i < 2; ++_i) \
        __builtin_amdgcn_global_load_lds((const unsigned*)((const char*)(gbase) + (voff)[_i]), (LAS unsigned*)(lds + (bufoff) + ldsw + _i * 8192), 16, 0, 0); } while (0)
#define PG8_LDA(dst, b, h) do { _Pragma("unroll") for (int m = 0; m < 4; ++m) _Pragma("unroll") for (int k = 0; k < 2; ++k) dst[m][k] = *(const LAS bf16x8*)(lds + PG8_SA(b, h) + aoff + m * 2048 + k * 1024); } while (0)
#define PG8_LDB(dst, b, h) do { _Pragma("unroll") for (int n = 0; n < 2; ++n) _Pragma("unroll") for (int k = 0; k < 2; ++k) dst[n][k] = *(const LAS bf16x8*)(lds + PG8_SB(b, h) + boff + n * 2048 + k * 1024); } while (0)
#define PG8_MMA(ai, bj, At, Bt) do { __builtin_amdgcn_s_setprio(1); _Pragma("unroll") for (int m = 0; m < 4; ++m) _Pragma("unroll") for (int n = 0; n < 2; ++n) _Pragma("unroll") for (int k = 0; k < 2; ++k) \
        acc[ai][bj][m][n] = __builtin_amdgcn_mfma_f32_16x16x32_bf16(Bt[n][k], At[m][k], acc[ai][bj][m][n], 0, 0, 0); __builtin_amdgcn_s_setprio(0); } while (0)
#define PG8_WAIT_V(n) asm volatile("s_waitcnt vmcnt(" #n ")" ::: "memory")
#define PG8_WAIT_L(n) asm volatile("s_waitcnt lgkmcnt(" #n ")" ::: "memory")
#define PG8_BAR __builtin_amdgcn_s_barrier()
#define PG8_SCHED __builtin_amdgcn_sched_barrier(0)
#define PG8_OFFS(dst, u) do { _Pragma("unroll") for (int _h = 0; _h < 2; ++_h) _Pragma("unroll") for (int _i = 0; _i < 2; ++_i) \
        dst[_h][_i] = Sched::GATHER ? (unsigned)((size_t)S.arow(u, _h * HALF + RA[_i]) * lda + CA[_i]) * 2u : (unsigned)((_h * HALF + RA[_i]) * lda + CA[_i]) * 2u; } while (0)
  Unit cur, nxt; int ui = 0;
  if (!S.next(0, cur)) return;
  f32x4 acc[2][2][4][2];
#pragma unroll
  for (int a = 0; a < 2; ++a)
#pragma unroll
    for (int b = 0; b < 2; ++b)
#pragma unroll
      for (int m = 0; m < 4; ++m)
#pragma unroll
        for (int n = 0; n < 2; ++n) acc[a][b][m][n] = (f32x4){0.f, 0.f, 0.f, 0.f};
  bf16x8 At[4][2], B0[2][2], B1[2][2];
  unsigned oAc[2][2], oAn[2][2];
  PG8_OFFS(oAc, cur);
  const char* cA = (const char*)g.A + (Sched::GATHER ? (size_t)0 : (size_t)cur.pm * tstepA); const char* cB = (const char*)g.Bt + (size_t)cur.pn * tstepB;
  PG8_STAGE(PG8_SB(0, 0), cB, voffB); PG8_STAGE(PG8_SB(0, 1), cB + hstepB, voffB); PG8_STAGE(PG8_SA(0, 0), cA, oAc[0]); PG8_STAGE(PG8_SA(0, 1), cA, oAc[1]);
  if (wr == 1) PG8_BAR;
  PG8_WAIT_V(2); PG8_BAR;
  PG8_STAGE(PG8_SB(1, 0), cB + kstep, voffB); PG8_STAGE(PG8_SA(1, 0), cA + kstep, oAc[0]); PG8_STAGE(PG8_SB(1, 1), cB + hstepB + kstep, voffB);
  PG8_WAIT_V(6); PG8_BAR;
  for (;;) {
    const bool has_next = S.next(ui + 1, nxt);
    if (has_next) { PG8_OFFS(oAn, nxt); }
    else {
#pragma unroll
      for (int _h = 0; _h < 2; ++_h)
#pragma unroll
        for (int _i = 0; _i < 2; ++_i) oAn[_h][_i] = oAc[_h][_i];
    }
    const char* nA = has_next ? (const char*)g.A + (Sched::GATHER ? (size_t)0 : (size_t)nxt.pm * tstepA) : cA; const char* nB = has_next ? (const char*)g.Bt + (size_t)nxt.pn * tstepB : cB;
    for (int t = 0; t < nt; t += 2) {
      const bool last = (t == nt - 2);
      const char* a1 = cA + (size_t)(t + 1) * kstep;
      const char* a2 = last ? nA : cA + (size_t)(t + 2) * kstep; const char* b2 = last ? nB : cB + (size_t)(t + 2) * kstep;
      const char* a3 = a2 + kstep; const char* b3 = b2 + kstep;
      unsigned o2[2][2];
#pragma unroll
      for (int _h = 0; _h < 2; ++_h)
#pragma unroll
        for (int _i = 0; _i < 2; ++_i) o2[_h][_i] = last ? oAn[_h][_i] : oAc[_h][_i];
      PG8_LDB(B0, 0, 0); PG8_LDB(B1, 0, 1); PG8_SCHED; PG8_LDA(At, 0, 0); PG8_STAGE(PG8_SA(1, 1), a1, oAc[1]);
      PG8_WAIT_V(8); PG8_WAIT_L(0); PG8_BAR; PG8_MMA(0, 0, At, B0); PG8_MMA(0, 1, At, B1); PG8_BAR; PG8_SCHED;
      PG8_LDA(At, 0, 1); PG8_STAGE(PG8_SB(0, 0), b2, voffB); PG8_STAGE(PG8_SB(0, 1), b2 + hstepB, voffB); PG8_STAGE(PG8_SA(0, 0), a2, o2[0]);
      PG8_WAIT_V(8); PG8_WAIT_L(0); PG8_BAR; PG8_MMA(1, 0, At, B0); PG8_MMA(1, 1, At, B1); PG8_BAR; PG8_SCHED;
      PG8_LDB(B0, 1, 0); PG8_LDB(B1, 1, 1); PG8_SCHED; PG8_LDA(At, 1, 0); PG8_STAGE(PG8_SA(0, 1), a2, o2[1]);
      PG8_WAIT_V(8); PG8_WAIT_L(0); PG8_BAR; PG8_MMA(0, 0, At, B0); PG8_MMA(0, 1, At, B1); PG8_BAR; PG8_SCHED;
      PG8_LDA(At, 1, 1); PG8_STAGE(PG8_SB(1, 0), b3, voffB); PG8_STAGE(PG8_SB(1, 1), b3 + hstepB, voffB); PG8_STAGE(PG8_SA(1, 0), a3, o2[0]);
      PG8_WAIT_V(8); PG8_WAIT_L(0); PG8_BAR; PG8_MMA(1, 0, At, B0); PG8_MMA(1, 1, At, B1); PG8_BAR; PG8_SCHED;
    }
    if (wr == 0) PG8_BAR;
    E(acc, cur, wr, wc, fr, fq);
    if (!has_next) break;
#pragma unroll
    for (int a = 0; a < 2; ++a)
#pragma unroll
      for (int b = 0; b < 2; ++b)
#pragma unroll
        for (int m = 0; m < 4; ++m)
#pragma unroll
          for (int n = 0; n < 2; ++n) acc[a][b][m][n] = (f32x4){0.f, 0.f, 0.f, 0.f};
    cur = nxt; cA = nA; cB = nB; ++ui;
#pragma unroll
    for (int _h = 0; _h < 2; ++_h)
#pragma unroll
      for (int _i = 0; _i < 2; ++_i) oAc[_h][_i] = oAn[_h][_i];
    if (wr == 1) PG8_BAR;
  }
  PG8_WAIT_V(0);
  PG8_BAR;
#undef PG8_SA
#undef PG8_SB
#undef PG8_STAGE
#undef PG8_LDA
#undef PG8_LDB
#undef PG8_MMA
#undef PG8_WAIT_V
#undef PG8_WAIT_L
#undef PG8_BAR
#undef PG8_SCHED
#undef PG8_OFFS
}
}
using pg8::Unit;
struct EpiU {
  static constexpr bool PERM = true;
  bf16_t* O; int ldc;
  DI void operator()(const f32x4 (&acc)[2][2][4][2], const Unit& u, int wr, int wc, int fr, int fq) const {
    const int row0 = u.pm * 256 + wr * 64 + fr;
#pragma unroll
    for (int ai = 0; ai < 2; ++ai)
#pragma unroll
      for (int m = 0; m < 4; ++m) { bf16_t* rowp = O + (size_t)(row0 + ai * 128 + m * 16) * ldc;
#pragma unroll
        for (int bj = 0; bj < 2; ++bj) { const int col = u.pn * 256 + bj * 128 + wc * 32 + 8 * fq;
          f32x4 v0 = acc[ai][bj][m][0], v1 = acc[ai][bj][m][1];
          if (col >= 1152 && col < 1216) {
#pragma unroll
            for (int j = 0; j < 4; ++j) { v0[j] = tanhf(v0[j]); v1[j] = tanhf(v1[j]); }
          } else if (col >= 1280 && col < 1536) {
#pragma unroll
            for (int j = 0; j < 4; ++j) { v0[j] = sigmoidf_(v0[j]); v1[j] = sigmoidf_(v1[j]); }
          }
          u32x4 w; w.x = cvtpk(v0[0], v0[1]); w.y = cvtpk(v0[2], v0[3]); w.z = cvtpk(v1[0], v1[1]); w.w = cvtpk(v1[2], v1[3]);
          *(u32x4*)(rowp + col) = w; } }
  }
};
struct EpiPlain {
  static constexpr bool PERM = true;
  bf16_t* O; int ldc;
  DI void operator()(const f32x4 (&acc)[2][2][4][2], const Unit& u, int wr, int wc, int fr, int fq) const {
    const int row0 = u.pm * 256 + wr * 64 + fr;
#pragma unroll
    for (int ai = 0; ai < 2; ++ai)
#pragma unroll
      for (int m = 0; m < 4; ++m) { bf16_t* rowp = O + (size_t)(row0 + ai * 128 + m * 16) * ldc;
#pragma unroll
        for (int bj = 0; bj < 2; ++bj) { const int col = u.pn * 256 + bj * 128 + wc * 32 + 8 * fq;
          const f32x4 v0 = acc[ai][bj][m][0], v1 = acc[ai][bj][m][1];
          u32x4 w; w.x = cvtpk(v0[0], v0[1]); w.y = cvtpk(v0[2], v0[3]); w.z = cvtpk(v1[0], v1[1]); w.w = cvtpk(v1[2], v1[3]);
          *(u32x4*)(rowp + col) = w; } }
  }
};
struct EpiLW {
  static constexpr bool PERM = true;
  bf16_t* EW; bf16_t* AS; const float* w0; const float* a0;
  DI void operator()(const f32x4 (&acc)[2][2][4][2], const Unit& u, int wr, int wc, int fr, int fq) const {
    const int row0 = u.pm * 256 + wr * 64 + fr;
    const bool isw = u.pn < 3;
    bf16_t* O = isw ? EW : AS; const float* bias = isw ? w0 : a0; const float sc = isw ? 0.6065306597126334f : 1.f;
    const int cb = (isw ? u.pn : u.pn - 3) * 256;
#pragma unroll
    for (int bj = 0; bj < 2; ++bj) { const int col = cb + bj * 128 + wc * 32 + 8 * fq;
      const f32x4 b0 = *(const f32x4*)(bias + col), b1 = *(const f32x4*)(bias + col + 4);
#pragma unroll
      for (int ai = 0; ai < 2; ++ai)
#pragma unroll
        for (int m = 0; m < 4; ++m) { bf16_t* rowp = O + (size_t)(row0 + ai * 128 + m * 16) * 768;
          f32x4 v0 = acc[ai][bj][m][0] + b0, v1 = acc[ai][bj][m][1] + b1;
#pragma unroll
          for (int j = 0; j < 4; ++j) { v0[j] = sc * sigmoidf_(v0[j]); v1[j] = sc * sigmoidf_(v1[j]); }
          u32x4 w; w.x = cvtpk(v0[0], v0[1]); w.y = cvtpk(v0[2], v0[3]); w.z = cvtpk(v1[0], v1[1]); w.w = cvtpk(v1[2], v1[3]);
          *(u32x4*)(rowp + col) = w; asm volatile("" ::: "memory"); } }
  }
};
struct EpiG {
  static constexpr bool PERM = true;
  bf16_t* G;
  DI void operator()(const f32x4 (&acc)[2][2][4][2], const Unit& u, int wr, int wc, int fr, int fq) const {
    const int row0 = u.pm * 256 + wr * 64 + fr;
#pragma unroll
    for (int bj = 0; bj < 2; ++bj) { const int col = u.pn * 256 + bj * 128 + wc * 32 + 8 * fq;
      if (col < 384) {
#pragma unroll
        for (int ai = 0; ai < 2; ++ai)
#pragma unroll
          for (int m = 0; m < 4; ++m) { bf16_t* rowp = G + (size_t)(row0 + ai * 128 + m * 16) * 384;
            const f32x4 v0 = acc[ai][bj][m][0], v1 = acc[ai][bj][m][1];
            u32x4 w; w.x = cvtpk(v0[0], v0[1]); w.y = cvtpk(v0[2], v0[3]); w.z = cvtpk(v1[0], v1[1]); w.w = cvtpk(v1[2], v1[3]);
            *(u32x4*)(rowp + col) = w; } } }
  }
};
struct EpiQ {
  static constexpr bool PERM = true;
  bf16_t* QB; const float* rstd; const float* rope;
  DI void operator()(const f32x4 (&acc)[2][2][4][2], const Unit& u, int wr, int wc, int fr, int fq) const {
    const int row0 = u.pm * 256 + wr * 64 + fr;
    const int b = (u.pm * 256) / PP;
#pragma unroll
    for (int bj = 0; bj < 2; ++bj) { const int col = u.pn * 256 + bj * 128 + wc * 32 + 8 * fq;
      const int hh = col / 96, dim = col - hh * 96;
      const bool isrope = dim >= 64;
#pragma unroll
      for (int ai = 0; ai < 2; ++ai)
#pragma unroll
        for (int m = 0; m < 4; ++m) { const int g = row0 + ai * 128 + m * 16; const int p = g - b * PP;
          const float s = rstd[g] * QSCALE;
          float v[8];
#pragma unroll
          for (int j = 0; j < 4; ++j) { v[j] = acc[ai][bj][m][0][j] * s; v[4 + j] = acc[ai][bj][m][1][j] * s; }
          if (isrope) {
            float o[8];
#pragma unroll
            for (int j = 0; j < 8; ++j) o[j] = __shfl_xor(v[j], 16);
            if (p >= CTX) { const int li = p - CTX; const int pos = (fq & 2) ? (li & 63) : (li >> 6);
              const f32x2* rp = (const f32x2*)rope + pos * 8;
#pragma unroll
              for (int j = 0; j < 8; ++j) { const f32x2 cs = rp[j]; v[j] = (fq & 1) ? (v[j] * cs.x + o[j] * cs.y) : (v[j] * cs.x - o[j] * cs.y); } }
          }
          if (col < 576) { u32x4 w; w.x = cvtpk(v[0], v[1]); w.y = cvtpk(v[2], v[3]); w.z = cvtpk(v[4], v[5]); w.w = cvtpk(v[6], v[7]);
            *(u32x4*)(QB + ((size_t)(b * NH + hh) * PP + p) * 96 + dim) = w; }
          asm volatile("" ::: "memory"); }
    }
  }
};
DI int vperm(int p) { const int q = p & 15; return (p & ~15) | (((q >> 2) & 1) << 3) | ((q >> 3) << 2) | (q & 3); }
struct EpiKV {
  static constexpr bool PERM = true;
  bf16_t* KB; bf16_t* VT; const float* rstd;
  DI void operator()(const f32x4 (&acc)[2][2][4][2], const Unit& u, int wr, int wc, int fr, int fq) const {
    const int row0 = u.pm * 256 + wr * 64 + fr;
    const int b = (u.pm * 256) / PP;
#pragma unroll
    for (int bj = 0; bj < 2; ++bj) { const int col = u.pn * 256 + bj * 128 + wc * 32 + 8 * fq;
      const int hh = col >> 7, j0 = col & 127;
#pragma unroll
      for (int ai = 0; ai < 2; ++ai)
#pragma unroll
        for (int m = 0; m < 4; ++m) { const int g = row0 + ai * 128 + m * 16; const int p = g - b * PP;
          const float s = rstd[g];
          float v[8];
#pragma unroll
          for (int j = 0; j < 4; ++j) { v[j] = acc[ai][bj][m][0][j] * s; v[4 + j] = acc[ai][bj][m][1][j] * s; }
          if (j0 < 64) { u32x4 w; w.x = cvtpk(v[0], v[1]); w.y = cvtpk(v[2], v[3]); w.z = cvtpk(v[4], v[5]); w.w = cvtpk(v[6], v[7]);
            *(u32x4*)(KB + ((size_t)(b * NH + hh) * PP + p) * 96 + j0) = w; }
          else { bf16_t* vt = VT + ((size_t)(b * NH + hh) * 64 + (j0 - 64)) * PP + vperm(p);
#pragma unroll
            for (int j = 0; j < 8; ++j) vt[(size_t)j * PP] = f2bf(v[j]); }
          asm volatile("" ::: "memory"); }
    }
  }
};
struct EpiMoe1 {
  static constexpr bool PERM = false;
  bf16_t* HID;
  DI void operator()(const f32x4 (&acc)[2][2][4][2], const Unit& u, int wr, int wc, int fr, int fq) const {
    const int row0 = u.pm * 256 + wr * 64 + fr; const int pnl = u.pn & 7;
#pragma unroll
    for (int ai = 0; ai < 2; ++ai)
#pragma unroll
      for (int m = 0; m < 4; ++m) { bf16_t* rowp = HID + (size_t)(row0 + ai * 128 + m * 16) * 1024 + pnl * 128 + wc * 32 + 4 * fq;
#pragma unroll
        for (int n = 0; n < 2; ++n) { const f32x4 gv = acc[ai][0][m][n], uv = acc[ai][1][m][n]; float h[4];
#pragma unroll
          for (int j = 0; j < 4; ++j) h[j] = gv[j] * sigmoidf_(gv[j]) * uv[j];
          u32x2 w; w.x = cvtpk(h[0], h[1]); w.y = cvtpk(h[2], h[3]);
          *(u32x2*)(rowp + 16 * n) = w; } }
  }
};
struct EpiMoe2 {
  static constexpr bool PERM = true;
  bf16_t* O;
  DI void operator()(const f32x4 (&acc)[2][2][4][2], const Unit& u, int wr, int wc, int fr, int fq) const {
    const int row0 = u.pm * 256 + wr * 64 + fr; const int pnl = u.pn & 3;
#pragma unroll
    for (int ai = 0; ai < 2; ++ai)
#pragma unroll
      for (int m = 0; m < 4; ++m) { bf16_t* rowp = O + (size_t)(row0 + ai * 128 + m * 16) * 1024;
#pragma unroll
        for (int bj = 0; bj < 2; ++bj) { const int col = pnl * 256 + bj * 128 + wc * 32 + 8 * fq;
          const f32x4 v0 = acc[ai][bj][m][0], v1 = acc[ai][bj][m][1];
          u32x4 w; w.x = cvtpk(v0[0], v0[1]); w.y = cvtpk(v0[2], v0[3]); w.z = cvtpk(v1[0], v1[1]); w.w = cvtpk(v1[2], v1[3]);
          *(u32x4*)(rowp + col) = w; } }
  }
};
template <bool GATH> struct MoeOrder {
  static constexpr bool GATHER = GATH;
  int tpe, nN, nwg, G, c; const int* idx;
  __device__ void init(int tpe_, int nN_, int G_, int c_, const int* idx_) { tpe = tpe_; nN = nN_; nwg = NEXP * tpe * nN; G = G_; c = c_; idx = idx_; }
  __device__ bool next(int i, Unit& u) const {
    const long L = (long)i * G + c; if (L >= nwg) return false;
    const int per = tpe * nN, e = (int)L / per, rem = (int)L % per, pnl = rem / tpe, pml = rem % tpe;
    u.pm = e * 17 + pml; u.pn = e * nN + pnl; return true;
  }
  __device__ int arow(const Unit& u, int r) const { return idx[u.pm * 256 + r]; }
};
constexpr size_t MiB = (size_t)1 << 20;
constexpr size_t WS_CTL = 0;
constexpr size_t WS_MODP = 1 * MiB;
constexpr size_t WS_MOD = 3 * MiB;
constexpr size_t WS_TW = 3 * MiB + 256 * 1024;
constexpr size_t WS_ROPE = 3 * MiB + 384 * 1024;
constexpr size_t WS_RSTD = 3 * MiB + 512 * 1024;
constexpr size_t WS_WIN = 4 * MiB;
constexpr size_t WS_WOUT = 13 * MiB;
constexpr size_t WS_WLW = 17 * MiB;
constexpr size_t WS_WG = 18 * MiB;
constexpr size_t WS_WQ = 19 * MiB;
constexpr size_t WS_WKV = 20 * MiB;
constexpr size_t WS_AFF = 21 * MiB;
constexpr size_t WS_IDX = 24 * MiB;
constexpr size_t WS_SLOT = 29 * MiB;
constexpr size_t WS_XCTX = 25 * MiB;
constexpr size_t WS_R1 = 36 * MiB;
constexpr size_t WS_R2 = 192 * MiB;
constexpr size_t WS_R3 = 292 * MiB;
constexpr size_t WS_R4 = 416 * MiB;
constexpr size_t WS_R5 = 452 * MiB;
constexpr size_t WS_R6 = 502 * MiB;
constexpr size_t WS_HID = 416 * MiB;
constexpr size_t WS_END = 568 * MiB;

struct Params {
  const float* in[32];
  float* out; unsigned char* ws;
};

typedef const float* cfptr;
struct Ctx {
  const __attribute__((address_space(4))) cfptr* in; float* out; unsigned char* ws;
  LAS unsigned char* lds; unsigned char* ldsg;
  int tid, lane, wave, G, bid;
};

DI const float* in_row(const Ctx& C, int g) { const int b = g / PP, p = g - b * PP; return p < CTX ? C.in[2] + ((size_t)b * CTX + p) * DM : C.in[0] + ((size_t)b * SEQ + (p - CTX)) * DM; }
DI float* xs_row(const Ctx& C, int g) { const int b = g / PP, p = g - b * PP; return p < CTX ? (float*)(C.ws + WS_XCTX) + ((size_t)b * CTX + p) * DM : C.out + ((size_t)b * SEQ + (p - CTX)) * DM; }
DI int mod_row(int g) { const int b = g / PP, p = g - b * PP; return p < CTX ? 4 : b; }
DI const float* modv(const Ctx& C, int l, int r, int j) { return (const float*)(C.ws + WS_MOD) + ((size_t)(l * 5 + r) * 6 + j) * DM; }

template <class RowMap>
DI void transpose_item(const float* W, int K, int N, bf16_t* WT, int ldk, LAS float* scr, int item, int lane, const RowMap& rm) {
  const int nblk = N / 32, kb = item / nblk, nb = item % nblk, k0 = 64 * kb, n0 = 32 * nb;
#pragma unroll 8
  for (int i = 0; i < 32; ++i) { const int kk = 2 * i + (lane >> 5); scr[kk * 33 + (lane & 31)] = W[(size_t)(k0 + kk) * N + n0 + (lane & 31)]; }
  asm volatile("s_waitcnt lgkmcnt(0)" ::: "memory");
  const int c = lane & 7;
#pragma unroll
  for (int j = 0; j < 4; ++j) { const int n = (lane >> 3) + 8 * j; const LAS float* s = scr + (8 * c) * 33 + n;
    u32x4 o; o.x = cvtpk(s[0 * 33], s[1 * 33]); o.y = cvtpk(s[2 * 33], s[3 * 33]); o.z = cvtpk(s[4 * 33], s[5 * 33]); o.w = cvtpk(s[6 * 33], s[7 * 33]);
    const int r = rm(n0 + n);
    if (r >= 0) *(u32x4*)(WT + (size_t)r * ldk + k0 + 8 * c) = o; }
  asm volatile("s_waitcnt lgkmcnt(0)" ::: "memory");
}
struct MapIn { DI int operator()(int n) const { return n < 1440 ? n : (n < 1856 ? n + 96 : n + 192); } };
struct MapId { DI int operator()(int n) const { return n; } };
struct MapGate { int up; DI int operator()(int f) const { return 256 * (f >> 7) + 128 * up + (f & 127); } };

DI void phase0(const Ctx& C) {
  const int gw = C.bid * NWAVES + C.wave, NGW = C.G * NWAVES;
  const int gt = C.bid * NTHREADS + C.tid, NGT = C.G * NTHREADS;
  LAS float* scr = (LAS float*)(C.lds + C.wave * 16384);
  {
    const float* cin = C.in[1]; const float* cctx = C.in[3];
    for (int it = gw; it < 2 * 96 * 8; it += NGW) {
      const int l = it / 768, r_ = it % 768, cc = r_ / 8, kc = r_ % 8;
      const float* W = C.in[4] + (size_t)l * DM * 6144 + (size_t)(kc * 128) * 6144 + cc * 64 + C.lane;
      float a0 = 0.f, a1 = 0.f, a2 = 0.f, a3 = 0.f, a4 = 0.f;
#pragma unroll 8
      for (int k = 0; k < 128; ++k) { const float w = W[(size_t)k * 6144]; const int kk = kc * 128 + k;
        const float c0 = cin[kk], c1 = cin[DM + kk], c2 = cin[2 * DM + kk], c3 = cin[3 * DM + kk], c4 = cctx[kk];
        a0 += c0 * sigmoidf_(c0) * w; a1 += c1 * sigmoidf_(c1) * w; a2 += c2 * sigmoidf_(c2) * w; a3 += c3 * sigmoidf_(c3) * w; a4 += c4 * sigmoidf_(c4) * w; }
      float* P = (float*)(C.ws + WS_MODP) + ((size_t)(l * 8 + kc) * 5) * 6144 + cc * 64 + C.lane;
      P[0] = a0; P[6144] = a1; P[2 * 6144] = a2; P[3 * 6144] = a3; P[4 * 6144] = a4;
    }
  }
  for (int l = 0; l < 2; ++l) {
    bf16_t* WT = (bf16_t*)(C.ws + WS_WIN) + (size_t)l * UW * DM;
    for (int i = gt; i < 192 * DM / 8; i += NGT) { const int r = i / (DM / 8), c8 = i % (DM / 8); const int row = r < 96 ? 1440 + r : 1952 + (r - 96);
      *(u32x4*)(WT + (size_t)row * DM + c8 * 8) = (u32x4){0u, 0u, 0u, 0u}; }
    for (int it = gw; it < 16 * 66; it += NGW) transpose_item(C.in[10] + (size_t)l * DM * 2112, DM, 2112, WT, DM, scr, it, C.lane, MapIn());
    bf16_t* WO = (bf16_t*)(C.ws + WS_WOUT) + (size_t)l * DM * DM;
    for (int it = gw; it < 12 * 32; it += NGW) transpose_item(C.in[11] + (size_t)l * DM * DM, 768, DM, WO, DM, scr, it, C.lane, MapId());
    const float* wf = C.in[27] + (size_t)l * 256 * 256; const float* wo = C.in[11] + (size_t)l * DM * DM + (size_t)768 * DM;
    for (int it = gw; it < 64 * 16; it += NGW) { const int kq = it / 16, nc = it % 16; const int n = nc * 64 + C.lane;
      float a0 = 0.f, a1 = 0.f, a2 = 0.f, a3 = 0.f;
#pragma unroll 4
      for (int j = 0; j < 256; ++j) { const float w = wo[(size_t)j * DM + n];
        a0 += wf[(kq * 4 + 0) * 256 + j] * w; a1 += wf[(kq * 4 + 1) * 256 + j] * w; a2 += wf[(kq * 4 + 2) * 256 + j] * w; a3 += wf[(kq * 4 + 3) * 256 + j] * w; }
      u32x2 o; o.x = cvtpk(a0, a1); o.y = cvtpk(a2, a3);
      *(u32x2*)(WO + (size_t)n * DM + 768 + kq * 4) = o; }
    bf16_t* WLW = (bf16_t*)(C.ws + WS_WLW) + (size_t)l * 1536 * 128;
    for (int i = gt; i < 1536 * 128; i += NGT) { const int n = i / 128, k = i % 128; float v = 0.f;
      if (n < 768) { if (k < 64) v = C.in[14][((size_t)(l * 2 + n / 384) * 64 + k) * 384 + n % 384]; }
      else { const int n2 = n - 768; if (k >= 64) v = C.in[16][((size_t)(l * 2 + n2 / 384) * 64 + (k - 64)) * 384 + n2 % 384]; }
      WLW[i] = f2bf(v); }
    bf16_t* WG = (bf16_t*)(C.ws + WS_WG) + (size_t)l * 512 * 256;
    for (int i = gt; i < 512 * 256; i += NGT) { const int n = i / 256, k = i % 256; float v = 0.f;
      if (n < 384 && k < 160) v = C.in[17][((size_t)l * 160 + k) * 384 + n];
      WG[i] = f2bf(v); }
    bf16_t* WQ = (bf16_t*)(C.ws + WS_WQ) + (size_t)l * 768 * 256;
    for (int i = gt; i < 768 * 256; i += NGT) { const int n = i / 256, k = i % 256; float v = 0.f;
      if (n < 576) v = C.in[23][l * 256 + k] * C.in[24][((size_t)l * 256 + k) * 576 + n];
      WQ[i] = f2bf(v); }
    bf16_t* WKV = (bf16_t*)(C.ws + WS_WKV) + (size_t)l * 768 * 128;
    for (int i = gt; i < 768 * 128; i += NGT) { const int n = i / 128, k = i % 128;
      WKV[i] = f2bf(C.in[25][l * 128 + k] * C.in[26][((size_t)l * 128 + k) * 768 + n]); }
  }
  for (int i = gt; i < 8192; i += NGT) { float s, c; sincospif((float)i * (2.0f / 8192.0f), &s, &c); ((f32x2*)(C.ws + WS_TW))[i] = (f32x2){c, -s}; }
  for (int i = gt; i < 128 * 8; i += NGT) { const int pos = i / 8, j = i % 8; const float inv = powf(10000.0f, -(float)j / 8.0f); float s, c; sincosf((float)pos * inv, &s, &c); ((f32x2*)(C.ws + WS_ROPE))[i] = (f32x2){c, s}; }
}
DI void phase0b(const Ctx& C) {
  const int gt = C.bid * NTHREADS + C.tid, NGT = C.G * NTHREADS;
  for (int i = gt; i < 2 * 5 * 6144; i += NGT) { const int l = i / (5 * 6144), r = (i / 6144) % 5, n = i % 6144;
    float s = C.in[5][l * 6144 + n];
#pragma unroll
    for (int kc = 0; kc < 8; ++kc) s += ((const float*)(C.ws + WS_MODP))[((size_t)(l * 8 + kc) * 5 + r) * 6144 + n];
    ((float*)(C.ws + WS_MOD))[i] = s; }
}

DI void convert_experts(const Ctx& C, int l, int first_item, int stride_items) {
  LAS float* scr = (LAS float*)(C.lds + C.wave * 16384);
  bf16_t* WGU = (bf16_t*)(C.ws + WS_R3); bf16_t* WDN = WGU + (size_t)NEXP * 2048 * 1024;
  for (int it = first_item; it < NEXP * 3 * 512; it += stride_items) { const int e = it / 1536, r = it % 1536, mat = r / 512, sub = r % 512;
    const size_t woff = ((size_t)l * NEXP + e) * 1024 * 1024;
    if (mat == 0) transpose_item(C.in[29] + woff, 1024, 1024, WGU + (size_t)e * 2048 * 1024, 1024, scr, sub, C.lane, MapGate{0});
    else if (mat == 1) transpose_item(C.in[30] + woff, 1024, 1024, WGU + (size_t)e * 2048 * 1024, 1024, scr, sub, C.lane, MapGate{1});
    else transpose_item(C.in[31] + woff, 1024, 1024, WDN + (size_t)e * 1024 * 1024, 1024, scr, sub, C.lane, MapId()); }
}

DI void norm_pass(const Ctx& C, int mode, int l, int lp) {
  const int gw = C.bid * NWAVES + C.wave, NGW = C.G * NWAVES, lane = C.lane;
  bf16_t* XN = (bf16_t*)(C.ws + WS_R2); const bf16_t* DOWN = (const bf16_t*)(C.ws + WS_R1); const int* SLOT = (const int*)(C.ws + WS_SLOT); const float* AFF = (const float*)(C.ws + WS_AFF);
  for (int g = gw; g < TT; g += NGW) {
    const int mr = mod_row(g); const bool isctx = (mr == 4);
    if (mode == 2 && isctx) continue;
    f32x4 v[4];
    if (mode == 0) { const f32x4* xr = (const f32x4*)in_row(C, g) + lane;
#pragma unroll
      for (int j = 0; j < 4; ++j) v[j] = xr[64 * j]; }
    else { f32x4* xr = (f32x4*)xs_row(C, g) + lane;
      f32x4 y[4]; float s = 0.f;
      const int myslot = lane < 16 ? SLOT[(size_t)g * 16 + lane] : -1; const float myaff = lane < 16 ? AFF[(size_t)g * 16 + lane] : 0.f;
#pragma unroll
      for (int j = 0; j < 4; ++j) { v[j] = xr[64 * j]; y[j] = (f32x4){0.f, 0.f, 0.f, 0.f}; }
      for (int e = 0; e < 16; ++e) { const int sl = __shfl(myslot, e);
        if (sl >= 0) { const float a = __shfl(myaff, e); const u32x2* dr = (const u32x2*)(DOWN + (size_t)sl * DM) + lane;
#pragma unroll
          for (int j = 0; j < 4; ++j) { const u32x2 w = dr[64 * j]; y[j] = y[j] + (f32x4){bflo(w.x), bfhi(w.x), bflo(w.y), bfhi(w.y)} * a; } } }
#pragma unroll
      for (int j = 0; j < 4; ++j) s += (y[j].x * y[j].x + y[j].y * y[j].y) + (y[j].z * y[j].z + y[j].w * y[j].w);
      const float rstd = rsqrtf(wave_sum(s) * (1.f / DM) + NORM_EPS);
      const f32x4* m5 = (const f32x4*)modv(C, lp, mr, 5) + lane; const f32x4* gp = (const f32x4*)(C.in[9] + lp * DM) + lane;
#pragma unroll
      for (int j = 0; j < 4; ++j) { v[j] = v[j] + m5[64 * j] * (y[j] * rstd * gp[64 * j]); xr[64 * j] = v[j]; }
      if (mode == 2) continue; }
    float s = 0.f;
#pragma unroll
    for (int j = 0; j < 4; ++j) s += (v[j].x * v[j].x + v[j].y * v[j].y) + (v[j].z * v[j].z + v[j].w * v[j].w);
    const float rstd = rsqrtf(wave_sum(s) * (1.f / DM) + NORM_EPS);
    const f32x4* m0 = (const f32x4*)modv(C, l, mr, 0) + lane; const f32x4* m1 = (const f32x4*)modv(C, l, mr, 1) + lane; const f32x4* gp = (const f32x4*)(C.in[6] + l * DM) + lane;
    u32x2* o = (u32x2*)(XN + (size_t)g * DM) + lane;
#pragma unroll
    for (int j = 0; j < 4; ++j) { const f32x4 t = v[j] * rstd * gp[64 * j] * (m1[64 * j] + 1.0f) + m0[64 * j]; u32x2 w; w.x = cvtpk(t.x, t.y); w.y = cvtpk(t.z, t.w); o[64 * j] = w; }
  }
}

DI void prep_a(const Ctx& C, int l) {
  const bf16_t* U = (const bf16_t*)(C.ws + WS_R1);
  float* rq = (float*)(C.ws + WS_RSTD); float* rkv = rq + TT;
  bf16_t* KB = (bf16_t*)(C.ws + WS_R2) + (size_t)NB * NH * PP * 96;
  const f32x2* rope = (const f32x2*)(C.ws + WS_ROPE);
  const int lane = C.lane;
  LAS float* zrow = (LAS float*)(C.lds + C.wave * 1024);
  LAS f32x2* stage = (LAS f32x2*)(C.lds + 16384);
  LAS f32x2* tw64 = (LAS f32x2*)(C.lds + 16384 + 132 * 64 * 8);
  if (C.tid < 64) { float s, c; sincospif((float)C.tid * (2.0f / 64.0f), &s, &c); tw64[C.tid] = (f32x2){c, s}; }
  __syncthreads();
  for (int tile = C.bid; tile < TT / 64; tile += C.G) {
    const int g0 = tile * 64; const int b = g0 / PP, p0 = g0 - b * PP;
    for (int i = 0; i < 8; ++i) { const int tl = C.wave * 8 + i; const int g = g0 + tl; const int p = p0 + tl;
      const bf16_t* ur = U + (size_t)g * UW;
      { const u32x2 w = *((const u32x2*)(ur + 1536) + lane); const float a0 = bflo(w.x), a1 = bfhi(w.x), a2 = bflo(w.y), a3 = bfhi(w.y);
        const float s = wave_sum(a0 * a0 + a1 * a1 + a2 * a2 + a3 * a3); if (lane == 0) rq[g] = rsqrtf(s * (1.f / 256.f) + NORM_EPS); }
      { const unsigned w = *((const unsigned*)(ur + 1792) + lane); const float a0 = bflo(w), a1 = bfhi(w);
        const float s = wave_sum(a0 * a0 + a1 * a1); if (lane == 0) rkv[g] = rsqrtf(s * (1.f / 128.f) + NORM_EPS); }
      { float x = lane < 32 ? bf2f(ur[1920 + lane]) : 0.f; const float o = __shfl_xor(x, 8);
        if (p >= CTX && lane < 32) { const int li = p - CTX; const int pos = (lane & 16) ? (li & 63) : (li >> 6); const f32x2 cs = rope[pos * 8 + (lane & 7)];
          x = (lane & 8) ? (x * cs.x + o * cs.y) : (x * cs.x - o * cs.y); }
        if (lane < 32) { const bf16_t xb = f2bf(x);
#pragma unroll
          for (int hh = 0; hh < NH; ++hh) KB[((size_t)(b * NH + hh) * PP + p) * 96 + 64 + lane] = xb; } }
      { const u32x2 w = *((const u32x2*)(ur + 2048) + lane); *(LAS f32x4*)(zrow + lane * 4) = (f32x4){bflo(w.x), bfhi(w.x), bflo(w.y), bfhi(w.y)}; }
      asm volatile("s_waitcnt lgkmcnt(0)" ::: "memory");
      { const int grp = lane >> 4, kq = lane & 15; const LAS float* z = zrow + grp * 64;
        float c0 = 0.f, s0 = 0.f, c1 = 0.f, s1 = 0.f, c2 = 0.f;
#pragma unroll 8
        for (int n = 0; n < 64; ++n) { const float zv = z[n]; const f32x2 t0 = tw64[(kq * n) & 63], t1 = tw64[((kq + 16) * n) & 63];
          c0 += zv * t0.x; s0 += zv * t0.y; c1 += zv * t1.x; s1 += zv * t1.y; c2 += (n & 1) ? -zv : zv; }
        stage[(grp * 33 + kq) * 64 + tl] = (f32x2){c0, -s0}; stage[(grp * 33 + kq + 16) * 64 + tl] = (f32x2){c1, -s1};
        if (kq == 0) stage[(grp * 33 + 32) * 64 + tl] = (f32x2){c2, 0.f}; }
      asm volatile("s_waitcnt lgkmcnt(0)" ::: "memory");
    }
    __syncthreads();
    f32x2* ZT = (f32x2*)(C.ws + WS_R4);
    for (int i = C.tid; i < 132 * 64; i += NTHREADS) { const int r = i >> 6, t = i & 63; ZT[((size_t)b * 132 + r) * PP + p0 + t] = stage[i]; }
    __syncthreads();
  }
}

DI void post_pass(const Ctx& C, int l, bool with_ctx) {
  const int gw = C.bid * NWAVES + C.wave, NGW = C.G * NWAVES, lane = C.lane;
  const bf16_t* U = (const bf16_t*)(C.ws + WS_R1);
  const bf16_t* AS = (const bf16_t*)(C.ws + WS_R3) + (size_t)TT * 768; const bf16_t* Gt = AS + (size_t)TT * 768;
  const bf16_t* Y0 = (const bf16_t*)(C.ws + WS_R5); const bf16_t* Y1 = Y0 + (size_t)TT * 384;
  bf16_t* MC = (bf16_t*)(C.ws + WS_R6);
  const float* cw = C.in[12] + (size_t)l * 3 * 1152; const float* k_a = C.in[19] + l * 384; const float* r_k = C.in[20] + l * 384;
  const float* lw = C.in[21] + l * 384; const float* lb = C.in[22] + l * 384;
  for (int g = gw; g < TT; g += NGW) {
    const int b = g / PP, p = g - b * PP; if (p < CTX && !with_ctx) continue;
    const bool hasl = (p != 0 && p != CTX), hasr = (p != CTX - 1 && p != PP - 1);
    const bf16_t* u0 = U + (size_t)g * UW;
#pragma unroll
    for (int hh = 0; hh < NH; ++hh) { const int c = hh * 64 + lane;
      float rkv[3];
#pragma unroll
      for (int q = 0; q < 3; ++q) { const int col = q * 384 + c; float a = bf2f(u0[col]) * cw[1152 + col];
        if (hasl) a += bf2f(u0[col - UW]) * cw[col]; if (hasr) a += bf2f(u0[col + UW]) * cw[2 * 1152 + col]; rkv[q] = a; }
      const float y = bf2f(Y0[(size_t)g * 384 + c]) + bf2f(Y1[(size_t)g * 384 + c]);
      const float mu = wave_sum(y) * (1.f / 64.f); const float dv = y - mu; const float var = wave_sum(dv * dv) * (1.f / 64.f);
      const float yn = dv * rsqrtf(var + GN_EPS) * lw[c] + lb[c];
      const float a0 = bf2f(AS[(size_t)g * 768 + c]), a1 = bf2f(AS[(size_t)g * 768 + 384 + c]); const float ka = k_a[c];
      const float kd0 = rkv[1] * (1.f + (a0 - 1.f) * ka), kd1 = rkv[1] * (1.f + (a1 - 1.f) * ka);
      const float bonus = wave_sum(rkv[0] * (kd0 + kd1) * r_k[c]);
      const float o = (yn + bonus * rkv[2]) * bf2f(Gt[(size_t)g * 384 + c]);
      MC[(size_t)g * DM + c] = f2bf(o); }
  }
}

DI void n2_pass(const Ctx& C, int l, bool with_ctx) {
  const int gw = C.bid * NWAVES + C.wave, NGW = C.G * NWAVES, lane = C.lane;
  const bf16_t* O = (const bf16_t*)(C.ws + WS_R1); bf16_t* TN = (bf16_t*)(C.ws + WS_R2); float* AFF = (float*)(C.ws + WS_AFF); int* SLOT = (int*)(C.ws + WS_SLOT);
  LAS float* wr = (LAS float*)C.lds; const float* wrg = C.in[28] + (size_t)l * DM * NEXP;
  for (int i = C.tid; i < DM * NEXP; i += NTHREADS) wr[(i & 15) * DM + (i >> 4)] = wrg[i];
  __syncthreads();
  for (int g = gw; g < TT; g += NGW) {
    const int mr = mod_row(g); if (mr == 4 && !with_ctx) continue;
    f32x4 v[4], o[4]; float s = 0.f;
    const f32x4* xr = (const f32x4*)(l == 0 ? in_row(C, g) : xs_row(C, g)) + lane; const u32x2* orow = (const u32x2*)(O + (size_t)g * DM) + lane;
#pragma unroll
    for (int j = 0; j < 4; ++j) { v[j] = xr[64 * j]; const u32x2 w = orow[64 * j]; o[j] = (f32x4){bflo(w.x), bfhi(w.x), bflo(w.y), bfhi(w.y)};
      s += (o[j].x * o[j].x + o[j].y * o[j].y) + (o[j].z * o[j].z + o[j].w * o[j].w); }
    float rstd = rsqrtf(wave_sum(s) * (1.f / DM) + NORM_EPS);
    { const f32x4* m2 = (const f32x4*)modv(C, l, mr, 2) + lane; const f32x4* gp = (const f32x4*)(C.in[7] + l * DM) + lane; f32x4* xo = (f32x4*)xs_row(C, g) + lane;
      s = 0.f;
#pragma unroll
      for (int j = 0; j < 4; ++j) { v[j] = v[j] + m2[64 * j] * (o[j] * rstd * gp[64 * j]); xo[64 * j] = v[j]; s += (v[j].x * v[j].x + v[j].y * v[j].y) + (v[j].z * v[j].z + v[j].w * v[j].w); } }
    rstd = rsqrtf(wave_sum(s) * (1.f / DM) + NORM_EPS);
    const f32x4* m3 = (const f32x4*)modv(C, l, mr, 3) + lane; const f32x4* m4 = (const f32x4*)modv(C, l, mr, 4) + lane; const f32x4* gp = (const f32x4*)(C.in[8] + l * DM) + lane;
    u32x2* to = (u32x2*)(TN + (size_t)g * DM) + lane;
    float lg[16];
#pragma unroll
    for (int e = 0; e < 16; ++e) lg[e] = 0.f;
#pragma unroll
    for (int j = 0; j < 4; ++j) { const f32x4 t = v[j] * rstd * gp[64 * j] * (m4[64 * j] + 1.0f) + m3[64 * j]; u32x2 w; w.x = cvtpk(t.x, t.y); w.y = cvtpk(t.z, t.w); to[64 * j] = w;
#pragma unroll
      for (int e = 0; e < 16; ++e) { const f32x4 ww = *(const LAS f32x4*)(wr + e * DM + 256 * j + 4 * lane); lg[e] += (t.x * ww.x + t.y * ww.y) + (t.z * ww.z + t.w * ww.w); if ((e & 3) == 3) asm volatile("" ::: "memory"); } }
    float mx = -1e30f;
#pragma unroll
    for (int e = 0; e < 16; ++e) { lg[e] = wave_sum(lg[e]); mx = fmaxf(mx, lg[e]); }
    float den = 0.f;
#pragma unroll
    for (int e = 0; e < 16; ++e) { lg[e] = __expf(lg[e] - mx); den += lg[e]; }
    const float inv = 1.f / den;
    float mine = 0.f;
#pragma unroll
    for (int e = 0; e < 16; ++e) mine = (lane == e) ? lg[e] * inv : mine;
    if (lane < 16) { AFF[(size_t)g * 16 + lane] = mine; SLOT[(size_t)g * 16 + lane] = -1; }
  }
  __syncthreads();
}

DI void topk_problem(const Ctx& C, int q) {
  const bool isctx = q >= 64; const int qq = q & 63, b = qq >> 4, e = qq & 15;
  const int n = isctx ? CTX : SEQ, cap = isctx ? 32 : 1024; const int g0 = b * PP + (isctx ? 0 : CTX);
  const float* AFF = (const float*)(C.ws + WS_AFF);
  int* IDX = (int*)(C.ws + WS_IDX); int* SLOT = (int*)(C.ws + WS_SLOT);
  const int obase = e * RPE + (isctx ? 4096 + b * 32 : b * 1024);
  LAS unsigned* keys = (LAS unsigned*)C.lds; LAS unsigned* hist = keys + 8192; LAS unsigned* ctl = hist + 256;
  for (int i = C.tid; i < n; i += NTHREADS) keys[i] = __float_as_uint(AFF[(size_t)(g0 + i) * 16 + e]);
  if (C.tid == 0) { ctl[0] = 0u; ctl[1] = (unsigned)cap; ctl[2] = 0u; ctl[3] = 0u; }
  unsigned mask = 0u;
  for (int pass = 0; pass < 4; ++pass) { const int shift = 24 - 8 * pass;
    if (C.tid < 256) hist[C.tid] = 0u;
    __syncthreads();
    const unsigned prefix = ctl[0];
    for (int i = C.tid; i < n; i += NTHREADS) { const unsigned k = keys[i]; if ((k & mask) == prefix) atomicAdd((unsigned*)&hist[(k >> shift) & 255u], 1u); }
    __syncthreads();
    if (C.tid == 0) { unsigned rem = ctl[1], cum = 0u; int bin = 255;
      for (; bin > 0; --bin) { const unsigned h = hist[bin]; if (cum + h >= rem) break; cum += h; }
      ctl[0] = prefix | ((unsigned)bin << shift); ctl[1] = rem - cum; }
    mask |= 255u << shift;
    __syncthreads();
  }
  const unsigned thr = ctl[0], need_eq = ctl[1];
  for (int i = C.tid; i < n; i += NTHREADS) { const unsigned k = keys[i];
    int slot = -1;
    if (k > thr) slot = (int)atomicAdd((unsigned*)&ctl[2], 1u);
    else if (k == thr) { const unsigned t = atomicAdd((unsigned*)&ctl[3], 1u); if (t < need_eq) slot = cap - (int)need_eq + (int)t; }
    if (slot >= 0) { IDX[obase + slot] = g0 + i; SLOT[(size_t)(g0 + i) * 16 + e] = obase + slot; } }
  __syncthreads();
}
#define MFMA32(a, b, c) __builtin_amdgcn_mfma_f32_32x32x16_bf16((a), (b), (c), 0, 0, 0)
constexpr int AT_KROW = 208, AT_VROW = 144, AT_KBUF = 64 * AT_KROW, AT_VBUF = 64 * AT_VROW;
constexpr int AT_K0 = 0, AT_V0 = 2 * AT_KBUF, AT_OST = AT_V0 + 2 * AT_VBUF, AT_OROW = 144;
constexpr float AT_THR = 8.0f;

DI void attn_unit(const Ctx& C, int b, int h, int pq0, int nkt) {
  const bf16_t* QB = (const bf16_t*)(C.ws + WS_R2); const bf16_t* KBp = QB + (size_t)NB * NH * PP * 96; const bf16_t* VTp = KBp + (size_t)NB * NH * PP * 96;
  const bf16_t* Qh = QB + (size_t)(b * NH + h) * PP * 96; const bf16_t* Kh = KBp + (size_t)(b * NH + h) * PP * 96; const bf16_t* Vh = VTp + (size_t)(b * NH + h) * 64 * PP;
  bf16_t* MC = (bf16_t*)(C.ws + WS_R6);
  const int tid = C.tid, lane = C.lane, wave = C.wave, r32 = lane & 31, hi = lane >> 5;
  LAS unsigned char* lds = C.lds;
  bf16x8 qf[6];
  { const bf16_t* qrow = Qh + (size_t)(pq0 + wave * 32 + r32) * 96 + hi * 8;
#pragma unroll
    for (int d0 = 0; d0 < 6; ++d0) qf[d0] = *(const bf16x8*)(qrow + d0 * 16); }
  const int k0row = tid / 12, k0c = tid % 12, k1row = (tid + 512) / 12, k1c = (tid + 512) % 12;
  const unsigned k0dst = k0row * AT_KROW + k0c * 16, k1dst = k1row * AT_KROW + k1c * 16, vdst = (tid >> 3) * AT_VROW + (tid & 7) * 16;
  const bf16_t* vsrc = Vh + (size_t)(tid >> 3) * PP + (tid & 7) * 8;
  u32x4 sk0, sk1 = (u32x4){0u, 0u, 0u, 0u}, sv;
#define AT_LOAD(kt) do { const char* kb_ = (const char*)(Kh + (size_t)(kt) * 64 * 96); sk0 = *(const u32x4*)(kb_ + tid * 16); if (tid < 256) sk1 = *(const u32x4*)(kb_ + (tid + 512) * 16); sv = *(const u32x4*)(vsrc + (kt) * 64); } while (0)
#define AT_STORE(buf) do { *(LAS u32x4*)(lds + AT_K0 + (buf) * AT_KBUF + k0dst) = sk0; if (tid < 256) *(LAS u32x4*)(lds + AT_K0 + (buf) * AT_KBUF + k1dst) = sk1; *(LAS u32x4*)(lds + AT_V0 + (buf) * AT_VBUF + vdst) = sv; } while (0)
  AT_LOAD(0); AT_STORE(0);
  __syncthreads();
  f32x16 negm, o0, o1;
#pragma unroll
  for (int i = 0; i < 16; ++i) { negm[i] = 0.f; o0[i] = 0.f; o1[i] = 0.f; }
  float mhat = 0.f, lsum = 0.f;
  for (int kt = 0; kt < nkt; ++kt) {
    const int buf = kt & 1;
    if (kt + 1 < nkt) AT_LOAD(kt + 1);
    const LAS unsigned char* kb = lds + AT_K0 + buf * AT_KBUF + r32 * AT_KROW + hi * 16;
    const LAS unsigned char* vb = lds + AT_V0 + buf * AT_VBUF + r32 * AT_VROW + hi * 16;
    f32x16 p0, p1;
#pragma unroll
    for (int d0 = 0; d0 < 6; ++d0) { const bf16x8 kf0 = *(const LAS bf16x8*)(kb + d0 * 32), kf1 = *(const LAS bf16x8*)(kb + 32 * AT_KROW + d0 * 32);
      if (d0 == 0) { p0 = MFMA32(kf0, qf[0], negm); p1 = MFMA32(kf1, qf[0], negm); } else { p0 = MFMA32(kf0, qf[d0], p0); p1 = MFMA32(kf1, qf[d0], p1); } }
    float rm = fmaxf(p0[0], p1[0]);
#pragma unroll
    for (int i = 1; i < 16; ++i) rm = fmaxf(rm, fmaxf(p0[i], p1[i]));
    rm = fmaxf(rm, __shfl_xor(rm, 32));
    if (kt == 0 || __any(rm > AT_THR)) {
      const float dl = (kt == 0) ? rm : fmaxf(rm, 0.f);
      mhat += dl; const float f = (kt == 0) ? 1.f : __builtin_amdgcn_exp2f(-dl); lsum *= f;
#pragma unroll
      for (int i = 0; i < 16; ++i) { p0[i] -= dl; p1[i] -= dl; o0[i] *= f; o1[i] *= f; negm[i] = -mhat; }
    }
    float ps = 0.f;
#pragma unroll
    for (int i = 0; i < 16; ++i) { p0[i] = __builtin_amdgcn_exp2f(p0[i]); p1[i] = __builtin_amdgcn_exp2f(p1[i]); ps += p0[i] + p1[i]; }
    lsum += ps;
    u32x4 w0, w1, w2, w3;
    w0 = (u32x4){cvtpk(p0[0], p0[1]), cvtpk(p0[2], p0[3]), cvtpk(p0[4], p0[5]), cvtpk(p0[6], p0[7])};
    w1 = (u32x4){cvtpk(p0[8], p0[9]), cvtpk(p0[10], p0[11]), cvtpk(p0[12], p0[13]), cvtpk(p0[14], p0[15])};
    w2 = (u32x4){cvtpk(p1[0], p1[1]), cvtpk(p1[2], p1[3]), cvtpk(p1[4], p1[5]), cvtpk(p1[6], p1[7])};
    w3 = (u32x4){cvtpk(p1[8], p1[9]), cvtpk(p1[10], p1[11]), cvtpk(p1[12], p1[13]), cvtpk(p1[14], p1[15])};
    const bf16x8 pf0 = __builtin_bit_cast(bf16x8, w0), pf1 = __builtin_bit_cast(bf16x8, w1), pf2 = __builtin_bit_cast(bf16x8, w2), pf3 = __builtin_bit_cast(bf16x8, w3);
#define AT_PV(s, pf) do { const bf16x8 va = *(const LAS bf16x8*)(vb + (s) * 32), vc = *(const LAS bf16x8*)(vb + 32 * AT_VROW + (s) * 32); o0 = MFMA32(va, pf, o0); o1 = MFMA32(vc, pf, o1); } while (0)
    AT_PV(0, pf0); AT_PV(1, pf1); AT_PV(2, pf2); AT_PV(3, pf3);
#undef AT_PV
    if (kt + 1 < nkt) AT_STORE(buf ^ 1);
    __syncthreads();
  }
#undef AT_LOAD
#undef AT_STORE
  lsum += __shfl_xor(lsum, 32);
  const float inv = 1.f / lsum;
  LAS bf16_t* stg = (LAS bf16_t*)(lds + AT_OST + wave * 32 * AT_OROW);
#pragma unroll
  for (int i = 0; i < 16; ++i) { const int d = (i & 3) + 8 * (i >> 2) + 4 * hi;
    stg[r32 * (AT_OROW / 2) + d] = f2bf(o0[i] * inv); stg[r32 * (AT_OROW / 2) + 32 + d] = f2bf(o1[i] * inv); }
  asm volatile("s_waitcnt lgkmcnt(0)" ::: "memory");
#pragma unroll
  for (int i = 0; i < 4; ++i) { const int piece = i * 64 + lane, row = piece >> 3, c = piece & 7;
    const u32x4 v = *(const LAS u32x4*)((const LAS unsigned char*)stg + row * AT_OROW + c * 16);
    *(u32x4*)(MC + (size_t)(b * PP + pq0 + wave * 32 + row) * DM + 384 + h * 64 + c * 8) = v; }
  __syncthreads();
}

constexpr int SC_CH = 32;
DI int scan_pos(int s, int d) { return d == 0 ? s : (s < CTX ? CTX - 1 - s : (PP - 1) - (s - CTX)); }
DI void scan_unit(const Ctx& C, int l, int chain) {
  const int b = chain / 12, h = (chain >> 1) % 6, d = chain & 1;
  const bf16_t* U = (const bf16_t*)(C.ws + WS_R1);
  const bf16_t* EW = (const bf16_t*)(C.ws + WS_R3); const bf16_t* AS = EW + (size_t)TT * 768;
  bf16_t* Y = (bf16_t*)(C.ws + WS_R5) + (size_t)d * TT * 384;
  const float* cw = C.in[12] + (size_t)l * 3 * 1152; const float* k_k = C.in[18] + l * 384; const float* k_a = C.in[19] + l * 384;
  const int tid = C.tid, lane = C.lane, wave = C.wave;
  LAS float* ops = (LAS float*)C.lds;
  LAS float* ybuf = ops + SC_CH * 6 * 64;
  const int row = wave * 8 + (lane >> 3), cg = lane & 7;
  float S[8];
#pragma unroll
  for (int j = 0; j < 8; ++j) S[j] = 0.f;
  const int c = h * 64 + lane;
  const float cwr0 = cw[c], cwr1 = cw[1152 + c], cwr2 = cw[2304 + c];
  const float cwk0 = cw[384 + c], cwk1 = cw[1152 + 384 + c], cwk2 = cw[2304 + 384 + c];
  const float cwv0 = cw[768 + c], cwv1 = cw[1152 + 768 + c], cwv2 = cw[2304 + 768 + c];
  const float kkc = k_k[c], kac = k_a[c];
  for (int chunk = 0; chunk < PP / SC_CH; ++chunk) {
    const int s0 = chunk * SC_CH;
#pragma unroll
    for (int i = 0; i < 4; ++i) { const int sl = wave * 4 + i; const int p = scan_pos(s0 + sl, d); const int g = b * PP + p;
      const bool hasl = (p != 0 && p != CTX), hasr = (p != CTX - 1 && p != PP - 1);
      const bf16_t* u0 = U + (size_t)g * UW;
      float r = bf2f(u0[c]) * cwr1, k = bf2f(u0[384 + c]) * cwk1, v = bf2f(u0[768 + c]) * cwv1;
      if (hasl) { r += bf2f(u0[c - UW]) * cwr0; k += bf2f(u0[384 + c - UW]) * cwk0; v += bf2f(u0[768 + c - UW]) * cwv0; }
      if (hasr) { r += bf2f(u0[c + UW]) * cwr2; k += bf2f(u0[384 + c + UW]) * cwk2; v += bf2f(u0[768 + c + UW]) * cwv2; }
      const float kr = k * kkc; const float nrm = sqrtf(wave_sum(kr * kr)); const float kk = kr / fmaxf(nrm, 1e-12f);
      const float ew = bf2f(EW[(size_t)g * 768 + d * 384 + c]); const float a = bf2f(AS[(size_t)g * 768 + d * 384 + c]);
      const float w = __expf(-ew); const float kd = k * (1.f + (a - 1.f) * kac);
      LAS float* o = ops + sl * 384 + lane;
      o[0] = r; o[64] = w; o[128] = kd; o[192] = v; o[256] = -kk; o[320] = kk * a; }
    __syncthreads();
    for (int sl = 0; sl < SC_CH; ++sl) {
      const LAS float* o = ops + sl * 384 + cg * 8;
      const f32x4 r0 = *(const LAS f32x4*)(o), r1 = *(const LAS f32x4*)(o + 4);
      const f32x4 w0 = *(const LAS f32x4*)(o + 64), w1 = *(const LAS f32x4*)(o + 68);
      const f32x4 k0 = *(const LAS f32x4*)(o + 128), k1 = *(const LAS f32x4*)(o + 132);
      const f32x4 a0 = *(const LAS f32x4*)(o + 256), a1 = *(const LAS f32x4*)(o + 260);
      const f32x4 b0 = *(const LAS f32x4*)(o + 320), b1 = *(const LAS f32x4*)(o + 324);
      const float v = ops[sl * 384 + 192 + row];
      float sa = (S[0] * a0.x + S[1] * a0.y) + (S[2] * a0.z + S[3] * a0.w) + (S[4] * a1.x + S[5] * a1.y) + (S[6] * a1.z + S[7] * a1.w);
      sa += __shfl_xor(sa, 1); sa += __shfl_xor(sa, 2); sa += __shfl_xor(sa, 4);
      S[0] = S[0] * w0.x + (sa * b0.x + v * k0.x); S[1] = S[1] * w0.y + (sa * b0.y + v * k0.y); S[2] = S[2] * w0.z + (sa * b0.z + v * k0.z); S[3] = S[3] * w0.w + (sa * b0.w + v * k0.w);
      S[4] = S[4] * w1.x + (sa * b1.x + v * k1.x); S[5] = S[5] * w1.y + (sa * b1.y + v * k1.y); S[6] = S[6] * w1.z + (sa * b1.z + v * k1.z); S[7] = S[7] * w1.w + (sa * b1.w + v * k1.w);
      float y = (S[0] * r0.x + S[1] * r0.y) + (S[2] * r0.z + S[3] * r0.w) + (S[4] * r1.x + S[5] * r1.y) + (S[6] * r1.z + S[7] * r1.w);
      y += __shfl_xor(y, 1); y += __shfl_xor(y, 2); y += __shfl_xor(y, 4);
      if (cg == 0) ybuf[sl * 64 + row] = y;
    }
    __syncthreads();
#pragma unroll
    for (int i = 0; i < 4; ++i) { const int sl = (tid >> 6) + 8 * i; const int p = scan_pos(s0 + sl, d);
      Y[(size_t)(b * PP + p) * 384 + h * 64 + lane] = f2bf(ybuf[sl * 64 + lane]); }
  }
  __syncthreads();
}

DI void fft_unit(const Ctx& C, int seq, bool isctx) {
  const int N = isctx ? CTX : SEQ, logN = isctx ? 8 : 13, off = isctx ? 0 : CTX;
  const f32x2* src = (const f32x2*)(C.ws + WS_R4) + (size_t)seq * PP + off;
  const f32x2* TW = (const f32x2*)(C.ws + WS_TW);
  bf16_t* MC = (bf16_t*)(C.ws + WS_R6);
  LAS f32x2* x = (LAS f32x2*)C.lds;
  const int tid = C.tid;
  for (int i = tid; i < N; i += NTHREADS) x[i] = src[i];
  __syncthreads();
  const int twmul = SEQ / N;
  for (int s = 0; s < logN; ++s) { const int hb = logN - 1 - s, hh = 1 << hb;
    for (int j = tid; j < N / 2; j += NTHREADS) { const int blk = j >> hb, i = j & (hh - 1); const int i0 = (blk << (hb + 1)) + i, i1 = i0 + hh;
      const f32x2 a = x[i0], bb = x[i1]; const f32x2 tw = TW[(i << s) * twmul];
      const float dr = a.x - bb.x, di = a.y - bb.y;
      x[i0] = (f32x2){a.x + bb.x, a.y + bb.y}; x[i1] = (f32x2){dr * tw.x - di * tw.y, dr * tw.y + di * tw.x}; }
    __syncthreads(); }
  const float scale = rsqrtf(64.0f * (float)N);
  const int b = seq / 132, grp = (seq / 33) & 3, k2 = seq % 33;
  for (int pi = tid; pi < N; pi += NTHREADS) { const int k1 = (int)(__brev((unsigned)pi) >> (32 - logN));
    const bf16_t val = f2bf(x[pi].x * scale);
    MC[(size_t)(b * PP + off + k1) * DM + 768 + grp * 64 + k2] = val;
    if (k2 >= 1 && k2 <= 31) MC[(size_t)(b * PP + off + ((N - k1) & (N - 1))) * DM + 768 + grp * 64 + 64 - k2] = val; }
  __syncthreads();
}

DI void mix_phase(const Ctx& C, int l, bool with_ctx) {
  unsigned* ctr = (unsigned*)(C.ws + WS_CTL) + 64 * (1 + l);
  LAS int* slot = (LAS int*)(C.lds + 147456 - 64);
  const int n_scan = 48, n_att = 768, n_attc = with_ctx ? 24 : 0, n_fft = 528, n_fftc = with_ctx ? 528 : 0;
  const int total = n_scan + n_att + n_attc + n_fft + n_fftc;
  for (;;) {
    __syncthreads();
    if (C.tid == 0) *slot = (int)atomicAdd(ctr, 1u);
    __syncthreads();
    int it = *slot;
    if (it >= total) break;
    if (it < n_scan) { scan_unit(C, l, it); continue; } it -= n_scan;
    if (it < n_att) { const int bh = it / 32, qb = it % 32; attn_unit(C, bh / NH, bh % NH, CTX + qb * 256, PP / 64); continue; } it -= n_att;
    if (it < n_attc) { attn_unit(C, it / NH, it % NH, 0, CTX / 64); continue; } it -= n_attc;
    if (it < n_fft) { fft_unit(C, it, false); continue; } it -= n_fft;
    fft_unit(C, it, true);
  }
}
constexpr int LDS_BYTES = 147456;
#ifndef MK_STOP
#define MK_STOP 1000
#endif

__global__ void __launch_bounds__(NTHREADS, 2) mk_fwd(Params P) {
  extern __shared__ __attribute__((aligned(16))) unsigned char lds_raw[];
  cg::grid_group grid = cg::this_grid();
  Ctx C;
  C.in = (const __attribute__((address_space(4))) cfptr*)__builtin_amdgcn_kernarg_segment_ptr(); C.out = P.out; C.ws = P.ws; C.lds = (LAS unsigned char*)lds_raw; C.ldsg = lds_raw;
  C.tid = threadIdx.x; C.lane = C.tid & 63; C.wave = __builtin_amdgcn_readfirstlane(C.tid >> 6); C.G = gridDim.x; C.bid = blockIdx.x;
#define PH() do { asm volatile("" : "+v"(C.tid), "+v"(C.lane)); asm volatile("" : "+s"(C.wave), "+s"(C.G), "+s"(C.bid), "+s"(C.ws), "+s"(C.out), "+s"(C.in), "+s"(ws)); } while (0)
  unsigned char* ws = P.ws;
#define R1 ((bf16_t*)(ws + WS_R1))
#define R2 ((bf16_t*)(ws + WS_R2))
#define R3 ((bf16_t*)(ws + WS_R3))
#define QB R2
#define KB (R2 + (size_t)NB * NH * PP * 96)
#define VT (R2 + (size_t)2 * NB * NH * PP * 96)
#define EW R3
#define AS (R3 + (size_t)TT * 768)
#define GG (R3 + (size_t)2 * TT * 768)
#define rq ((float*)(ws + WS_RSTD))
#define rkv (((float*)(ws + WS_RSTD)) + TT)
#define IDX ((int*)(ws + WS_IDX))

  PH(); phase0(C);
  grid.sync();
  PH(); phase0b(C);
  grid.sync();
  for (int l = 0; l < 2; ++l) {
    const bool last = (l == 1);
    PH(); if (l == 0) norm_pass(C, 0, 0, 0); else norm_pass(C, 1, 1, 0);
    grid.sync();
    PH(); { pg8::Gemm g{R2, (const bf16_t*)(ws + WS_WIN) + (size_t)l * UW * DM, DM, DM}; pg8::StaticOrder S; S.init(TT, UW, C.G, C.bid);
      EpiU E{R1, UW}; pg8::gemm_phase(C.lds, C.tid, g, S, E); }
    grid.sync();
    PH(); prep_a(C, l);
    grid.sync();
    PH(); { pg8::Gemm g{R1 + 1152, (const bf16_t*)(ws + WS_WLW) + (size_t)l * 1536 * 128, UW, 128}; pg8::StaticOrder S; S.init(TT, 1536, C.G, C.bid);
      EpiLW E{EW, AS, C.in[13] + l * 768, C.in[15] + l * 768}; pg8::gemm_phase(C.lds, C.tid, g, S, E); }
    PH(); { pg8::Gemm g{R1 + 1280, (const bf16_t*)(ws + WS_WG) + (size_t)l * 512 * 256, UW, 256}; pg8::StaticOrder S; S.init(TT, 512, C.G, C.bid);
      EpiG E{GG}; pg8::gemm_phase(C.lds, C.tid, g, S, E); }
    PH(); { pg8::Gemm g{R1 + 1536, (const bf16_t*)(ws + WS_WQ) + (size_t)l * 768 * 256, UW, 256}; pg8::StaticOrder S; S.init(TT, 768, C.G, C.bid);
      EpiQ E{QB, rq, (const float*)(ws + WS_ROPE)}; pg8::gemm_phase(C.lds, C.tid, g, S, E); }
    PH(); { pg8::Gemm g{R1 + 1792, (const bf16_t*)(ws + WS_WKV) + (size_t)l * 768 * 128, UW, 128}; pg8::StaticOrder S; S.init(TT, 768, C.G, C.bid);
      EpiKV E{KB, VT, rkv}; pg8::gemm_phase(C.lds, C.tid, g, S, E); }
    grid.sync();
    PH(); mix_phase(C, l, !last);
    grid.sync();
    PH(); post_pass(C, l, !last);
    grid.sync();
    PH(); { pg8::Gemm g{(const bf16_t*)(ws + WS_R6), (const bf16_t*)(ws + WS_WOUT) + (size_t)l * DM * DM, DM, DM}; pg8::StaticOrder S; S.init(TT, DM, C.G, C.bid);
      EpiPlain E{R1, DM}; pg8::gemm_phase(C.lds, C.tid, g, S, E); }
    grid.sync();
    PH(); n2_pass(C, l, !last);
    grid.sync();
    PH(); { const int nprob = last ? 64 : 128;
      if (C.bid < nprob) topk_problem(C, C.bid);
      const int gt = C.bid * NTHREADS + C.tid, NGT = C.G * NTHREADS;
      for (int i = gt; i < NEXP * 256; i += NGT) { const int e = i >> 8, r = i & 255; const int row = e * RPE + 4096 + r; if (last || r >= 128) IDX[row] = 0; }
      convert_experts(C, l, C.bid * NWAVES + C.wave, C.G * NWAVES); }
    grid.sync();
    PH(); { pg8::Gemm g{R2, R3, DM, DM}; MoeOrder<true> S; S.init(last ? 16 : 17, 8, C.G, C.bid, IDX);
      EpiMoe1 E{(bf16_t*)(ws + WS_HID)}; pg8::gemm_phase(C.lds, C.tid, g, S, E); }
    grid.sync();
    PH(); { pg8::Gemm g{(const bf16_t*)(ws + WS_HID), R3 + (size_t)NEXP * 2048 * 1024, DM, DM}; MoeOrder<false> S; S.init(last ? 16 : 17, 4, C.G, C.bid, IDX);
      EpiMoe2 E{R1}; pg8::gemm_phase(C.lds, C.tid, g, S, E); }
    grid.sync();
  }
  PH(); norm_pass(C, 2, 0, 1);
}

extern "C" void kernel_launch(void* const* d_in, const int* in_sizes, int n_in, void* d_out, int out_size, void* d_ws, size_t ws_size, hipStream_t stream) {
  static int grid = 0;
  if (grid == 0) {
    int dev = 0, cus = 0, per_cu = 0;
    if (n_in != 32 || out_size != NB * SEQ * DM || ws_size < WS_END) { fprintf(stderr, "kernel_launch: unexpected shapes (n_in %d out %d ws %zu)\n", n_in, out_size, ws_size); grid = -1; return; }
    (void)hipGetDevice(&dev);
    (void)hipDeviceGetAttribute(&cus, hipDeviceAttributeMultiprocessorCount, dev);
    (void)hipFuncSetAttribute((const void*)mk_fwd, hipFuncAttributeMaxDynamicSharedMemorySize, LDS_BYTES);
    (void)hipOccupancyMaxActiveBlocksPerMultiprocessor(&per_cu, (const void*)mk_fwd, NTHREADS, LDS_BYTES);
    if (per_cu < 1) { fprintf(stderr, "kernel_launch: occupancy query reports %d blocks per CU\n", per_cu); grid = -1; return; }
    grid = cus;
  }
  if (grid < 0) return;
  (void)hipMemsetAsync((char*)d_ws + WS_CTL, 0, 4096, stream);
  Params p{};
  for (int i = 0; i < 32; ++i) p.in[i] = (const float*)d_in[i];
  p.out = (float*)d_out; p.ws = (unsigned char*)d_ws;
  void* args[] = {&p};
  hipError_t e = hipLaunchCooperativeKernel((const void*)mk_fwd, dim3(grid), dim3(NTHREADS), args, LDS_BYTES, stream);
  if (e != hipSuccess) fprintf(stderr, "cooperative launch failed: %s (grid %d)\n", hipGetErrorString(e), grid);
}
```

```cpp
#include <hip/hip_runtime.h>
#include <hip/hip_cooperative_groups.h>
#include <cstdio>
#include <cstdint>
namespace cg = cooperative_groups;

#define LAS __attribute__((address_space(3)))
typedef unsigned short bf16_t;
typedef short bf16x8 __attribute__((ext_vector_type(8)));
typedef float f32x4 __attribute__((ext_vector_type(4)));
typedef float f32x2 __attribute__((ext_vector_type(2)));
typedef float f32x16 __attribute__((ext_vector_type(16)));
typedef unsigned u32x4 __attribute__((ext_vector_type(4)));
typedef unsigned u32x2 __attribute__((ext_vector_type(2)));
typedef __bf16 bf16x2_t __attribute__((ext_vector_type(2)));
#define DI __device__ __forceinline__

constexpr int NB = 4, SEQ = 8192, CTX = 256, PP = SEQ + CTX  , TT = NB * PP  , DM = 1024;
constexpr int UW = 2304;
constexpr int NH = 6;
constexpr int NEXP = 16, RPE = 4352  ;
constexpr float NORM_EPS = 1e-6f, GN_EPS = 64e-5f;
constexpr float QSCALE = 0.10206207261596577f * 1.4426950408889634f;
constexpr int NWAVES = 8, NTHREADS = 512;

DI unsigned cvtpk(float lo, float hi) { f32x2 v = {lo, hi}; bf16x2_t b = __builtin_convertvector(v, bf16x2_t); return __builtin_bit_cast(unsigned, b); }
DI bf16_t f2bf(float f) { return (bf16_t)(cvtpk(f, 0.f) & 0xffffu); }
DI float bf2f(bf16_t b) { return __uint_as_float(((unsigned)b) << 16); }
DI float bflo(unsigned u) { return __uint_as_float(u << 16); }
DI float bfhi(unsigned u) { return __uint_as_float(u & 0xffff0000u); }
template <int CTRL> DI float dpp_add(float x) { return x + __builtin_bit_cast(float, __builtin_amdgcn_update_dpp(0, __builtin_bit_cast(int, x), CTRL, 0xf, 0xf, true)); }
DI float rdlane(float x, int l) { return __builtin_bit_cast(float, __builtin_amdgcn_readlane(__builtin_bit_cast(int, x), l)); }
DI float wave_sum(float x) {
  x = dpp_add<0xB1>(x); x = dpp_add<0x4E>(x); x = dpp_add<0x141>(x); x = dpp_add<0x140>(x);
  return (rdlane(x, 0) + rdlane(x, 16)) + (rdlane(x, 32) + rdlane(x, 48));
}
DI float swz_xor16(float x) { return __builtin_bit_cast(float, __builtin_amdgcn_ds_swizzle(__builtin_bit_cast(int, x), 0x401F)); }
DI float swz_xor8(float x) { return __builtin_bit_cast(float, __builtin_amdgcn_ds_swizzle(__builtin_bit_cast(int, x), 0x201F)); }
DI float half_max(float x) { auto r = __builtin_amdgcn_permlane32_swap(__float_as_uint(x), __float_as_uint(x), false, false); return fmaxf(__uint_as_float(r[0]), __uint_as_float(r[1])); }
DI float half_sum(float x) { auto r = __builtin_amdgcn_permlane32_swap(__float_as_uint(x), __float_as_uint(x), false, false); return __uint_as_float(r[0]) + __uint_as_float(r[1]); }
DI float sigmoidf_(float x) { return 1.f / (1.f + __expf(-x)); }

namespace pg8 {
constexpr int BM = 256, BK = 64, HALF = 128, HTB = HALF * BK * 2, STAGE_BYTES = 8 * HTB, NXCD = 8, WGM = 8;
__host__ __device__ __forceinline__ int lds_byte(int r, int c) { const int st = (r >> 4) * 2 + (c >> 5), rr = r & 15, cc = c & 31, ob = rr * 64 + cc * 2; return st * 1024 + (ob ^ (((ob >> 9) & 1) << 5)); }
__host__ __device__ __forceinline__ void stage_rc(int b, int& R, int& C) { const int st = b / 1024, sb = b % 1024, swz = sb ^ (((sb >> 9) & 1) << 5); R = (st >> 1) * 16 + swz / 64; C = (st & 1) * 32 + (swz % 64) / 2; }
__host__ __device__ __forceinline__ int perm32(int rho) { const int n = rho >> 4, i = rho & 15; return 8 * (i >> 2) + 4 * n + (i & 3); }

struct Unit { int pm, pn; };
struct Gemm { const bf16_t* A; const bf16_t* Bt; int lda; int K; };

struct StaticOrder {
  int nM, nN, nwg, G, c;
  static constexpr bool GATHER = false;
  __device__ void init(int M, int N, int G_, int c_) { nM = M / BM; nN = N / BM; nwg = nM * nN; G = G_; c = c_; }
  __device__ bool next(int i, Unit& u) const {
    const long L = (long)i * G + c; if (L >= nwg) return false;
    int wgid = (int)L; { const int q = nwg / NXCD, r = nwg % NXCD, xcd = wgid % NXCD, off = wgid / NXCD; wgid = (xcd < r ? xcd * (q + 1) : r * (q + 1) + (xcd - r) * q) + off; }
    const int nig = WGM * nN, gid = wgid / nig, fm = gid * WGM, gsz = (nM - fm) < WGM ? (nM - fm) : WGM;
    u.pm = fm + ((wgid % nig) % gsz); u.pn = (wgid % nig) / gsz; return true;
  }
  __device__ int arow(const Unit&, int) const { return 0; }
};

template <class Epi, class Sched>
__device__ __forceinline__ void gemm_phase(LAS unsigned char* lds, const int tid, const Gemm g, const Sched& S, const Epi& E) {
  const int wid = __builtin_amdgcn_readfirstlane(tid >> 6), lane = tid & 63, wr = wid >> 2, wc = wid & 3, fr = lane & 15, fq = lane >> 4;
  int K_ = g.K, lda_ = g.lda; asm volatile("" : "+s"(K_), "+s"(lda_));
  const int K = K_, nt = K / BK, lda = lda_;
  unsigned voffB[2]; int RA[2], CA[2];
#pragma unroll
  for (int i = 0; i < 2; ++i) { int R, C; stage_rc(tid * 16 + i * 8192, R, C); const int Rb = Epi::PERM ? ((R & ~31) + perm32(R & 31)) : R;
    RA[i] = R; CA[i] = C; voffB[i] = (unsigned)(Rb * K + C) * 2u; }
  const size_t kstep = (size_t)(BK * 2);
  const size_t hstepB = (size_t)HALF * K * 2, tstepB = 2 * hstepB;
  const size_t tstepA = (size_t)BM * lda * 2;
  const unsigned ldsw = (unsigned)wid * 1024u;
  const int aoff = lds_byte(wr * 64 + fr, fq * 8), boff = lds_byte(wc * 32 + fr, fq * 8);
#define PG8_SA(b, h) (((b) * 2 + (h)) * HTB)
#define PG8_SB(b, h) ((4 + (b) * 2 + (h)) * HTB)
#define PG8_STAGE(bufoff, gbase, voff) do { _Pragma("unroll") for (int _i = 0; _i < 2; ++_i) \
        __builtin_amdgcn_global_load_lds((const unsigned*)((const char*)(gbase) + (voff)[_i]), (LAS unsigned*)(lds + (bufoff) + ldsw + _i * 8192), 16, 0, 0); } while (0)
#define PG8_LDA(dst, b, h) do { _Pragma("unroll") for (int m = 0; m < 4; ++m) _Pragma("unroll") for (int k = 0; k < 2; ++k) dst[m][k] = *(const LAS bf16x8*)(lds + PG8_SA(b, h) + aoff + m * 2048 + k * 1024); } while (0)
#define PG8_LDB(dst, b, h) do { _Pragma("unroll") for (int n = 0; n < 2; ++n) _Pragma("unroll") for (int k = 0; k < 2; ++k) dst[n][k] = *(const LAS bf16x8*)(lds + PG8_SB(b, h) + boff + n * 2048 + k * 1024); } while (0)
#define PG8_MMA(ai, bj, At, Bt) do { __builtin_amdgcn_s_setprio(1); _Pragma("unroll") for (int m = 0; m < 4; ++m) _Pragma("unroll") for (int n = 0; n < 2; ++n) _Pragma("unroll") for (int k = 0; k < 2; ++k) \
        acc[ai][bj][m][n] = __builtin_amdgcn_mfma_f32_16x16x32_bf16(Bt[n][k], At[m][k], acc[ai][bj][m][n], 0, 0, 0); __builtin_amdgcn_s_setprio(0); } while (0)
#define PG8_WAIT_V(n) asm volatile("s_waitcnt vmcnt(" #n ")" ::: "memory")
#define PG8_WAIT_L(n) asm volatile("s_waitcnt lgkmcnt(" #n ")" ::: "memory")
#define PG8_BAR __builtin_amdgcn_s_barrier()
#define PG8_SCHED __builtin_amdgcn_sched_barrier(0)
#define PG8_OFFS(dst, u) do { _Pragma("unroll") for (int _h = 0; _h < 2; ++_h) _Pragma("unroll") for (int _i = 0; _i < 2; ++_i) \
        dst[_h][_i] = Sched::GATHER ? (unsigned)((size_t)S.arow(u, _h * HALF + RA[_i]) * lda + CA[_i]) * 2u : (unsigned)((_h * HALF + RA[_i]) * lda + CA[_i]) * 2u; } while (0)
  Unit cur, nxt; int ui = 0;
  if (!S.next(0, cur)) return;
  f32x4 acc[2][2][4][2];
#pragma unroll
  for (int a = 0; a < 2; ++a)
#pragma unroll
    for (int b = 0; b < 2; ++b)
#pragma unroll
      for (int m = 0; m < 4; ++m)
#pragma unroll
        for (int n = 0; n < 2; ++n) acc[a][b][m][n] = (f32x4){0.f, 0.f, 0.f, 0.f};
  bf16x8 At[4][2], B0[2][2], B1[2][2];
  unsigned oAc[2][2], oAn[2][2];
  PG8_OFFS(oAc, cur);
  const char* cA = (const char*)g.A + (Sched::GATHER ? (size_t)0 : (size_t)cur.pm * tstepA); const char* cB = (const char*)g.Bt + (size_t)cur.pn * tstepB;
  PG8_STAGE(PG8_SB(0, 0), cB, voffB); PG8_STAGE(PG8_SB(0, 1), cB + hstepB, voffB); PG8_STAGE(PG8_SA(0, 0), cA, oAc[0]); PG8_STAGE(PG8_SA(0, 1), cA, oAc[1]);
  if (wr == 1) PG8_BAR;
  PG8_WAIT_V(2); PG8_BAR;
  PG8_STAGE(PG8_SB(1, 0), cB + kstep, voffB); PG8_STAGE(PG8_SA(1, 0), cA + kstep, oAc[0]); PG8_STAGE(PG8_SB(1, 1), cB + hstepB + kstep, voffB);
  PG8_WAIT_V(6); PG8_BAR;
  for (;;) {
    const bool has_next = S.next(ui + 1, nxt);
    if (has_next) { PG8_OFFS(oAn, nxt); }
    else {
#pragma unroll
      for (int _h = 0; _h < 2; ++_h)
#pragma unroll
        for (int _i = 0; _i < 2; ++_i) oAn[_h][_i] = oAc[_h][_i];
    }
    const char* nA = has_next ? (const char*)g.A + (Sched::GATHER ? (size_t)0 : (size_t)nxt.pm * tstepA) : cA; const char* nB = has_next ? (const char*)g.Bt + (size_t)nxt.pn * tstepB : cB;
    for (int t = 0; t < nt; t += 2) {
      const bool last = (t == nt - 2);
      const char* a1 = cA + (size_t)(t + 1) * kstep;
      const char* a2 = last ? nA : cA + (size_t)(t + 2) * kstep; const char* b2 = last ? nB : cB + (size_t)(t + 2) * kstep;
      const char* a3 = a2 + kstep; const char* b3 = b2 + kstep;
      unsigned o2[2][2];
#pragma unroll
      for (int _h = 0; _h < 2; ++_h)
#pragma unroll
        for (int _i = 0; _i < 2; ++_i) o2[_h][_i] = last ? oAn[_h][_i] : oAc[_h][_i];
      PG8_LDB(B0, 0, 0); PG8_LDB(B1, 0, 1); PG8_SCHED; PG8_LDA(At, 0, 0); PG8_STAGE(PG8_SA(1, 1), a1, oAc[1]);
      PG8_WAIT_V(8); PG8_WAIT_L(0); PG8_BAR; PG8_MMA(0, 0, At, B0); PG8_MMA(0, 1, At, B1); PG8_BAR; PG8_SCHED;
      PG8_LDA(At, 0, 1); PG8_STAGE(PG8_SB(0, 0), b2, voffB); PG8_STAGE(PG8_SB(0, 1), b2 + hstepB, voffB); PG8_STAGE(PG8_SA(0, 0), a2, o2[0]);
      PG8_WAIT_V(8); PG8_WAIT_L(0); PG8_BAR; PG8_MMA(1, 0, At, B0); PG8_MMA(1, 1, At, B1); PG8_BAR; PG8_SCHED;
      PG8_LDB(B0, 1, 0); PG8_LDB(B1, 1, 1); PG8_SCHED; PG8_LDA(At, 1, 0); PG8_STAGE(PG8_SA(0, 1), a2, o2[1]);
      PG8_WAIT_V(8); PG8_WAIT_L(0); PG8_BAR; PG8_MMA(0, 0, At, B0); PG8_MMA(0, 1, At, B1); PG8_BAR; PG8_SCHED;
      PG8_LDA(At, 1, 1); PG8_STAGE(PG8_SB(1, 0), b3, voffB); PG8_STAGE(PG8_SB(1, 1), b3 + hstepB, voffB); PG8_STAGE(PG8_SA(1, 0), a3, o2[0]);
      PG8_WAIT_V(8); PG8_WAIT_L(0); PG8_BAR; PG8_MMA(1, 0, At, B0); PG8_MMA(1, 1, At, B1); PG8_BAR; PG8_SCHED;
    }
    if (wr == 0) PG8_BAR;
    E(acc, cur, wr, wc, fr, fq);
    if (!has_next) break;
#pragma unroll
    for (int a = 0; a < 2; ++a)
#pragma unroll
      for (int b = 0; b < 2; ++b)
#pragma unroll
        for (int m = 0; m < 4; ++m)
#pragma unroll
          for (int n = 0; n < 2; ++n) acc[a][b][m][n] = (f32x4){0.f, 0.f, 0.f, 0.f};
    cur = nxt; cA = nA; cB = nB; ++ui;
#pragma unroll
    for (int _h = 0; _h < 2; ++_h)
#pragma unroll
      for (int _i = 0; _i < 2; ++_i) oAc[_h][_i] = oAn[_h][_i];
    if (wr == 1) PG8_BAR;
  }
  PG8_WAIT_V(0);
  PG8_BAR;
#undef PG8_SA
#undef PG8_SB
#undef PG8_STAGE
#undef PG8_LDA
#undef PG8_LDB
#undef PG8_MMA
#undef PG8_WAIT_V
#undef PG8_WAIT_L
#undef PG8_BAR
#undef PG8_SCHED
#undef PG8_OFFS
}
}
using pg8::Unit;
struct EpiU {
  static constexpr bool PERM = true;
  bf16_t* O; int ldc;
  DI void operator()(const f32x4 (&acc)[2][2][4][2], const Unit& u, int wr, int wc, int fr, int fq) const {
    const int row0 = u.pm * 256 + wr * 64 + fr;
#pragma unroll
    for (int ai = 0; ai < 2; ++ai)
#pragma unroll
      for (int m = 0; m < 4; ++m) { bf16_t* rowp = O + (size_t)(row0 + ai * 128 + m * 16) * ldc;
#pragma unroll
        for (int bj = 0; bj < 2; ++bj) { const int col = u.pn * 256 + bj * 128 + wc * 32 + 8 * fq;
          f32x4 v0 = acc[ai][bj][m][0], v1 = acc[ai][bj][m][1];
          if (col >= 1152 && col < 1216) {
#pragma unroll
            for (int j = 0; j < 4; ++j) { v0[j] = tanhf(v0[j]); v1[j] = tanhf(v1[j]); }
          } else if (col >= 1280 && col < 1536) {
#pragma unroll
            for (int j = 0; j < 4; ++j) { v0[j] = sigmoidf_(v0[j]); v1[j] = sigmoidf_(v1[j]); }
          }
          u32x4 w; w.x = cvtpk(v0[0], v0[1]); w.y = cvtpk(v0[2], v0[3]); w.z = cvtpk(v1[0], v1[1]); w.w = cvtpk(v1[2], v1[3]);
          *(u32x4*)(rowp + col) = w; } }
  }
};
struct EpiPlain {
  static constexpr bool PERM = true;
  bf16_t* O; int ldc;
  DI void operator()(const f32x4 (&acc)[2][2][4][2], const Unit& u, int wr, int wc, int fr, int fq) const {
    const int row0 = u.pm * 256 + wr * 64 + fr;
#pragma unroll
    for (int ai = 0; ai < 2; ++ai)
#pragma unroll
      for (int m = 0; m < 4; ++m) { bf16_t* rowp = O + (size_t)(row0 + ai * 128 + m * 16) * ldc;
#pragma unroll
        for (int bj = 0; bj < 2; ++bj) { const int col = u.pn * 256 + bj * 128 + wc * 32 + 8 * fq;
          const f32x4 v0 = acc[ai][bj][m][0], v1 = acc[ai][bj][m][1];
          u32x4 w; w.x = cvtpk(v0[0], v0[1]); w.y = cvtpk(v0[2], v0[3]); w.z = cvtpk(v1[0], v1[1]); w.w = cvtpk(v1[2], v1[3]);
          *(u32x4*)(rowp + col) = w; } }
  }
};
struct EpiLW {
  static constexpr bool PERM = true;
  bf16_t* EW; bf16_t* AS; const float* w0; const float* a0;
  DI void operator()(const f32x4 (&acc)[2][2][4][2], const Unit& u, int wr, int wc, int fr, int fq) const {
    const int row0 = u.pm * 256 + wr * 64 + fr;
    const bool isw = u.pn < 3;
    bf16_t* O = isw ? EW : AS; const float* bias = isw ? w0 : a0; const float sc = isw ? 0.6065306597126334f : 1.f;
    const int cb = (isw ? u.pn : u.pn - 3) * 256;
#pragma unroll
    for (int bj = 0; bj < 2; ++bj) { const int col = cb + bj * 128 + wc * 32 + 8 * fq;
      const f32x4 b0 = *(const f32x4*)(bias + col), b1 = *(const f32x4*)(bias + col + 4);
#pragma unroll
      for (int ai = 0; ai < 2; ++ai)
#pragma unroll
        for (int m = 0; m < 4; ++m) { bf16_t* rowp = O + (size_t)(row0 + ai * 128 + m * 16) * 768;
          f32x4 v0 = acc[ai][bj][m][0] + b0, v1 = acc[ai][bj][m][1] + b1;
#pragma unroll
          for (int j = 0; j < 4; ++j) { v0[j] = sc * sigmoidf_(v0[j]); v1[j] = sc * sigmoidf_(v1[j]); }
          u32x4 w; w.x = cvtpk(v0[0], v0[1]); w.y = cvtpk(v0[2], v0[3]); w.z = cvtpk(v1[0], v1[1]); w.w = cvtpk(v1[2], v1[3]);
          *(u32x4*)(rowp + col) = w; asm volatile("" ::: "memory"); } }
  }
};
struct EpiG {
  static constexpr bool PERM = true;
  bf16_t* G;
  DI void operator()(const f32x4 (&acc)[2][2][4][2], const Unit& u, int wr, int wc, int fr, int fq) const {
    const int row0 = u.pm * 256 + wr * 64 + fr;
#pragma unroll
    for (int bj = 0; bj < 2; ++bj) { const int col = u.pn * 256 + bj * 128 + wc * 32 + 8 * fq;
      if (col < 384) {
#pragma unroll
        for (int ai = 0; ai < 2; ++ai)
#pragma unroll
          for (int m = 0; m < 4; ++m) { bf16_t* rowp = G + (size_t)(row0 + ai * 128 + m * 16) * 384;
            const f32x4 v0 = acc[ai][bj][m][0], v1 = acc[ai][bj][m][1];
            u32x4 w; w.x = cvtpk(v0[0], v0[1]); w.y = cvtpk(v0[2], v0[3]); w.z = cvtpk(v1[0], v1[1]); w.w = cvtpk(v1[2], v1[3]);
            *(u32x4*)(rowp + col) = w; } } }
  }
};
struct EpiQ {
  static constexpr bool PERM = true;
  bf16_t* QB; const float* rstd; const float* rope;
  DI void operator()(const f32x4 (&acc)[2][2][4][2], const Unit& u, int wr, int wc, int fr, int fq) const {
    const int row0 = u.pm * 256 + wr * 64 + fr;
    const int b = (u.pm * 256) / PP;
#pragma unroll
    for (int bj = 0; bj < 2; ++bj) { const int col = u.pn * 256 + bj * 128 + wc * 32 + 8 * fq;
      const int hh = col / 96, dim = col - hh * 96;
      const bool isrope = dim >= 64;
#pragma unroll
      for (int ai = 0; ai < 2; ++ai)
#pragma unroll
        for (int m = 0; m < 4; ++m) { const int g = row0 + ai * 128 + m * 16; const int p = g - b * PP;
          const float s = rstd[g] * QSCALE;
          float v[8];
#pragma unroll
          for (int j = 0; j < 4; ++j) { v[j] = acc[ai][bj][m][0][j] * s; v[4 + j] = acc[ai][bj][m][1][j] * s; }
          if (isrope) {
            float o[8];
#pragma unroll
            for (int j = 0; j < 8; ++j) o[j] = swz_xor16(v[j]);
            if (p >= CTX) { const int li = p - CTX; const int pos = (fq & 2) ? (li & 63) : (li >> 6);
              const f32x2* rp = (const f32x2*)rope + pos * 8;
#pragma unroll
              for (int j = 0; j < 8; ++j) { const f32x2 cs = rp[j]; v[j] = (fq & 1) ? (v[j] * cs.x + o[j] * cs.y) : (v[j] * cs.x - o[j] * cs.y); } }
          }
          if (col < 576) { u32x4 w; w.x = cvtpk(v[0], v[1]); w.y = cvtpk(v[2], v[3]); w.z = cvtpk(v[4], v[5]); w.w = cvtpk(v[6], v[7]);
            *(u32x4*)(QB + ((size_t)(b * NH + hh) * PP + p) * 96 + dim) = w; }
          asm volatile("" ::: "memory"); }
    }
  }
};
DI int vperm(int p) { const int q = p & 15; return (p & ~15) | (((q >> 2) & 1) << 3) | ((q >> 3) << 2) | (q & 3); }
struct EpiKV {
  static constexpr bool PERM = true;
  bf16_t* KB; bf16_t* VT; const float* rstd;
  DI void operator()(const f32x4 (&acc)[2][2][4][2], const Unit& u, int wr, int wc, int fr, int fq) const {
    const int row0 = u.pm * 256 + wr * 64 + fr;
    const int b = (u.pm * 256) / PP;
#pragma unroll
    for (int bj = 0; bj < 2; ++bj) { const int col = u.pn * 256 + bj * 128 + wc * 32 + 8 * fq;
      const int hh = col >> 7, j0 = col & 127;
#pragma unroll
      for (int ai = 0; ai < 2; ++ai)
#pragma unroll
        for (int m = 0; m < 4; ++m) { const int g = row0 + ai * 128 + m * 16; const int p = g - b * PP;
          const float s = rstd[g];
          float v[8];
#pragma unroll
          for (int j = 0; j < 4; ++j) { v[j] = acc[ai][bj][m][0][j] * s; v[4 + j] = acc[ai][bj][m][1][j] * s; }
          if (j0 < 64) { u32x4 w; w.x = cvtpk(v[0], v[1]); w.y = cvtpk(v[2], v[3]); w.z = cvtpk(v[4], v[5]); w.w = cvtpk(v[6], v[7]);
            *(u32x4*)(KB + ((size_t)(b * NH + hh) * PP + p) * 96 + j0) = w; }
          else { bf16_t* vt = VT + ((size_t)(b * NH + hh) * 64 + (j0 - 64)) * PP + vperm(p);
#pragma unroll
            for (int j = 0; j < 8; ++j) vt[(size_t)j * PP] = f2bf(v[j]); }
          asm volatile("" ::: "memory"); }
    }
  }
};
struct EpiMoe1 {
  static constexpr bool PERM = false;
  bf16_t* HID;
  DI void operator()(const f32x4 (&acc)[2][2][4][2], const Unit& u, int wr, int wc, int fr, int fq) const {
    const int row0 = u.pm * 256 + wr * 64 + fr; const int pnl = u.pn & 7;
#pragma unroll
    for (int ai = 0; ai < 2; ++ai)
#pragma unroll
      for (int m = 0; m < 4; ++m) { bf16_t* rowp = HID + (size_t)(row0 + ai * 128 + m * 16) * 1024 + pnl * 128 + wc * 32 + 4 * fq;
#pragma unroll
        for (int n = 0; n < 2; ++n) { const f32x4 gv = acc[ai][0][m][n], uv = acc[ai][1][m][n]; float h[4];
#pragma unroll
          for (int j = 0; j < 4; ++j) h[j] = gv[j] * sigmoidf_(gv[j]) * uv[j];
          u32x2 w; w.x = cvtpk(h[0], h[1]); w.y = cvtpk(h[2], h[3]);
          *(u32x2*)(rowp + 16 * n) = w; } }
  }
};
struct EpiMoe2 {
  static constexpr bool PERM = true;
  bf16_t* O;
  DI void operator()(const f32x4 (&acc)[2][2][4][2], const Unit& u, int wr, int wc, int fr, int fq) const {
    const int row0 = u.pm * 256 + wr * 64 + fr; const int pnl = u.pn & 3;
#pragma unroll
    for (int ai = 0; ai < 2; ++ai)
#pragma unroll
      for (int m = 0; m < 4; ++m) { bf16_t* rowp = O + (size_t)(row0 + ai * 128 + m * 16) * 1024;
#pragma unroll
        for (int bj = 0; bj < 2; ++bj) { const int col = pnl * 256 + bj * 128 + wc * 32 + 8 * fq;
          const f32x4 v0 = acc[ai][bj][m][0], v1 = acc[ai][bj][m][1];
          u32x4 w; w.x = cvtpk(v0[0], v0[1]); w.y = cvtpk(v0[2], v0[3]); w.z = cvtpk(v1[0], v1[1]); w.w = cvtpk(v1[2], v1[3]);
          *(u32x4*)(rowp + col) = w; } }
  }
};
template <bool GATH> struct MoeOrder {
  static constexpr bool GATHER = GATH;
  int tpe, nN, nwg, G, c; const int* idx;
  __device__ void init(int tpe_, int nN_, int G_, int c_, const int* idx_) { tpe = tpe_; nN = nN_; nwg = NEXP * tpe * nN; G = G_; c = c_; idx = idx_; }
  __device__ bool next(int i, Unit& u) const {
    const long L = (long)i * G + c; if (L >= nwg) return false;
    const int per = tpe * nN, e = (int)L / per, rem = (int)L % per, pnl = rem / tpe, pml = rem % tpe;
    u.pm = e * 17 + pml; u.pn = e * nN + pnl; return true;
  }
  __device__ int arow(const Unit& u, int r) const { return idx[u.pm * 256 + r]; }
};
constexpr size_t MiB = (size_t)1 << 20;
constexpr size_t WS_CTL = 0;
constexpr size_t WS_MODP = 1 * MiB;
constexpr size_t WS_MOD = 3 * MiB;
constexpr size_t WS_TW = 3 * MiB + 256 * 1024;
constexpr size_t WS_ROPE = 3 * MiB + 384 * 1024;
constexpr size_t WS_RSTD = 3 * MiB + 512 * 1024;
constexpr size_t WS_WIN = 4 * MiB;
constexpr size_t WS_WOUT = 13 * MiB;
constexpr size_t WS_WLW = 17 * MiB;
constexpr size_t WS_WG = 18 * MiB;
constexpr size_t WS_WQ = 19 * MiB;
constexpr size_t WS_WKV = 20 * MiB;
constexpr size_t WS_AFF = 21 * MiB;
constexpr size_t WS_IDX = 24 * MiB;
constexpr size_t WS_SLOT = 29 * MiB;
constexpr size_t WS_XCTX = 25 * MiB;
constexpr size_t WS_R1 = 36 * MiB;
constexpr size_t WS_R2 = 192 * MiB;
constexpr size_t WS_R3 = 292 * MiB;
constexpr size_t WS_R4 = 416 * MiB;
constexpr size_t WS_R5 = 452 * MiB;
constexpr size_t WS_R6 = 502 * MiB;
constexpr size_t WS_HID = 416 * MiB;
constexpr size_t WS_END = 568 * MiB;

struct Params {
  const float* in[32];
  float* out; unsigned char* ws;
};

typedef const float* cfptr;
struct Ctx {
  const __attribute__((address_space(4))) cfptr* in; float* out; unsigned char* ws;
  LAS unsigned char* lds; unsigned char* ldsg;
  int tid, lane, wave, G, bid;
};

#define GAS __attribute__((address_space(1)))
DI const float* inp(const Ctx& C, int k) { return (const float*)(const GAS float*)C.in[k]; }
DI const float* in_row(const Ctx& C, int g) { const int b = g / PP, p = g - b * PP; return p < CTX ? inp(C, 2) + ((size_t)b * CTX + p) * DM : inp(C, 0) + ((size_t)b * SEQ + (p - CTX)) * DM; }
DI float* xs_row(const Ctx& C, int g) { const int b = g / PP, p = g - b * PP; return p < CTX ? (float*)(C.ws + WS_XCTX) + ((size_t)b * CTX + p) * DM : C.out + ((size_t)b * SEQ + (p - CTX)) * DM; }
DI int mod_row(int g) { const int b = g / PP, p = g - b * PP; return p < CTX ? 4 : b; }
DI const float* modv(const Ctx& C, int l, int r, int j) { return (const float*)(C.ws + WS_MOD) + ((size_t)(l * 5 + r) * 6 + j) * DM; }

template <class RowMap>
DI void transpose_item(const float* W, int K, int N, bf16_t* WT, int ldk, LAS float* scr, int item, int lane, const RowMap& rm) {
  const int nblk = N / 32, kb = item / nblk, nb = item % nblk, k0 = 64 * kb, n0 = 32 * nb;
#pragma unroll 8
  for (int i = 0; i < 32; ++i) { const int kk = 2 * i + (lane >> 5); scr[kk * 33 + (lane & 31)] = W[(size_t)(k0 + kk) * N + n0 + (lane & 31)]; }
  asm volatile("s_waitcnt lgkmcnt(0)" ::: "memory");
  const int c = lane & 7;
#pragma unroll
  for (int j = 0; j < 4; ++j) { const int n = (lane >> 3) + 8 * j; const LAS float* s = scr + (8 * c) * 33 + n;
    u32x4 o; o.x = cvtpk(s[0 * 33], s[1 * 33]); o.y = cvtpk(s[2 * 33], s[3 * 33]); o.z = cvtpk(s[4 * 33], s[5 * 33]); o.w = cvtpk(s[6 * 33], s[7 * 33]);
    const int r = rm(n0 + n);
    if (r >= 0) *(u32x4*)(WT + (size_t)r * ldk + k0 + 8 * c) = o; }
  asm volatile("s_waitcnt lgkmcnt(0)" ::: "memory");
}
struct MapIn { DI int operator()(int n) const { return n < 1440 ? n : (n < 1856 ? n + 96 : n + 192); } };
struct MapId { DI int operator()(int n) const { return n; } };
struct MapGate { int up; DI int operator()(int f) const { return 256 * (f >> 7) + 128 * up + (f & 127); } };

DI void phase0(const Ctx& C) {
  const int gw = C.bid * NWAVES + C.wave, NGW = C.G * NWAVES;
  const int gt = C.bid * NTHREADS + C.tid, NGT = C.G * NTHREADS;
  LAS float* scr = (LAS float*)(C.lds + C.wave * 16384);
  {
    const float* cin = inp(C, 1); const float* cctx = inp(C, 3);
    for (int it = gw; it < 2 * 96 * 8; it += NGW) {
      const int l = it / 768, r_ = it % 768, cc = r_ / 8, kc = r_ % 8;
      const float* W = inp(C, 4) + (size_t)l * DM * 6144 + (size_t)(kc * 128) * 6144 + cc * 64 + C.lane;
      float a0 = 0.f, a1 = 0.f, a2 = 0.f, a3 = 0.f, a4 = 0.f;
#pragma unroll 8
      for (int k = 0; k < 128; ++k) { const float w = W[(size_t)k * 6144]; const int kk = kc * 128 + k;
        const float c0 = cin[kk], c1 = cin[DM + kk], c2 = cin[2 * DM + kk], c3 = cin[3 * DM + kk], c4 = cctx[kk];
        a0 += c0 * sigmoidf_(c0) * w; a1 += c1 * sigmoidf_(c1) * w; a2 += c2 * sigmoidf_(c2) * w; a3 += c3 * sigmoidf_(c3) * w; a4 += c4 * sigmoidf_(c4) * w; }
      float* P = (float*)(C.ws + WS_MODP) + ((size_t)(l * 8 + kc) * 5) * 6144 + cc * 64 + C.lane;
      P[0] = a0; P[6144] = a1; P[2 * 6144] = a2; P[3 * 6144] = a3; P[4 * 6144] = a4;
    }
  }
  for (int l = 0; l < 2; ++l) {
    bf16_t* WT = (bf16_t*)(C.ws + WS_WIN) + (size_t)l * UW * DM;
    for (int i = gt; i < 192 * DM / 8; i += NGT) { const int r = i / (DM / 8), c8 = i % (DM / 8); const int row = r < 96 ? 1440 + r : 1952 + (r - 96);
      *(u32x4*)(WT + (size_t)row * DM + c8 * 8) = (u32x4){0u, 0u, 0u, 0u}; }
    for (int it = gw; it < 16 * 66; it += NGW) transpose_item(inp(C, 10) + (size_t)l * DM * 2112, DM, 2112, WT, DM, scr, it, C.lane, MapIn());
    bf16_t* WO = (bf16_t*)(C.ws + WS_WOUT) + (size_t)l * DM * DM;
    for (int it = gw; it < 12 * 32; it += NGW) transpose_item(inp(C, 11) + (size_t)l * DM * DM, 768, DM, WO, DM, scr, it, C.lane, MapId());
    const float* wf = inp(C, 27) + (size_t)l * 256 * 256; const float* wo = inp(C, 11) + (size_t)l * DM * DM + (size_t)768 * DM;
    for (int it = gw; it < 64 * 16; it += NGW) { const int kq = it / 16, nc = it % 16; const int n = nc * 64 + C.lane;
      float a0 = 0.f, a1 = 0.f, a2 = 0.f, a3 = 0.f;
#pragma unroll 4
      for (int j = 0; j < 256; ++j) { const float w = wo[(size_t)j * DM + n];
        a0 += wf[(kq * 4 + 0) * 256 + j] * w; a1 += wf[(kq * 4 + 1) * 256 + j] * w; a2 += wf[(kq * 4 + 2) * 256 + j] * w; a3 += wf[(kq * 4 + 3) * 256 + j] * w; }
      u32x2 o; o.x = cvtpk(a0, a1); o.y = cvtpk(a2, a3);
      *(u32x2*)(WO + (size_t)n * DM + 768 + kq * 4) = o; }
    bf16_t* WLW = (bf16_t*)(C.ws + WS_WLW) + (size_t)l * 1536 * 128;
    for (int i = gt; i < 1536 * 128; i += NGT) { const int n = i / 128, k = i % 128; float v = 0.f;
      if (n < 768) { if (k < 64) v = inp(C, 14)[((size_t)(l * 2 + n / 384) * 64 + k) * 384 + n % 384]; }
      else { const int n2 = n - 768; if (k >= 64) v = inp(C, 16)[((size_t)(l * 2 + n2 / 384) * 64 + (k - 64)) * 384 + n2 % 384]; }
      WLW[i] = f2bf(v); }
    bf16_t* WG = (bf16_t*)(C.ws + WS_WG) + (size_t)l * 512 * 256;
    for (int i = gt; i < 512 * 256; i += NGT) { const int n = i / 256, k = i % 256; float v = 0.f;
      if (n < 384 && k < 160) v = inp(C, 17)[((size_t)l * 160 + k) * 384 + n];
      WG[i] = f2bf(v); }
    bf16_t* WQ = (bf16_t*)(C.ws + WS_WQ) + (size_t)l * 768 * 256;
    for (int i = gt; i < 768 * 256; i += NGT) { const int n = i / 256, k = i % 256; float v = 0.f;
      if (n < 576) v = inp(C, 23)[l * 256 + k] * inp(C, 24)[((size_t)l * 256 + k) * 576 + n];
      WQ[i] = f2bf(v); }
    bf16_t* WKV = (bf16_t*)(C.ws + WS_WKV) + (size_t)l * 768 * 128;
    for (int i = gt; i < 768 * 128; i += NGT) { const int n = i / 128, k = i % 128;
      WKV[i] = f2bf(inp(C, 25)[l * 128 + k] * inp(C, 26)[((size_t)l * 128 + k) * 768 + n]); }
  }
  for (int i = gt; i < 8192; i += NGT) { float s, c; sincospif((float)i * (2.0f / 8192.0f), &s, &c); ((f32x2*)(C.ws + WS_TW))[i] = (f32x2){c, -s}; }
  for (int i = gt; i < 128 * 8; i += NGT) { const int pos = i / 8, j = i % 8; const float inv = powf(10000.0f, -(float)j / 8.0f); float s, c; sincosf((float)pos * inv, &s, &c); ((f32x2*)(C.ws + WS_ROPE))[i] = (f32x2){c, s}; }
}
DI void phase0b(const Ctx& C) {
  const int gt = C.bid * NTHREADS + C.tid, NGT = C.G * NTHREADS;
  for (int i = gt; i < 2 * 5 * 6144; i += NGT) { const int l = i / (5 * 6144), r = (i / 6144) % 5, n = i % 6144;
    float s = inp(C, 5)[l * 6144 + n];
#pragma unroll
    for (int kc = 0; kc < 8; ++kc) s += ((const float*)(C.ws + WS_MODP))[((size_t)(l * 8 + kc) * 5 + r) * 6144 + n];
    ((float*)(C.ws + WS_MOD))[i] = s; }
}

DI void convert_experts(const Ctx& C, int l, int first_item, int stride_items) {
  LAS float* scr = (LAS float*)(C.lds + C.wave * 16384);
  bf16_t* WGU = (bf16_t*)(C.ws + WS_R3); bf16_t* WDN = WGU + (size_t)NEXP * 2048 * 1024;
  for (int it = first_item; it < NEXP * 3 * 512; it += stride_items) { const int e = it / 1536, r = it % 1536, mat = r / 512, sub = r % 512;
    const size_t woff = ((size_t)l * NEXP + e) * 1024 * 1024;
    if (mat == 0) transpose_item(inp(C, 29) + woff, 1024, 1024, WGU + (size_t)e * 2048 * 1024, 1024, scr, sub, C.lane, MapGate{0});
    else if (mat == 1) transpose_item(inp(C, 30) + woff, 1024, 1024, WGU + (size_t)e * 2048 * 1024, 1024, scr, sub, C.lane, MapGate{1});
    else transpose_item(inp(C, 31) + woff, 1024, 1024, WDN + (size_t)e * 1024 * 1024, 1024, scr, sub, C.lane, MapId()); }
}

DI void norm_pass(const Ctx& C, int mode, int l, int lp) {
  const int gw = C.bid * NWAVES + C.wave, NGW = C.G * NWAVES, lane = C.lane;
  bf16_t* XN = (bf16_t*)(C.ws + WS_R2); const bf16_t* DOWN = (const bf16_t*)(C.ws + WS_R1); const int* SLOT = (const int*)(C.ws + WS_SLOT); const float* AFF = (const float*)(C.ws + WS_AFF);
  for (int g = gw; g < TT; g += NGW) {
    const int mr = mod_row(g); const bool isctx = (mr == 4);
    if (mode == 2 && isctx) continue;
    f32x4 v[4];
    if (mode == 0) { const f32x4* xr = (const f32x4*)in_row(C, g) + lane;
#pragma unroll
      for (int j = 0; j < 4; ++j) v[j] = xr[64 * j]; }
    else { f32x4* xr = (f32x4*)xs_row(C, g) + lane;
      f32x4 y[4]; float s = 0.f;
      const int myslot = lane < 16 ? SLOT[(size_t)g * 16 + lane] : -1; const float myaff = lane < 16 ? AFF[(size_t)g * 16 + lane] : 0.f;
#pragma unroll
      for (int j = 0; j < 4; ++j) { v[j] = xr[64 * j]; y[j] = (f32x4){0.f, 0.f, 0.f, 0.f}; }
      for (int e = 0; e < 16; ++e) { const int sl = __builtin_amdgcn_readlane(myslot, e);
        if (sl >= 0) { const float a = rdlane(myaff, e); const u32x2* dr = (const u32x2*)(DOWN + (size_t)sl * DM) + lane;
#pragma unroll
          for (int j = 0; j < 4; ++j) { const u32x2 w = dr[64 * j]; y[j] = y[j] + (f32x4){bflo(w.x), bfhi(w.x), bflo(w.y), bfhi(w.y)} * a; } } }
#pragma unroll
      for (int j = 0; j < 4; ++j) s += (y[j].x * y[j].x + y[j].y * y[j].y) + (y[j].z * y[j].z + y[j].w * y[j].w);
      const float rstd = rsqrtf(wave_sum(s) * (1.f / DM) + NORM_EPS);
      const f32x4* m5 = (const f32x4*)modv(C, lp, mr, 5) + lane; const f32x4* gp = (const f32x4*)(inp(C, 9) + lp * DM) + lane;
#pragma unroll
      for (int j = 0; j < 4; ++j) { v[j] = v[j] + m5[64 * j] * (y[j] * rstd * gp[64 * j]); xr[64 * j] = v[j]; }
      if (mode == 2) continue; }
    float s = 0.f;
#pragma unroll
    for (int j = 0; j < 4; ++j) s += (v[j].x * v[j].x + v[j].y * v[j].y) + (v[j].z * v[j].z + v[j].w * v[j].w);
    const float rstd = rsqrtf(wave_sum(s) * (1.f / DM) + NORM_EPS);
    const f32x4* m0 = (const f32x4*)modv(C, l, mr, 0) + lane; const f32x4* m1 = (const f32x4*)modv(C, l, mr, 1) + lane; const f32x4* gp = (const f32x4*)(inp(C, 6) + l * DM) + lane;
    u32x2* o = (u32x2*)(XN + (size_t)g * DM) + lane;
#pragma unroll
    for (int j = 0; j < 4; ++j) { const f32x4 t = v[j] * rstd * gp[64 * j] * (m1[64 * j] + 1.0f) + m0[64 * j]; u32x2 w; w.x = cvtpk(t.x, t.y); w.y = cvtpk(t.z, t.w); o[64 * j] = w; }
  }
}

DI void prep_a(const Ctx& C, int l) {
  const bf16_t* U = (const bf16_t*)(C.ws + WS_R1);
  float* rq = (float*)(C.ws + WS_RSTD); float* rkv = rq + TT;
  bf16_t* KB = (bf16_t*)(C.ws + WS_R2) + (size_t)NB * NH * PP * 96;
  const f32x2* rope = (const f32x2*)(C.ws + WS_ROPE);
  const int lane = C.lane;
  LAS float* zrow = (LAS float*)(C.lds + C.wave * 1024);
  LAS f32x2* stage = (LAS f32x2*)(C.lds + 16384);
  LAS f32x2* tw64 = (LAS f32x2*)(C.lds + 16384 + 132 * 64 * 8);
  if (C.tid < 64) { float s, c; sincospif((float)C.tid * (2.0f / 64.0f), &s, &c); tw64[C.tid] = (f32x2){c, s}; }
  __syncthreads();
  for (int tile = C.bid; tile < TT / 64; tile += C.G) {
    const int g0 = tile * 64; const int b = g0 / PP, p0 = g0 - b * PP;
    for (int i = 0; i < 8; ++i) { const int tl = C.wave * 8 + i; const int g = g0 + tl; const int p = p0 + tl;
      const bf16_t* ur = U + (size_t)g * UW;
      { const u32x2 w = *((const u32x2*)(ur + 1536) + lane); const float a0 = bflo(w.x), a1 = bfhi(w.x), a2 = bflo(w.y), a3 = bfhi(w.y);
        const float s = wave_sum(a0 * a0 + a1 * a1 + a2 * a2 + a3 * a3); if (lane == 0) rq[g] = rsqrtf(s * (1.f / 256.f) + NORM_EPS); }
      { const unsigned w = *((const unsigned*)(ur + 1792) + lane); const float a0 = bflo(w), a1 = bfhi(w);
        const float s = wave_sum(a0 * a0 + a1 * a1); if (lane == 0) rkv[g] = rsqrtf(s * (1.f / 128.f) + NORM_EPS); }
      { float x = lane < 32 ? bf2f(ur[1920 + lane]) : 0.f; const float o = swz_xor8(x);
        if (p >= CTX && lane < 32) { const int li = p - CTX; const int pos = (lane & 16) ? (li & 63) : (li >> 6); const f32x2 cs = rope[pos * 8 + (lane & 7)];
          x = (lane & 8) ? (x * cs.x + o * cs.y) : (x * cs.x - o * cs.y); }
        if (lane < 32) { const bf16_t xb = f2bf(x);
#pragma unroll
          for (int hh = 0; hh < NH; ++hh) KB[((size_t)(b * NH + hh) * PP + p) * 96 + 64 + lane] = xb; } }
      { const u32x2 w = *((const u32x2*)(ur + 2048) + lane); *(LAS f32x4*)(zrow + lane * 4) = (f32x4){bflo(w.x), bfhi(w.x), bflo(w.y), bfhi(w.y)}; }
      asm volatile("s_waitcnt lgkmcnt(0)" ::: "memory");
      { const int grp = lane >> 4, kq = lane & 15; const LAS float* z = zrow + grp * 64;
        float c0 = 0.f, s0 = 0.f, c1 = 0.f, s1 = 0.f, c2 = 0.f;
#pragma unroll 8
        for (int n = 0; n < 64; ++n) { const float zv = z[n]; const f32x2 t0 = tw64[(kq * n) & 63], t1 = tw64[((kq + 16) * n) & 63];
          c0 += zv * t0.x; s0 += zv * t0.y; c1 += zv * t1.x; s1 += zv * t1.y; c2 += (n & 1) ? -zv : zv; }
        stage[(grp * 33 + kq) * 64 + tl] = (f32x2){c0, -s0}; stage[(grp * 33 + kq + 16) * 64 + tl] = (f32x2){c1, -s1};
        if (kq == 0) stage[(grp * 33 + 32) * 64 + tl] = (f32x2){c2, 0.f}; }
      asm volatile("s_waitcnt lgkmcnt(0)" ::: "memory");
    }
    __syncthreads();
    f32x2* ZT = (f32x2*)(C.ws + WS_R4);
    for (int i = C.tid; i < 132 * 64; i += NTHREADS) { const int r = i >> 6, t = i & 63; ZT[((size_t)b * 132 + r) * PP + p0 + t] = stage[i]; }
    __syncthreads();
  }
}

DI void post_pass(const Ctx& C, int l, bool with_ctx) {
  const int gw = C.bid * NWAVES + C.wave, NGW = C.G * NWAVES, lane = C.lane;
  const bf16_t* U = (const bf16_t*)(C.ws + WS_R1);
  const bf16_t* AS = (const bf16_t*)(C.ws + WS_R3) + (size_t)TT * 768; const bf16_t* Gt = AS + (size_t)TT * 768;
  const bf16_t* Y0 = (const bf16_t*)(C.ws + WS_R5); const bf16_t* Y1 = Y0 + (size_t)TT * 384;
  bf16_t* MC = (bf16_t*)(C.ws + WS_R6);
  const float* cw = inp(C, 12) + (size_t)l * 3 * 1152; const float* k_a = inp(C, 19) + l * 384; const float* r_k = inp(C, 20) + l * 384;
  const float* lw = inp(C, 21) + l * 384; const float* lb = inp(C, 22) + l * 384;
  for (int g = gw; g < TT; g += NGW) {
    const int b = g / PP, p = g - b * PP; if (p < CTX && !with_ctx) continue;
    const float ml = (p != 0 && p != CTX) ? 1.f : 0.f, mr = (p != CTX - 1 && p != PP - 1) ? 1.f : 0.f;
    const bf16_t* u0 = U + (size_t)g * UW; const bf16_t* ul = ml != 0.f ? u0 - UW : u0; const bf16_t* ur_ = mr != 0.f ? u0 + UW : u0;
    unsigned short xu[6][3][3], y0[6], y1[6], a0[6], a1[6], gg[6];
#pragma unroll
    for (int hh = 0; hh < NH; ++hh) { const int c = hh * 64 + lane;
#pragma unroll
      for (int q = 0; q < 3; ++q) { xu[hh][q][0] = ul[q * 384 + c]; xu[hh][q][1] = u0[q * 384 + c]; xu[hh][q][2] = ur_[q * 384 + c]; }
      y0[hh] = Y0[(size_t)g * 384 + c]; y1[hh] = Y1[(size_t)g * 384 + c]; a0[hh] = AS[(size_t)g * 768 + c]; a1[hh] = AS[(size_t)g * 768 + 384 + c]; gg[hh] = Gt[(size_t)g * 384 + c]; }
#pragma unroll
    for (int hh = 0; hh < NH; ++hh) { const int c = hh * 64 + lane;
      float rkv[3];
#pragma unroll
      for (int q = 0; q < 3; ++q) { const int col = q * 384 + c; rkv[q] = bf2f(xu[hh][q][1]) * cw[1152 + col] + ml * bf2f(xu[hh][q][0]) * cw[col] + mr * bf2f(xu[hh][q][2]) * cw[2 * 1152 + col]; }
      const float y = bf2f(y0[hh]) + bf2f(y1[hh]);
      const float mu = wave_sum(y) * (1.f / 64.f); const float dv = y - mu; const float var = wave_sum(dv * dv) * (1.f / 64.f);
      const float yn = dv * rsqrtf(var + GN_EPS) * lw[c] + lb[c];
      const float al0 = bf2f(a0[hh]), al1 = bf2f(a1[hh]); const float ka = k_a[c];
      const float kd0 = rkv[1] * (1.f + (al0 - 1.f) * ka), kd1 = rkv[1] * (1.f + (al1 - 1.f) * ka);
      const float bonus = wave_sum(rkv[0] * (kd0 + kd1) * r_k[c]);
      const float o = (yn + bonus * rkv[2]) * bf2f(gg[hh]);
      MC[(size_t)g * DM + c] = f2bf(o); }
  }
}

DI void n2_pass(const Ctx& C, int l, bool with_ctx) {
  const int gw = C.bid * NWAVES + C.wave, NGW = C.G * NWAVES, lane = C.lane;
  const bf16_t* O = (const bf16_t*)(C.ws + WS_R1); bf16_t* TN = (bf16_t*)(C.ws + WS_R2); float* AFF = (float*)(C.ws + WS_AFF); int* SLOT = (int*)(C.ws + WS_SLOT);
  LAS float* wr = (LAS float*)C.lds; const float* wrg = inp(C, 28) + (size_t)l * DM * NEXP;
  for (int i = C.tid; i < DM * NEXP; i += NTHREADS) wr[(i & 15) * DM + (i >> 4)] = wrg[i];
  __syncthreads();
  for (int g = gw; g < TT; g += NGW) {
    const int mr = mod_row(g); if (mr == 4 && !with_ctx) continue;
    f32x4 v[4], o[4]; float s = 0.f;
    const f32x4* xr = (const f32x4*)(l == 0 ? in_row(C, g) : xs_row(C, g)) + lane; const u32x2* orow = (const u32x2*)(O + (size_t)g * DM) + lane;
#pragma unroll
    for (int j = 0; j < 4; ++j) { v[j] = xr[64 * j]; const u32x2 w = orow[64 * j]; o[j] = (f32x4){bflo(w.x), bfhi(w.x), bflo(w.y), bfhi(w.y)};
      s += (o[j].x * o[j].x + o[j].y * o[j].y) + (o[j].z * o[j].z + o[j].w * o[j].w); }
    float rstd = rsqrtf(wave_sum(s) * (1.f / DM) + NORM_EPS);
    { const f32x4* m2 = (const f32x4*)modv(C, l, mr, 2) + lane; const f32x4* gp = (const f32x4*)(inp(C, 7) + l * DM) + lane; f32x4* xo = (f32x4*)xs_row(C, g) + lane;
      s = 0.f;
#pragma unroll
      for (int j = 0; j < 4; ++j) { v[j] = v[j] + m2[64 * j] * (o[j] * rstd * gp[64 * j]); xo[64 * j] = v[j]; s += (v[j].x * v[j].x + v[j].y * v[j].y) + (v[j].z * v[j].z + v[j].w * v[j].w); } }
    rstd = rsqrtf(wave_sum(s) * (1.f / DM) + NORM_EPS);
    const f32x4* m3 = (const f32x4*)modv(C, l, mr, 3) + lane; const f32x4* m4 = (const f32x4*)modv(C, l, mr, 4) + lane; const f32x4* gp = (const f32x4*)(inp(C, 8) + l * DM) + lane;
    u32x2* to = (u32x2*)(TN + (size_t)g * DM) + lane;
    float lg[16];
#pragma unroll
    for (int e = 0; e < 16; ++e) lg[e] = 0.f;
#pragma unroll
    for (int j = 0; j < 4; ++j) { const f32x4 t = v[j] * rstd * gp[64 * j] * (m4[64 * j] + 1.0f) + m3[64 * j]; u32x2 w; w.x = cvtpk(t.x, t.y); w.y = cvtpk(t.z, t.w); to[64 * j] = w;
#pragma unroll
      for (int e = 0; e < 16; ++e) { const f32x4 ww = *(const LAS f32x4*)(wr + e * DM + 256 * j + 4 * lane); lg[e] += (t.x * ww.x + t.y * ww.y) + (t.z * ww.z + t.w * ww.w); if ((e & 3) == 3) asm volatile("" ::: "memory"); } }
    float mx = -1e30f;
#pragma unroll
    for (int e = 0; e < 16; ++e) { lg[e] = wave_sum(lg[e]); mx = fmaxf(mx, lg[e]); }
    float den = 0.f;
#pragma unroll
    for (int e = 0; e < 16; ++e) { lg[e] = __expf(lg[e] - mx); den += lg[e]; }
    const float inv = 1.f / den;
    float mine = 0.f;
#pragma unroll
    for (int e = 0; e < 16; ++e) mine = (lane == e) ? lg[e] * inv : mine;
    if (lane < 16) { AFF[(size_t)g * 16 + lane] = mine; SLOT[(size_t)g * 16 + lane] = -1; }
  }
  __syncthreads();
}

DI void topk_problem(const Ctx& C, int q) {
  const bool isctx = q >= 64; const int qq = q & 63, b = qq >> 4, e = qq & 15;
  const int n = isctx ? CTX : SEQ, cap = isctx ? 32 : 1024; const int g0 = b * PP + (isctx ? 0 : CTX);
  const float* AFF = (const float*)(C.ws + WS_AFF);
  int* IDX = (int*)(C.ws + WS_IDX); int* SLOT = (int*)(C.ws + WS_SLOT);
  const int obase = e * RPE + (isctx ? 4096 + b * 32 : b * 1024);
  LAS unsigned* keys = (LAS unsigned*)C.lds; LAS unsigned* hist = keys + 8192; LAS unsigned* ctl = hist + 256;
  for (int i = C.tid; i < n; i += NTHREADS) keys[i] = __float_as_uint(AFF[(size_t)(g0 + i) * 16 + e]);
  if (C.tid == 0) { ctl[0] = 0u; ctl[1] = (unsigned)cap; ctl[2] = 0u; ctl[3] = 0u; }
  unsigned mask = 0u;
  for (int pass = 0; pass < 4; ++pass) { const int shift = 24 - 8 * pass;
    if (C.tid < 256) hist[C.tid] = 0u;
    __syncthreads();
    const unsigned prefix = ctl[0];
    for (int i = C.tid; i < n; i += NTHREADS) { const unsigned k = keys[i]; if ((k & mask) == prefix) atomicAdd((unsigned*)&hist[(k >> shift) & 255u], 1u); }
    __syncthreads();
    if (C.tid == 0) { unsigned rem = ctl[1], cum = 0u; int bin = 255;
      for (; bin > 0; --bin) { const unsigned h = hist[bin]; if (cum + h >= rem) break; cum += h; }
      ctl[0] = prefix | ((unsigned)bin << shift); ctl[1] = rem - cum; }
    mask |= 255u << shift;
    __syncthreads();
  }
  const unsigned thr = ctl[0], need_eq = ctl[1];
  for (int i = C.tid; i < n; i += NTHREADS) { const unsigned k = keys[i];
    int slot = -1;
    if (k > thr) slot = (int)atomicAdd((unsigned*)&ctl[2], 1u);
    else if (k == thr) { const unsigned t = atomicAdd((unsigned*)&ctl[3], 1u); if (t < need_eq) slot = cap - (int)need_eq + (int)t; }
    if (slot >= 0) { IDX[obase + slot] = g0 + i; SLOT[(size_t)(g0 + i) * 16 + e] = obase + slot; } }
  __syncthreads();
}
#define MFMA32(a, b, c) __builtin_amdgcn_mfma_f32_32x32x16_bf16((a), (b), (c), 0, 0, 0)
constexpr int AT_KROW = 208, AT_VROW = 144, AT_KBUF = 64 * AT_KROW, AT_VBUF = 64 * AT_VROW;
constexpr int AT_K0 = 0, AT_V0 = 2 * AT_KBUF, AT_OST = AT_V0 + 2 * AT_VBUF, AT_OROW = 144;
constexpr float AT_THR = 8.0f;

DI void attn_unit(const Ctx& C, int b, int h, int pq0, int nkt) {
  const bf16_t* QB = (const bf16_t*)(C.ws + WS_R2); const bf16_t* KBp = QB + (size_t)NB * NH * PP * 96; const bf16_t* VTp = KBp + (size_t)NB * NH * PP * 96;
  const bf16_t* Qh = QB + (size_t)(b * NH + h) * PP * 96; const bf16_t* Kh = KBp + (size_t)(b * NH + h) * PP * 96; const bf16_t* Vh = VTp + (size_t)(b * NH + h) * 64 * PP;
  bf16_t* MC = (bf16_t*)(C.ws + WS_R6);
  const int tid = C.tid, lane = C.lane, wave = C.wave, r32 = lane & 31, hi = lane >> 5;
  LAS unsigned char* lds = C.lds;
  bf16x8 qf[6];
  { const bf16_t* qrow = Qh + (size_t)(pq0 + wave * 32 + r32) * 96 + hi * 8;
#pragma unroll
    for (int d0 = 0; d0 < 6; ++d0) qf[d0] = *(const bf16x8*)(qrow + d0 * 16); }
  const int k0row = tid / 12, k0c = tid % 12, k1row = (tid + 512) / 12, k1c = (tid + 512) % 12;
  const unsigned k0dst = k0row * AT_KROW + k0c * 16, k1dst = k1row * AT_KROW + k1c * 16, vdst = (tid >> 3) * AT_VROW + (tid & 7) * 16;
  const bf16_t* vsrc = Vh + (size_t)(tid >> 3) * PP + (tid & 7) * 8;
  u32x4 sk0, sk1 = (u32x4){0u, 0u, 0u, 0u}, sv;
#define AT_LOAD(kt) do { const char* kb_ = (const char*)(Kh + (size_t)(kt) * 64 * 96); sk0 = *(const u32x4*)(kb_ + tid * 16); if (tid < 256) sk1 = *(const u32x4*)(kb_ + (tid + 512) * 16); sv = *(const u32x4*)(vsrc + (kt) * 64); } while (0)
#define AT_STORE(buf) do { *(LAS u32x4*)(lds + AT_K0 + (buf) * AT_KBUF + k0dst) = sk0; if (tid < 256) *(LAS u32x4*)(lds + AT_K0 + (buf) * AT_KBUF + k1dst) = sk1; *(LAS u32x4*)(lds + AT_V0 + (buf) * AT_VBUF + vdst) = sv; } while (0)
  AT_LOAD(0); AT_STORE(0);
  __syncthreads();
  f32x16 negm, o0, o1;
#pragma unroll
  for (int i = 0; i < 16; ++i) { negm[i] = 0.f; o0[i] = 0.f; o1[i] = 0.f; }
  float mhat = 0.f, lsum = 0.f;
  for (int kt = 0; kt < nkt; ++kt) {
    const int buf = kt & 1;
    if (kt + 1 < nkt) AT_LOAD(kt + 1);
    const LAS unsigned char* kb = lds + AT_K0 + buf * AT_KBUF + r32 * AT_KROW + hi * 16;
    const LAS unsigned char* vb = lds + AT_V0 + buf * AT_VBUF + r32 * AT_VROW + hi * 16;
    f32x16 p0, p1;
#pragma unroll
    for (int d0 = 0; d0 < 6; ++d0) { const bf16x8 kf0 = *(const LAS bf16x8*)(kb + d0 * 32), kf1 = *(const LAS bf16x8*)(kb + 32 * AT_KROW + d0 * 32);
      if (d0 == 0) { p0 = MFMA32(kf0, qf[0], negm); p1 = MFMA32(kf1, qf[0], negm); } else { p0 = MFMA32(kf0, qf[d0], p0); p1 = MFMA32(kf1, qf[d0], p1); } }
    float rm = fmaxf(p0[0], p1[0]);
#pragma unroll
    for (int i = 1; i < 16; ++i) rm = fmaxf(rm, fmaxf(p0[i], p1[i]));
    rm = half_max(rm);
    if (kt == 0 || __any(rm > AT_THR)) {
      const float dl = (kt == 0) ? rm : fmaxf(rm, 0.f);
      mhat += dl; const float f = (kt == 0) ? 1.f : __builtin_amdgcn_exp2f(-dl); lsum *= f;
#pragma unroll
      for (int i = 0; i < 16; ++i) { p0[i] -= dl; p1[i] -= dl; o0[i] *= f; o1[i] *= f; negm[i] = -mhat; }
    }
    float ps = 0.f;
#pragma unroll
    for (int i = 0; i < 16; ++i) { p0[i] = __builtin_amdgcn_exp2f(p0[i]); p1[i] = __builtin_amdgcn_exp2f(p1[i]); ps += p0[i] + p1[i]; }
    lsum += ps;
    u32x4 w0, w1, w2, w3;
    w0 = (u32x4){cvtpk(p0[0], p0[1]), cvtpk(p0[2], p0[3]), cvtpk(p0[4], p0[5]), cvtpk(p0[6], p0[7])};
    w1 = (u32x4){cvtpk(p0[8], p0[9]), cvtpk(p0[10], p0[11]), cvtpk(p0[12], p0[13]), cvtpk(p0[14], p0[15])};
    w2 = (u32x4){cvtpk(p1[0], p1[1]), cvtpk(p1[2], p1[3]), cvtpk(p1[4], p1[5]), cvtpk(p1[6], p1[7])};
    w3 = (u32x4){cvtpk(p1[8], p1[9]), cvtpk(p1[10], p1[11]), cvtpk(p1[12], p1[13]), cvtpk(p1[14], p1[15])};
    const bf16x8 pf0 = __builtin_bit_cast(bf16x8, w0), pf1 = __builtin_bit_cast(bf16x8, w1), pf2 = __builtin_bit_cast(bf16x8, w2), pf3 = __builtin_bit_cast(bf16x8, w3);
#define AT_PV(s, pf) do { const bf16x8 va = *(const LAS bf16x8*)(vb + (s) * 32), vc = *(const LAS bf16x8*)(vb + 32 * AT_VROW + (s) * 32); o0 = MFMA32(va, pf, o0); o1 = MFMA32(vc, pf, o1); } while (0)
    AT_PV(0, pf0); AT_PV(1, pf1); AT_PV(2, pf2); AT_PV(3, pf3);
#undef AT_PV
    if (kt + 1 < nkt) AT_STORE(buf ^ 1);
    __syncthreads();
  }
#undef AT_LOAD
#undef AT_STORE
  lsum = half_sum(lsum);
  const float inv = 1.f / lsum;
  LAS bf16_t* stg = (LAS bf16_t*)(lds + AT_OST + wave * 32 * AT_OROW);
#pragma unroll
  for (int i = 0; i < 16; ++i) { const int d = (i & 3) + 8 * (i >> 2) + 4 * hi;
    stg[r32 * (AT_OROW / 2) + d] = f2bf(o0[i] * inv); stg[r32 * (AT_OROW / 2) + 32 + d] = f2bf(o1[i] * inv); }
  asm volatile("s_waitcnt lgkmcnt(0)" ::: "memory");
#pragma unroll
  for (int i = 0; i < 4; ++i) { const int piece = i * 64 + lane, row = piece >> 3, c = piece & 7;
    const u32x4 v = *(const LAS u32x4*)((const LAS unsigned char*)stg + row * AT_OROW + c * 16);
    *(u32x4*)(MC + (size_t)(b * PP + pq0 + wave * 32 + row) * DM + 384 + h * 64 + c * 8) = v; }
  __syncthreads();
}

constexpr int SC_CH = 32;
DI int scan_pos(int s, int d) { return d == 0 ? s : (s < CTX ? CTX - 1 - s : (PP - 1) - (s - CTX)); }
DI void scan_unit(const Ctx& C, int l, int unit) {
  const int chain = unit >> 1, half = unit & 1;
  const int b = chain / 12, h = (chain >> 1) % 6, d = chain & 1;
  const bf16_t* U = (const bf16_t*)(C.ws + WS_R1);
  const bf16_t* EW = (const bf16_t*)(C.ws + WS_R3); const bf16_t* AS = EW + (size_t)TT * 768;
  bf16_t* Y = (bf16_t*)(C.ws + WS_R5) + (size_t)d * TT * 384;
  const float* cw = inp(C, 12) + (size_t)l * 3 * 1152; const float* k_k = inp(C, 18) + l * 384; const float* k_a = inp(C, 19) + l * 384;
  const int lane = C.lane, wave = C.wave;
  LAS float* opsb = (LAS float*)C.lds;
  LAS float* ybuf = opsb + 2 * SC_CH * 384;
  constexpr int NCH = PP / SC_CH;
  if (wave >= 4) {
    const int pw = wave - 4;
    const int c = h * 64 + lane;
    const float cwr0 = cw[c], cwr1 = cw[1152 + c], cwr2 = cw[2304 + c];
    const float cwk0 = cw[384 + c], cwk1 = cw[1152 + 384 + c], cwk2 = cw[2304 + 384 + c];
    const float cwv0 = cw[768 + c], cwv1 = cw[1152 + 768 + c], cwv2 = cw[2304 + 768 + c];
    const float kkc = k_k[c], kac = k_a[c];
    for (int chunk = -1; chunk < NCH; ++chunk) {
      if (chunk >= 1) { const int cb = (chunk - 1) & 1;
#pragma unroll
        for (int i = 0; i < 4; ++i) { const int sl = pw * 8 + 2 * i + (lane >> 5), rw = lane & 31; const int p = scan_pos((chunk - 1) * SC_CH + sl, d);
          Y[(size_t)(b * PP + p) * 384 + h * 64 + half * 32 + rw] = f2bf(ybuf[(cb * SC_CH + sl) * 32 + rw]); } }
      if (chunk + 1 < NCH) { const int nb = (chunk + 1) & 1; const int s0 = (chunk + 1) * SC_CH;
#pragma unroll
        for (int hf = 0; hf < 2; ++hf) {
          unsigned short ur[4][3], uk[4][3], uv[4][3], uew[4], uas[4]; float ml[4], mr[4];
#pragma unroll
          for (int i = 0; i < 4; ++i) { const int sl = pw * 8 + hf * 4 + i; const int p = scan_pos(s0 + sl, d); const int g = b * PP + p;
            const bool hasl = (p != 0 && p != CTX), hasr = (p != CTX - 1 && p != PP - 1);
            ml[i] = hasl ? 1.f : 0.f; mr[i] = hasr ? 1.f : 0.f;
            const bf16_t* u0 = U + (size_t)g * UW + c; const bf16_t* ul = hasl ? u0 - UW : u0; const bf16_t* urr = hasr ? u0 + UW : u0;
            ur[i][0] = ul[0]; ur[i][1] = u0[0]; ur[i][2] = urr[0];
            uk[i][0] = ul[384]; uk[i][1] = u0[384]; uk[i][2] = urr[384];
            uv[i][0] = ul[768]; uv[i][1] = u0[768]; uv[i][2] = urr[768];
            uew[i] = EW[(size_t)g * 768 + d * 384 + c]; uas[i] = AS[(size_t)g * 768 + d * 384 + c]; }
#pragma unroll
          for (int i = 0; i < 4; ++i) { const int sl = pw * 8 + hf * 4 + i;
            const float r = bf2f(ur[i][1]) * cwr1 + ml[i] * bf2f(ur[i][0]) * cwr0 + mr[i] * bf2f(ur[i][2]) * cwr2;
            const float k = bf2f(uk[i][1]) * cwk1 + ml[i] * bf2f(uk[i][0]) * cwk0 + mr[i] * bf2f(uk[i][2]) * cwk2;
            const float v = bf2f(uv[i][1]) * cwv1 + ml[i] * bf2f(uv[i][0]) * cwv0 + mr[i] * bf2f(uv[i][2]) * cwv2;
            const float kr = k * kkc; const float nrm = sqrtf(wave_sum(kr * kr)); const float kk = kr / fmaxf(nrm, 1e-12f);
            const float ew = bf2f(uew[i]), a = bf2f(uas[i]);
            const float w = __expf(-ew); const float kd = k * (1.f + (a - 1.f) * kac);
            LAS float* o = opsb + (nb * SC_CH + sl) * 384 + lane;
            o[0] = r; o[64] = w; o[128] = kd; o[192] = v; o[256] = -kk; o[320] = kk * a; }
        } }
      __syncthreads();
    }
    { const int cb = (NCH - 1) & 1;
#pragma unroll
      for (int i = 0; i < 4; ++i) { const int sl = pw * 8 + 2 * i + (lane >> 5), rw = lane & 31; const int p = scan_pos((NCH - 1) * SC_CH + sl, d);
        Y[(size_t)(b * PP + p) * 384 + h * 64 + half * 32 + rw] = f2bf(ybuf[(cb * SC_CH + sl) * 32 + rw]); } }
  } else {
    const int rowl = wave * 8 + (lane >> 3), cg = lane & 7;
    const int vrow = half * 32 + rowl;
    f32x2 S[4];
#pragma unroll
    for (int j = 0; j < 4; ++j) S[j] = (f32x2){0.f, 0.f};
    __syncthreads();
    for (int chunk = 0; chunk < NCH; ++chunk) {
      const LAS float* ob = opsb + (chunk & 1) * SC_CH * 384;
      LAS float* yb = ybuf + (chunk & 1) * SC_CH * 32;
#define SC_LOADOPS(R0, R1, W0, W1, K0, K1, A0, A1, B0, B1, VV, slx) do { const LAS float* o_ = ob + (slx) * 384 + cg * 8; \
        R0 = *(const LAS f32x4*)(o_); R1 = *(const LAS f32x4*)(o_ + 4); W0 = *(const LAS f32x4*)(o_ + 64); W1 = *(const LAS f32x4*)(o_ + 68); \
        K0 = *(const LAS f32x4*)(o_ + 128); K1 = *(const LAS f32x4*)(o_ + 132); A0 = *(const LAS f32x4*)(o_ + 256); A1 = *(const LAS f32x4*)(o_ + 260); \
        B0 = *(const LAS f32x4*)(o_ + 320); B1 = *(const LAS f32x4*)(o_ + 324); VV = ob[(slx) * 384 + 192 + vrow]; } while (0)
#define SC_STEP(r0, r1, w0, w1, k0, k1, a0, a1, b0, b1, vv, YOUT) do { \
        f32x2 t = S[0] * (f32x2){a0.x, a0.y} + S[1] * (f32x2){a0.z, a0.w}; t = t + S[2] * (f32x2){a1.x, a1.y}; t = t + S[3] * (f32x2){a1.z, a1.w}; \
        float sa = t.x + t.y; \
        sa = dpp_add<0xB1>(sa); sa = dpp_add<0x4E>(sa); sa = dpp_add<0x141>(sa); \
        const f32x2 sa2 = (f32x2){sa, sa}, vv2 = (f32x2){vv, vv}; \
        S[0] = S[0] * (f32x2){w0.x, w0.y} + (sa2 * (f32x2){b0.x, b0.y} + vv2 * (f32x2){k0.x, k0.y}); \
        S[1] = S[1] * (f32x2){w0.z, w0.w} + (sa2 * (f32x2){b0.z, b0.w} + vv2 * (f32x2){k0.z, k0.w}); \
        S[2] = S[2] * (f32x2){w1.x, w1.y} + (sa2 * (f32x2){b1.x, b1.y} + vv2 * (f32x2){k1.x, k1.y}); \
        S[3] = S[3] * (f32x2){w1.z, w1.w} + (sa2 * (f32x2){b1.z, b1.w} + vv2 * (f32x2){k1.z, k1.w}); \
        f32x2 yy = S[0] * (f32x2){r0.x, r0.y} + S[1] * (f32x2){r0.z, r0.w}; yy = yy + S[2] * (f32x2){r1.x, r1.y}; yy = yy + S[3] * (f32x2){r1.z, r1.w}; \
        float y = yy.x + yy.y; \
        y = dpp_add<0xB1>(y); y = dpp_add<0x4E>(y); y = dpp_add<0x141>(y); YOUT = y; } while (0)
      f32x4 pr0, pr1, pw0, pw1, pk0, pk1, pa0, pa1, pb0, pb1; float pv;
      f32x4 qr0, qr1, qw0, qw1, qk0, qk1, qa0, qa1, qb0, qb1; float qv;
      SC_LOADOPS(pr0, pr1, pw0, pw1, pk0, pk1, pa0, pa1, pb0, pb1, pv, 0);
#pragma unroll 1
      for (int sg = 0; sg < SC_CH / 8; ++sg) {
        float ykeep = 0.f;
#pragma unroll
        for (int j = 0; j < 8; j += 2) { const int sl = sg * 8 + j; float y0, y1;
          SC_LOADOPS(qr0, qr1, qw0, qw1, qk0, qk1, qa0, qa1, qb0, qb1, qv, sl + 1);
          SC_STEP(pr0, pr1, pw0, pw1, pk0, pk1, pa0, pa1, pb0, pb1, pv, y0);
          SC_LOADOPS(pr0, pr1, pw0, pw1, pk0, pk1, pa0, pa1, pb0, pb1, pv, (sl + 2) & (SC_CH - 1));
          SC_STEP(qr0, qr1, qw0, qw1, qk0, qk1, qa0, qa1, qb0, qb1, qv, y1);
          ykeep = (cg == j) ? y0 : ykeep; ykeep = (cg == j + 1) ? y1 : ykeep; }
        yb[(sg * 8 + cg) * 32 + rowl] = ykeep;
      }
#undef SC_LOADOPS
#undef SC_STEP
      __syncthreads();
    }
  }
  __syncthreads();
}

DI void fft_unit(const Ctx& C, int seq, bool isctx) {
  const int N = isctx ? CTX : SEQ, logN = isctx ? 8 : 13, off = isctx ? 0 : CTX;
  const f32x2* src = (const f32x2*)(C.ws + WS_R4) + (size_t)seq * PP + off;
  const f32x2* TW = (const f32x2*)(C.ws + WS_TW);
  bf16_t* MC = (bf16_t*)(C.ws + WS_R6);
  LAS f32x2* x = (LAS f32x2*)C.lds;
  const int tid = C.tid;
  for (int i = tid; i < N; i += NTHREADS) x[i] = src[i];
  __syncthreads();
  const int twmul = SEQ / N;
  for (int s = 0; s < logN; ++s) { const int hb = logN - 1 - s, hh = 1 << hb;
    for (int j = tid; j < N / 2; j += NTHREADS) { const int blk = j >> hb, i = j & (hh - 1); const int i0 = (blk << (hb + 1)) + i, i1 = i0 + hh;
      const f32x2 a = x[i0], bb = x[i1]; const f32x2 tw = TW[(i << s) * twmul];
      const float dr = a.x - bb.x, di = a.y - bb.y;
      x[i0] = (f32x2){a.x + bb.x, a.y + bb.y}; x[i1] = (f32x2){dr * tw.x - di * tw.y, dr * tw.y + di * tw.x}; }
    __syncthreads(); }
  const float scale = rsqrtf(64.0f * (float)N);
  const int b = seq / 132, grp = (seq / 33) & 3, k2 = seq % 33;
  for (int pi = tid; pi < N; pi += NTHREADS) { const int k1 = (int)(__brev((unsigned)pi) >> (32 - logN));
    const bf16_t val = f2bf(x[pi].x * scale);
    MC[(size_t)(b * PP + off + k1) * DM + 768 + grp * 64 + k2] = val;
    if (k2 >= 1 && k2 <= 31) MC[(size_t)(b * PP + off + ((N - k1) & (N - 1))) * DM + 768 + grp * 64 + 64 - k2] = val; }
  __syncthreads();
}

constexpr int CK_ROW = 144, CK_SLOT = 64 * CK_ROW;
DI void ck_mma(f32x16& acc, const LAS unsigned char* A, int arow0, const LAS unsigned char* B, int brow0, int r32, int hi) {
  const LAS unsigned char* ap = A + (arow0 + r32) * CK_ROW + hi * 16; const LAS unsigned char* bp = B + (brow0 + r32) * CK_ROW + hi * 16;
#pragma unroll
  for (int kk = 0; kk < 4; ++kk) acc = MFMA32(*(const LAS bf16x8*)(ap + kk * 32), *(const LAS bf16x8*)(bp + kk * 32), acc);
}
DI void ck_store(const f32x16& acc, LAS unsigned char* Out, int arow0, int brow0, int r32, int hi) {
  LAS unsigned char* op = Out + (brow0 + r32) * CK_ROW + (arow0 + 4 * hi) * 2;
#pragma unroll
  for (int g = 0; g < 4; ++g) { u32x2 w; w.x = cvtpk(acc[4 * g], acc[4 * g + 1]); w.y = cvtpk(acc[4 * g + 2], acc[4 * g + 3]); *(LAS u32x2*)(op + g * 16) = w; }
}
#ifdef PROF_SEL
#define PROF_T0(k) unsigned long long pt0_##k = 0; if (PROF_SEL == (k)) pt0_##k = __builtin_amdgcn_s_memrealtime();
#define PROF_T1(k) if (PROF_SEL == (k) && chain == 0 && l == 0 && C.tid == PROF_TID) atomicAdd((unsigned*)(C.ws + WS_CTL) + 1024, (unsigned)(__builtin_amdgcn_s_memrealtime() - pt0_##k));
#else
#define PROF_T0(k)
#define PROF_T1(k)
#endif
#ifndef PROF_TID
#define PROF_TID 0
#endif
DI void scan_chain(const Ctx& C, int l, int chain) {
  PROF_T0(1)
  const int b = chain / 12, h = (chain >> 1) % 6, d = chain & 1;
  const bf16_t* U = (const bf16_t*)(C.ws + WS_R1);
  const bf16_t* EW = (const bf16_t*)(C.ws + WS_R3); const bf16_t* AS = EW + (size_t)TT * 768;
  bf16_t* Y = (bf16_t*)(C.ws + WS_R5) + (size_t)d * TT * 384;
  const float* cw = inp(C, 12) + (size_t)l * 3 * 1152; const float* k_k = inp(C, 18) + l * 384; const float* k_a = inp(C, 19) + l * 384;
  const int lane = C.lane, wave = C.wave, r32 = lane & 31, hi = lane >> 5;
  LAS unsigned char* L = C.lds;
#define SLOT(n) (L + (n) * CK_SLOT)
  LAS unsigned char* const sAT = SLOT(0); LAS unsigned char* const sRT = SLOT(1); LAS unsigned char* const sBT = SLOT(2); LAS unsigned char* const sKT = SLOT(3);
  LAS unsigned char* const sVT = SLOT(4); LAS unsigned char* const sBH = SLOT(5); LAS unsigned char* const sKH = SLOT(6); LAS unsigned char* const sSB = SLOT(7);
  LAS unsigned char* const sP0 = SLOT(8); LAS unsigned char* const sP0T = SLOT(9); LAS unsigned char* const sAAK = SLOT(10); LAS unsigned char* const sARB = SLOT(11);
  LAS unsigned char* const sARK = SLOT(12); LAS unsigned char* const sXa = SLOT(13); LAS unsigned char* const sXb = SLOT(14);
  LAS float* gamC = (LAS float*)SLOT(15); LAS float* wtot = gamC + 64;
  const int t4 = wave & 3, arow0 = (t4 >> 1) * 32, brow0 = (t4 & 1) * 32;
  const int c = h * 64 + lane;
  const float cwr0 = cw[c], cwr1 = cw[1152 + c], cwr2 = cw[2304 + c];
  const float cwk0 = cw[384 + c], cwk1 = cw[1152 + 384 + c], cwk2 = cw[2304 + 384 + c];
  const float cwv0 = cw[768 + c], cwv1 = cw[1152 + 768 + c], cwv2 = cw[2304 + 768 + c];
  const float kkc = k_k[c], kac = k_a[c];
  f32x16 xacc, sacc;
#pragma unroll
  for (int i = 0; i < 16; ++i) { xacc[i] = 0.f; sacc[i] = 0.f; }
  unsigned short pr[10], pk[10], pv[10], pew[8], pas[8];
#define CK_PREFETCH(ci) do { const int p0_ = scan_pos((ci) * 64 + wave * 8, d); const int sg_ = d == 0 ? 1 : -1; const int lo_ = p0_ < CTX ? 0 : CTX, hi_ = p0_ < CTX ? CTX - 1 : PP - 1; \
    _Pragma("unroll") for (int q = 0; q < 10; ++q) { int pp_ = p0_ + sg_ * (q - 1); pp_ = pp_ < lo_ ? lo_ : (pp_ > hi_ ? hi_ : pp_); const bf16_t* u_ = U + (size_t)(b * PP + pp_) * UW;     \
      pr[q] = u_[c]; pk[q] = u_[384 + c]; pv[q] = u_[768 + c]; } \
    _Pragma("unroll") for (int j = 0; j < 8; ++j) { const int pj_ = p0_ + sg_ * j; const size_t o_ = (size_t)(b * PP + pj_) * 768 + d * 384; pew[j] = (EW + o_)[c]; pas[j] = (AS + o_)[c]; } } while (0)
  CK_PREFETCH(0);
  for (int ci = 0; ci < PP / 64; ++ci) {
    PROF_T0(2)
    PROF_T0(6)
    if (wave >= 4) ck_store(sacc, sSB, arow0, brow0, r32, hi);
    float fr[8], fkd[8], fv[8], fkk[8], fal[8], flg[8];
    { const int p0 = scan_pos(ci * 64 + wave * 8, d); const int lo = p0 < CTX ? 0 : CTX, hi_p = p0 < CTX ? CTX - 1 : PP - 1;
      float run = 0.f;
#pragma unroll
      for (int j = 0; j < 8; ++j) { const int pj = d == 0 ? p0 + j : p0 - j;
        const float ml = pj != lo ? 1.f : 0.f, mr = pj != hi_p ? 1.f : 0.f;
        const float rl = bf2f(d == 0 ? pr[j] : pr[j + 2]), rr_ = bf2f(d == 0 ? pr[j + 2] : pr[j]);
        const float kl = bf2f(d == 0 ? pk[j] : pk[j + 2]), kr_ = bf2f(d == 0 ? pk[j + 2] : pk[j]);
        const float vl = bf2f(d == 0 ? pv[j] : pv[j + 2]), vr_ = bf2f(d == 0 ? pv[j + 2] : pv[j]);
        const float r = bf2f(pr[j + 1]) * cwr1 + ml * rl * cwr0 + mr * rr_ * cwr2;
        const float k = bf2f(pk[j + 1]) * cwk1 + ml * kl * cwk0 + mr * kr_ * cwk2;
        const float v = bf2f(pv[j + 1]) * cwv1 + ml * vl * cwv0 + mr * vr_ * cwv2;
        const float kr = k * kkc; const float kk = kr * __builtin_amdgcn_rsqf(fmaxf(wave_sum(kr * kr), 1e-24f));
        const float al = bf2f(pas[j]);
        run -= bf2f(pew[j]);
        fr[j] = r; fkd[j] = k * (1.f + (al - 1.f) * kac); fv[j] = v; fkk[j] = kk; fal[j] = al; flg[j] = run; }
      wtot[wave * 64 + lane] = run; }
    if (ci > 0) { const int s_ = C.tid >> 3, pc_ = C.tid & 7; const int p_ = scan_pos((ci - 1) * 64 + s_, d);
      *(u32x4*)(Y + (size_t)(b * PP + p_) * 384 + h * 64 + pc_ * 8) = *(const LAS u32x4*)(SLOT(8) + s_ * CK_ROW + pc_ * 16); }
    if (ci + 1 < PP / 64) CK_PREFETCH(ci + 1);
    __syncthreads();
    PROF_T1(6)
    PROF_T0(7)
    { float off = 0.f, tot = 0.f;
#pragma unroll
      for (int w2 = 0; w2 < 8; ++w2) { const float t = wtot[w2 * 64 + lane]; off += (w2 < wave) ? t : 0.f; tot += t; }
      if (wave == 0) gamC[lane] = __expf(tot);
      u32x4 wv, wbh, wkh; float tv[8], tbh[8], tkh[8];
      const float eTot = __expf(tot); float eGprev = __expf(off);
#pragma unroll
      for (int j = 0; j < 8; ++j) { const int s = wave * 8 + j; const float Lc = off + flg[j];
        const float eG = __expf(Lc), eGp = eGprev, eGi = __builtin_amdgcn_rcpf(eG), eGc = eTot * eGi; eGprev = eG;
        const float bb = fkk[j] * fal[j];
        *(LAS bf16_t*)(sAT + s * CK_ROW + lane * 2) = f2bf(-fkk[j] * eGp);
        *(LAS bf16_t*)(sRT + s * CK_ROW + lane * 2) = f2bf(fr[j] * eG);
        *(LAS bf16_t*)(sBT + s * CK_ROW + lane * 2) = f2bf(bb * eGi);
        *(LAS bf16_t*)(sKT + s * CK_ROW + lane * 2) = f2bf(fkd[j] * eGi);
        tv[j] = fv[j]; tbh[j] = bb * eGc; tkh[j] = fkd[j] * eGc; }
      wv = (u32x4){cvtpk(tv[0], tv[1]), cvtpk(tv[2], tv[3]), cvtpk(tv[4], tv[5]), cvtpk(tv[6], tv[7])};
      wbh = (u32x4){cvtpk(tbh[0], tbh[1]), cvtpk(tbh[2], tbh[3]), cvtpk(tbh[4], tbh[5]), cvtpk(tbh[6], tbh[7])};
      wkh = (u32x4){cvtpk(tkh[0], tkh[1]), cvtpk(tkh[2], tkh[3]), cvtpk(tkh[4], tkh[5]), cvtpk(tkh[6], tkh[7])};
      *(LAS u32x4*)(sVT + lane * CK_ROW + wave * 16) = wv; *(LAS u32x4*)(sBH + lane * CK_ROW + wave * 16) = wbh; *(LAS u32x4*)(sKH + lane * CK_ROW + wave * 16) = wkh; }
    __syncthreads();
    PROF_T1(2)
    PROF_T1(7)
    PROF_T0(3)
    { f32x16 z;
#pragma unroll
      for (int i = 0; i < 16; ++i) z[i] = 0.f;
      const int bi = brow0 + r32;
      if (wave < 4) {
        f32x16 t = z; ck_mma(t, sBT, arow0, sAT, brow0, r32, hi);
#pragma unroll
        for (int i = 0; i < 16; ++i) { const int ai = arow0 + (i & 3) + 8 * (i >> 2) + 4 * hi; t[i] = ai < bi ? t[i] : 0.f; }
        ck_store(t, sP0, arow0, brow0, r32, hi);
        t = z; ck_mma(t, sAT, arow0, sBT, brow0, r32, hi);
#pragma unroll
        for (int i = 0; i < 16; ++i) { const int ai = arow0 + (i & 3) + 8 * (i >> 2) + 4 * hi; t[i] = bi < ai ? t[i] : 0.f; }
        ck_store(t, sP0T, arow0, brow0, r32, hi);
        t = z; ck_mma(t, sBT, arow0, sRT, brow0, r32, hi);
#pragma unroll
        for (int i = 0; i < 16; ++i) { const int ai = arow0 + (i & 3) + 8 * (i >> 2) + 4 * hi; t[i] = ai <= bi ? t[i] : 0.f; }
        ck_store(t, sARB, arow0, brow0, r32, hi);
      } else {
        f32x16 t = z; ck_mma(t, sKT, arow0, sAT, brow0, r32, hi);
#pragma unroll
        for (int i = 0; i < 16; ++i) { const int ai = arow0 + (i & 3) + 8 * (i >> 2) + 4 * hi; t[i] = ai < bi ? t[i] : 0.f; }
        ck_store(t, sAAK, arow0, brow0, r32, hi);
        t = z; ck_mma(t, sKT, arow0, sRT, brow0, r32, hi);
#pragma unroll
        for (int i = 0; i < 16; ++i) { const int ai = arow0 + (i & 3) + 8 * (i >> 2) + 4 * hi; t[i] = ai <= bi ? t[i] : 0.f; }
        ck_store(t, sARK, arow0, brow0, r32, hi);
      } }
    __syncthreads();
    PROF_T1(3)
    PROF_T0(4)
#define CK_SQUARE(Pin, PTin, Pout, PTout, needT) do { f32x16 t_; _Pragma("unroll") for (int i = 0; i < 16; ++i) t_[i] = 0.f; \
      ck_mma(t_, PTin, arow0, Pin, brow0, r32, hi); ck_store(t_, Pout, arow0, brow0, r32, hi);             \
      if (needT) { _Pragma("unroll") for (int i = 0; i < 16; ++i) t_[i] = 0.f; ck_mma(t_, Pin, arow0, PTin, brow0, r32, hi); ck_store(t_, PTout, arow0, brow0, r32, hi); } } while (0)
#define CK_XSTEP(Pj, Xin, Xout) do { ck_mma(xacc, Pj, arow0, Xin, brow0, r32, hi); ck_store(xacc, Xout, arow0, brow0, r32, hi); } while (0)
    if (wave < 4) CK_SQUARE(sP0, sP0T, SLOT(2), SLOT(3), true);
    else {
#pragma unroll
      for (int i = 0; i < 16; ++i) xacc[i] = 0.f;
      ck_mma(xacc, sAT, arow0, sSB, brow0, r32, hi); ck_mma(xacc, sAAK, arow0, sVT, brow0, r32, hi); ck_store(xacc, sXa, arow0, brow0, r32, hi); }
    __syncthreads();
    if (wave < 4) CK_SQUARE(SLOT(2), SLOT(3), SLOT(0), SLOT(10), true); else CK_XSTEP(sP0, sXa, sXb);
    __syncthreads();
    if (wave < 4) CK_SQUARE(SLOT(0), SLOT(10), SLOT(8), SLOT(9), true); else CK_XSTEP(SLOT(2), sXb, sXa);
    __syncthreads();
    if (wave < 4) CK_SQUARE(SLOT(8), SLOT(9), SLOT(2), SLOT(3), true); else CK_XSTEP(SLOT(0), sXa, sXb);
    __syncthreads();
    if (wave < 4) CK_SQUARE(SLOT(2), SLOT(3), SLOT(0), SLOT(10), false); else CK_XSTEP(SLOT(8), sXb, sXa);
    __syncthreads();
    if (wave >= 4) CK_XSTEP(SLOT(2), sXa, sXb);
    __syncthreads();
    if (wave >= 4) CK_XSTEP(SLOT(0), sXb, sXa);
    __syncthreads();
    PROF_T1(4)
    PROF_T0(5)
    if (wave < 4) { f32x16 t;
#pragma unroll
      for (int i = 0; i < 16; ++i) t[i] = 0.f;
      ck_mma(t, sSB, arow0, sRT, brow0, r32, hi); ck_mma(t, sXa, arow0, sARB, brow0, r32, hi); ck_mma(t, sVT, arow0, sARK, brow0, r32, hi);
      ck_store(t, SLOT(8), arow0, brow0, r32, hi);
    } else {
#pragma unroll
      for (int i = 0; i < 16; ++i) sacc[i] *= gamC[arow0 + (i & 3) + 8 * (i >> 2) + 4 * hi];
      ck_mma(sacc, sBH, arow0, sXa, brow0, r32, hi); ck_mma(sacc, sKH, arow0, sVT, brow0, r32, hi);
    }
    __syncthreads();
    PROF_T1(5)
  }
  PROF_T1(1)
  { const int s_ = C.tid >> 3, pc_ = C.tid & 7; const int p_ = scan_pos((PP / 64 - 1) * 64 + s_, d);
    *(u32x4*)(Y + (size_t)(b * PP + p_) * 384 + h * 64 + pc_ * 8) = *(const LAS u32x4*)(SLOT(8) + s_ * CK_ROW + pc_ * 16); }
  __syncthreads();
#undef SLOT
#undef CK_PREFETCH
#undef CK_SQUARE
#undef CK_XSTEP
}
DI void mix_phase(const Ctx& C0, int l, bool with_ctx, int rep = 0) {
  unsigned* ctr = (unsigned*)(C0.ws + WS_CTL) + 64 * (1 + l + 2 * rep);
  LAS int* slot = (LAS int*)(C0.lds + 147456 - 64);
    const int n_scan = 48;
#ifdef REP_ATT
  const int n_att = 1536;
#else
  const int n_att = 768;
#endif
  const int n_attc = with_ctx ? 24 : 0, n_fft = 528, n_fftc = with_ctx ? 528 : 0;
  const int total = n_scan + n_att + n_attc + n_fft + n_fftc;
  for (;;) {
    __syncthreads();
    if (C0.tid == 0) *slot = (int)atomicAdd(ctr, 1u);
    __syncthreads();
    int it = __builtin_amdgcn_readfirstlane(*slot);
    if (it >= total) break;
    Ctx C = C0; { int t_ = C0.tid; asm volatile("" : "+v"(t_)); C.tid = t_; C.lane = t_ & 63; C.wave = __builtin_amdgcn_readfirstlane(t_ >> 6); GAS unsigned char* w_ = (GAS unsigned char*)C0.ws; asm volatile("" : "+s"(w_), "+s"(it)); C.ws = (unsigned char*)w_; }
    if (it < n_scan) { scan_chain(C, l, it); continue; } it -= n_scan;
    if (it < n_att) { const int bh = (it % 768) / 32, qb = it % 32; attn_unit(C, bh / NH, bh % NH, CTX + qb * 256, PP / 64); continue; } it -= n_att;
    if (it < n_attc) { attn_unit(C, it / NH, it % NH, 0, CTX / 64); continue; } it -= n_attc;
    if (it < n_fft) { fft_unit(C, it, false); continue; } it -= n_fft;
    fft_unit(C, it, true);
  }
}
constexpr int LDS_BYTES = 147456;
#ifndef REP_PHASE
#define REP_PHASE 0
#endif
#define NREP(k) ((REP_PHASE == (k)) ? 2 : 1)

#ifdef PROF_SEL
#define TPH0(k) unsigned long long tph_##k = 0; if (PROF_SEL == 100 + (k)) tph_##k = __builtin_amdgcn_s_memrealtime();
#define TPH1(k) if (PROF_SEL == 100 + (k) && blockIdx.x == 0 && threadIdx.x == 0) atomicAdd((unsigned*)(P.ws + WS_CTL) + 1024, (unsigned)(__builtin_amdgcn_s_memrealtime() - tph_##k));
#else
#define TPH0(k)
#define TPH1(k)
#endif
__global__ void __launch_bounds__(NTHREADS, 2) mk_fwd(Params P) {
  extern __shared__ __attribute__((aligned(16))) unsigned char lds_raw[];
  cg::grid_group grid = cg::this_grid();
  Ctx C; unsigned char* ws;
#define PH() do { const __attribute__((address_space(4))) char* kp_ = (const __attribute__((address_space(4))) char*)__builtin_amdgcn_kernarg_segment_ptr(); asm volatile("" : "+s"(kp_)); \
    int t_ = threadIdx.x; asm volatile("" : "+v"(t_)); \
    C.in = (const __attribute__((address_space(4))) cfptr*)kp_; C.out = (float*)(GAS float*)*(float* const __attribute__((address_space(4)))*)(kp_ + 256); C.ws = (unsigned char*)(GAS unsigned char*)*(unsigned char* const __attribute__((address_space(4)))*)(kp_ + 264); ws = C.ws; \
    C.lds = (LAS unsigned char*)lds_raw; C.ldsg = lds_raw; C.tid = t_; C.lane = t_ & 63; C.wave = __builtin_amdgcn_readfirstlane(t_ >> 6); int g_ = gridDim.x, b_ = blockIdx.x; asm volatile("" : "+s"(g_), "+s"(b_)); C.G = g_; C.bid = b_; } while (0)
#define R1 ((bf16_t*)(ws + WS_R1))
#define R2 ((bf16_t*)(ws + WS_R2))
#define R3 ((bf16_t*)(ws + WS_R3))
#define QB R2
#define KB (R2 + (size_t)NB * NH * PP * 96)
#define VT (R2 + (size_t)2 * NB * NH * PP * 96)
#define EW R3
#define AS (R3 + (size_t)TT * 768)
#define GG (R3 + (size_t)2 * TT * 768)
#define rq ((float*)(ws + WS_RSTD))
#define rkv (((float*)(ws + WS_RSTD)) + TT)
#define IDX ((int*)(ws + WS_IDX))

  { TPH0(12) for (int rep = 0; rep < NREP(12); ++rep) { PH(); phase0(C);
  grid.sync(); } TPH1(12) }
  PH(); phase0b(C);
  grid.sync();
  for (int l = 0; l < 2; ++l) {
    const bool last = (l == 1);
    { TPH0(1) PH(); if (l == 0) norm_pass(C, 0, 0, 0); else norm_pass(C, 1, 1, 0);
    grid.sync(); TPH1(1) }
    { TPH0(2) for (int rep = 0; rep < NREP(2); ++rep) { PH(); { pg8::Gemm g{R2, (const bf16_t*)(ws + WS_WIN) + (size_t)l * UW * DM, DM, DM}; pg8::StaticOrder S; S.init(TT, UW, C.G, C.bid);
      EpiU E{R1, UW}; pg8::gemm_phase(C.lds, C.tid, g, S, E); }
    grid.sync(); } TPH1(2) }
    { TPH0(3) for (int rep = 0; rep < NREP(3); ++rep) { PH(); prep_a(C, l);
    grid.sync(); } TPH1(3) }
    { TPH0(4) for (int rep = 0; rep < NREP(4); ++rep) { PH(); { pg8::Gemm g{R1 + 1152, (const bf16_t*)(ws + WS_WLW) + (size_t)l * 1536 * 128, UW, 128}; pg8::StaticOrder S; S.init(TT, 1536, C.G, C.bid);
      EpiLW E{EW, AS, inp(C, 13) + l * 768, inp(C, 15) + l * 768}; pg8::gemm_phase(C.lds, C.tid, g, S, E); }
    PH(); { pg8::Gemm g{R1 + 1280, (const bf16_t*)(ws + WS_WG) + (size_t)l * 512 * 256, UW, 256}; pg8::StaticOrder S; S.init(TT, 512, C.G, C.bid);
      EpiG E{GG}; pg8::gemm_phase(C.lds, C.tid, g, S, E); }
    PH(); { pg8::Gemm g{R1 + 1536, (const bf16_t*)(ws + WS_WQ) + (size_t)l * 768 * 256, UW, 256}; pg8::StaticOrder S; S.init(TT, 768, C.G, C.bid);
      EpiQ E{QB, rq, (const float*)(ws + WS_ROPE)}; pg8::gemm_phase(C.lds, C.tid, g, S, E); }
    PH(); { pg8::Gemm g{R1 + 1792, (const bf16_t*)(ws + WS_WKV) + (size_t)l * 768 * 128, UW, 128}; pg8::StaticOrder S; S.init(TT, 768, C.G, C.bid);
      EpiKV E{KB, VT, rkv}; pg8::gemm_phase(C.lds, C.tid, g, S, E); }
    grid.sync(); } TPH1(4) }
    { TPH0(5) for (int rep = 0; rep < NREP(5); ++rep) { PH(); mix_phase(C, l, !last, rep);
    grid.sync(); } TPH1(5) }
    { TPH0(6) for (int rep = 0; rep < NREP(6); ++rep) { PH(); post_pass(C, l, !last);
    grid.sync(); } TPH1(6) }
    { TPH0(7) for (int rep = 0; rep < NREP(7); ++rep) { PH(); { pg8::Gemm g{(const bf16_t*)(ws + WS_R6), (const bf16_t*)(ws + WS_WOUT) + (size_t)l * DM * DM, DM, DM}; pg8::StaticOrder S; S.init(TT, DM, C.G, C.bid);
      EpiPlain E{R1, DM}; pg8::gemm_phase(C.lds, C.tid, g, S, E); }
    grid.sync(); } TPH1(7) }
    { TPH0(8) PH(); n2_pass(C, l, !last);
    grid.sync(); TPH1(8) }
    { TPH0(9) for (int rep = 0; rep < NREP(9); ++rep) { PH(); { const int nprob = last ? 64 : 128;
      if (C.bid < nprob) topk_problem(C, C.bid);
      const int gt = C.bid * NTHREADS + C.tid, NGT = C.G * NTHREADS;
      for (int i = gt; i < NEXP * 256; i += NGT) { const int e = i >> 8, r = i & 255; const int row = e * RPE + 4096 + r; if (last || r >= 128) IDX[row] = 0; }
      convert_experts(C, l, C.bid * NWAVES + C.wave, C.G * NWAVES); }
    grid.sync(); } TPH1(9) }
    { TPH0(10) for (int rep = 0; rep < NREP(10); ++rep) { PH(); { pg8::Gemm g{R2, R3, DM, DM}; MoeOrder<true> S; S.init(last ? 16 : 17, 8, C.G, C.bid, IDX);
      EpiMoe1 E{(bf16_t*)(ws + WS_HID)}; pg8::gemm_phase(C.lds, C.tid, g, S, E); }
    grid.sync(); } TPH1(10) }
    { TPH0(11) for (int rep = 0; rep < NREP(11); ++rep) { PH(); { pg8::Gemm g{(const bf16_t*)(ws + WS_HID), R3 + (size_t)NEXP * 2048 * 1024, DM, DM}; MoeOrder<false> S; S.init(last ? 16 : 17, 4, C.G, C.bid, IDX);
      EpiMoe2 E{R1}; pg8::gemm_phase(C.lds, C.tid, g, S, E); }
    grid.sync(); } TPH1(11) }
  }
  { TPH0(13) PH(); norm_pass(C, 2, 0, 1); TPH1(13) }
#ifdef PROF_SEL
  grid.sync();
  if (blockIdx.x == 0 && threadIdx.x == 0) { const unsigned ticks = __hip_atomic_load((unsigned*)(P.ws + WS_CTL) + 1024, __ATOMIC_RELAXED, __HIP_MEMORY_SCOPE_AGENT) * PROF_MUL;
    const unsigned long long t0 = __builtin_amdgcn_s_memrealtime(); while (__builtin_amdgcn_s_memrealtime() - t0 < ticks) __builtin_amdgcn_s_sleep(4); }
#endif
}

extern "C" void kernel_launch(void* const* d_in, const int* in_sizes, int n_in, void* d_out, int out_size, void* d_ws, size_t ws_size, hipStream_t stream) {
  static int grid = 0;
  if (grid == 0) {
    int dev = 0, cus = 0, per_cu = 0;
    if (n_in != 32 || out_size != NB * SEQ * DM || ws_size < WS_END) { fprintf(stderr, "kernel_launch: unexpected shapes (n_in %d out %d ws %zu)\n", n_in, out_size, ws_size); grid = -1; return; }
    (void)hipGetDevice(&dev);
    (void)hipDeviceGetAttribute(&cus, hipDeviceAttributeMultiprocessorCount, dev);
    (void)hipFuncSetAttribute((const void*)mk_fwd, hipFuncAttributeMaxDynamicSharedMemorySize, LDS_BYTES);
    (void)hipOccupancyMaxActiveBlocksPerMultiprocessor(&per_cu, (const void*)mk_fwd, NTHREADS, LDS_BYTES);
    if (per_cu < 1) { fprintf(stderr, "kernel_launch: occupancy query reports %d blocks per CU\n", per_cu); grid = -1; return; }
    grid = cus;
  }
  if (grid < 0) return;
  (void)hipMemsetAsync((char*)d_ws + WS_CTL, 0, 8192, stream);
  Params p{};
  for (int i = 0; i < 32; ++i) p.in[i] = (const float*)d_in[i];
  p.out = (float*)d_out; p.ws = (unsigned char*)d_ws;
  void* args[] = {&p};
  hipError_t e = hipLaunchCooperativeKernel((const void*)mk_fwd, dim3(grid), dim3(NTHREADS), args, LDS_BYTES, stream);
  if (e != hipSuccess) fprintf(stderr, "cooperative launch failed: %s (grid %d)\n", hipGetErrorString(e), grid);
}
```

```cpp
#include <hip/hip_runtime.h>
#include <hip/hip_cooperative_groups.h>
#include <cstdio>
#include <cstdint>
namespace cg = cooperative_groups;

#define LAS __attribute__((address_space(3)))
typedef unsigned short bf16_t;
typedef short bf16x8 __attribute__((ext_vector_type(8)));
typedef float f32x4 __attribute__((ext_vector_type(4)));
typedef float f32x2 __attribute__((ext_vector_type(2)));
typedef float f32x16 __attribute__((ext_vector_type(16)));
typedef unsigned u32x4 __attribute__((ext_vector_type(4)));
typedef unsigned u32x2 __attribute__((ext_vector_type(2)));
typedef __bf16 bf16x2_t __attribute__((ext_vector_type(2)));
#define DI __device__ __forceinline__

constexpr int NB = 4, SEQ = 8192, CTX = 256, PP = SEQ + CTX  , TT = NB * PP  , DM = 1024;
constexpr int UW = 2304;
constexpr int NH = 6;
constexpr int NEXP = 16, RPE = 4352  ;
constexpr float NORM_EPS = 1e-6f, GN_EPS = 64e-5f;
constexpr float QSCALE = 0.10206207261596577f * 1.4426950408889634f;
constexpr int NWAVES = 8, NTHREADS = 512;

DI unsigned cvtpk(float lo, float hi) { f32x2 v = {lo, hi}; bf16x2_t b = __builtin_convertvector(v, bf16x2_t); return __builtin_bit_cast(unsigned, b); }
DI bf16_t f2bf(float f) { return (bf16_t)(cvtpk(f, 0.f) & 0xffffu); }
DI float bf2f(bf16_t b) { return __uint_as_float(((unsigned)b) << 16); }
DI float bflo(unsigned u) { return __uint_as_float(u << 16); }
DI float bfhi(unsigned u) { return __uint_as_float(u & 0xffff0000u); }
template <int CTRL> DI float dpp_add(float x) { return x + __builtin_bit_cast(float, __builtin_amdgcn_update_dpp(0, __builtin_bit_cast(int, x), CTRL, 0xf, 0xf, true)); }
DI float rdlane(float x, int l) { return __builtin_bit_cast(float, __builtin_amdgcn_readlane(__builtin_bit_cast(int, x), l)); }
DI float wave_sum(float x) {
  x = dpp_add<0xB1>(x); x = dpp_add<0x4E>(x); x = dpp_add<0x141>(x); x = dpp_add<0x140>(x);
  return (rdlane(x, 0) + rdlane(x, 16)) + (rdlane(x, 32) + rdlane(x, 48));
}
DI float swz_xor16(float x) { return __builtin_bit_cast(float, __builtin_amdgcn_ds_swizzle(__builtin_bit_cast(int, x), 0x401F)); }
DI float swz_xor8(float x) { return __builtin_bit_cast(float, __builtin_amdgcn_ds_swizzle(__builtin_bit_cast(int, x), 0x201F)); }
DI float half_max(float x) { auto r = __builtin_amdgcn_permlane32_swap(__float_as_uint(x), __float_as_uint(x), false, false); return fmaxf(__uint_as_float(r[0]), __uint_as_float(r[1])); }
DI float half_sum(float x) { auto r = __builtin_amdgcn_permlane32_swap(__float_as_uint(x), __float_as_uint(x), false, false); return __uint_as_float(r[0]) + __uint_as_float(r[1]); }
DI float sigmoidf_(float x) { return 1.f / (1.f + __expf(-x)); }

namespace pg8 {
constexpr int BM = 256, BK = 64, HALF = 128, HTB = HALF * BK * 2, STAGE_BYTES = 8 * HTB, NXCD = 8, WGM = 8;
__host__ __device__ __forceinline__ int lds_byte(int r, int c) { const int st = (r >> 4) * 2 + (c >> 5), rr = r & 15, cc = c & 31, ob = rr * 64 + cc * 2; return st * 1024 + (ob ^ (((ob >> 9) & 1) << 5)); }
__host__ __device__ __forceinline__ void stage_rc(int b, int& R, int& C) { const int st = b / 1024, sb = b % 1024, swz = sb ^ (((sb >> 9) & 1) << 5); R = (st >> 1) * 16 + swz / 64; C = (st & 1) * 32 + (swz % 64) / 2; }
__host__ __device__ __forceinline__ int perm32(int rho) { const int n = rho >> 4, i = rho & 15; return 8 * (i >> 2) + 4 * n + (i & 3); }

struct Unit { int pm, pn; };
struct Gemm { const bf16_t* A; const bf16_t* Bt; int lda; int K; };

struct StaticOrder {
  int nM, nN, nwg, G, c;
  static constexpr bool GATHER = false;
  __device__ void init(int M, int N, int G_, int c_) { nM = M / BM; nN = N / BM; nwg = nM * nN; G = G_; c = c_; }
  __device__ bool next(int i, Unit& u) const {
    const long L = (long)i * G + c; if (L >= nwg) return false;
    int wgid = (int)L; { const int q = nwg / NXCD, r = nwg % NXCD, xcd = wgid % NXCD, off = wgid / NXCD; wgid = (xcd < r ? xcd * (q + 1) : r * (q + 1) + (xcd - r) * q) + off; }
    const int nig = WGM * nN, gid = wgid / nig, fm = gid * WGM, gsz = (nM - fm) < WGM ? (nM - fm) : WGM;
    u.pm = fm + ((wgid % nig) % gsz); u.pn = (wgid % nig) / gsz; return true;
  }
  __device__ int arow(const Unit&, int) const { return 0; }
};

template <class Epi, class Sched>
__device__ __forceinline__ void gemm_phase(LAS unsigned char* lds, const int tid, const Gemm g, const Sched& S, const Epi& E) {
  const int wid = __builtin_amdgcn_readfirstlane(tid >> 6), lane = tid & 63, wr = wid >> 2, wc = wid & 3, fr = lane & 15, fq = lane >> 4;
  int K_ = g.K, lda_ = g.lda; asm volatile("" : "+s"(K_), "+s"(lda_));
  const int K = K_, nt = K / BK, lda = lda_;
  unsigned voffB[2]; int RA[2], CA[2];
#pragma unroll
  for (int i = 0; i < 2; ++i) { int R, C; stage_rc(tid * 16 + i * 8192, R, C); const int Rb = Epi::PERM ? ((R & ~31) + perm32(R & 31)) : R;
    RA[i] = R; CA[i] = C; voffB[i] = (unsigned)(Rb * K + C) * 2u; }
  const size_t kstep = (size_t)(BK * 2);
  const size_t hstepB = (size_t)HALF * K * 2, tstepB = 2 * hstepB;
  const size_t tstepA = (size_t)BM * lda * 2;
  const unsigned ldsw = (unsigned)wid * 1024u;
  const int aoff = lds_byte(wr * 64 + fr, fq * 8), boff = lds_byte(wc * 32 + fr, fq * 8);
#define PG8_SA(b, h) (((b) * 2 + (h)) * HTB)
#define PG8_SB(b, h) ((4 + (b) * 2 + (h)) * HTB)
#define PG8_STAGE(bufoff, gbase, voff) do { _Pragma("unroll") for (int _i = 0; _i < 2; ++_i) \
        __builtin_amdgcn_global_load_lds((const unsigned*)((const char*)(gbase) + (voff)[_i]), (LAS unsigned*)(lds + (bufoff) + ldsw + _i * 8192), 16, 0, 0); } while (0)
#define PG8_LDA(dst, b, h) do { _Pragma("unroll") for (int m = 0; m < 4; ++m) _Pragma("unroll") for (int k = 0; k < 2; ++k) dst[m][k] = *(const LAS bf16x8*)(lds + PG8_SA(b, h) + aoff + m * 2048 + k * 1024); } while (0)
#define PG8_LDB(dst, b, h) do { _Pragma("unroll") for (int n = 0; n < 2; ++n) _Pragma("unroll") for (int k = 0; k < 2; ++k) dst[n][k] = *(const LAS bf16x8*)(lds + PG8_SB(b, h) + boff + n * 2048 + k * 1024); } while (0)
#define PG8_MMA(ai, bj, At, Bt) do { __builtin_amdgcn_s_setprio(1); _Pragma("unroll") for (int m = 0; m < 4; ++m) _Pragma("unroll") for (int n = 0; n < 2; ++n) _Pragma("unroll") for (int k = 0; k < 2; ++k) \
        acc[ai][bj][m][n] = __builtin_amdgcn_mfma_f32_16x16x32_bf16(Bt[n][k], At[m][k], acc[ai][bj][m][n], 0, 0, 0); __builtin_amdgcn_s_setprio(0); } while (0)
#define PG8_WAIT_V(n) asm volatile("s_waitcnt vmcnt(" #n ")" ::: "memory")
#define PG8_WAIT_L(n) asm volatile("s_waitcnt lgkmcnt(" #n ")" ::: "memory")
#define PG8_BAR __builtin_amdgcn_s_barrier()
#define PG8_SCHED __builtin_amdgcn_sched_barrier(0)
#define PG8_OFFS(dst, u) do { _Pragma("unroll") for (int _h = 0; _h < 2; ++_h) _Pragma("unroll") for (int _i = 0; _i < 2; ++_i) \
        dst[_h][_i] = Sched::GATHER ? (unsigned)((size_t)S.arow(u, _h * HALF + RA[_i]) * lda + CA[_i]) * 2u : (unsigned)((_h * HALF + RA[_i]) * lda + CA[_i]) * 2u; } while (0)
  Unit cur, nxt; int ui = 0;
  if (!S.next(0, cur)) return;
  f32x4 acc[2][2][4][2];
#pragma unroll
  for (int a = 0; a < 2; ++a)
#pragma unroll
    for (int b = 0; b < 2; ++b)
#pragma unroll
      for (int m = 0; m < 4; ++m)
#pragma unroll
        for (int n = 0; n < 2; ++n) acc[a][b][m][n] = (f32x4){0.f, 0.f, 0.f, 0.f};
  bf16x8 At[4][2], B0[2][2], B1[2][2];
  unsigned oAc[2][2], oAn[2][2];
  PG8_OFFS(oAc, cur);
  const char* cA = (const char*)g.A + (Sched::GATHER ? (size_t)0 : (size_t)cur.pm * tstepA); const char* cB = (const char*)g.Bt + (size_t)cur.pn * tstepB;
  PG8_STAGE(PG8_SB(0, 0), cB, voffB); PG8_STAGE(PG8_SB(0, 1), cB + hstepB, voffB); PG8_STAGE(PG8_SA(0, 0), cA, oAc[0]); PG8_STAGE(PG8_SA(0, 1), cA, oAc[1]);
  if (wr == 1) PG8_BAR;
  PG8_WAIT_V(2); PG8_BAR;
  PG8_STAGE(PG8_SB(1, 0), cB + kstep, voffB); PG8_STAGE(PG8_SA(1, 0), cA + kstep, oAc[0]); PG8_STAGE(PG8_SB(1, 1), cB + hstepB + kstep, voffB);
  PG8_WAIT_V(6); PG8_BAR;
  for (;;) {
    const bool has_next = S.next(ui + 1, nxt);
    if (has_next) { PG8_OFFS(oAn, nxt); }
    else {
#pragma unroll
      for (int _h = 0; _h < 2; ++_h)
#pragma unroll
        for (int _i = 0; _i < 2; ++_i) oAn[_h][_i] = oAc[_h][_i];
    }
    const char* nA = has_next ? (const char*)g.A + (Sched::GATHER ? (size_t)0 : (size_t)nxt.pm * tstepA) : cA; const char* nB = has_next ? (const char*)g.Bt + (size_t)nxt.pn * tstepB : cB;
    for (int t = 0; t < nt; t += 2) {
      const bool last = (t == nt - 2);
      const char* a1 = cA + (size_t)(t + 1) * kstep;
      const char* a2 = last ? nA : cA + (size_t)(t + 2) * kstep; const char* b2 = last ? nB : cB + (size_t)(t + 2) * kstep;
      const char* a3 = a2 + kstep; const char* b3 = b2 + kstep;
      unsigned o2[2][2];
#pragma unroll
      for (int _h = 0; _h < 2; ++_h)
#pragma unroll
        for (int _i = 0; _i < 2; ++_i) o2[_h][_i] = last ? oAn[_h][_i] : oAc[_h][_i];
      PG8_LDB(B0, 0, 0); PG8_LDB(B1, 0, 1); PG8_SCHED; PG8_LDA(At, 0, 0); PG8_STAGE(PG8_SA(1, 1), a1, oAc[1]);
      PG8_WAIT_V(8); PG8_WAIT_L(0); PG8_BAR; PG8_MMA(0, 0, At, B0); PG8_MMA(0, 1, At, B1); PG8_BAR; PG8_SCHED;
      PG8_LDA(At, 0, 1); PG8_STAGE(PG8_SB(0, 0), b2, voffB); PG8_STAGE(PG8_SB(0, 1), b2 + hstepB, voffB); PG8_STAGE(PG8_SA(0, 0), a2, o2[0]);
      PG8_WAIT_V(8); PG8_WAIT_L(0); PG8_BAR; PG8_MMA(1, 0, At, B0); PG8_MMA(1, 1, At, B1); PG8_BAR; PG8_SCHED;
      PG8_LDB(B0, 1, 0); PG8_LDB(B1, 1, 1); PG8_SCHED; PG8_LDA(At, 1, 0); PG8_STAGE(PG8_SA(0, 1), a2, o2[1]);
      PG8_WAIT_V(8); PG8_WAIT_L(0); PG8_BAR; PG8_MMA(0, 0, At, B0); PG8_MMA(0, 1, At, B1); PG8_BAR; PG8_SCHED;
      PG8_LDA(At, 1, 1); PG8_STAGE(PG8_SB(1, 0), b3, voffB); PG8_STAGE(PG8_SB(1, 1), b3 + hstepB, voffB); PG8_STAGE(PG8_SA(1, 0), a3, o2[0]);
      PG8_WAIT_V(8); PG8_WAIT_L(0); PG8_BAR; PG8_MMA(1, 0, At, B0); PG8_MMA(1, 1, At, B1); PG8_BAR; PG8_SCHED;
    }
    if (wr == 0) PG8_BAR;
    E(acc, cur, wr, wc, fr, fq);
    if (!has_next) break;
#pragma unroll
    for (int a = 0; a < 2; ++a)
#pragma unroll
      for (int b = 0; b < 2; ++b)
#pragma unroll
        for (int m = 0; m < 4; ++m)
#pragma unroll
          for (int n = 0; n < 2; ++n) acc[a][b][m][n] = (f32x4){0.f, 0.f, 0.f, 0.f};
    cur = nxt; cA = nA; cB = nB; ++ui;
#pragma unroll
    for (int _h = 0; _h < 2; ++_h)
#pragma unroll
      for (int _i = 0; _i < 2; ++_i) oAc[_h][_i] = oAn[_h][_i];
    if (wr == 1) PG8_BAR;
  }
  PG8_WAIT_V(0);
  PG8_BAR;
#undef PG8_SA
#undef PG8_SB
#undef PG8_STAGE
#undef PG8_LDA
#undef PG8_LDB
#undef PG8_MMA
#undef PG8_WAIT_V
#undef PG8_WAIT_L
#undef PG8_BAR
#undef PG8_SCHED
#undef PG8_OFFS
}
}
using pg8::Unit;
struct EpiU {
  static constexpr bool PERM = true;
  bf16_t* O; int ldc;
  DI void operator()(const f32x4 (&acc)[2][2][4][2], const Unit& u, int wr, int wc, int fr, int fq) const {
    const int row0 = u.pm * 256 + wr * 64 + fr;
#pragma unroll
    for (int ai = 0; ai < 2; ++ai)
#pragma unroll
      for (int m = 0; m < 4; ++m) { bf16_t* rowp = O + (size_t)(row0 + ai * 128 + m * 16) * ldc;
#pragma unroll
        for (int bj = 0; bj < 2; ++bj) { const int col = u.pn * 256 + bj * 128 + wc * 32 + 8 * fq;
          f32x4 v0 = acc[ai][bj][m][0], v1 = acc[ai][bj][m][1];
          if (col >= 1152 && col < 1216) {
#pragma unroll
            for (int j = 0; j < 4; ++j) { v0[j] = tanhf(v0[j]); v1[j] = tanhf(v1[j]); }
          } else if (col >= 1280 && col < 1536) {
#pragma unroll
            for (int j = 0; j < 4; ++j) { v0[j] = sigmoidf_(v0[j]); v1[j] = sigmoidf_(v1[j]); }
          }
          u32x4 w; w.x = cvtpk(v0[0], v0[1]); w.y = cvtpk(v0[2], v0[3]); w.z = cvtpk(v1[0], v1[1]); w.w = cvtpk(v1[2], v1[3]);
          *(u32x4*)(rowp + col) = w; } }
  }
};
struct EpiPlain {
  static constexpr bool PERM = true;
  bf16_t* O; int ldc;
  DI void operator()(const f32x4 (&acc)[2][2][4][2], const Unit& u, int wr, int wc, int fr, int fq) const {
    const int row0 = u.pm * 256 + wr * 64 + fr;
#pragma unroll
    for (int ai = 0; ai < 2; ++ai)
#pragma unroll
      for (int m = 0; m < 4; ++m) { bf16_t* rowp = O + (size_t)(row0 + ai * 128 + m * 16) * ldc;
#pragma unroll
        for (int bj = 0; bj < 2; ++bj) { const int col = u.pn * 256 + bj * 128 + wc * 32 + 8 * fq;
          const f32x4 v0 = acc[ai][bj][m][0], v1 = acc[ai][bj][m][1];
          u32x4 w; w.x = cvtpk(v0[0], v0[1]); w.y = cvtpk(v0[2], v0[3]); w.z = cvtpk(v1[0], v1[1]); w.w = cvtpk(v1[2], v1[3]);
          *(u32x4*)(rowp + col) = w; } }
  }
};
struct EpiLW {
  static constexpr bool PERM = true;
  bf16_t* EW; bf16_t* AS; const float* w0; const float* a0;
  DI void operator()(const f32x4 (&acc)[2][2][4][2], const Unit& u, int wr, int wc, int fr, int fq) const {
    const int row0 = u.pm * 256 + wr * 64 + fr;
    const bool isw = u.pn < 3;
    bf16_t* O = isw ? EW : AS; const float* bias = isw ? w0 : a0; const float sc = isw ? 0.6065306597126334f : 1.f;
    const int cb = (isw ? u.pn : u.pn - 3) * 256;
#pragma unroll
    for (int bj = 0; bj < 2; ++bj) { const int col = cb + bj * 128 + wc * 32 + 8 * fq;
      const f32x4 b0 = *(const f32x4*)(bias + col), b1 = *(const f32x4*)(bias + col + 4);
#pragma unroll
      for (int ai = 0; ai < 2; ++ai)
#pragma unroll
        for (int m = 0; m < 4; ++m) { bf16_t* rowp = O + (size_t)(row0 + ai * 128 + m * 16) * 768;
          f32x4 v0 = acc[ai][bj][m][0] + b0, v1 = acc[ai][bj][m][1] + b1;
#pragma unroll
          for (int j = 0; j < 4; ++j) { v0[j] = sc * sigmoidf_(v0[j]); v1[j] = sc * sigmoidf_(v1[j]); }
          u32x4 w; w.x = cvtpk(v0[0], v0[1]); w.y = cvtpk(v0[2], v0[3]); w.z = cvtpk(v1[0], v1[1]); w.w = cvtpk(v1[2], v1[3]);
          *(u32x4*)(rowp + col) = w; asm volatile("" ::: "memory"); } }
  }
};
struct EpiG {
  static constexpr bool PERM = true;
  bf16_t* G;
  DI void operator()(const f32x4 (&acc)[2][2][4][2], const Unit& u, int wr, int wc, int fr, int fq) const {
    const int row0 = u.pm * 256 + wr * 64 + fr;
#pragma unroll
    for (int bj = 0; bj < 2; ++bj) { const int col = u.pn * 256 + bj * 128 + wc * 32 + 8 * fq;
      if (col < 384) {
#pragma unroll
        for (int ai = 0; ai < 2; ++ai)
#pragma unroll
          for (int m = 0; m < 4; ++m) { bf16_t* rowp = G + (size_t)(row0 + ai * 128 + m * 16) * 384;
            const f32x4 v0 = acc[ai][bj][m][0], v1 = acc[ai][bj][m][1];
            u32x4 w; w.x = cvtpk(v0[0], v0[1]); w.y = cvtpk(v0[2], v0[3]); w.z = cvtpk(v1[0], v1[1]); w.w = cvtpk(v1[2], v1[3]);
            *(u32x4*)(rowp + col) = w; } } }
  }
};
struct EpiQ {
  static constexpr bool PERM = true;
  bf16_t* QB; const float* rstd; const float* rope;
  DI void operator()(const f32x4 (&acc)[2][2][4][2], const Unit& u, int wr, int wc, int fr, int fq) const {
    const int row0 = u.pm * 256 + wr * 64 + fr;
    const int b = (u.pm * 256) / PP;
#pragma unroll
    for (int bj = 0; bj < 2; ++bj) { const int col = u.pn * 256 + bj * 128 + wc * 32 + 8 * fq;
      const int hh = col / 96, dim = col - hh * 96;
      const bool isrope = dim >= 64;
#pragma unroll
      for (int ai = 0; ai < 2; ++ai)
#pragma unroll
        for (int m = 0; m < 4; ++m) { const int g = row0 + ai * 128 + m * 16; const int p = g - b * PP;
          const float s = rstd[g] * QSCALE;
          float v[8];
#pragma unroll
          for (int j = 0; j < 4; ++j) { v[j] = acc[ai][bj][m][0][j] * s; v[4 + j] = acc[ai][bj][m][1][j] * s; }
          if (isrope) {
            float o[8];
#pragma unroll
            for (int j = 0; j < 8; ++j) o[j] = swz_xor16(v[j]);
            if (p >= CTX) { const int li = p - CTX; const int pos = (fq & 2) ? (li & 63) : (li >> 6);
              const f32x2* rp = (const f32x2*)rope + pos * 8;
#pragma unroll
              for (int j = 0; j < 8; ++j) { const f32x2 cs = rp[j]; v[j] = (fq & 1) ? (v[j] * cs.x + o[j] * cs.y) : (v[j] * cs.x - o[j] * cs.y); } }
          }
          if (col < 576) { u32x4 w; w.x = cvtpk(v[0], v[1]); w.y = cvtpk(v[2], v[3]); w.z = cvtpk(v[4], v[5]); w.w = cvtpk(v[6], v[7]);
            *(u32x4*)(QB + ((size_t)(b * NH + hh) * PP + p) * 96 + dim) = w; }
          asm volatile("" ::: "memory"); }
    }
  }
};
DI int vperm(int p) { const int q = p & 15; return (p & ~15) | (((q >> 2) & 1) << 3) | ((q >> 3) << 2) | (q & 3); }
struct EpiKV {
  static constexpr bool PERM = true;
  bf16_t* KB; bf16_t* VT; const float* rstd;
  DI void operator()(const f32x4 (&acc)[2][2][4][2], const Unit& u, int wr, int wc, int fr, int fq) const {
    const int row0 = u.pm * 256 + wr * 64 + fr;
    const int b = (u.pm * 256) / PP;
#pragma unroll
    for (int bj = 0; bj < 2; ++bj) { const int col = u.pn * 256 + bj * 128 + wc * 32 + 8 * fq;
      const int hh = col >> 7, j0 = col & 127;
#pragma unroll
      for (int ai = 0; ai < 2; ++ai)
#pragma unroll
        for (int m = 0; m < 4; ++m) { const int g = row0 + ai * 128 + m * 16; const int p = g - b * PP;
          const float s = rstd[g];
          float v[8];
#pragma unroll
          for (int j = 0; j < 4; ++j) { v[j] = acc[ai][bj][m][0][j] * s; v[4 + j] = acc[ai][bj][m][1][j] * s; }
          if (j0 < 64) { u32x4 w; w.x = cvtpk(v[0], v[1]); w.y = cvtpk(v[2], v[3]); w.z = cvtpk(v[4], v[5]); w.w = cvtpk(v[6], v[7]);
            *(u32x4*)(KB + ((size_t)(b * NH + hh) * PP + p) * 96 + j0) = w; }
          else { bf16_t* vt = VT + ((size_t)(b * NH + hh) * 64 + (j0 - 64)) * PP + vperm(p);
#pragma unroll
            for (int j = 0; j < 8; ++j) vt[(size_t)j * PP] = f2bf(v[j]); }
          asm volatile("" ::: "memory"); }
    }
  }
};
struct EpiMoe1 {
  static constexpr bool PERM = false;
  bf16_t* HID;
  DI void operator()(const f32x4 (&acc)[2][2][4][2], const Unit& u, int wr, int wc, int fr, int fq) const {
    const int row0 = u.pm * 256 + wr * 64 + fr; const int pnl = u.pn & 7;
#pragma unroll
    for (int ai = 0; ai < 2; ++ai)
#pragma unroll
      for (int m = 0; m < 4; ++m) { bf16_t* rowp = HID + (size_t)(row0 + ai * 128 + m * 16) * 1024 + pnl * 128 + wc * 32 + 4 * fq;
#pragma unroll
        for (int n = 0; n < 2; ++n) { const f32x4 gv = acc[ai][0][m][n], uv = acc[ai][1][m][n]; float h[4];
#pragma unroll
          for (int j = 0; j < 4; ++j) h[j] = gv[j] * sigmoidf_(gv[j]) * uv[j];
          u32x2 w; w.x = cvtpk(h[0], h[1]); w.y = cvtpk(h[2], h[3]);
          *(u32x2*)(rowp + 16 * n) = w; } }
  }
};
struct EpiMoe2 {
  static constexpr bool PERM = true;
  bf16_t* O;
  DI void operator()(const f32x4 (&acc)[2][2][4][2], const Unit& u, int wr, int wc, int fr, int fq) const {
    const int row0 = u.pm * 256 + wr * 64 + fr; const int pnl = u.pn & 3;
#pragma unroll
    for (int ai = 0; ai < 2; ++ai)
#pragma unroll
      for (int m = 0; m < 4; ++m) { bf16_t* rowp = O + (size_t)(row0 + ai * 128 + m * 16) * 1024;
#pragma unroll
        for (int bj = 0; bj < 2; ++bj) { const int col = pnl * 256 + bj * 128 + wc * 32 + 8 * fq;
          const f32x4 v0 = acc[ai][bj][m][0], v1 = acc[ai][bj][m][1];
          u32x4 w; w.x = cvtpk(v0[0], v0[1]); w.y = cvtpk(v0[2], v0[3]); w.z = cvtpk(v1[0], v1[1]); w.w = cvtpk(v1[2], v1[3]);
          *(u32x4*)(rowp + col) = w; } }
  }
};
template <bool GATH> struct MoeOrder {
  static constexpr bool GATHER = GATH;
  int tpe, nN, nwg, G, c; const int* idx;
  __device__ void init(int tpe_, int nN_, int G_, int c_, const int* idx_) { tpe = tpe_; nN = nN_; nwg = NEXP * tpe * nN; G = G_; c = c_; idx = idx_; }
  __device__ bool next(int i, Unit& u) const {
    const long L = (long)i * G + c; if (L >= nwg) return false;
    const int per = tpe * nN, e = (int)L / per, rem = (int)L % per, pnl = rem / tpe, pml = rem % tpe;
    u.pm = e * 17 + pml; u.pn = e * nN + pnl; return true;
  }
  __device__ int arow(const Unit& u, int r) const { return idx[u.pm * 256 + r]; }
};
constexpr size_t MiB = (size_t)1 << 20;
constexpr size_t WS_CTL = 0;
constexpr size_t WS_MODP = 1 * MiB;
constexpr size_t WS_MOD = 3 * MiB;
constexpr size_t WS_TW = 3 * MiB + 256 * 1024;
constexpr size_t WS_ROPE = 3 * MiB + 384 * 1024;
constexpr size_t WS_RSTD = 3 * MiB + 512 * 1024;
constexpr size_t WS_WIN = 4 * MiB;
constexpr size_t WS_WOUT = 13 * MiB;
constexpr size_t WS_WLW = 17 * MiB;
constexpr size_t WS_WG = 18 * MiB;
constexpr size_t WS_WQ = 19 * MiB;
constexpr size_t WS_WKV = 20 * MiB;
constexpr size_t WS_AFF = 21 * MiB;
constexpr size_t WS_IDX = 24 * MiB;
constexpr size_t WS_SLOT = 29 * MiB;
constexpr size_t WS_XCTX = 25 * MiB;
constexpr size_t WS_R1 = 36 * MiB;
constexpr size_t WS_R2 = 192 * MiB;
constexpr size_t WS_R3 = 292 * MiB;
constexpr size_t WS_R4 = 416 * MiB;
constexpr size_t WS_R5 = 452 * MiB;
constexpr size_t WS_R6 = 502 * MiB;
constexpr size_t WS_HID = 416 * MiB;
constexpr size_t WS_END = 568 * MiB;

struct Params {
  const float* in[32];
  float* out; unsigned char* ws;
};

typedef const float* cfptr;
struct Ctx {
  const __attribute__((address_space(4))) cfptr* in; float* out; unsigned char* ws;
  LAS unsigned char* lds; unsigned char* ldsg;
  int tid, lane, wave, G, bid;
};

#define GAS __attribute__((address_space(1)))
DI const float* inp(const Ctx& C, int k) { return (const float*)(const GAS float*)C.in[k]; }
DI const float* in_row(const Ctx& C, int g) { const int b = g / PP, p = g - b * PP; return p < CTX ? inp(C, 2) + ((size_t)b * CTX + p) * DM : inp(C, 0) + ((size_t)b * SEQ + (p - CTX)) * DM; }
DI float* xs_row(const Ctx& C, int g) { const int b = g / PP, p = g - b * PP; return p < CTX ? (float*)(C.ws + WS_XCTX) + ((size_t)b * CTX + p) * DM : C.out + ((size_t)b * SEQ + (p - CTX)) * DM; }
DI int mod_row(int g) { const int b = g / PP, p = g - b * PP; return p < CTX ? 4 : b; }
DI const float* modv(const Ctx& C, int l, int r, int j) { return (const float*)(C.ws + WS_MOD) + ((size_t)(l * 5 + r) * 6 + j) * DM; }

template <class RowMap>
DI void transpose_item(const float* W, int K, int N, bf16_t* WT, int ldk, LAS float* scr, int item, int lane, const RowMap& rm) {
  const int nblk = N / 32, kb = item / nblk, nb = item % nblk, k0 = 64 * kb, n0 = 32 * nb;
#pragma unroll 8
  for (int i = 0; i < 32; ++i) { const int kk = 2 * i + (lane >> 5); scr[kk * 33 + (lane & 31)] = W[(size_t)(k0 + kk) * N + n0 + (lane & 31)]; }
  asm volatile("s_waitcnt lgkmcnt(0)" ::: "memory");
  const int c = lane & 7;
#pragma unroll
  for (int j = 0; j < 4; ++j) { const int n = (lane >> 3) + 8 * j; const LAS float* s = scr + (8 * c) * 33 + n;
    u32x4 o; o.x = cvtpk(s[0 * 33], s[1 * 33]); o.y = cvtpk(s[2 * 33], s[3 * 33]); o.z = cvtpk(s[4 * 33], s[5 * 33]); o.w = cvtpk(s[6 * 33], s[7 * 33]);
    const int r = rm(n0 + n);
    if (r >= 0) *(u32x4*)(WT + (size_t)r * ldk + k0 + 8 * c) = o; }
  asm volatile("s_waitcnt lgkmcnt(0)" ::: "memory");
}
struct MapIn { DI int operator()(int n) const { return n < 1440 ? n : (n < 1856 ? n + 96 : n + 192); } };
struct MapId { DI int operator()(int n) const { return n; } };
struct MapGate { int up; DI int operator()(int f) const { return 256 * (f >> 7) + 128 * up + (f & 127); } };

DI void phase0(const Ctx& C) {
  const int gw = C.bid * NWAVES + C.wave, NGW = C.G * NWAVES;
  const int gt = C.bid * NTHREADS + C.tid, NGT = C.G * NTHREADS;
  LAS float* scr = (LAS float*)(C.lds + C.wave * 16384);
  {
    const float* cin = inp(C, 1); const float* cctx = inp(C, 3);
    for (int it = gw; it < 2 * 96 * 8; it += NGW) {
      const int l = it / 768, r_ = it % 768, cc = r_ / 8, kc = r_ % 8;
      const float* W = inp(C, 4) + (size_t)l * DM * 6144 + (size_t)(kc * 128) * 6144 + cc * 64 + C.lane;
      float a0 = 0.f, a1 = 0.f, a2 = 0.f, a3 = 0.f, a4 = 0.f;
#pragma unroll 8
      for (int k = 0; k < 128; ++k) { const float w = W[(size_t)k * 6144]; const int kk = kc * 128 + k;
        const float c0 = cin[kk], c1 = cin[DM + kk], c2 = cin[2 * DM + kk], c3 = cin[3 * DM + kk], c4 = cctx[kk];
        a0 += c0 * sigmoidf_(c0) * w; a1 += c1 * sigmoidf_(c1) * w; a2 += c2 * sigmoidf_(c2) * w; a3 += c3 * sigmoidf_(c3) * w; a4 += c4 * sigmoidf_(c4) * w; }
      float* P = (float*)(C.ws + WS_MODP) + ((size_t)(l * 8 + kc) * 5) * 6144 + cc * 64 + C.lane;
      P[0] = a0; P[6144] = a1; P[2 * 6144] = a2; P[3 * 6144] = a3; P[4 * 6144] = a4;
    }
  }
  for (int l = 0; l < 2; ++l) {
    bf16_t* WT = (bf16_t*)(C.ws + WS_WIN) + (size_t)l * UW * DM;
    for (int i = gt; i < 192 * DM / 8; i += NGT) { const int r = i / (DM / 8), c8 = i % (DM / 8); const int row = r < 96 ? 1440 + r : 1952 + (r - 96);
      *(u32x4*)(WT + (size_t)row * DM + c8 * 8) = (u32x4){0u, 0u, 0u, 0u}; }
    for (int it = gw; it < 16 * 66; it += NGW) transpose_item(inp(C, 10) + (size_t)l * DM * 2112, DM, 2112, WT, DM, scr, it, C.lane, MapIn());
    bf16_t* WO = (bf16_t*)(C.ws + WS_WOUT) + (size_t)l * DM * DM;
    for (int it = gw; it < 12 * 32; it += NGW) transpose_item(inp(C, 11) + (size_t)l * DM * DM, 768, DM, WO, DM, scr, it, C.lane, MapId());
    const float* wf = inp(C, 27) + (size_t)l * 256 * 256; const float* wo = inp(C, 11) + (size_t)l * DM * DM + (size_t)768 * DM;
    for (int it = gw; it < 64 * 16; it += NGW) { const int kq = it / 16, nc = it % 16; const int n = nc * 64 + C.lane;
      float a0 = 0.f, a1 = 0.f, a2 = 0.f, a3 = 0.f;
#pragma unroll 4
      for (int j = 0; j < 256; ++j) { const float w = wo[(size_t)j * DM + n];
        a0 += wf[(kq * 4 + 0) * 256 + j] * w; a1 += wf[(kq * 4 + 1) * 256 + j] * w; a2 += wf[(kq * 4 + 2) * 256 + j] * w; a3 += wf[(kq * 4 + 3) * 256 + j] * w; }
      u32x2 o; o.x = cvtpk(a0, a1); o.y = cvtpk(a2, a3);
      *(u32x2*)(WO + (size_t)n * DM + 768 + kq * 4) = o; }
    bf16_t* WLW = (bf16_t*)(C.ws + WS_WLW) + (size_t)l * 1536 * 128;
    for (int i = gt; i < 1536 * 128; i += NGT) { const int n = i / 128, k = i % 128; float v = 0.f;
      if (n < 768) { if (k < 64) v = inp(C, 14)[((size_t)(l * 2 + n / 384) * 64 + k) * 384 + n % 384]; }
      else { const int n2 = n - 768; if (k >= 64) v = inp(C, 16)[((size_t)(l * 2 + n2 / 384) * 64 + (k - 64)) * 384 + n2 % 384]; }
      WLW[i] = f2bf(v); }
    bf16_t* WG = (bf16_t*)(C.ws + WS_WG) + (size_t)l * 512 * 256;
    for (int i = gt; i < 512 * 256; i += NGT) { const int n = i / 256, k = i % 256; float v = 0.f;
      if (n < 384 && k < 160) v = inp(C, 17)[((size_t)l * 160 + k) * 384 + n];
      WG[i] = f2bf(v); }
    bf16_t* WQ = (bf16_t*)(C.ws + WS_WQ) + (size_t)l * 768 * 256;
    for (int i = gt; i < 768 * 256; i += NGT) { const int n = i / 256, k = i % 256; float v = 0.f;
      if (n < 576) v = inp(C, 23)[l * 256 + k] * inp(C, 24)[((size_t)l * 256 + k) * 576 + n];
      WQ[i] = f2bf(v); }
    bf16_t* WKV = (bf16_t*)(C.ws + WS_WKV) + (size_t)l * 768 * 128;
    for (int i = gt; i < 768 * 128; i += NGT) { const int n = i / 128, k = i % 128;
      WKV[i] = f2bf(inp(C, 25)[l * 128 + k] * inp(C, 26)[((size_t)l * 128 + k) * 768 + n]); }
  }
  for (int i = gt; i < 8192; i += NGT) { float s, c; sincospif((float)i * (2.0f / 8192.0f), &s, &c); ((f32x2*)(C.ws + WS_TW))[i] = (f32x2){c, -s}; }
  for (int i = gt; i < 128 * 8; i += NGT) { const int pos = i / 8, j = i % 8; const float inv = powf(10000.0f, -(float)j / 8.0f); float s, c; sincosf((float)pos * inv, &s, &c); ((f32x2*)(C.ws + WS_ROPE))[i] = (f32x2){c, s}; }
}
DI void phase0b(const Ctx& C) {
  const int gt = C.bid * NTHREADS + C.tid, NGT = C.G * NTHREADS;
  for (int i = gt; i < 2 * 5 * 6144; i += NGT) { const int l = i / (5 * 6144), r = (i / 6144) % 5, n = i % 6144;
    float s = inp(C, 5)[l * 6144 + n];
#pragma unroll
    for (int kc = 0; kc < 8; ++kc) s += ((const float*)(C.ws + WS_MODP))[((size_t)(l * 8 + kc) * 5 + r) * 6144 + n];
    ((float*)(C.ws + WS_MOD))[i] = s; }
}

DI void convert_experts(const Ctx& C, int l) {
  LAS float* scr = (LAS float*)(C.lds + C.wave * 16384);
  bf16_t* WGU = (bf16_t*)(C.ws + WS_R3); bf16_t* WDN = WGU + (size_t)NEXP * 2048 * 1024;
  unsigned* ctr = (unsigned*)(C.ws + WS_CTL) + 64 * (8 + l);
  for (;;) { unsigned base = 0; if (C.lane == 0) base = atomicAdd(ctr, 8u); base = __builtin_amdgcn_readfirstlane(base);
    if (base >= NEXP * 3 * 512) break;
    for (int k = 0; k < 8; ++k) { const int it = base + k; const int e = it / 1536, r = it % 1536, mat = r / 512, sub = r % 512;
      const size_t woff = ((size_t)l * NEXP + e) * 1024 * 1024;
      if (mat == 0) transpose_item(inp(C, 29) + woff, 1024, 1024, WGU + (size_t)e * 2048 * 1024, 1024, scr, sub, C.lane, MapGate{0});
      else if (mat == 1) transpose_item(inp(C, 30) + woff, 1024, 1024, WGU + (size_t)e * 2048 * 1024, 1024, scr, sub, C.lane, MapGate{1});
      else transpose_item(inp(C, 31) + woff, 1024, 1024, WDN + (size_t)e * 1024 * 1024, 1024, scr, sub, C.lane, MapId()); } }
}

DI void norm_pass(const Ctx& C, int mode, int l, int lp) {
  const int gw = C.bid * NWAVES + C.wave, NGW = C.G * NWAVES, lane = C.lane;
  bf16_t* XN = (bf16_t*)(C.ws + WS_R2); const bf16_t* DOWN = (const bf16_t*)(C.ws + WS_R1); const int* SLOT = (const int*)(C.ws + WS_SLOT); const float* AFF = (const float*)(C.ws + WS_AFF);
  f32x4 vn[4]; int slotn = -1; float affn = 0.f;
#define NP_LOAD(gg) do { const f32x4* xr_ = (const f32x4*)(mode == 0 ? in_row(C, gg) : xs_row(C, gg)) + lane; _Pragma("unroll") for (int j = 0; j < 4; ++j) vn[j] = xr_[64 * j]; \
    if (mode != 0) { slotn = lane < 16 ? SLOT[(size_t)(gg) * 16 + lane] : -1; affn = lane < 16 ? AFF[(size_t)(gg) * 16 + lane] : 0.f; } } while (0)
  if (gw < TT) NP_LOAD(gw);
  for (int g = gw; g < TT; g += NGW) {
    const int mr = mod_row(g); const bool isctx = (mr == 4);
    f32x4 v[4]; const int myslot = slotn; const float myaff = affn;
#pragma unroll
    for (int j = 0; j < 4; ++j) v[j] = vn[j];
    if (g + NGW < TT) NP_LOAD(g + NGW);
    if (mode == 2 && isctx) continue;
    if (mode != 0) { f32x4* xr = (f32x4*)xs_row(C, g) + lane;
      f32x4 y[4]; float s = 0.f;
#pragma unroll
      for (int j = 0; j < 4; ++j) y[j] = (f32x4){0.f, 0.f, 0.f, 0.f};
      for (int e = 0; e < 16; ++e) { const int sl = __builtin_amdgcn_readlane(myslot, e);
        if (sl >= 0) { const float a = rdlane(myaff, e); const u32x2* dr = (const u32x2*)(DOWN + (size_t)sl * DM) + lane;
#pragma unroll
          for (int j = 0; j < 4; ++j) { const u32x2 w = dr[64 * j]; y[j] = y[j] + (f32x4){bflo(w.x), bfhi(w.x), bflo(w.y), bfhi(w.y)} * a; } } }
#pragma unroll
      for (int j = 0; j < 4; ++j) s += (y[j].x * y[j].x + y[j].y * y[j].y) + (y[j].z * y[j].z + y[j].w * y[j].w);
      const float rstd = rsqrtf(wave_sum(s) * (1.f / DM) + NORM_EPS);
      const f32x4* m5 = (const f32x4*)modv(C, lp, mr, 5) + lane; const f32x4* gp = (const f32x4*)(inp(C, 9) + lp * DM) + lane;
#pragma unroll
      for (int j = 0; j < 4; ++j) { v[j] = v[j] + m5[64 * j] * (y[j] * rstd * gp[64 * j]); xr[64 * j] = v[j]; }
      if (mode == 2) continue; }
    float s = 0.f;
#pragma unroll
    for (int j = 0; j < 4; ++j) s += (v[j].x * v[j].x + v[j].y * v[j].y) + (v[j].z * v[j].z + v[j].w * v[j].w);
    const float rstd = rsqrtf(wave_sum(s) * (1.f / DM) + NORM_EPS);
    const f32x4* m0 = (const f32x4*)modv(C, l, mr, 0) + lane; const f32x4* m1 = (const f32x4*)modv(C, l, mr, 1) + lane; const f32x4* gp = (const f32x4*)(inp(C, 6) + l * DM) + lane;
    u32x2* o = (u32x2*)(XN + (size_t)g * DM) + lane;
#pragma unroll
    for (int j = 0; j < 4; ++j) { const f32x4 t = v[j] * rstd * gp[64 * j] * (m1[64 * j] + 1.0f) + m0[64 * j]; u32x2 w; w.x = cvtpk(t.x, t.y); w.y = cvtpk(t.z, t.w); o[64 * j] = w; }
  }
#undef NP_LOAD
}

DI void prep_a(const Ctx& C, int l) {
  const bf16_t* U = (const bf16_t*)(C.ws + WS_R1);
  float* rq = (float*)(C.ws + WS_RSTD); float* rkv = rq + TT;
  bf16_t* KB = (bf16_t*)(C.ws + WS_R2) + (size_t)NB * NH * PP * 96;
  const f32x2* rope = (const f32x2*)(C.ws + WS_ROPE);
  const int lane = C.lane;
  LAS float* zrow = (LAS float*)(C.lds + C.wave * 1024);
  LAS f32x2* stage = (LAS f32x2*)(C.lds + 16384);
  LAS f32x2* tw64 = (LAS f32x2*)(C.lds + 16384 + 132 * 64 * 8);
  if (C.tid < 64) { float s, c; sincospif((float)C.tid * (2.0f / 64.0f), &s, &c); tw64[C.tid] = (f32x2){c, s}; }
  __syncthreads();
  for (int tile = C.bid; tile < TT / 64; tile += C.G) {
    const int g0 = tile * 64; const int b = g0 / PP, p0 = g0 - b * PP;
    for (int i = 0; i < 8; ++i) { const int tl = C.wave * 8 + i; const int g = g0 + tl; const int p = p0 + tl;
      const bf16_t* ur = U + (size_t)g * UW;
      { const u32x2 w = *((const u32x2*)(ur + 1536) + lane); const float a0 = bflo(w.x), a1 = bfhi(w.x), a2 = bflo(w.y), a3 = bfhi(w.y);
        const float s = wave_sum(a0 * a0 + a1 * a1 + a2 * a2 + a3 * a3); if (lane == 0) rq[g] = rsqrtf(s * (1.f / 256.f) + NORM_EPS); }
      { const unsigned w = *((const unsigned*)(ur + 1792) + lane); const float a0 = bflo(w), a1 = bfhi(w);
        const float s = wave_sum(a0 * a0 + a1 * a1); if (lane == 0) rkv[g] = rsqrtf(s * (1.f / 128.f) + NORM_EPS); }
      { float x = lane < 32 ? bf2f(ur[1920 + lane]) : 0.f; const float o = swz_xor8(x);
        if (p >= CTX && lane < 32) { const int li = p - CTX; const int pos = (lane & 16) ? (li & 63) : (li >> 6); const f32x2 cs = rope[pos * 8 + (lane & 7)];
          x = (lane & 8) ? (x * cs.x + o * cs.y) : (x * cs.x - o * cs.y); }
        if (lane < 32) { const bf16_t xb = f2bf(x);
#pragma unroll
          for (int hh = 0; hh < NH; ++hh) KB[((size_t)(b * NH + hh) * PP + p) * 96 + 64 + lane] = xb; } }
      { const u32x2 w = *((const u32x2*)(ur + 2048) + lane); *(LAS f32x4*)(zrow + lane * 4) = (f32x4){bflo(w.x), bfhi(w.x), bflo(w.y), bfhi(w.y)}; }
      asm volatile("s_waitcnt lgkmcnt(0)" ::: "memory");
      { const int grp = lane >> 4, kq = lane & 15; const LAS float* z = zrow + grp * 64;
        float c0 = 0.f, s0 = 0.f, c1 = 0.f, s1 = 0.f, c2 = 0.f;
#pragma unroll 8
        for (int n = 0; n < 64; ++n) { const float zv = z[n]; const f32x2 t0 = tw64[(kq * n) & 63], t1 = tw64[((kq + 16) * n) & 63];
          c0 += zv * t0.x; s0 += zv * t0.y; c1 += zv * t1.x; s1 += zv * t1.y; c2 += (n & 1) ? -zv : zv; }
        stage[(grp * 33 + kq) * 64 + tl] = (f32x2){c0, -s0}; stage[(grp * 33 + kq + 16) * 64 + tl] = (f32x2){c1, -s1};
        if (kq == 0) stage[(grp * 33 + 32) * 64 + tl] = (f32x2){c2, 0.f}; }
      asm volatile("s_waitcnt lgkmcnt(0)" ::: "memory");
    }
    __syncthreads();
    f32x2* ZT = (f32x2*)(C.ws + WS_R4);
    for (int i = C.tid; i < 132 * 64; i += NTHREADS) { const int r = i >> 6, t = i & 63; ZT[((size_t)b * 132 + r) * PP + p0 + t] = stage[i]; }
    __syncthreads();
  }
}

DI void post_pass(const Ctx& C, int l, bool with_ctx) {
  const int gw = C.bid * NWAVES + C.wave, NGW = C.G * NWAVES, lane = C.lane;
  const bf16_t* U = (const bf16_t*)(C.ws + WS_R1);
  const bf16_t* AS = (const bf16_t*)(C.ws + WS_R3) + (size_t)TT * 768; const bf16_t* Gt = AS + (size_t)TT * 768;
  const bf16_t* Y0 = (const bf16_t*)(C.ws + WS_R5); const bf16_t* Y1 = Y0 + (size_t)TT * 384;
  bf16_t* MC = (bf16_t*)(C.ws + WS_R6);
  const float* cw = inp(C, 12) + (size_t)l * 3 * 1152; const float* k_a = inp(C, 19) + l * 384; const float* r_k = inp(C, 20) + l * 384;
  const float* lw = inp(C, 21) + l * 384; const float* lb = inp(C, 22) + l * 384;
  for (int g = gw; g < TT; g += NGW) {
    const int b = g / PP, p = g - b * PP; if (p < CTX && !with_ctx) continue;
    const float ml = (p != 0 && p != CTX) ? 1.f : 0.f, mr = (p != CTX - 1 && p != PP - 1) ? 1.f : 0.f;
    const bf16_t* u0 = U + (size_t)g * UW; const bf16_t* ul = ml != 0.f ? u0 - UW : u0; const bf16_t* ur_ = mr != 0.f ? u0 + UW : u0;
    unsigned short xu[6][3][3], y0[6], y1[6], a0[6], a1[6], gg[6];
#pragma unroll
    for (int hh = 0; hh < NH; ++hh) { const int c = hh * 64 + lane;
#pragma unroll
      for (int q = 0; q < 3; ++q) { xu[hh][q][0] = ul[q * 384 + c]; xu[hh][q][1] = u0[q * 384 + c]; xu[hh][q][2] = ur_[q * 384 + c]; }
      y0[hh] = Y0[(size_t)g * 384 + c]; y1[hh] = Y1[(size_t)g * 384 + c]; a0[hh] = AS[(size_t)g * 768 + c]; a1[hh] = AS[(size_t)g * 768 + 384 + c]; gg[hh] = Gt[(size_t)g * 384 + c]; }
#pragma unroll
    for (int hh = 0; hh < NH; ++hh) { const int c = hh * 64 + lane;
      float rkv[3];
#pragma unroll
      for (int q = 0; q < 3; ++q) { const int col = q * 384 + c; rkv[q] = bf2f(xu[hh][q][1]) * cw[1152 + col] + ml * bf2f(xu[hh][q][0]) * cw[col] + mr * bf2f(xu[hh][q][2]) * cw[2 * 1152 + col]; }
      const float y = bf2f(y0[hh]) + bf2f(y1[hh]);
      const float mu = wave_sum(y) * (1.f / 64.f); const float dv = y - mu; const float var = wave_sum(dv * dv) * (1.f / 64.f);
      const float yn = dv * rsqrtf(var + GN_EPS) * lw[c] + lb[c];
      const float al0 = bf2f(a0[hh]), al1 = bf2f(a1[hh]); const float ka = k_a[c];
      const float kd0 = rkv[1] * (1.f + (al0 - 1.f) * ka), kd1 = rkv[1] * (1.f + (al1 - 1.f) * ka);
      const float bonus = wave_sum(rkv[0] * (kd0 + kd1) * r_k[c]);
      const float o = (yn + bonus * rkv[2]) * bf2f(gg[hh]);
      MC[(size_t)g * DM + c] = f2bf(o); }
  }
}

DI void n2_pass(const Ctx& C, int l, bool with_ctx) {
  const int gw = C.bid * NWAVES + C.wave, NGW = C.G * NWAVES, lane = C.lane;
  const bf16_t* O = (const bf16_t*)(C.ws + WS_R1); bf16_t* TN = (bf16_t*)(C.ws + WS_R2); float* AFF = (float*)(C.ws + WS_AFF); int* SLOT = (int*)(C.ws + WS_SLOT);
  LAS float* wr = (LAS float*)C.lds; const float* wrg = inp(C, 28) + (size_t)l * DM * NEXP;
  for (int i = C.tid; i < DM * NEXP; i += NTHREADS) wr[(i & 15) * DM + (i >> 4)] = wrg[i];
  __syncthreads();
  f32x4 vn[4]; u32x2 on[4];
#define N2_LOAD(gg) do { const f32x4* xr_ = (const f32x4*)(l == 0 ? in_row(C, gg) : xs_row(C, gg)) + lane; const u32x2* or_ = (const u32x2*)(O + (size_t)(gg) * DM) + lane; \
    _Pragma("unroll") for (int j = 0; j < 4; ++j) { vn[j] = xr_[64 * j]; on[j] = or_[64 * j]; } } while (0)
  if (gw < TT) N2_LOAD(gw);
  for (int g = gw; g < TT; g += NGW) {
    const int mr = mod_row(g);
    f32x4 v[4], o[4]; float s = 0.f;
#pragma unroll
    for (int j = 0; j < 4; ++j) { v[j] = vn[j]; const u32x2 w = on[j]; o[j] = (f32x4){bflo(w.x), bfhi(w.x), bflo(w.y), bfhi(w.y)};
      s += (o[j].x * o[j].x + o[j].y * o[j].y) + (o[j].z * o[j].z + o[j].w * o[j].w); }
    if (g + NGW < TT) N2_LOAD(g + NGW);
    if (mr == 4 && !with_ctx) continue;
    float rstd = rsqrtf(wave_sum(s) * (1.f / DM) + NORM_EPS);
    { const f32x4* m2 = (const f32x4*)modv(C, l, mr, 2) + lane; const f32x4* gp = (const f32x4*)(inp(C, 7) + l * DM) + lane; f32x4* xo = (f32x4*)xs_row(C, g) + lane;
      s = 0.f;
#pragma unroll
      for (int j = 0; j < 4; ++j) { v[j] = v[j] + m2[64 * j] * (o[j] * rstd * gp[64 * j]); xo[64 * j] = v[j]; s += (v[j].x * v[j].x + v[j].y * v[j].y) + (v[j].z * v[j].z + v[j].w * v[j].w); } }
    rstd = rsqrtf(wave_sum(s) * (1.f / DM) + NORM_EPS);
    const f32x4* m3 = (const f32x4*)modv(C, l, mr, 3) + lane; const f32x4* m4 = (const f32x4*)modv(C, l, mr, 4) + lane; const f32x4* gp = (const f32x4*)(inp(C, 8) + l * DM) + lane;
    u32x2* to = (u32x2*)(TN + (size_t)g * DM) + lane;
    float lg[16];
#pragma unroll
    for (int e = 0; e < 16; ++e) lg[e] = 0.f;
#pragma unroll
    for (int j = 0; j < 4; ++j) { const f32x4 t = v[j] * rstd * gp[64 * j] * (m4[64 * j] + 1.0f) + m3[64 * j]; u32x2 w; w.x = cvtpk(t.x, t.y); w.y = cvtpk(t.z, t.w); to[64 * j] = w;
#pragma unroll
      for (int e = 0; e < 16; ++e) { const f32x4 ww = *(const LAS f32x4*)(wr + e * DM + 256 * j + 4 * lane); lg[e] += (t.x * ww.x + t.y * ww.y) + (t.z * ww.z + t.w * ww.w); if ((e & 3) == 3) asm volatile("" ::: "memory"); } }
    float mx = -1e30f;
#pragma unroll
    for (int e = 0; e < 16; ++e) { lg[e] = wave_sum(lg[e]); mx = fmaxf(mx, lg[e]); }
    float den = 0.f;
#pragma unroll
    for (int e = 0; e < 16; ++e) { lg[e] = __expf(lg[e] - mx); den += lg[e]; }
    const float inv = 1.f / den;
    float mine = 0.f;
#pragma unroll
    for (int e = 0; e < 16; ++e) mine = (lane == e) ? lg[e] * inv : mine;
    if (lane < 16) { AFF[(size_t)g * 16 + lane] = mine; SLOT[(size_t)g * 16 + lane] = -1; }
  }
#undef N2_LOAD
  __syncthreads();
}

DI void topk_problem(const Ctx& C, int q) {
  const bool isctx = q >= 64; const int qq = q & 63, b = qq >> 4, e = qq & 15;
  const int n = isctx ? CTX : SEQ, cap = isctx ? 32 : 1024; const int g0 = b * PP + (isctx ? 0 : CTX);
  const float* AFF = (const float*)(C.ws + WS_AFF);
  int* IDX = (int*)(C.ws + WS_IDX); int* SLOT = (int*)(C.ws + WS_SLOT);
  const int obase = e * RPE + (isctx ? 4096 + b * 32 : b * 1024);
  LAS unsigned* keys = (LAS unsigned*)C.lds; LAS unsigned* hist = keys + 8192; LAS unsigned* ctl = hist + 256;
  for (int i = C.tid; i < n; i += NTHREADS) keys[i] = __float_as_uint(AFF[(size_t)(g0 + i) * 16 + e]);
  if (C.tid == 0) { ctl[0] = 0u; ctl[1] = (unsigned)cap; ctl[2] = 0u; ctl[3] = 0u; }
  unsigned mask = 0u;
  for (int pass = 0; pass < 4; ++pass) { const int shift = 24 - 8 * pass;
    if (C.tid < 256) hist[C.tid] = 0u;
    __syncthreads();
    const unsigned prefix = ctl[0];
    for (int i = C.tid; i < n; i += NTHREADS) { const unsigned k = keys[i]; if ((k & mask) == prefix) atomicAdd((unsigned*)&hist[(k >> shift) & 255u], 1u); }
    __syncthreads();
    if (C.tid < 256) { const unsigned rem = ctl[1]; unsigned sfx = 0u;
      for (int b2 = 255; b2 >= C.tid; --b2) sfx += hist[b2];
      const unsigned nxt = sfx - hist[C.tid];
      if (sfx >= rem && nxt < rem) { ctl[0] = prefix | ((unsigned)C.tid << shift); ctl[1] = rem - nxt; } }
    mask |= 255u << shift;
    __syncthreads();
  }
  const unsigned thr = ctl[0], need_eq = ctl[1];
  for (int i = C.tid; i < n; i += NTHREADS) { const unsigned k = keys[i];
    int slot = -1;
    if (k > thr) slot = (int)atomicAdd((unsigned*)&ctl[2], 1u);
    else if (k == thr) { const unsigned t = atomicAdd((unsigned*)&ctl[3], 1u); if (t < need_eq) slot = cap - (int)need_eq + (int)t; }
    if (slot >= 0) { IDX[obase + slot] = g0 + i; SLOT[(size_t)(g0 + i) * 16 + e] = obase + slot; } }
  __syncthreads();
}
#define MFMA32(a, b, c) __builtin_amdgcn_mfma_f32_32x32x16_bf16((a), (b), (c), 0, 0, 0)
constexpr int AT_KROW = 208, AT_VROW = 144, AT_KBUF = 64 * AT_KROW, AT_VBUF = 64 * AT_VROW;
constexpr int AT_K0 = 0, AT_V0 = 2 * AT_KBUF, AT_OST = AT_V0 + 2 * AT_VBUF, AT_OROW = 144;
constexpr float AT_THR = 8.0f;

DI void attn_unit(const Ctx& C, int b, int h, int pq0, int nkt) {
  const bf16_t* QB = (const bf16_t*)(C.ws + WS_R2); const bf16_t* KBp = QB + (size_t)NB * NH * PP * 96; const bf16_t* VTp = KBp + (size_t)NB * NH * PP * 96;
  const bf16_t* Qh = QB + (size_t)(b * NH + h) * PP * 96; const bf16_t* Kh = KBp + (size_t)(b * NH + h) * PP * 96; const bf16_t* Vh = VTp + (size_t)(b * NH + h) * 64 * PP;
  bf16_t* MC = (bf16_t*)(C.ws + WS_R6);
  const int tid = C.tid, lane = C.lane, wave = C.wave, r32 = lane & 31, hi = lane >> 5;
  LAS unsigned char* lds = C.lds;
  bf16x8 qf[6];
  { const bf16_t* qrow = Qh + (size_t)(pq0 + wave * 32 + r32) * 96 + hi * 8;
#pragma unroll
    for (int d0 = 0; d0 < 6; ++d0) qf[d0] = *(const bf16x8*)(qrow + d0 * 16); }
  const int k0row = tid / 12, k0c = tid % 12, k1row = (tid + 512) / 12, k1c = (tid + 512) % 12;
  const unsigned k0dst = k0row * AT_KROW + k0c * 16, k1dst = k1row * AT_KROW + k1c * 16, vdst = (tid >> 3) * AT_VROW + (tid & 7) * 16;
  const bf16_t* vsrc = Vh + (size_t)(tid >> 3) * PP + (tid & 7) * 8;
  u32x4 sk0, sk1 = (u32x4){0u, 0u, 0u, 0u}, sv;
#define AT_LOAD(kt) do { const char* kb_ = (const char*)(Kh + (size_t)(kt) * 64 * 96); sk0 = *(const u32x4*)(kb_ + tid * 16); if (tid < 256) sk1 = *(const u32x4*)(kb_ + (tid + 512) * 16); sv = *(const u32x4*)(vsrc + (kt) * 64); } while (0)
#define AT_STORE(buf) do { *(LAS u32x4*)(lds + AT_K0 + (buf) * AT_KBUF + k0dst) = sk0; if (tid < 256) *(LAS u32x4*)(lds + AT_K0 + (buf) * AT_KBUF + k1dst) = sk1; *(LAS u32x4*)(lds + AT_V0 + (buf) * AT_VBUF + vdst) = sv; } while (0)
  AT_LOAD(0); AT_STORE(0);
  __syncthreads();
  f32x16 negm, o0, o1;
#pragma unroll
  for (int i = 0; i < 16; ++i) { negm[i] = 0.f; o0[i] = 0.f; o1[i] = 0.f; }
  float mhat = 0.f, lsum = 0.f;
  for (int kt = 0; kt < nkt; ++kt) {
    const int buf = kt & 1;
    if (kt + 1 < nkt) AT_LOAD(kt + 1);
    const LAS unsigned char* kb = lds + AT_K0 + buf * AT_KBUF + r32 * AT_KROW + hi * 16;
    const LAS unsigned char* vb = lds + AT_V0 + buf * AT_VBUF + r32 * AT_VROW + hi * 16;
    f32x16 p0, p1;
#pragma unroll
    for (int d0 = 0; d0 < 6; ++d0) { const bf16x8 kf0 = *(const LAS bf16x8*)(kb + d0 * 32), kf1 = *(const LAS bf16x8*)(kb + 32 * AT_KROW + d0 * 32);
      if (d0 == 0) { p0 = MFMA32(kf0, qf[0], negm); p1 = MFMA32(kf1, qf[0], negm); } else { p0 = MFMA32(kf0, qf[d0], p0); p1 = MFMA32(kf1, qf[d0], p1); } }
    float rm = fmaxf(p0[0], p1[0]);
#pragma unroll
    for (int i = 1; i < 16; ++i) rm = fmaxf(rm, fmaxf(p0[i], p1[i]));
    rm = half_max(rm);
    if (kt == 0 || __any(rm > AT_THR)) {
      const float dl = (kt == 0) ? rm : fmaxf(rm, 0.f);
      mhat += dl; const float f = (kt == 0) ? 1.f : __builtin_amdgcn_exp2f(-dl); lsum *= f;
#pragma unroll
      for (int i = 0; i < 16; ++i) { p0[i] -= dl; p1[i] -= dl; o0[i] *= f; o1[i] *= f; negm[i] = -mhat; }
    }
    float ps = 0.f;
#pragma unroll
    for (int i = 0; i < 16; ++i) { p0[i] = __builtin_amdgcn_exp2f(p0[i]); p1[i] = __builtin_amdgcn_exp2f(p1[i]); ps += p0[i] + p1[i]; }
    lsum += ps;
    u32x4 w0, w1, w2, w3;
    w0 = (u32x4){cvtpk(p0[0], p0[1]), cvtpk(p0[2], p0[3]), cvtpk(p0[4], p0[5]), cvtpk(p0[6], p0[7])};
    w1 = (u32x4){cvtpk(p0[8], p0[9]), cvtpk(p0[10], p0[11]), cvtpk(p0[12], p0[13]), cvtpk(p0[14], p0[15])};
    w2 = (u32x4){cvtpk(p1[0], p1[1]), cvtpk(p1[2], p1[3]), cvtpk(p1[4], p1[5]), cvtpk(p1[6], p1[7])};
    w3 = (u32x4){cvtpk(p1[8], p1[9]), cvtpk(p1[10], p1[11]), cvtpk(p1[12], p1[13]), cvtpk(p1[14], p1[15])};
    const bf16x8 pf0 = __builtin_bit_cast(bf16x8, w0), pf1 = __builtin_bit_cast(bf16x8, w1), pf2 = __builtin_bit_cast(bf16x8, w2), pf3 = __builtin_bit_cast(bf16x8, w3);
#define AT_PV(s, pf) do { const bf16x8 va = *(const LAS bf16x8*)(vb + (s) * 32), vc = *(const LAS bf16x8*)(vb + 32 * AT_VROW + (s) * 32); o0 = MFMA32(va, pf, o0); o1 = MFMA32(vc, pf, o1); } while (0)
    AT_PV(0, pf0); AT_PV(1, pf1); AT_PV(2, pf2); AT_PV(3, pf3);
#undef AT_PV
    if (kt + 1 < nkt) AT_STORE(buf ^ 1);
    __syncthreads();
  }
#undef AT_LOAD
#undef AT_STORE
  lsum = half_sum(lsum);
  const float inv = 1.f / lsum;
  LAS bf16_t* stg = (LAS bf16_t*)(lds + AT_OST + wave * 32 * AT_OROW);
#pragma unroll
  for (int i = 0; i < 16; ++i) { const int d = (i & 3) + 8 * (i >> 2) + 4 * hi;
    stg[r32 * (AT_OROW / 2) + d] = f2bf(o0[i] * inv); stg[r32 * (AT_OROW / 2) + 32 + d] = f2bf(o1[i] * inv); }
  asm volatile("s_waitcnt lgkmcnt(0)" ::: "memory");
#pragma unroll
  for (int i = 0; i < 4; ++i) { const int piece = i * 64 + lane, row = piece >> 3, c = piece & 7;
    const u32x4 v = *(const LAS u32x4*)((const LAS unsigned char*)stg + row * AT_OROW + c * 16);
    *(u32x4*)(MC + (size_t)(b * PP + pq0 + wave * 32 + row) * DM + 384 + h * 64 + c * 8) = v; }
  __syncthreads();
}

constexpr int SC_CH = 32;
DI int scan_pos(int s, int d) { return d == 0 ? s : (s < CTX ? CTX - 1 - s : (PP - 1) - (s - CTX)); }
DI void scan_unit(const Ctx& C, int l, int unit) {
  const int chain = unit >> 1, half = unit & 1;
  const int b = chain / 12, h = (chain >> 1) % 6, d = chain & 1;
  const bf16_t* U = (const bf16_t*)(C.ws + WS_R1);
  const bf16_t* EW = (const bf16_t*)(C.ws + WS_R3); const bf16_t* AS = EW + (size_t)TT * 768;
  bf16_t* Y = (bf16_t*)(C.ws + WS_R5) + (size_t)d * TT * 384;
  const float* cw = inp(C, 12) + (size_t)l * 3 * 1152; const float* k_k = inp(C, 18) + l * 384; const float* k_a = inp(C, 19) + l * 384;
  const int lane = C.lane, wave = C.wave;
  LAS float* opsb = (LAS float*)C.lds;
  LAS float* ybuf = opsb + 2 * SC_CH * 384;
  constexpr int NCH = PP / SC_CH;
  if (wave >= 4) {
    const int pw = wave - 4;
    const int c = h * 64 + lane;
    const float cwr0 = cw[c], cwr1 = cw[1152 + c], cwr2 = cw[2304 + c];
    const float cwk0 = cw[384 + c], cwk1 = cw[1152 + 384 + c], cwk2 = cw[2304 + 384 + c];
    const float cwv0 = cw[768 + c], cwv1 = cw[1152 + 768 + c], cwv2 = cw[2304 + 768 + c];
    const float kkc = k_k[c], kac = k_a[c];
    for (int chunk = -1; chunk < NCH; ++chunk) {
      if (chunk >= 1) { const int cb = (chunk - 1) & 1;
#pragma unroll
        for (int i = 0; i < 4; ++i) { const int sl = pw * 8 + 2 * i + (lane >> 5), rw = lane & 31; const int p = scan_pos((chunk - 1) * SC_CH + sl, d);
          Y[(size_t)(b * PP + p) * 384 + h * 64 + half * 32 + rw] = f2bf(ybuf[(cb * SC_CH + sl) * 32 + rw]); } }
      if (chunk + 1 < NCH) { const int nb = (chunk + 1) & 1; const int s0 = (chunk + 1) * SC_CH;
#pragma unroll
        for (int hf = 0; hf < 2; ++hf) {
          unsigned short ur[4][3], uk[4][3], uv[4][3], uew[4], uas[4]; float ml[4], mr[4];
#pragma unroll
          for (int i = 0; i < 4; ++i) { const int sl = pw * 8 + hf * 4 + i; const int p = scan_pos(s0 + sl, d); const int g = b * PP + p;
            const bool hasl = (p != 0 && p != CTX), hasr = (p != CTX - 1 && p != PP - 1);
            ml[i] = hasl ? 1.f : 0.f; mr[i] = hasr ? 1.f : 0.f;
            const bf16_t* u0 = U + (size_t)g * UW + c; const bf16_t* ul = hasl ? u0 - UW : u0; const bf16_t* urr = hasr ? u0 + UW : u0;
            ur[i][0] = ul[0]; ur[i][1] = u0[0]; ur[i][2] = urr[0];
            uk[i][0] = ul[384]; uk[i][1] = u0[384]; uk[i][2] = urr[384];
            uv[i][0] = ul[768]; uv[i][1] = u0[768]; uv[i][2] = urr[768];
            uew[i] = EW[(size_t)g * 768 + d * 384 + c]; uas[i] = AS[(size_t)g * 768 + d * 384 + c]; }
#pragma unroll
          for (int i = 0; i < 4; ++i) { const int sl = pw * 8 + hf * 4 + i;
            const float r = bf2f(ur[i][1]) * cwr1 + ml[i] * bf2f(ur[i][0]) * cwr0 + mr[i] * bf2f(ur[i][2]) * cwr2;
            const float k = bf2f(uk[i][1]) * cwk1 + ml[i] * bf2f(uk[i][0]) * cwk0 + mr[i] * bf2f(uk[i][2]) * cwk2;
            const float v = bf2f(uv[i][1]) * cwv1 + ml[i] * bf2f(uv[i][0]) * cwv0 + mr[i] * bf2f(uv[i][2]) * cwv2;
            const float kr = k * kkc; const float nrm = sqrtf(wave_sum(kr * kr)); const float kk = kr / fmaxf(nrm, 1e-12f);
            const float ew = bf2f(uew[i]), a = bf2f(uas[i]);
            const float w = __expf(-ew); const float kd = k * (1.f + (a - 1.f) * kac);
            LAS float* o = opsb + (nb * SC_CH + sl) * 384 + lane;
            o[0] = r; o[64] = w; o[128] = kd; o[192] = v; o[256] = -kk; o[320] = kk * a; }
        } }
      __syncthreads();
    }
    { const int cb = (NCH - 1) & 1;
#pragma unroll
      for (int i = 0; i < 4; ++i) { const int sl = pw * 8 + 2 * i + (lane >> 5), rw = lane & 31; const int p = scan_pos((NCH - 1) * SC_CH + sl, d);
        Y[(size_t)(b * PP + p) * 384 + h * 64 + half * 32 + rw] = f2bf(ybuf[(cb * SC_CH + sl) * 32 + rw]); } }
  } else {
    const int rowl = wave * 8 + (lane >> 3), cg = lane & 7;
    const int vrow = half * 32 + rowl;
    f32x2 S[4];
#pragma unroll
    for (int j = 0; j < 4; ++j) S[j] = (f32x2){0.f, 0.f};
    __syncthreads();
    for (int chunk = 0; chunk < NCH; ++chunk) {
      const LAS float* ob = opsb + (chunk & 1) * SC_CH * 384;
      LAS float* yb = ybuf + (chunk & 1) * SC_CH * 32;
#define SC_LOADOPS(R0, R1, W0, W1, K0, K1, A0, A1, B0, B1, VV, slx) do { const LAS float* o_ = ob + (slx) * 384 + cg * 8; \
        R0 = *(const LAS f32x4*)(o_); R1 = *(const LAS f32x4*)(o_ + 4); W0 = *(const LAS f32x4*)(o_ + 64); W1 = *(const LAS f32x4*)(o_ + 68); \
        K0 = *(const LAS f32x4*)(o_ + 128); K1 = *(const LAS f32x4*)(o_ + 132); A0 = *(const LAS f32x4*)(o_ + 256); A1 = *(const LAS f32x4*)(o_ + 260); \
        B0 = *(const LAS f32x4*)(o_ + 320); B1 = *(const LAS f32x4*)(o_ + 324); VV = ob[(slx) * 384 + 192 + vrow]; } while (0)
#define SC_STEP(r0, r1, w0, w1, k0, k1, a0, a1, b0, b1, vv, YOUT) do { \
        f32x2 t = S[0] * (f32x2){a0.x, a0.y} + S[1] * (f32x2){a0.z, a0.w}; t = t + S[2] * (f32x2){a1.x, a1.y}; t = t + S[3] * (f32x2){a1.z, a1.w}; \
        float sa = t.x + t.y; \
        sa = dpp_add<0xB1>(sa); sa = dpp_add<0x4E>(sa); sa = dpp_add<0x141>(sa); \
        const f32x2 sa2 = (f32x2){sa, sa}, vv2 = (f32x2){vv, vv}; \
        S[0] = S[0] * (f32x2){w0.x, w0.y} + (sa2 * (f32x2){b0.x, b0.y} + vv2 * (f32x2){k0.x, k0.y}); \
        S[1] = S[1] * (f32x2){w0.z, w0.w} + (sa2 * (f32x2){b0.z, b0.w} + vv2 * (f32x2){k0.z, k0.w}); \
        S[2] = S[2] * (f32x2){w1.x, w1.y} + (sa2 * (f32x2){b1.x, b1.y} + vv2 * (f32x2){k1.x, k1.y}); \
        S[3] = S[3] * (f32x2){w1.z, w1.w} + (sa2 * (f32x2){b1.z, b1.w} + vv2 * (f32x2){k1.z, k1.w}); \
        f32x2 yy = S[0] * (f32x2){r0.x, r0.y} + S[1] * (f32x2){r0.z, r0.w}; yy = yy + S[2] * (f32x2){r1.x, r1.y}; yy = yy + S[3] * (f32x2){r1.z, r1.w}; \
        float y = yy.x + yy.y; \
        y = dpp_add<0xB1>(y); y = dpp_add<0x4E>(y); y = dpp_add<0x141>(y); YOUT = y; } while (0)
      f32x4 pr0, pr1, pw0, pw1, pk0, pk1, pa0, pa1, pb0, pb1; float pv;
      f32x4 qr0, qr1, qw0, qw1, qk0, qk1, qa0, qa1, qb0, qb1; float qv;
      SC_LOADOPS(pr0, pr1, pw0, pw1, pk0, pk1, pa0, pa1, pb0, pb1, pv, 0);
#pragma unroll 1
      for (int sg = 0; sg < SC_CH / 8; ++sg) {
        float ykeep = 0.f;
#pragma unroll
        for (int j = 0; j < 8; j += 2) { const int sl = sg * 8 + j; float y0, y1;
          SC_LOADOPS(qr0, qr1, qw0, qw1, qk0, qk1, qa0, qa1, qb0, qb1, qv, sl + 1);
          SC_STEP(pr0, pr1, pw0, pw1, pk0, pk1, pa0, pa1, pb0, pb1, pv, y0);
          SC_LOADOPS(pr0, pr1, pw0, pw1, pk0, pk1, pa0, pa1, pb0, pb1, pv, (sl + 2) & (SC_CH - 1));
          SC_STEP(qr0, qr1, qw0, qw1, qk0, qk1, qa0, qa1, qb0, qb1, qv, y1);
          ykeep = (cg == j) ? y0 : ykeep; ykeep = (cg == j + 1) ? y1 : ykeep; }
        yb[(sg * 8 + cg) * 32 + rowl] = ykeep;
      }
#undef SC_LOADOPS
#undef SC_STEP
      __syncthreads();
    }
  }
  __syncthreads();
}

DI void fft_unit(const Ctx& C, int seq, bool isctx) {
  const int N = isctx ? CTX : SEQ, logN = isctx ? 8 : 13, off = isctx ? 0 : CTX;
  const f32x2* src = (const f32x2*)(C.ws + WS_R4) + (size_t)seq * PP + off;
  const f32x2* TW = (const f32x2*)(C.ws + WS_TW);
  bf16_t* MC = (bf16_t*)(C.ws + WS_R6);
  LAS f32x2* x = (LAS f32x2*)C.lds;
  const int tid = C.tid;
  for (int i = tid; i < N; i += NTHREADS) x[i] = src[i];
  __syncthreads();
  const int twmul = SEQ / N;
  for (int s = 0; s < logN; ++s) { const int hb = logN - 1 - s, hh = 1 << hb;
    for (int j = tid; j < N / 2; j += NTHREADS) { const int blk = j >> hb, i = j & (hh - 1); const int i0 = (blk << (hb + 1)) + i, i1 = i0 + hh;
      const f32x2 a = x[i0], bb = x[i1]; const f32x2 tw = TW[(i << s) * twmul];
      const float dr = a.x - bb.x, di = a.y - bb.y;
      x[i0] = (f32x2){a.x + bb.x, a.y + bb.y}; x[i1] = (f32x2){dr * tw.x - di * tw.y, dr * tw.y + di * tw.x}; }
    __syncthreads(); }
  const float scale = rsqrtf(64.0f * (float)N);
  const int b = seq / 132, grp = (seq / 33) & 3, k2 = seq % 33;
  for (int pi = tid; pi < N; pi += NTHREADS) { const int k1 = (int)(__brev((unsigned)pi) >> (32 - logN));
    const bf16_t val = f2bf(x[pi].x * scale);
    MC[(size_t)(b * PP + off + k1) * DM + 768 + grp * 64 + k2] = val;
    if (k2 >= 1 && k2 <= 31) MC[(size_t)(b * PP + off + ((N - k1) & (N - 1))) * DM + 768 + grp * 64 + 64 - k2] = val; }
  __syncthreads();
}

constexpr int CK_ROW = 144, CK_SLOT = 64 * CK_ROW;
DI void ck_mma(f32x16& acc, const LAS unsigned char* A, int arow0, const LAS unsigned char* B, int brow0, int r32, int hi) {
  const LAS unsigned char* ap = A + (arow0 + r32) * CK_ROW + hi * 16; const LAS unsigned char* bp = B + (brow0 + r32) * CK_ROW + hi * 16;
#pragma unroll
  for (int kk = 0; kk < 4; ++kk) acc = MFMA32(*(const LAS bf16x8*)(ap + kk * 32), *(const LAS bf16x8*)(bp + kk * 32), acc);
}
DI void ck_store(const f32x16& acc, LAS unsigned char* Out, int arow0, int brow0, int r32, int hi) {
  LAS unsigned char* op = Out + (brow0 + r32) * CK_ROW + (arow0 + 4 * hi) * 2;
#pragma unroll
  for (int g = 0; g < 4; ++g) { u32x2 w; w.x = cvtpk(acc[4 * g], acc[4 * g + 1]); w.y = cvtpk(acc[4 * g + 2], acc[4 * g + 3]); *(LAS u32x2*)(op + g * 16) = w; }
}
#ifdef PROF_SEL
#define PROF_T0(k) unsigned long long pt0_##k = 0; if (PROF_SEL == (k)) pt0_##k = __builtin_amdgcn_s_memrealtime();
#define PROF_T1(k) if (PROF_SEL == (k) && chain == 0 && l == 0 && C.tid == PROF_TID) atomicAdd((unsigned*)(C.ws + WS_CTL) + 1024, (unsigned)(__builtin_amdgcn_s_memrealtime() - pt0_##k));
#else
#define PROF_T0(k)
#define PROF_T1(k)
#endif
#ifndef PROF_TID
#define PROF_TID 0
#endif
DI void scan_chain(const Ctx& C, int l, int chain) {
  PROF_T0(1)
  const int b = chain / 12, h = (chain >> 1) % 6, d = chain & 1;
  const bf16_t* U = (const bf16_t*)(C.ws + WS_R1);
  const bf16_t* EW = (const bf16_t*)(C.ws + WS_R3); const bf16_t* AS = EW + (size_t)TT * 768;
  bf16_t* Y = (bf16_t*)(C.ws + WS_R5) + (size_t)d * TT * 384;
  const float* cw = inp(C, 12) + (size_t)l * 3 * 1152; const float* k_k = inp(C, 18) + l * 384; const float* k_a = inp(C, 19) + l * 384;
  const int lane = C.lane, wave = C.wave, r32 = lane & 31, hi = lane >> 5;
  LAS unsigned char* L = C.lds;
#define SLOT(n) (L + (n) * CK_SLOT)
  LAS unsigned char* const sAT = SLOT(0); LAS unsigned char* const sRT = SLOT(1); LAS unsigned char* const sBT = SLOT(2); LAS unsigned char* const sKT = SLOT(3);
  LAS unsigned char* const sVT = SLOT(4); LAS unsigned char* const sBH = SLOT(5); LAS unsigned char* const sKH = SLOT(6); LAS unsigned char* const sSB = SLOT(7);
  LAS unsigned char* const sP0 = SLOT(8); LAS unsigned char* const sP0T = SLOT(9); LAS unsigned char* const sAAK = SLOT(10); LAS unsigned char* const sARB = SLOT(11);
  LAS unsigned char* const sARK = SLOT(12); LAS unsigned char* const sXa = SLOT(13); LAS unsigned char* const sXb = SLOT(14);
  LAS float* gamC = (LAS float*)SLOT(15); LAS float* wtot = gamC + 64;
  const int t4 = wave & 3, arow0 = (t4 >> 1) * 32, brow0 = (t4 & 1) * 32;
  const int c = h * 64 + lane;
  const float cwr0 = cw[c], cwr1 = cw[1152 + c], cwr2 = cw[2304 + c];
  const float cwk0 = cw[384 + c], cwk1 = cw[1152 + 384 + c], cwk2 = cw[2304 + 384 + c];
  const float cwv0 = cw[768 + c], cwv1 = cw[1152 + 768 + c], cwv2 = cw[2304 + 768 + c];
  const float kkc = k_k[c], kac = k_a[c];
  f32x16 xacc, sacc;
#pragma unroll
  for (int i = 0; i < 16; ++i) { xacc[i] = 0.f; sacc[i] = 0.f; }
  unsigned short pr[10], pk[10], pv[10], pew[8], pas[8];
#define CK_PREFETCH(ci) do { const int p0_ = scan_pos((ci) * 64 + wave * 8, d); const int sg_ = d == 0 ? 1 : -1; const int lo_ = p0_ < CTX ? 0 : CTX, hi_ = p0_ < CTX ? CTX - 1 : PP - 1; \
    _Pragma("unroll") for (int q = 0; q < 10; ++q) { int pp_ = p0_ + sg_ * (q - 1); pp_ = pp_ < lo_ ? lo_ : (pp_ > hi_ ? hi_ : pp_); const bf16_t* u_ = U + (size_t)(b * PP + pp_) * UW;     \
      pr[q] = u_[c]; pk[q] = u_[384 + c]; pv[q] = u_[768 + c]; } \
    _Pragma("unroll") for (int j = 0; j < 8; ++j) { const int pj_ = p0_ + sg_ * j; const size_t o_ = (size_t)(b * PP + pj_) * 768 + d * 384; pew[j] = (EW + o_)[c]; pas[j] = (AS + o_)[c]; } } while (0)
  CK_PREFETCH(0);
  for (int ci = 0; ci < PP / 64; ++ci) {
    PROF_T0(2)
    PROF_T0(6)
    if (wave >= 4) ck_store(sacc, sSB, arow0, brow0, r32, hi);
    float fr[8], fkd[8], fv[8], fkk[8], fal[8], flg[8];
    { const int p0 = scan_pos(ci * 64 + wave * 8, d); const int lo = p0 < CTX ? 0 : CTX, hi_p = p0 < CTX ? CTX - 1 : PP - 1;
      float run = 0.f;
#pragma unroll
      for (int j = 0; j < 8; ++j) { const int pj = d == 0 ? p0 + j : p0 - j;
        const float ml = pj != lo ? 1.f : 0.f, mr = pj != hi_p ? 1.f : 0.f;
        const float rl = bf2f(d == 0 ? pr[j] : pr[j + 2]), rr_ = bf2f(d == 0 ? pr[j + 2] : pr[j]);
        const float kl = bf2f(d == 0 ? pk[j] : pk[j + 2]), kr_ = bf2f(d == 0 ? pk[j + 2] : pk[j]);
        const float vl = bf2f(d == 0 ? pv[j] : pv[j + 2]), vr_ = bf2f(d == 0 ? pv[j + 2] : pv[j]);
        const float r = bf2f(pr[j + 1]) * cwr1 + ml * rl * cwr0 + mr * rr_ * cwr2;
        const float k = bf2f(pk[j + 1]) * cwk1 + ml * kl * cwk0 + mr * kr_ * cwk2;
        const float v = bf2f(pv[j + 1]) * cwv1 + ml * vl * cwv0 + mr * vr_ * cwv2;
        const float kr = k * kkc; const float kk = kr * __builtin_amdgcn_rsqf(fmaxf(wave_sum(kr * kr), 1e-24f));
        const float al = bf2f(pas[j]);
        run -= bf2f(pew[j]);
        fr[j] = r; fkd[j] = k * (1.f + (al - 1.f) * kac); fv[j] = v; fkk[j] = kk; fal[j] = al; flg[j] = run; }
      wtot[wave * 64 + lane] = run; }
    if (ci > 0) { const int s_ = C.tid >> 3, pc_ = C.tid & 7; const int p_ = scan_pos((ci - 1) * 64 + s_, d);
      *(u32x4*)(Y + (size_t)(b * PP + p_) * 384 + h * 64 + pc_ * 8) = *(const LAS u32x4*)(SLOT(8) + s_ * CK_ROW + pc_ * 16); }
    if (ci + 1 < PP / 64) CK_PREFETCH(ci + 1);
    __syncthreads();
    PROF_T1(6)
    PROF_T0(7)
    { float off = 0.f, tot = 0.f;
#pragma unroll
      for (int w2 = 0; w2 < 8; ++w2) { const float t = wtot[w2 * 64 + lane]; off += (w2 < wave) ? t : 0.f; tot += t; }
      if (wave == 0) gamC[lane] = __expf(tot);
      u32x4 wv, wbh, wkh; float tv[8], tbh[8], tkh[8];
      const float eTot = __expf(tot); float eGprev = __expf(off);
#pragma unroll
      for (int j = 0; j < 8; ++j) { const int s = wave * 8 + j; const float Lc = off + flg[j];
        const float eG = __expf(Lc), eGp = eGprev, eGi = __builtin_amdgcn_rcpf(eG), eGc = eTot * eGi; eGprev = eG;
        const float bb = fkk[j] * fal[j];
        *(LAS bf16_t*)(sAT + s * CK_ROW + lane * 2) = f2bf(-fkk[j] * eGp);
        *(LAS bf16_t*)(sRT + s * CK_ROW + lane * 2) = f2bf(fr[j] * eG);
        *(LAS bf16_t*)(sBT + s * CK_ROW + lane * 2) = f2bf(bb * eGi);
        *(LAS bf16_t*)(sKT + s * CK_ROW + lane * 2) = f2bf(fkd[j] * eGi);
        tv[j] = fv[j]; tbh[j] = bb * eGc; tkh[j] = fkd[j] * eGc; }
      wv = (u32x4){cvtpk(tv[0], tv[1]), cvtpk(tv[2], tv[3]), cvtpk(tv[4], tv[5]), cvtpk(tv[6], tv[7])};
      wbh = (u32x4){cvtpk(tbh[0], tbh[1]), cvtpk(tbh[2], tbh[3]), cvtpk(tbh[4], tbh[5]), cvtpk(tbh[6], tbh[7])};
      wkh = (u32x4){cvtpk(tkh[0], tkh[1]), cvtpk(tkh[2], tkh[3]), cvtpk(tkh[4], tkh[5]), cvtpk(tkh[6], tkh[7])};
      *(LAS u32x4*)(sVT + lane * CK_ROW + wave * 16) = wv; *(LAS u32x4*)(sBH + lane * CK_ROW + wave * 16) = wbh; *(LAS u32x4*)(sKH + lane * CK_ROW + wave * 16) = wkh; }
    __syncthreads();
    PROF_T1(2)
    PROF_T1(7)
    PROF_T0(3)
    { f32x16 z;
#pragma unroll
      for (int i = 0; i < 16; ++i) z[i] = 0.f;
      const int bi = brow0 + r32;
      if (wave < 4) {
        f32x16 t = z; ck_mma(t, sBT, arow0, sAT, brow0, r32, hi);
#pragma unroll
        for (int i = 0; i < 16; ++i) { const int ai = arow0 + (i & 3) + 8 * (i >> 2) + 4 * hi; t[i] = ai < bi ? t[i] : 0.f; }
        ck_store(t, sP0, arow0, brow0, r32, hi);
        t = z; ck_mma(t, sAT, arow0, sBT, brow0, r32, hi);
#pragma unroll
        for (int i = 0; i < 16; ++i) { const int ai = arow0 + (i & 3) + 8 * (i >> 2) + 4 * hi; t[i] = bi < ai ? t[i] : 0.f; }
        ck_store(t, sP0T, arow0, brow0, r32, hi);
        t = z; ck_mma(t, sBT, arow0, sRT, brow0, r32, hi);
#pragma unroll
        for (int i = 0; i < 16; ++i) { const int ai = arow0 + (i & 3) + 8 * (i >> 2) + 4 * hi; t[i] = ai <= bi ? t[i] : 0.f; }
        ck_store(t, sARB, arow0, brow0, r32, hi);
      } else {
        f32x16 t = z; ck_mma(t, sKT, arow0, sAT, brow0, r32, hi);
#pragma unroll
        for (int i = 0; i < 16; ++i) { const int ai = arow0 + (i & 3) + 8 * (i >> 2) + 4 * hi; t[i] = ai < bi ? t[i] : 0.f; }
        ck_store(t, sAAK, arow0, brow0, r32, hi);
        t = z; ck_mma(t, sKT, arow0, sRT, brow0, r32, hi);
#pragma unroll
        for (int i = 0; i < 16; ++i) { const int ai = arow0 + (i & 3) + 8 * (i >> 2) + 4 * hi; t[i] = ai <= bi ? t[i] : 0.f; }
        ck_store(t, sARK, arow0, brow0, r32, hi);
      } }
    __syncthreads();
    PROF_T1(3)
    PROF_T0(4)
#define CK_SQUARE(Pin, PTin, Pout, PTout, needT) do { f32x16 t_; _Pragma("unroll") for (int i = 0; i < 16; ++i) t_[i] = 0.f; \
      ck_mma(t_, PTin, arow0, Pin, brow0, r32, hi); ck_store(t_, Pout, arow0, brow0, r32, hi);             \
      if (needT) { _Pragma("unroll") for (int i = 0; i < 16; ++i) t_[i] = 0.f; ck_mma(t_, Pin, arow0, PTin, brow0, r32, hi); ck_store(t_, PTout, arow0, brow0, r32, hi); } } while (0)
#define CK_XSTEP(Pj, Xin, Xout) do { ck_mma(xacc, Pj, arow0, Xin, brow0, r32, hi); ck_store(xacc, Xout, arow0, brow0, r32, hi); } while (0)
    if (wave < 4) CK_SQUARE(sP0, sP0T, SLOT(2), SLOT(3), true);
    else {
#pragma unroll
      for (int i = 0; i < 16; ++i) xacc[i] = 0.f;
      ck_mma(xacc, sAT, arow0, sSB, brow0, r32, hi); ck_mma(xacc, sAAK, arow0, sVT, brow0, r32, hi); ck_store(xacc, sXa, arow0, brow0, r32, hi); }
    __syncthreads();
    if (wave < 4) CK_SQUARE(SLOT(2), SLOT(3), SLOT(0), SLOT(10), true); else CK_XSTEP(sP0, sXa, sXb);
    __syncthreads();
    if (wave < 4) CK_SQUARE(SLOT(0), SLOT(10), SLOT(8), SLOT(9), true); else CK_XSTEP(SLOT(2), sXb, sXa);
    __syncthreads();
    if (wave < 4) CK_SQUARE(SLOT(8), SLOT(9), SLOT(2), SLOT(3), true); else CK_XSTEP(SLOT(0), sXa, sXb);
    __syncthreads();
    if (wave < 4) CK_SQUARE(SLOT(2), SLOT(3), SLOT(0), SLOT(10), false); else CK_XSTEP(SLOT(8), sXb, sXa);
    __syncthreads();
    if (wave >= 4) CK_XSTEP(SLOT(2), sXa, sXb);
    __syncthreads();
    if (wave >= 4) CK_XSTEP(SLOT(0), sXb, sXa);
    __syncthreads();
    PROF_T1(4)
    PROF_T0(5)
    if (wave < 4) { f32x16 t;
#pragma unroll
      for (int i = 0; i < 16; ++i) t[i] = 0.f;
      ck_mma(t, sSB, arow0, sRT, brow0, r32, hi); ck_mma(t, sXa, arow0, sARB, brow0, r32, hi); ck_mma(t, sVT, arow0, sARK, brow0, r32, hi);
      ck_store(t, SLOT(8), arow0, brow0, r32, hi);
    } else {
#pragma unroll
      for (int i = 0; i < 16; ++i) sacc[i] *= gamC[arow0 + (i & 3) + 8 * (i >> 2) + 4 * hi];
      ck_mma(sacc, sBH, arow0, sXa, brow0, r32, hi); ck_mma(sacc, sKH, arow0, sVT, brow0, r32, hi);
    }
    __syncthreads();
    PROF_T1(5)
  }
  PROF_T1(1)
  { const int s_ = C.tid >> 3, pc_ = C.tid & 7; const int p_ = scan_pos((PP / 64 - 1) * 64 + s_, d);
    *(u32x4*)(Y + (size_t)(b * PP + p_) * 384 + h * 64 + pc_ * 8) = *(const LAS u32x4*)(SLOT(8) + s_ * CK_ROW + pc_ * 16); }
  __syncthreads();
#undef SLOT
#undef CK_PREFETCH
#undef CK_SQUARE
#undef CK_XSTEP
}
DI void mix_phase(const Ctx& C0, int l, bool with_ctx, int rep = 0) {
  unsigned* ctr = (unsigned*)(C0.ws + WS_CTL) + 64 * (1 + l + 2 * rep);
  LAS int* slot = (LAS int*)(C0.lds + 147456 - 64);
    const int n_scan = 48;
#ifdef REP_ATT
  const int n_att = 1536;
#else
  const int n_att = 768;
#endif
  const int n_attc = with_ctx ? 24 : 0, n_fft = 528, n_fftc = with_ctx ? 528 : 0;
  const int total = n_scan + n_att + n_attc + n_fft + n_fftc;
  for (;;) {
    __syncthreads();
    if (C0.tid == 0) *slot = (int)atomicAdd(ctr, 1u);
    __syncthreads();
    int it = __builtin_amdgcn_readfirstlane(*slot);
    if (it >= total) break;
    Ctx C = C0; { int t_ = C0.tid; asm volatile("" : "+v"(t_)); C.tid = t_; C.lane = t_ & 63; C.wave = __builtin_amdgcn_readfirstlane(t_ >> 6); GAS unsigned char* w_ = (GAS unsigned char*)C0.ws; asm volatile("" : "+s"(w_), "+s"(it)); C.ws = (unsigned char*)w_; }
    if (it < n_scan) { scan_chain(C, l, it); continue; } it -= n_scan;
    if (it < n_att) { const int bh = (it % 768) / 32, qb = it % 32; attn_unit(C, bh / NH, bh % NH, CTX + qb * 256, PP / 64); continue; } it -= n_att;
    if (it < n_attc) { attn_unit(C, it / NH, it % NH, 0, CTX / 64); continue; } it -= n_attc;
    if (it < n_fft) { fft_unit(C, it, false); continue; } it -= n_fft;
    fft_unit(C, it, true);
  }
}
#define XB_TMO      128
#define XB_XCNT(j)  (256  + 64 * (j))
#define XB_XSUB(j)  (1280 + 64 * (j))
#define XB_XGEN(j)  (2304 + 64 * (j))
#define XB_TOP      3328
#define XB_TOPGEN   3392
#define XCD_BAR_WORDS 3456
#define XB_SPIN_CAP (1u << 18)

__device__ __forceinline__ unsigned xb_ld(unsigned* p)              { return __hip_atomic_load(p, __ATOMIC_RELAXED, __HIP_MEMORY_SCOPE_AGENT); }
__device__ __forceinline__ unsigned xb_add(unsigned* p, unsigned v) { return __hip_atomic_fetch_add(p, v, __ATOMIC_RELAXED, __HIP_MEMORY_SCOPE_AGENT); }
__device__ __forceinline__ unsigned xb_xcc_id() { return (unsigned)__builtin_amdgcn_s_getreg((3 << 11) | 20) & 0xFu; }
#define XB_SPIN(cond, bar) do { unsigned _sp = 0; while (cond) { __builtin_amdgcn_s_sleep(1); \
    if ((++_sp & 255u) == 0u) { if (xb_ld(&(bar)[XB_TMO])) break; if (_sp > XB_SPIN_CAP) { atomicAdd(&(bar)[XB_TMO], 1u); break; } } } } while (0)

struct XcdBarrier {
    unsigned* bar; unsigned x;
    volatile LAS unsigned* st;
};

__device__ __forceinline__ XcdBarrier xcd_barrier_post(unsigned* bar, volatile LAS unsigned* st) {
    XcdBarrier b; b.bar = bar; b.x = xb_xcc_id(); b.st = st;
    if (threadIdx.x == 0) (void)xb_add(&bar[XB_XCNT(b.x)], 1u);
    return b;
}
__device__ __forceinline__ void xcd_barrier_complete(unsigned* bar, unsigned x, unsigned& nloc, unsigned& nx) {
    const unsigned G = gridDim.x * gridDim.y * gridDim.z;
    unsigned sum, cnt, mine, sp = 0u;
    for (;;) {
        sum = 0u; cnt = 0u; mine = 0u;
#pragma unroll
        for (unsigned j = 0; j < 16; ++j) { const unsigned c = xb_ld(&bar[XB_XCNT(j)]); sum += c; cnt += (c > 0u) ? 1u : 0u; mine = (j == x) ? c : mine; }
        if (sum == G) break;
        __builtin_amdgcn_s_sleep(1);
        if ((++sp & 255u) == 0u) { if (xb_ld(&bar[XB_TMO])) break; if (sp > XB_SPIN_CAP) { atomicAdd(&bar[XB_TMO], 1u); break; } }
    }
    nloc = mine > 0u ? mine : 1u; nx = cnt > 0u ? cnt : 1u;
}

__device__ __forceinline__ void xcd_barrier(const XcdBarrier& b) {
    asm volatile("s_waitcnt vmcnt(0)" ::: "memory");
    __syncthreads();
    if (threadIdx.x == 0) {
        unsigned* bar = b.bar;
        __builtin_amdgcn_s_waitcnt(0);
        unsigned nloc = b.st[0], nx = b.st[1];
        if (nloc == 0u) { xcd_barrier_complete(bar, b.x, nloc, nx); b.st[0] = nloc; b.st[1] = nx; }
        const unsigned old = xb_add(&bar[XB_XSUB(b.x)], 1u);
        const unsigned gen = old / nloc;
        if (old + 1u == (gen + 1u) * nloc) {
            __builtin_amdgcn_fence(__ATOMIC_RELEASE, "agent");
            asm volatile("s_waitcnt vmcnt(0)" ::: "memory");
            const unsigned og = xb_add(&bar[XB_TOP], 1u);
            const unsigned tg = og / nx;
            if (og + 1u == (tg + 1u) * nx) xb_add(&bar[XB_TOPGEN], 1u);
            else XB_SPIN(xb_ld(&bar[XB_TOPGEN]) == tg, bar);
            __builtin_amdgcn_fence(__ATOMIC_ACQUIRE, "agent");
            xb_add(&bar[XB_XGEN(b.x)], 1u);
            asm volatile("s_waitcnt vmcnt(0)" ::: "memory");
        } else {
            XB_SPIN(xb_ld(&bar[XB_XGEN(b.x)]) == gen, bar);
            __builtin_amdgcn_fence(__ATOMIC_ACQUIRE, "agent");
            asm volatile("s_waitcnt vmcnt(0)" ::: "memory");
        }
    }
    __syncthreads();
}

constexpr int LDS_BYTES = 147456;
#ifndef REP_PHASE
#define REP_PHASE 0
#endif
#define NREP(k) ((REP_PHASE == (k)) ? 2 : 1)

#ifdef PROF_SEL
#define TPH0(k) unsigned long long tph_##k = 0; if (PROF_SEL == 100 + (k)) tph_##k = __builtin_amdgcn_s_memrealtime();
#define TPH1(k) if (PROF_SEL == 100 + (k) && blockIdx.x == 0 && threadIdx.x == 0) atomicAdd((unsigned*)(P.ws + WS_CTL) + 1024, (unsigned)(__builtin_amdgcn_s_memrealtime() - tph_##k));
#else
#define TPH0(k)
#define TPH1(k)
#endif
__global__ void __launch_bounds__(NTHREADS, 2) mk_fwd(Params P) {
  extern __shared__ __attribute__((aligned(16))) unsigned char lds_raw[];
  cg::grid_group grid = cg::this_grid();
  Ctx C; unsigned char* ws;
#define PH() do { const __attribute__((address_space(4))) char* kp_ = (const __attribute__((address_space(4))) char*)__builtin_amdgcn_kernarg_segment_ptr(); asm volatile("" : "+s"(kp_)); \
    int t_ = threadIdx.x; asm volatile("" : "+v"(t_)); \
    C.in = (const __attribute__((address_space(4))) cfptr*)kp_; C.out = (float*)(GAS float*)*(float* const __attribute__((address_space(4)))*)(kp_ + 256); C.ws = (unsigned char*)(GAS unsigned char*)*(unsigned char* const __attribute__((address_space(4)))*)(kp_ + 264); ws = C.ws; \
    C.lds = (LAS unsigned char*)lds_raw; C.ldsg = lds_raw; C.tid = t_; C.lane = t_ & 63; C.wave = __builtin_amdgcn_readfirstlane(t_ >> 6); int g_ = gridDim.x, b_ = blockIdx.x; asm volatile("" : "+s"(g_), "+s"(b_)); C.G = g_; C.bid = b_; } while (0)
#define R1 ((bf16_t*)(ws + WS_R1))
#define R2 ((bf16_t*)(ws + WS_R2))
#define R3 ((bf16_t*)(ws + WS_R3))
#define QB R2
#define KB (R2 + (size_t)NB * NH * PP * 96)
#define VT (R2 + (size_t)2 * NB * NH * PP * 96)
#define EW R3
#define AS (R3 + (size_t)TT * 768)
#define GG (R3 + (size_t)2 * TT * 768)
#define rq ((float*)(ws + WS_RSTD))
#define rkv (((float*)(ws + WS_RSTD)) + TT)
#define IDX ((int*)(ws + WS_IDX))

  { volatile LAS unsigned* xst = (volatile LAS unsigned*)((LAS unsigned char*)lds_raw + LDS_BYTES - 32);
    if (threadIdx.x == 0) { xst[0] = 0u; xst[1] = 0u; } }
  __syncthreads();
  (void)xcd_barrier_post((unsigned*)(P.ws + WS_CTL) + 4096, (volatile LAS unsigned*)((LAS unsigned char*)lds_raw + LDS_BYTES - 32));
#define GSYNC() do { XcdBarrier xb_; xb_.bar = (unsigned*)(C.ws + WS_CTL) + 4096; xb_.x = xb_xcc_id(); xb_.st = (volatile LAS unsigned*)((LAS unsigned char*)lds_raw + LDS_BYTES - 32); xcd_barrier(xb_); } while (0)
  { TPH0(12) for (int rep = 0; rep < NREP(12); ++rep) { PH(); phase0(C);
  grid.sync(); } TPH1(12) }
  PH(); phase0b(C);
  GSYNC();
  for (int l = 0; l < 2; ++l) {
    const bool last = (l == 1);
    { TPH0(1) PH(); if (l == 0) norm_pass(C, 0, 0, 0); else norm_pass(C, 1, 1, 0);
    GSYNC(); TPH1(1) }
    { TPH0(2) for (int rep = 0; rep < NREP(2); ++rep) { PH(); { pg8::Gemm g{R2, (const bf16_t*)(ws + WS_WIN) + (size_t)l * UW * DM, DM, DM}; pg8::StaticOrder S; S.init(TT, UW, C.G, C.bid);
      EpiU E{R1, UW}; pg8::gemm_phase(C.lds, C.tid, g, S, E); }
    GSYNC(); } TPH1(2) }
    { TPH0(3) for (int rep = 0; rep < NREP(3); ++rep) { PH(); prep_a(C, l);
    GSYNC(); } TPH1(3) }
    { TPH0(4) for (int rep = 0; rep < NREP(4); ++rep) { PH(); { pg8::Gemm g{R1 + 1152, (const bf16_t*)(ws + WS_WLW) + (size_t)l * 1536 * 128, UW, 128}; pg8::StaticOrder S; S.init(TT, 1536, C.G, C.bid);
      EpiLW E{EW, AS, inp(C, 13) + l * 768, inp(C, 15) + l * 768}; pg8::gemm_phase(C.lds, C.tid, g, S, E); }
    PH(); { pg8::Gemm g{R1 + 1280, (const bf16_t*)(ws + WS_WG) + (size_t)l * 512 * 256, UW, 256}; pg8::StaticOrder S; S.init(TT, 512, C.G, C.bid);
      EpiG E{GG}; pg8::gemm_phase(C.lds, C.tid, g, S, E); }
    PH(); { pg8::Gemm g{R1 + 1536, (const bf16_t*)(ws + WS_WQ) + (size_t)l * 768 * 256, UW, 256}; pg8::StaticOrder S; S.init(TT, 768, C.G, C.bid);
      EpiQ E{QB, rq, (const float*)(ws + WS_ROPE)}; pg8::gemm_phase(C.lds, C.tid, g, S, E); }
    PH(); { pg8::Gemm g{R1 + 1792, (const bf16_t*)(ws + WS_WKV) + (size_t)l * 768 * 128, UW, 128}; pg8::StaticOrder S; S.init(TT, 768, C.G, C.bid);
      EpiKV E{KB, VT, rkv}; pg8::gemm_phase(C.lds, C.tid, g, S, E); }
    GSYNC(); } TPH1(4) }
    { TPH0(5) for (int rep = 0; rep < NREP(5); ++rep) { PH(); mix_phase(C, l, !last, rep);
    GSYNC(); } TPH1(5) }
    { TPH0(6) for (int rep = 0; rep < NREP(6); ++rep) { PH(); post_pass(C, l, !last);
    GSYNC(); } TPH1(6) }
    { TPH0(7) for (int rep = 0; rep < NREP(7); ++rep) { PH(); { pg8::Gemm g{(const bf16_t*)(ws + WS_R6), (const bf16_t*)(ws + WS_WOUT) + (size_t)l * DM * DM, DM, DM}; pg8::StaticOrder S; S.init(TT, DM, C.G, C.bid);
      EpiPlain E{R1, DM}; pg8::gemm_phase(C.lds, C.tid, g, S, E); }
    GSYNC(); } TPH1(7) }
    { TPH0(8) PH(); n2_pass(C, l, !last);
    GSYNC(); TPH1(8) }
    { TPH0(9) for (int rep = 0; rep < NREP(9); ++rep) { PH(); { const int nprob = last ? 64 : 128;
      if (C.bid < nprob) topk_problem(C, C.bid);
      const int gt = C.bid * NTHREADS + C.tid, NGT = C.G * NTHREADS;
      for (int i = gt; i < NEXP * 256; i += NGT) { const int e = i >> 8, r = i & 255; const int row = e * RPE + 4096 + r; if (last || r >= 128) IDX[row] = 0; }
      convert_experts(C, l); }
    GSYNC(); } TPH1(9) }
    { TPH0(10) for (int rep = 0; rep < NREP(10); ++rep) { PH(); { pg8::Gemm g{R2, R3, DM, DM}; MoeOrder<true> S; S.init(last ? 16 : 17, 8, C.G, C.bid, IDX);
      EpiMoe1 E{(bf16_t*)(ws + WS_HID)}; pg8::gemm_phase(C.lds, C.tid, g, S, E); }
    GSYNC(); } TPH1(10) }
    { TPH0(11) for (int rep = 0; rep < NREP(11); ++rep) { PH(); { pg8::Gemm g{(const bf16_t*)(ws + WS_HID), R3 + (size_t)NEXP * 2048 * 1024, DM, DM}; MoeOrder<false> S; S.init(last ? 16 : 17, 4, C.G, C.bid, IDX);
      EpiMoe2 E{R1}; pg8::gemm_phase(C.lds, C.tid, g, S, E); }
    GSYNC(); } TPH1(11) }
  }
#ifdef EXTRA_SYNCS
  for (int i_ = 0; i_ < EXTRA_SYNCS; ++i_) GSYNC();
#endif
  { TPH0(13) PH(); norm_pass(C, 2, 0, 1); TPH1(13) }
#ifdef PROF_SEL
  GSYNC();
  if (blockIdx.x == 0 && threadIdx.x == 0) { const unsigned ticks = __hip_atomic_load((unsigned*)(P.ws + WS_CTL) + 1024, __ATOMIC_RELAXED, __HIP_MEMORY_SCOPE_AGENT) * PROF_MUL;
    const unsigned long long t0 = __builtin_amdgcn_s_memrealtime(); while (__builtin_amdgcn_s_memrealtime() - t0 < ticks) __builtin_amdgcn_s_sleep(4); }
#endif
}

extern "C" void kernel_launch(void* const* d_in, const int* in_sizes, int n_in, void* d_out, int out_size, void* d_ws, size_t ws_size, hipStream_t stream) {
  static int grid = 0;
  if (grid == 0) {
    int dev = 0, cus = 0, per_cu = 0;
    if (n_in != 32 || out_size != NB * SEQ * DM || ws_size < WS_END) { fprintf(stderr, "kernel_launch: unexpected shapes (n_in %d out %d ws %zu)\n", n_in, out_size, ws_size); grid = -1; return; }
    (void)hipGetDevice(&dev);
    (void)hipDeviceGetAttribute(&cus, hipDeviceAttributeMultiprocessorCount, dev);
    (void)hipFuncSetAttribute((const void*)mk_fwd, hipFuncAttributeMaxDynamicSharedMemorySize, LDS_BYTES);
    (void)hipOccupancyMaxActiveBlocksPerMultiprocessor(&per_cu, (const void*)mk_fwd, NTHREADS, LDS_BYTES);
    if (per_cu < 1) { fprintf(stderr, "kernel_launch: occupancy query reports %d blocks per CU\n", per_cu); grid = -1; return; }
    grid = cus;
  }
  if (grid < 0) return;
  (void)hipMemsetAsync((char*)d_ws + WS_CTL, 0, 32768, stream);
  Params p{};
  for (int i = 0; i < 32; ++i) p.in[i] = (const float*)d_in[i];
  p.out = (float*)d_out; p.ws = (unsigned char*)d_ws;
  void* args[] = {&p};
  hipError_t e = hipLaunchCooperativeKernel((const void*)mk_fwd, dim3(grid), dim3(NTHREADS), args, LDS_BYTES, stream);
  if (e != hipSuccess) fprintf(stderr, "cooperative launch failed: %s (grid %d)\n", hipGetErrorString(e), grid);
}
```

```cpp
#include <hip/hip_runtime.h>
#include <hip/hip_cooperative_groups.h>
#include <cstdio>
#include <cstdint>
namespace cg = cooperative_groups;

#define LAS __attribute__((address_space(3)))
typedef unsigned short bf16_t;
typedef short bf16x8 __attribute__((ext_vector_type(8)));
typedef float f32x4 __attribute__((ext_vector_type(4)));
typedef float f32x2 __attribute__((ext_vector_type(2)));
typedef float f32x16 __attribute__((ext_vector_type(16)));
typedef unsigned u32x4 __attribute__((ext_vector_type(4)));
typedef unsigned u32x2 __attribute__((ext_vector_type(2)));
typedef __bf16 bf16x2_t __attribute__((ext_vector_type(2)));
#define DI __device__ __forceinline__

constexpr int NB = 4, SEQ = 8192, CTX = 256, PP = SEQ + CTX  , TT = NB * PP  , DM = 1024;
constexpr int UW = 2304;
constexpr int NH = 6;
constexpr int NEXP = 16, RPE = 4352  ;
constexpr float NORM_EPS = 1e-6f, GN_EPS = 64e-5f;
constexpr float QSCALE = 0.10206207261596577f * 1.4426950408889634f;
constexpr int NWAVES = 8, NTHREADS = 512;

DI unsigned cvtpk(float lo, float hi) { f32x2 v = {lo, hi}; bf16x2_t b = __builtin_convertvector(v, bf16x2_t); return __builtin_bit_cast(unsigned, b); }
DI bf16_t f2bf(float f) { return (bf16_t)(cvtpk(f, 0.f) & 0xffffu); }
DI float bf2f(bf16_t b) { return __uint_as_float(((unsigned)b) << 16); }
DI float bflo(unsigned u) { return __uint_as_float(u << 16); }
DI float bfhi(unsigned u) { return __uint_as_float(u & 0xffff0000u); }
template <int CTRL> DI float dpp_add(float x) { return x + __builtin_bit_cast(float, __builtin_amdgcn_update_dpp(0, __builtin_bit_cast(int, x), CTRL, 0xf, 0xf, true)); }
DI float rdlane(float x, int l) { return __builtin_bit_cast(float, __builtin_amdgcn_readlane(__builtin_bit_cast(int, x), l)); }
DI float wave_sum(float x) {
  x = dpp_add<0xB1>(x); x = dpp_add<0x4E>(x); x = dpp_add<0x141>(x); x = dpp_add<0x140>(x);
  return (rdlane(x, 0) + rdlane(x, 16)) + (rdlane(x, 32) + rdlane(x, 48));
}
DI float swz_xor16(float x) { return __builtin_bit_cast(float, __builtin_amdgcn_ds_swizzle(__builtin_bit_cast(int, x), 0x401F)); }
DI float swz_xor8(float x) { return __builtin_bit_cast(float, __builtin_amdgcn_ds_swizzle(__builtin_bit_cast(int, x), 0x201F)); }
DI float half_max(float x) { auto r = __builtin_amdgcn_permlane32_swap(__float_as_uint(x), __float_as_uint(x), false, false); float o; asm("v_max_f32_e32 %0, %1, %2" : "=v"(o) : "v"(__uint_as_float(r[0])), "v"(__uint_as_float(r[1]))); return o; }
DI float half_sum(float x) { auto r = __builtin_amdgcn_permlane32_swap(__float_as_uint(x), __float_as_uint(x), false, false); return __uint_as_float(r[0]) + __uint_as_float(r[1]); }
DI float sigmoidf_(float x) { return 1.f / (1.f + __expf(-x)); }

namespace pg8 {
constexpr int BM = 256, BK = 64, HALF = 128, HTB = HALF * BK * 2, STAGE_BYTES = 8 * HTB, NXCD = 8, WGM = 8;
__host__ __device__ __forceinline__ int lds_byte(int r, int c) { const int st = (r >> 4) * 2 + (c >> 5), rr = r & 15, cc = c & 31, ob = rr * 64 + cc * 2; return st * 1024 + (ob ^ (((ob >> 9) & 1) << 5)); }
__host__ __device__ __forceinline__ void stage_rc(int b, int& R, int& C) { const int st = b / 1024, sb = b % 1024, swz = sb ^ (((sb >> 9) & 1) << 5); R = (st >> 1) * 16 + swz / 64; C = (st & 1) * 32 + (swz % 64) / 2; }
__host__ __device__ __forceinline__ int perm32(int rho) { const int n = rho >> 4, i = rho & 15; return 8 * (i >> 2) + 4 * n + (i & 3); }

struct Unit { int pm, pn; };
struct Gemm { const bf16_t* A; const bf16_t* Bt; int lda; int K; };

struct StaticOrder {
  int nM, nN, nwg, G, c;
  static constexpr bool GATHER = false;
  __device__ void init(int M, int N, int G_, int c_) { nM = M / BM; nN = N / BM; nwg = nM * nN; G = G_; c = c_; }
  __device__ bool next(int i, Unit& u) const {
    const long L = (long)i * G + c; if (L >= nwg) return false;
    int wgid = (int)L; { const int q = nwg / NXCD, r = nwg % NXCD, xcd = wgid % NXCD, off = wgid / NXCD; wgid = (xcd < r ? xcd * (q + 1) : r * (q + 1) + (xcd - r) * q) + off; }
    const int nig = WGM * nN, gid = wgid / nig, fm = gid * WGM, gsz = (nM - fm) < WGM ? (nM - fm) : WGM;
    u.pm = fm + ((wgid % nig) % gsz); u.pn = (wgid % nig) / gsz; return true;
  }
  __device__ int arow(const Unit&, int) const { return 0; }
};

template <class Epi, class Sched>
__device__ __forceinline__ void gemm_phase(LAS unsigned char* lds, const int tid, const Gemm g, const Sched& S, const Epi& E) {
  const int wid = __builtin_amdgcn_readfirstlane(tid >> 6), lane = tid & 63, wr = wid >> 2, wc = wid & 3, fr = lane & 15, fq = lane >> 4;
  int K_ = g.K, lda_ = g.lda; asm volatile("" : "+s"(K_), "+s"(lda_));
  const int K = K_, nt = K / BK, lda = lda_;
  unsigned voffB[2]; int RA[2], CA[2];
#pragma unroll
  for (int i = 0; i < 2; ++i) { int R, C; stage_rc(tid * 16 + i * 8192, R, C); const int Rb = Epi::PERM ? ((R & ~31) + perm32(R & 31)) : R;
    RA[i] = R; CA[i] = C; voffB[i] = (unsigned)(Rb * K + C) * 2u; }
  const size_t kstep = (size_t)(BK * 2);
  const size_t hstepB = (size_t)HALF * K * 2, tstepB = 2 * hstepB;
  const size_t tstepA = (size_t)BM * lda * 2;
  const unsigned ldsw = (unsigned)wid * 1024u;
  const int aoff = lds_byte(wr * 64 + fr, fq * 8), boff = lds_byte(wc * 32 + fr, fq * 8);
#define PG8_SA(b, h) (((b) * 2 + (h)) * HTB)
#define PG8_SB(b, h) ((4 + (b) * 2 + (h)) * HTB)
#define PG8_STAGE(bufoff, gbase, voff) do { _Pragma("unroll") for (int _i = 0; _i < 2; ++_i) \
        __builtin_amdgcn_global_load_lds((const unsigned*)((const char*)(gbase) + (voff)[_i]), (LAS unsigned*)(lds + (bufoff) + ldsw + _i * 8192), 16, 0, 0); } while (0)
#define PG8_LDA(dst, b, h) do { _Pragma("unroll") for (int m = 0; m < 4; ++m) _Pragma("unroll") for (int k = 0; k < 2; ++k) dst[m][k] = *(const LAS bf16x8*)(lds + PG8_SA(b, h) + aoff + m * 2048 + k * 1024); } while (0)
#define PG8_LDB(dst, b, h) do { _Pragma("unroll") for (int n = 0; n < 2; ++n) _Pragma("unroll") for (int k = 0; k < 2; ++k) dst[n][k] = *(const LAS bf16x8*)(lds + PG8_SB(b, h) + boff + n * 2048 + k * 1024); } while (0)
#define PG8_MMA(ai, bj, At, Bt) do { __builtin_amdgcn_s_setprio(1); _Pragma("unroll") for (int m = 0; m < 4; ++m) _Pragma("unroll") for (int n = 0; n < 2; ++n) _Pragma("unroll") for (int k = 0; k < 2; ++k) \
        acc[ai][bj][m][n] = __builtin_amdgcn_mfma_f32_16x16x32_bf16(Bt[n][k], At[m][k], acc[ai][bj][m][n], 0, 0, 0); __builtin_amdgcn_s_setprio(0); } while (0)
#define PG8_WAIT_V(n) asm volatile("s_waitcnt vmcnt(" #n ")" ::: "memory")
#define PG8_WAIT_L(n) asm volatile("s_waitcnt lgkmcnt(" #n ")" ::: "memory")
#define PG8_BAR __builtin_amdgcn_s_barrier()
#define PG8_SCHED __builtin_amdgcn_sched_barrier(0)
#define PG8_OFFS(dst, u) do { _Pragma("unroll") for (int _h = 0; _h < 2; ++_h) _Pragma("unroll") for (int _i = 0; _i < 2; ++_i) \
        dst[_h][_i] = Sched::GATHER ? (unsigned)((size_t)S.arow(u, _h * HALF + RA[_i]) * lda + CA[_i]) * 2u : (unsigned)((_h * HALF + RA[_i]) * lda + CA[_i]) * 2u; } while (0)
  Unit cur, nxt; int ui = 0;
  if (!S.next(0, cur)) return;
  f32x4 acc[2][2][4][2];
#pragma unroll
  for (int a = 0; a < 2; ++a)
#pragma unroll
    for (int b = 0; b < 2; ++b)
#pragma unroll
      for (int m = 0; m < 4; ++m)
#pragma unroll
        for (int n = 0; n < 2; ++n) acc[a][b][m][n] = (f32x4){0.f, 0.f, 0.f, 0.f};
  bf16x8 At[4][2], B0[2][2], B1[2][2];
  unsigned oAc[2][2], oAn[2][2];
  PG8_OFFS(oAc, cur);
  const char* cA = (const char*)g.A + (Sched::GATHER ? (size_t)0 : (size_t)cur.pm * tstepA); const char* cB = (const char*)g.Bt + (size_t)cur.pn * tstepB;
  PG8_STAGE(PG8_SB(0, 0), cB, voffB); PG8_STAGE(PG8_SB(0, 1), cB + hstepB, voffB); PG8_STAGE(PG8_SA(0, 0), cA, oAc[0]); PG8_STAGE(PG8_SA(0, 1), cA, oAc[1]);
  if (wr == 1) PG8_BAR;
  PG8_WAIT_V(2); PG8_BAR;
  PG8_STAGE(PG8_SB(1, 0), cB + kstep, voffB); PG8_STAGE(PG8_SA(1, 0), cA + kstep, oAc[0]); PG8_STAGE(PG8_SB(1, 1), cB + hstepB + kstep, voffB);
  PG8_WAIT_V(6); PG8_BAR;
  for (;;) {
    const bool has_next = S.next(ui + 1, nxt);
    if (has_next) { PG8_OFFS(oAn, nxt); }
    else {
#pragma unroll
      for (int _h = 0; _h < 2; ++_h)
#pragma unroll
        for (int _i = 0; _i < 2; ++_i) oAn[_h][_i] = oAc[_h][_i];
    }
    const char* nA = has_next ? (const char*)g.A + (Sched::GATHER ? (size_t)0 : (size_t)nxt.pm * tstepA) : cA; const char* nB = has_next ? (const char*)g.Bt + (size_t)nxt.pn * tstepB : cB;
    for (int t = 0; t < nt; t += 2) {
      const bool last = (t == nt - 2);
      const char* a1 = cA + (size_t)(t + 1) * kstep;
      const char* a2 = last ? nA : cA + (size_t)(t + 2) * kstep; const char* b2 = last ? nB : cB + (size_t)(t + 2) * kstep;
      const char* a3 = a2 + kstep; const char* b3 = b2 + kstep;
      unsigned o2[2][2];
#pragma unroll
      for (int _h = 0; _h < 2; ++_h)
#pragma unroll
        for (int _i = 0; _i < 2; ++_i) o2[_h][_i] = last ? oAn[_h][_i] : oAc[_h][_i];
      PG8_LDB(B0, 0, 0); PG8_LDB(B1, 0, 1); PG8_SCHED; PG8_LDA(At, 0, 0); PG8_STAGE(PG8_SA(1, 1), a1, oAc[1]);
      PG8_WAIT_V(8); PG8_WAIT_L(0); PG8_BAR; PG8_MMA(0, 0, At, B0); PG8_MMA(0, 1, At, B1); PG8_BAR; PG8_SCHED;
      PG8_LDA(At, 0, 1); PG8_STAGE(PG8_SB(0, 0), b2, voffB); PG8_STAGE(PG8_SB(0, 1), b2 + hstepB, voffB); PG8_STAGE(PG8_SA(0, 0), a2, o2[0]);
      PG8_WAIT_V(8); PG8_WAIT_L(0); PG8_BAR; PG8_MMA(1, 0, At, B0); PG8_MMA(1, 1, At, B1); PG8_BAR; PG8_SCHED;
      PG8_LDB(B0, 1, 0); PG8_LDB(B1, 1, 1); PG8_SCHED; PG8_LDA(At, 1, 0); PG8_STAGE(PG8_SA(0, 1), a2, o2[1]);
      PG8_WAIT_V(8); PG8_WAIT_L(0); PG8_BAR; PG8_MMA(0, 0, At, B0); PG8_MMA(0, 1, At, B1); PG8_BAR; PG8_SCHED;
      PG8_LDA(At, 1, 1); PG8_STAGE(PG8_SB(1, 0), b3, voffB); PG8_STAGE(PG8_SB(1, 1), b3 + hstepB, voffB); PG8_STAGE(PG8_SA(1, 0), a3, o2[0]);
      PG8_WAIT_V(8); PG8_WAIT_L(0); PG8_BAR; PG8_MMA(1, 0, At, B0); PG8_MMA(1, 1, At, B1); PG8_BAR; PG8_SCHED;
    }
    if (wr == 0) PG8_BAR;
    E(acc, cur, wr, wc, fr, fq);
    if (!has_next) break;
#pragma unroll
    for (int a = 0; a < 2; ++a)
#pragma unroll
      for (int b = 0; b < 2; ++b)
#pragma unroll
        for (int m = 0; m < 4; ++m)
#pragma unroll
          for (int n = 0; n < 2; ++n) acc[a][b][m][n] = (f32x4){0.f, 0.f, 0.f, 0.f};
    cur = nxt; cA = nA; cB = nB; ++ui;
#pragma unroll
    for (int _h = 0; _h < 2; ++_h)
#pragma unroll
      for (int _i = 0; _i < 2; ++_i) oAc[_h][_i] = oAn[_h][_i];
    if (wr == 1) PG8_BAR;
  }
  PG8_WAIT_V(0);
  PG8_BAR;
#undef PG8_SA
#undef PG8_SB
#undef PG8_STAGE
#undef PG8_LDA
#undef PG8_LDB
#undef PG8_MMA
#undef PG8_WAIT_V
#undef PG8_WAIT_L
#undef PG8_BAR
#undef PG8_SCHED
#undef PG8_OFFS
}
}
using pg8::Unit;
struct EpiU {
  static constexpr bool PERM = true;
  bf16_t* O; int ldc;
  DI void operator()(const f32x4 (&acc)[2][2][4][2], const Unit& u, int wr, int wc, int fr, int fq) const {
    const int row0 = u.pm * 256 + wr * 64 + fr;
#pragma unroll
    for (int ai = 0; ai < 2; ++ai)
#pragma unroll
      for (int m = 0; m < 4; ++m) { bf16_t* rowp = O + (size_t)(row0 + ai * 128 + m * 16) * ldc;
#pragma unroll
        for (int bj = 0; bj < 2; ++bj) { const int col = u.pn * 256 + bj * 128 + wc * 32 + 8 * fq;
          f32x4 v0 = acc[ai][bj][m][0], v1 = acc[ai][bj][m][1];
          if (col >= 1152 && col < 1216) {
#pragma unroll
            for (int j = 0; j < 4; ++j) { v0[j] = tanhf(v0[j]); v1[j] = tanhf(v1[j]); }
          } else if (col >= 1280 && col < 1536) {
#pragma unroll
            for (int j = 0; j < 4; ++j) { v0[j] = sigmoidf_(v0[j]); v1[j] = sigmoidf_(v1[j]); }
          }
          u32x4 w; w.x = cvtpk(v0[0], v0[1]); w.y = cvtpk(v0[2], v0[3]); w.z = cvtpk(v1[0], v1[1]); w.w = cvtpk(v1[2], v1[3]);
          *(u32x4*)(rowp + col) = w; } }
  }
};
struct EpiPlain {
  static constexpr bool PERM = true;
  bf16_t* O; int ldc;
  DI void operator()(const f32x4 (&acc)[2][2][4][2], const Unit& u, int wr, int wc, int fr, int fq) const {
    const int row0 = u.pm * 256 + wr * 64 + fr;
#pragma unroll
    for (int ai = 0; ai < 2; ++ai)
#pragma unroll
      for (int m = 0; m < 4; ++m) { bf16_t* rowp = O + (size_t)(row0 + ai * 128 + m * 16) * ldc;
#pragma unroll
        for (int bj = 0; bj < 2; ++bj) { const int col = u.pn * 256 + bj * 128 + wc * 32 + 8 * fq;
          const f32x4 v0 = acc[ai][bj][m][0], v1 = acc[ai][bj][m][1];
          u32x4 w; w.x = cvtpk(v0[0], v0[1]); w.y = cvtpk(v0[2], v0[3]); w.z = cvtpk(v1[0], v1[1]); w.w = cvtpk(v1[2], v1[3]);
          *(u32x4*)(rowp + col) = w; } }
  }
};
struct EpiLW {
  static constexpr bool PERM = true;
  bf16_t* EW; bf16_t* AS; const float* w0; const float* a0;
  DI void operator()(const f32x4 (&acc)[2][2][4][2], const Unit& u, int wr, int wc, int fr, int fq) const {
    const int row0 = u.pm * 256 + wr * 64 + fr;
    const bool isw = u.pn < 3;
    bf16_t* O = isw ? EW : AS; const float* bias = isw ? w0 : a0; const float sc = isw ? 0.6065306597126334f : 1.f;
    const int cb = (isw ? u.pn : u.pn - 3) * 256;
#pragma unroll
    for (int bj = 0; bj < 2; ++bj) { const int col = cb + bj * 128 + wc * 32 + 8 * fq;
      const f32x4 b0 = *(const f32x4*)(bias + col), b1 = *(const f32x4*)(bias + col + 4);
#pragma unroll
      for (int ai = 0; ai < 2; ++ai)
#pragma unroll
        for (int m = 0; m < 4; ++m) { bf16_t* rowp = O + (size_t)(row0 + ai * 128 + m * 16) * 768;
          f32x4 v0 = acc[ai][bj][m][0] + b0, v1 = acc[ai][bj][m][1] + b1;
#pragma unroll
          for (int j = 0; j < 4; ++j) { v0[j] = sc * sigmoidf_(v0[j]); v1[j] = sc * sigmoidf_(v1[j]); }
          u32x4 w; w.x = cvtpk(v0[0], v0[1]); w.y = cvtpk(v0[2], v0[3]); w.z = cvtpk(v1[0], v1[1]); w.w = cvtpk(v1[2], v1[3]);
          *(u32x4*)(rowp + col) = w; asm volatile("" ::: "memory"); } }
  }
};
struct EpiG {
  static constexpr bool PERM = true;
  bf16_t* G;
  DI void operator()(const f32x4 (&acc)[2][2][4][2], const Unit& u, int wr, int wc, int fr, int fq) const {
    const int row0 = u.pm * 256 + wr * 64 + fr;
#pragma unroll
    for (int bj = 0; bj < 2; ++bj) { const int col = u.pn * 256 + bj * 128 + wc * 32 + 8 * fq;
      if (col < 384) {
#pragma unroll
        for (int ai = 0; ai < 2; ++ai)
#pragma unroll
          for (int m = 0; m < 4; ++m) { bf16_t* rowp = G + (size_t)(row0 + ai * 128 + m * 16) * 384;
            const f32x4 v0 = acc[ai][bj][m][0], v1 = acc[ai][bj][m][1];
            u32x4 w; w.x = cvtpk(v0[0], v0[1]); w.y = cvtpk(v0[2], v0[3]); w.z = cvtpk(v1[0], v1[1]); w.w = cvtpk(v1[2], v1[3]);
            *(u32x4*)(rowp + col) = w; } } }
  }
};
struct EpiQ {
  static constexpr bool PERM = true;
  bf16_t* QB; const float* rstd; const float* rope;
  DI void operator()(const f32x4 (&acc)[2][2][4][2], const Unit& u, int wr, int wc, int fr, int fq) const {
    const int row0 = u.pm * 256 + wr * 64 + fr;
    const int b = (u.pm * 256) / PP;
#pragma unroll
    for (int bj = 0; bj < 2; ++bj) { const int col = u.pn * 256 + bj * 128 + wc * 32 + 8 * fq;
      const int hh = col / 96, dim = col - hh * 96;
      const bool isrope = dim >= 64;
#pragma unroll
      for (int ai = 0; ai < 2; ++ai)
#pragma unroll
        for (int m = 0; m < 4; ++m) { const int g = row0 + ai * 128 + m * 16; const int p = g - b * PP;
          const float s = rstd[g] * QSCALE;
          float v[8];
#pragma unroll
          for (int j = 0; j < 4; ++j) { v[j] = acc[ai][bj][m][0][j] * s; v[4 + j] = acc[ai][bj][m][1][j] * s; }
          if (isrope) {
            float o[8];
#pragma unroll
            for (int j = 0; j < 8; ++j) o[j] = swz_xor16(v[j]);
            if (p >= CTX) { const int li = p - CTX; const int pos = (fq & 2) ? (li & 63) : (li >> 6);
              const f32x2* rp = (const f32x2*)rope + pos * 8;
#pragma unroll
              for (int j = 0; j < 8; ++j) { const f32x2 cs = rp[j]; v[j] = (fq & 1) ? (v[j] * cs.x + o[j] * cs.y) : (v[j] * cs.x - o[j] * cs.y); } }
          }
          if (col < 576) { u32x4 w; w.x = cvtpk(v[0], v[1]); w.y = cvtpk(v[2], v[3]); w.z = cvtpk(v[4], v[5]); w.w = cvtpk(v[6], v[7]);
            *(u32x4*)(QB + ((size_t)(b * NH + hh) * PP + p) * 96 + dim) = w; }
          asm volatile("" ::: "memory"); }
    }
  }
};
DI int vperm(int p) { const int q = p & 15; return (p & ~15) | (((q >> 2) & 1) << 3) | ((q >> 3) << 2) | (q & 3); }
struct EpiKV {
  static constexpr bool PERM = true;
  bf16_t* KB; bf16_t* VT; const float* rstd;
  DI void operator()(const f32x4 (&acc)[2][2][4][2], const Unit& u, int wr, int wc, int fr, int fq) const {
    const int row0 = u.pm * 256 + wr * 64 + fr;
    const int b = (u.pm * 256) / PP;
#pragma unroll
    for (int bj = 0; bj < 2; ++bj) { const int col = u.pn * 256 + bj * 128 + wc * 32 + 8 * fq;
      const int hh = col >> 7, j0 = col & 127;
#pragma unroll
      for (int ai = 0; ai < 2; ++ai)
#pragma unroll
        for (int m = 0; m < 4; ++m) { const int g = row0 + ai * 128 + m * 16; const int p = g - b * PP;
          const float s = rstd[g];
          float v[8];
#pragma unroll
          for (int j = 0; j < 4; ++j) { v[j] = acc[ai][bj][m][0][j] * s; v[4 + j] = acc[ai][bj][m][1][j] * s; }
          if (j0 < 64) { u32x4 w; w.x = cvtpk(v[0], v[1]); w.y = cvtpk(v[2], v[3]); w.z = cvtpk(v[4], v[5]); w.w = cvtpk(v[6], v[7]);
            *(u32x4*)(KB + ((size_t)(b * NH + hh) * PP + p) * 96 + j0) = w; }
          else { bf16_t* vt = VT + ((size_t)(b * NH + hh) * 64 + (j0 - 64)) * PP + vperm(p);
#pragma unroll
            for (int j = 0; j < 8; ++j) vt[(size_t)j * PP] = f2bf(v[j]); }
          asm volatile("" ::: "memory"); }
    }
  }
};
struct EpiMoe1 {
  static constexpr bool PERM = false;
  bf16_t* HID;
  DI void operator()(const f32x4 (&acc)[2][2][4][2], const Unit& u, int wr, int wc, int fr, int fq) const {
    const int row0 = u.pm * 256 + wr * 64 + fr; const int pnl = u.pn & 7;
#pragma unroll
    for (int ai = 0; ai < 2; ++ai)
#pragma unroll
      for (int m = 0; m < 4; ++m) { bf16_t* rowp = HID + (size_t)(row0 + ai * 128 + m * 16) * 1024 + pnl * 128 + wc * 32 + 4 * fq;
#pragma unroll
        for (int n = 0; n < 2; ++n) { const f32x4 gv = acc[ai][0][m][n], uv = acc[ai][1][m][n]; float h[4];
#pragma unroll
          for (int j = 0; j < 4; ++j) h[j] = gv[j] * sigmoidf_(gv[j]) * uv[j];
          u32x2 w; w.x = cvtpk(h[0], h[1]); w.y = cvtpk(h[2], h[3]);
          *(u32x2*)(rowp + 16 * n) = w; } }
  }
};
struct EpiMoe2 {
  static constexpr bool PERM = true;
  bf16_t* O;
  DI void operator()(const f32x4 (&acc)[2][2][4][2], const Unit& u, int wr, int wc, int fr, int fq) const {
    const int row0 = u.pm * 256 + wr * 64 + fr; const int pnl = u.pn & 3;
#pragma unroll
    for (int ai = 0; ai < 2; ++ai)
#pragma unroll
      for (int m = 0; m < 4; ++m) { bf16_t* rowp = O + (size_t)(row0 + ai * 128 + m * 16) * 1024;
#pragma unroll
        for (int bj = 0; bj < 2; ++bj) { const int col = pnl * 256 + bj * 128 + wc * 32 + 8 * fq;
          const f32x4 v0 = acc[ai][bj][m][0], v1 = acc[ai][bj][m][1];
          u32x4 w; w.x = cvtpk(v0[0], v0[1]); w.y = cvtpk(v0[2], v0[3]); w.z = cvtpk(v1[0], v1[1]); w.w = cvtpk(v1[2], v1[3]);
          *(u32x4*)(rowp + col) = w; } }
  }
};
template <bool GATH> struct MoeOrder {
  static constexpr bool GATHER = GATH;
  int tpe, nN, nwg, G, c; const int* idx;
  __device__ void init(int tpe_, int nN_, int G_, int c_, const int* idx_) { tpe = tpe_; nN = nN_; nwg = NEXP * tpe * nN; G = G_; c = c_; idx = idx_; }
  __device__ bool next(int i, Unit& u) const {
    const long L = (long)i * G + c; if (L >= nwg) return false;
    const int per = tpe * nN, e = (int)L / per, rem = (int)L % per, pnl = rem / tpe, pml = rem % tpe;
    u.pm = e * 17 + pml; u.pn = e * nN + pnl; return true;
  }
  __device__ int arow(const Unit& u, int r) const { return idx[u.pm * 256 + r]; }
};
constexpr size_t MiB = (size_t)1 << 20;
constexpr size_t WS_CTL = 0;
constexpr size_t WS_MODP = 1 * MiB;
constexpr size_t WS_MOD = 3 * MiB;
constexpr size_t WS_TW = 3 * MiB + 256 * 1024;
constexpr size_t WS_ROPE = 3 * MiB + 384 * 1024;
constexpr size_t WS_RSTD = 3 * MiB + 512 * 1024;
constexpr size_t WS_WIN = 4 * MiB;
constexpr size_t WS_WOUT = 13 * MiB;
constexpr size_t WS_WLW = 17 * MiB;
constexpr size_t WS_WG = 18 * MiB;
constexpr size_t WS_WQ = 19 * MiB;
constexpr size_t WS_WKV = 20 * MiB;
constexpr size_t WS_AFF = 21 * MiB;
constexpr size_t WS_IDX = 24 * MiB;
constexpr size_t WS_SLOT = 29 * MiB;
constexpr size_t WS_XCTX = 25 * MiB;
constexpr size_t WS_R1 = 36 * MiB;
constexpr size_t WS_R2 = 192 * MiB;
constexpr size_t WS_R3 = 292 * MiB;
constexpr size_t WS_R4 = 416 * MiB;
constexpr size_t WS_R5 = 452 * MiB;
constexpr size_t WS_R6 = 502 * MiB;
constexpr size_t WS_HID = 416 * MiB;
constexpr size_t WS_END = 568 * MiB;

struct Params {
  const float* in[32];
  float* out; unsigned char* ws;
};

typedef const float* cfptr;
struct Ctx {
  const __attribute__((address_space(4))) cfptr* in; float* out; unsigned char* ws;
  LAS unsigned char* lds; unsigned char* ldsg;
  int tid, lane, wave, G, bid;
};

#define GAS __attribute__((address_space(1)))
DI const float* inp(const Ctx& C, int k) { return (const float*)(const GAS float*)C.in[k]; }
DI const float* in_row(const Ctx& C, int g) { const int b = g / PP, p = g - b * PP; return p < CTX ? inp(C, 2) + ((size_t)b * CTX + p) * DM : inp(C, 0) + ((size_t)b * SEQ + (p - CTX)) * DM; }
DI float* xs_row(const Ctx& C, int g) { const int b = g / PP, p = g - b * PP; return p < CTX ? (float*)(C.ws + WS_XCTX) + ((size_t)b * CTX + p) * DM : C.out + ((size_t)b * SEQ + (p - CTX)) * DM; }
DI int mod_row(int g) { const int b = g / PP, p = g - b * PP; return p < CTX ? 4 : b; }
DI const float* modv(const Ctx& C, int l, int r, int j) { return (const float*)(C.ws + WS_MOD) + ((size_t)(l * 5 + r) * 6 + j) * DM; }

template <class RowMap>
DI void transpose_item(const float* W, int K, int N, bf16_t* WT, int ldk, LAS float* scr, int item, int lane, const RowMap& rm) {
  const int nblk = N / 32, kb = item / nblk, nb = item % nblk, k0 = 64 * kb, n0 = 32 * nb;
#pragma unroll 8
  for (int i = 0; i < 32; ++i) { const int kk = 2 * i + (lane >> 5); scr[kk * 33 + (lane & 31)] = W[(size_t)(k0 + kk) * N + n0 + (lane & 31)]; }
  asm volatile("s_waitcnt lgkmcnt(0)" ::: "memory");
  const int c = lane & 7;
#pragma unroll
  for (int j = 0; j < 4; ++j) { const int n = (lane >> 3) + 8 * j; const LAS float* s = scr + (8 * c) * 33 + n;
    u32x4 o; o.x = cvtpk(s[0 * 33], s[1 * 33]); o.y = cvtpk(s[2 * 33], s[3 * 33]); o.z = cvtpk(s[4 * 33], s[5 * 33]); o.w = cvtpk(s[6 * 33], s[7 * 33]);
    const int r = rm(n0 + n);
    if (r >= 0) *(u32x4*)(WT + (size_t)r * ldk + k0 + 8 * c) = o; }
  asm volatile("s_waitcnt lgkmcnt(0)" ::: "memory");
}
struct MapIn { DI int operator()(int n) const { return n < 1440 ? n : (n < 1856 ? n + 96 : -1); } };
struct MapId { DI int operator()(int n) const { return n; } };
struct MapGate { int up; DI int operator()(int f) const { return 256 * (f >> 7) + 128 * up + (f & 127); } };

DI void phase0(const Ctx& C) {
  const int gw = C.bid * NWAVES + C.wave, NGW = C.G * NWAVES;
  const int gt = C.bid * NTHREADS + C.tid, NGT = C.G * NTHREADS;
  LAS float* scr = (LAS float*)(C.lds + C.wave * 16384);
  LAS f32x2* tw64p = (LAS f32x2*)(C.lds + 8 * 16384);
  if (C.tid < 64) { float s_, c_; sincospif((float)C.tid * (2.0f / 64.0f), &s_, &c_); tw64p[C.tid] = (f32x2){c_, s_}; }
  __syncthreads();
  {
    const float* cin = inp(C, 1); const float* cctx = inp(C, 3);
    for (int it = gw; it < 2 * 96 * 8; it += NGW) {
      const int l = it / 768, r_ = it % 768, cc = r_ / 8, kc = r_ % 8;
      const float* W = inp(C, 4) + (size_t)l * DM * 6144 + (size_t)(kc * 128) * 6144 + cc * 64 + C.lane;
      float a0 = 0.f, a1 = 0.f, a2 = 0.f, a3 = 0.f, a4 = 0.f;
#pragma unroll 8
      for (int k = 0; k < 128; ++k) { const float w = W[(size_t)k * 6144]; const int kk = kc * 128 + k;
        const float c0 = cin[kk], c1 = cin[DM + kk], c2 = cin[2 * DM + kk], c3 = cin[3 * DM + kk], c4 = cctx[kk];
        a0 += c0 * sigmoidf_(c0) * w; a1 += c1 * sigmoidf_(c1) * w; a2 += c2 * sigmoidf_(c2) * w; a3 += c3 * sigmoidf_(c3) * w; a4 += c4 * sigmoidf_(c4) * w; }
      float* P = (float*)(C.ws + WS_MODP) + ((size_t)(l * 8 + kc) * 5) * 6144 + cc * 64 + C.lane;
      P[0] = a0; P[6144] = a1; P[2 * 6144] = a2; P[3 * 6144] = a3; P[4 * 6144] = a4;
    }
  }
  for (int l = 0; l < 2; ++l) {
    bf16_t* WT = (bf16_t*)(C.ws + WS_WIN) + (size_t)l * UW * DM;
    for (int i = gt; i < 192 * DM / 8; i += NGT) { const int r = i / (DM / 8), c8 = i % (DM / 8); const int row = r < 96 ? 1440 + r : 1952 + (r - 96);
      *(u32x4*)(WT + (size_t)row * DM + c8 * 8) = (u32x4){0u, 0u, 0u, 0u}; }
    for (int it = gw; it < 16 * 66; it += NGW) transpose_item(inp(C, 10) + (size_t)l * DM * 2112, DM, 2112, WT, DM, scr, it, C.lane, MapIn());
    for (int it = gw; it < 4 * DM; it += NGW) { const int g = it / DM, k = it % DM; const float* wrow = inp(C, 10) + (size_t)l * DM * 2112 + (size_t)k * 2112 + 1856 + 64 * g;
      const int c_ = C.lane, k2 = c_ <= 32 ? c_ : c_ - 32; float acc = 0.f;
      for (int n = 0; n < 64; ++n) { const f32x2 t_ = tw64p[(k2 * n) & 63]; acc += wrow[n] * (c_ <= 32 ? t_.x : t_.y); }
      WT[(size_t)(2048 + 64 * g + c_) * DM + k] = f2bf(acc); }
    bf16_t* WO = (bf16_t*)(C.ws + WS_WOUT) + (size_t)l * DM * DM;
    for (int it = gw; it < 12 * 32; it += NGW) transpose_item(inp(C, 11) + (size_t)l * DM * DM, 768, DM, WO, DM, scr, it, C.lane, MapId());
    const float* wf = inp(C, 27) + (size_t)l * 256 * 256; const float* wo = inp(C, 11) + (size_t)l * DM * DM + (size_t)768 * DM;
    for (int it = gw; it < 64 * 16; it += NGW) { const int kq = it / 16, nc = it % 16; const int n = nc * 64 + C.lane;
      float a0 = 0.f, a1 = 0.f, a2 = 0.f, a3 = 0.f;
#pragma unroll 4
      for (int j = 0; j < 256; ++j) { const float w = wo[(size_t)j * DM + n];
        a0 += wf[(kq * 4 + 0) * 256 + j] * w; a1 += wf[(kq * 4 + 1) * 256 + j] * w; a2 += wf[(kq * 4 + 2) * 256 + j] * w; a3 += wf[(kq * 4 + 3) * 256 + j] * w; }
      u32x2 o; o.x = cvtpk(a0, a1); o.y = cvtpk(a2, a3);
      *(u32x2*)(WO + (size_t)n * DM + 768 + kq * 4) = o; }
    bf16_t* WLW = (bf16_t*)(C.ws + WS_WLW) + (size_t)l * 1536 * 128;
    for (int i = gt; i < 1536 * 128; i += NGT) { const int n = i / 128, k = i % 128; float v = 0.f;
      if (n < 768) { if (k < 64) v = inp(C, 14)[((size_t)(l * 2 + n / 384) * 64 + k) * 384 + n % 384]; }
      else { const int n2 = n - 768; if (k >= 64) v = inp(C, 16)[((size_t)(l * 2 + n2 / 384) * 64 + (k - 64)) * 384 + n2 % 384]; }
      WLW[i] = f2bf(v); }
    bf16_t* WG = (bf16_t*)(C.ws + WS_WG) + (size_t)l * 512 * 256;
    for (int i = gt; i < 512 * 256; i += NGT) { const int n = i / 256, k = i % 256; float v = 0.f;
      if (n < 384 && k < 160) v = inp(C, 17)[((size_t)l * 160 + k) * 384 + n];
      WG[i] = f2bf(v); }
    bf16_t* WQ = (bf16_t*)(C.ws + WS_WQ) + (size_t)l * 768 * 256;
    for (int i = gt; i < 768 * 256; i += NGT) { const int n = i / 256, k = i % 256; float v = 0.f;
      if (n < 576) v = inp(C, 23)[l * 256 + k] * inp(C, 24)[((size_t)l * 256 + k) * 576 + n];
      WQ[i] = f2bf(v); }
    bf16_t* WKV = (bf16_t*)(C.ws + WS_WKV) + (size_t)l * 768 * 128;
    for (int i = gt; i < 768 * 128; i += NGT) { const int n = i / 128, k = i % 128;
      WKV[i] = f2bf(inp(C, 25)[l * 128 + k] * inp(C, 26)[((size_t)l * 128 + k) * 768 + n]); }
  }
  for (int i = gt; i < 8192; i += NGT) { float s, c; sincospif((float)i * (2.0f / 8192.0f), &s, &c); ((f32x2*)(C.ws + WS_TW))[i] = (f32x2){c, -s}; }
  for (int i = gt; i < 128 * 8; i += NGT) { const int pos = i / 8, j = i % 8; const float inv = powf(10000.0f, -(float)j / 8.0f); float s, c; sincosf((float)pos * inv, &s, &c); ((f32x2*)(C.ws + WS_ROPE))[i] = (f32x2){c, s}; }
}
DI void phase0b(const Ctx& C) {
  const int gt = C.bid * NTHREADS + C.tid, NGT = C.G * NTHREADS;
  for (int i = gt; i < 2 * 5 * 6144; i += NGT) { const int l = i / (5 * 6144), r = (i / 6144) % 5, n = i % 6144;
    float s = inp(C, 5)[l * 6144 + n];
#pragma unroll
    for (int kc = 0; kc < 8; ++kc) s += ((const float*)(C.ws + WS_MODP))[((size_t)(l * 8 + kc) * 5 + r) * 6144 + n];
    ((float*)(C.ws + WS_MOD))[i] = s; }
}

DI void convert_experts(const Ctx& C, int l) {
  LAS float* scr = (LAS float*)(C.lds + C.wave * 16384);
  bf16_t* WGU = (bf16_t*)(C.ws + WS_R3); bf16_t* WDN = WGU + (size_t)NEXP * 2048 * 1024;
  unsigned* ctr = (unsigned*)(C.ws + WS_CTL) + 64 * (8 + l);
  for (;;) { unsigned base = 0; if (C.lane == 0) base = atomicAdd(ctr, 8u); base = __builtin_amdgcn_readfirstlane(base);
    if (base >= NEXP * 3 * 512) break;
    for (int k = 0; k < 8; ++k) { const int it = base + k; const int e = it / 1536, r = it % 1536, mat = r / 512, sub = r % 512;
      const size_t woff = ((size_t)l * NEXP + e) * 1024 * 1024;
      if (mat == 0) transpose_item(inp(C, 29) + woff, 1024, 1024, WGU + (size_t)e * 2048 * 1024, 1024, scr, sub, C.lane, MapGate{0});
      else if (mat == 1) transpose_item(inp(C, 30) + woff, 1024, 1024, WGU + (size_t)e * 2048 * 1024, 1024, scr, sub, C.lane, MapGate{1});
      else transpose_item(inp(C, 31) + woff, 1024, 1024, WDN + (size_t)e * 1024 * 1024, 1024, scr, sub, C.lane, MapId()); } }
}

DI void norm_pass(const Ctx& C, int mode, int l, int lp) {
  const int gw = C.bid * NWAVES + C.wave, NGW = C.G * NWAVES, lane = C.lane;
  bf16_t* XN = (bf16_t*)(C.ws + WS_R2); const bf16_t* DOWN = (const bf16_t*)(C.ws + WS_R1); const int* SLOT = (const int*)(C.ws + WS_SLOT); const float* AFF = (const float*)(C.ws + WS_AFF);
  f32x4 vn[4]; int slotn = -1; float affn = 0.f;
#define NP_LOAD(gg) do { const f32x4* xr_ = (const f32x4*)(mode == 0 ? in_row(C, gg) : xs_row(C, gg)) + lane; _Pragma("unroll") for (int j = 0; j < 4; ++j) vn[j] = xr_[64 * j]; \
    if (mode != 0) { slotn = lane < 16 ? SLOT[(size_t)(gg) * 16 + lane] : -1; affn = lane < 16 ? AFF[(size_t)(gg) * 16 + lane] : 0.f; } } while (0)
  if (gw < TT) NP_LOAD(gw);
  for (int g = gw; g < TT; g += NGW) {
    const int mr = mod_row(g); const bool isctx = (mr == 4);
    f32x4 v[4]; const int myslot = slotn; const float myaff = affn;
#pragma unroll
    for (int j = 0; j < 4; ++j) v[j] = vn[j];
    const bool skip = (mode == 2 && isctx);
    f32x4 y[4], a5[4], g9[4], a0[4], a1[4], g6[4];
    if (!skip) {
      if (mode != 0) { const f32x4* m5 = (const f32x4*)modv(C, lp, mr, 5) + lane; const f32x4* gp = (const f32x4*)(inp(C, 9) + lp * DM) + lane;
#pragma unroll
        for (int j = 0; j < 4; ++j) { a5[j] = m5[64 * j]; g9[j] = gp[64 * j]; y[j] = (f32x4){0.f, 0.f, 0.f, 0.f}; } }
      if (mode != 2) { const f32x4* m0 = (const f32x4*)modv(C, l, mr, 0) + lane; const f32x4* m1 = (const f32x4*)modv(C, l, mr, 1) + lane; const f32x4* gp = (const f32x4*)(inp(C, 6) + l * DM) + lane;
#pragma unroll
        for (int j = 0; j < 4; ++j) { a0[j] = m0[64 * j]; a1[j] = m1[64 * j]; g6[j] = gp[64 * j]; } }
      if (mode != 0) {
        for (int e = 0; e < 16; ++e) { const int sl = __builtin_amdgcn_readlane(myslot, e);
          if (sl >= 0) { const float a = rdlane(myaff, e); const u32x2* dr = (const u32x2*)(DOWN + (size_t)sl * DM) + lane;
#pragma unroll
            for (int j = 0; j < 4; ++j) { const u32x2 w = dr[64 * j]; y[j] = y[j] + (f32x4){bflo(w.x), bfhi(w.x), bflo(w.y), bfhi(w.y)} * a; } } } }
    }
    if (g + NGW < TT) NP_LOAD(g + NGW);
    if (skip) continue;
    if (mode != 0) { f32x4* xr = (f32x4*)xs_row(C, g) + lane; float s = 0.f;
#pragma unroll
      for (int j = 0; j < 4; ++j) s += (y[j].x * y[j].x + y[j].y * y[j].y) + (y[j].z * y[j].z + y[j].w * y[j].w);
      const float rstd = rsqrtf(wave_sum(s) * (1.f / DM) + NORM_EPS);
#pragma unroll
      for (int j = 0; j < 4; ++j) { v[j] = v[j] + a5[j] * (y[j] * rstd * g9[j]); xr[64 * j] = v[j]; }
      if (mode == 2) continue; }
    float s = 0.f;
#pragma unroll
    for (int j = 0; j < 4; ++j) s += (v[j].x * v[j].x + v[j].y * v[j].y) + (v[j].z * v[j].z + v[j].w * v[j].w);
    const float rstd = rsqrtf(wave_sum(s) * (1.f / DM) + NORM_EPS);
    u32x2* o = (u32x2*)(XN + (size_t)g * DM) + lane;
#pragma unroll
    for (int j = 0; j < 4; ++j) { const f32x4 t = v[j] * rstd * g6[j] * (a1[j] + 1.0f) + a0[j]; u32x2 w; w.x = cvtpk(t.x, t.y); w.y = cvtpk(t.z, t.w); o[64 * j] = w; }
  }
#undef NP_LOAD
}

DI void prep_a(const Ctx& C, int l) {
  const bf16_t* U = (const bf16_t*)(C.ws + WS_R1);
  float* rq = (float*)(C.ws + WS_RSTD); float* rkv = rq + TT;
  bf16_t* KB = (bf16_t*)(C.ws + WS_R2) + (size_t)NB * NH * PP * 96;
  const f32x2* rope = (const f32x2*)(C.ws + WS_ROPE);
  const int lane = C.lane;
  LAS float* zrow = (LAS float*)(C.lds + C.wave * 1024);
  LAS f32x2* stage = (LAS f32x2*)(C.lds + 16384);
  LAS f32x2* tw64 = (LAS f32x2*)(C.lds + 16384 + 132 * 64 * 8);
  if (C.tid < 64) { float s, c; sincospif((float)C.tid * (2.0f / 64.0f), &s, &c); tw64[C.tid] = (f32x2){c, s}; }
  __syncthreads();
  for (int tile = C.bid; tile < TT / 64; tile += C.G) {
    const int g0 = tile * 64; const int b = g0 / PP, p0 = g0 - b * PP;
    for (int i = 0; i < 8; ++i) { const int tl = C.wave * 8 + i; const int g = g0 + tl; const int p = p0 + tl;
      const bf16_t* ur = U + (size_t)g * UW;
      { const u32x2 w = *((const u32x2*)(ur + 1536) + lane); const float a0 = bflo(w.x), a1 = bfhi(w.x), a2 = bflo(w.y), a3 = bfhi(w.y);
        const float s = wave_sum(a0 * a0 + a1 * a1 + a2 * a2 + a3 * a3); if (lane == 0) rq[g] = rsqrtf(s * (1.f / 256.f) + NORM_EPS); }
      { const unsigned w = *((const unsigned*)(ur + 1792) + lane); const float a0 = bflo(w), a1 = bfhi(w);
        const float s = wave_sum(a0 * a0 + a1 * a1); if (lane == 0) rkv[g] = rsqrtf(s * (1.f / 128.f) + NORM_EPS); }
      { float x = lane < 32 ? bf2f(ur[1920 + lane]) : 0.f; const float o = swz_xor8(x);
        if (p >= CTX && lane < 32) { const int li = p - CTX; const int pos = (lane & 16) ? (li & 63) : (li >> 6); const f32x2 cs = rope[pos * 8 + (lane & 7)];
          x = (lane & 8) ? (x * cs.x + o * cs.y) : (x * cs.x - o * cs.y); }
        if (lane < 32) { const bf16_t xb = f2bf(x);
#pragma unroll
          for (int hh = 0; hh < NH; ++hh) KB[((size_t)(b * NH + hh) * PP + p) * 96 + 64 + lane] = xb; } }
      { const u32x2 w = *((const u32x2*)(ur + 2048) + lane); *(LAS f32x4*)(zrow + lane * 4) = (f32x4){bflo(w.x), bfhi(w.x), bflo(w.y), bfhi(w.y)}; }
      asm volatile("s_waitcnt lgkmcnt(0)" ::: "memory");
      { const int grp = lane >> 4, kq = lane & 15; const LAS float* z = zrow + grp * 64;
        const float c0 = z[kq], c1 = z[kq + 16], s0 = kq == 0 ? 0.f : z[32 + kq], s1 = z[48 + kq];
        stage[(grp * 33 + kq) * 64 + tl] = (f32x2){c0, -s0}; stage[(grp * 33 + kq + 16) * 64 + tl] = (f32x2){c1, -s1};
        if (kq == 0) stage[(grp * 33 + 32) * 64 + tl] = (f32x2){z[32], 0.f}; }
      asm volatile("s_waitcnt lgkmcnt(0)" ::: "memory");
    }
    __syncthreads();
    f32x2* ZT = (f32x2*)(C.ws + WS_R4);
    for (int i = C.tid; i < 132 * 64; i += NTHREADS) { const int r = i >> 6, t = i & 63; ZT[((size_t)b * 132 + r) * PP + p0 + t] = stage[i]; }
    __syncthreads();
  }
}

DI void post_pass(const Ctx& C, int l, bool with_ctx) {
  const int gw = C.bid * NWAVES + C.wave, NGW = C.G * NWAVES, lane = C.lane;
  const bf16_t* U = (const bf16_t*)(C.ws + WS_R1);
  const bf16_t* AS = (const bf16_t*)(C.ws + WS_R3) + (size_t)TT * 768; const bf16_t* Gt = AS + (size_t)TT * 768;
  const bf16_t* Y0 = (const bf16_t*)(C.ws + WS_R5); const bf16_t* Y1 = Y0 + (size_t)TT * 384;
  bf16_t* MC = (bf16_t*)(C.ws + WS_R6);
  const float* cw = inp(C, 12) + (size_t)l * 3 * 1152; const float* k_a = inp(C, 19) + l * 384; const float* r_k = inp(C, 20) + l * 384;
  const float* lw = inp(C, 21) + l * 384; const float* lb = inp(C, 22) + l * 384;
  for (int g = gw; g < TT; g += NGW) {
    const int b = g / PP, p = g - b * PP; if (p < CTX && !with_ctx) continue;
    const float ml = (p != 0 && p != CTX) ? 1.f : 0.f, mr = (p != CTX - 1 && p != PP - 1) ? 1.f : 0.f;
    const bf16_t* u0 = U + (size_t)g * UW; const bf16_t* ul = ml != 0.f ? u0 - UW : u0; const bf16_t* ur_ = mr != 0.f ? u0 + UW : u0;
    unsigned short xu[6][3][3], y0[6], y1[6], a0[6], a1[6], gg[6];
#pragma unroll
    for (int hh = 0; hh < NH; ++hh) { const int c = hh * 64 + lane;
#pragma unroll
      for (int q = 0; q < 3; ++q) { xu[hh][q][0] = ul[q * 384 + c]; xu[hh][q][1] = u0[q * 384 + c]; xu[hh][q][2] = ur_[q * 384 + c]; }
      y0[hh] = Y0[(size_t)g * 384 + c]; y1[hh] = Y1[(size_t)g * 384 + c]; a0[hh] = AS[(size_t)g * 768 + c]; a1[hh] = AS[(size_t)g * 768 + 384 + c]; gg[hh] = Gt[(size_t)g * 384 + c]; }
#pragma unroll
    for (int hh = 0; hh < NH; ++hh) { const int c = hh * 64 + lane;
      float rkv[3];
#pragma unroll
      for (int q = 0; q < 3; ++q) { const int col = q * 384 + c; rkv[q] = bf2f(xu[hh][q][1]) * cw[1152 + col] + ml * bf2f(xu[hh][q][0]) * cw[col] + mr * bf2f(xu[hh][q][2]) * cw[2 * 1152 + col]; }
      const float y = bf2f(y0[hh]) + bf2f(y1[hh]);
      const float mu = wave_sum(y) * (1.f / 64.f); const float dv = y - mu; const float var = wave_sum(dv * dv) * (1.f / 64.f);
      const float yn = dv * rsqrtf(var + GN_EPS) * lw[c] + lb[c];
      const float al0 = bf2f(a0[hh]), al1 = bf2f(a1[hh]); const float ka = k_a[c];
      const float kd0 = rkv[1] * (1.f + (al0 - 1.f) * ka), kd1 = rkv[1] * (1.f + (al1 - 1.f) * ka);
      const float bonus = wave_sum(rkv[0] * (kd0 + kd1) * r_k[c]);
      const float o = (yn + bonus * rkv[2]) * bf2f(gg[hh]);
      MC[(size_t)g * DM + c] = f2bf(o); }
  }
}

DI void n2_pass(const Ctx& C, int l, bool with_ctx) {
  const int gw = C.bid * NWAVES + C.wave, NGW = C.G * NWAVES, lane = C.lane;
  const bf16_t* O = (const bf16_t*)(C.ws + WS_R1); bf16_t* TN = (bf16_t*)(C.ws + WS_R2); float* AFF = (float*)(C.ws + WS_AFF); int* SLOT = (int*)(C.ws + WS_SLOT);
  LAS float* wr = (LAS float*)C.lds; const float* wrg = inp(C, 28) + (size_t)l * DM * NEXP;
  for (int i = C.tid; i < DM * NEXP; i += NTHREADS) wr[(i & 15) * DM + (i >> 4)] = wrg[i];
  __syncthreads();
  f32x4 vn[4]; u32x2 on[4];
#define N2_LOAD(gg) do { const f32x4* xr_ = (const f32x4*)(l == 0 ? in_row(C, gg) : xs_row(C, gg)) + lane; const u32x2* or_ = (const u32x2*)(O + (size_t)(gg) * DM) + lane; \
    _Pragma("unroll") for (int j = 0; j < 4; ++j) { vn[j] = xr_[64 * j]; on[j] = or_[64 * j]; } } while (0)
  if (gw < TT) N2_LOAD(gw);
  for (int g = gw; g < TT; g += NGW) {
    const int mr = mod_row(g);
    f32x4 v[4], o[4]; float s = 0.f;
#pragma unroll
    for (int j = 0; j < 4; ++j) { v[j] = vn[j]; const u32x2 w = on[j]; o[j] = (f32x4){bflo(w.x), bfhi(w.x), bflo(w.y), bfhi(w.y)};
      s += (o[j].x * o[j].x + o[j].y * o[j].y) + (o[j].z * o[j].z + o[j].w * o[j].w); }
    const bool skip = (mr == 4 && !with_ctx);
    f32x4 a2[4], g7[4], a3[4], a4[4], g8[4];
    if (!skip) { const f32x4* m2 = (const f32x4*)modv(C, l, mr, 2) + lane; const f32x4* gp = (const f32x4*)(inp(C, 7) + l * DM) + lane;
      const f32x4* m3 = (const f32x4*)modv(C, l, mr, 3) + lane; const f32x4* m4 = (const f32x4*)modv(C, l, mr, 4) + lane; const f32x4* gq = (const f32x4*)(inp(C, 8) + l * DM) + lane;
#pragma unroll
      for (int j = 0; j < 4; ++j) { a2[j] = m2[64 * j]; g7[j] = gp[64 * j]; a3[j] = m3[64 * j]; a4[j] = m4[64 * j]; g8[j] = gq[64 * j]; } }
    if (g + NGW < TT) N2_LOAD(g + NGW);
    if (skip) continue;
    float rstd = rsqrtf(wave_sum(s) * (1.f / DM) + NORM_EPS);
    { f32x4* xo = (f32x4*)xs_row(C, g) + lane;
      s = 0.f;
#pragma unroll
      for (int j = 0; j < 4; ++j) { v[j] = v[j] + a2[j] * (o[j] * rstd * g7[j]); xo[64 * j] = v[j]; s += (v[j].x * v[j].x + v[j].y * v[j].y) + (v[j].z * v[j].z + v[j].w * v[j].w); } }
    rstd = rsqrtf(wave_sum(s) * (1.f / DM) + NORM_EPS);
    u32x2* to = (u32x2*)(TN + (size_t)g * DM) + lane;
    float lg[16];
#pragma unroll
    for (int e = 0; e < 16; ++e) lg[e] = 0.f;
#pragma unroll
    for (int j = 0; j < 4; ++j) { const f32x4 t = v[j] * rstd * g8[j] * (a4[j] + 1.0f) + a3[j]; u32x2 w; w.x = cvtpk(t.x, t.y); w.y = cvtpk(t.z, t.w); to[64 * j] = w;
#pragma unroll
      for (int e = 0; e < 16; ++e) { const f32x4 ww = *(const LAS f32x4*)(wr + e * DM + 256 * j + 4 * lane); lg[e] += (t.x * ww.x + t.y * ww.y) + (t.z * ww.z + t.w * ww.w); if ((e & 3) == 3) asm volatile("" ::: "memory"); } }
    float mx = -1e30f;
#pragma unroll
    for (int e = 0; e < 16; ++e) { lg[e] = wave_sum(lg[e]); mx = fmaxf(mx, lg[e]); }
    float den = 0.f;
#pragma unroll
    for (int e = 0; e < 16; ++e) { lg[e] = __expf(lg[e] - mx); den += lg[e]; }
    const float inv = 1.f / den;
    float mine = 0.f;
#pragma unroll
    for (int e = 0; e < 16; ++e) mine = (lane == e) ? lg[e] * inv : mine;
    if (lane < 16) { AFF[(size_t)g * 16 + lane] = mine; SLOT[(size_t)g * 16 + lane] = -1; }
  }
#undef N2_LOAD
  __syncthreads();
}

DI void topk_problem(const Ctx& C, int q) {
  const bool isctx = q >= 64; const int qq = q & 63, b = qq >> 4, e = qq & 15;
  const int n = isctx ? CTX : SEQ, cap = isctx ? 32 : 1024; const int g0 = b * PP + (isctx ? 0 : CTX);
  const float* AFF = (const float*)(C.ws + WS_AFF);
  int* IDX = (int*)(C.ws + WS_IDX); int* SLOT = (int*)(C.ws + WS_SLOT);
  const int obase = e * RPE + (isctx ? 4096 + b * 32 : b * 1024);
  LAS unsigned* keys = (LAS unsigned*)C.lds; LAS unsigned* hist = keys + 8192; LAS unsigned* ctl = hist + 256;
  for (int i = C.tid; i < n; i += NTHREADS) keys[i] = __float_as_uint(AFF[(size_t)(g0 + i) * 16 + e]);
  if (C.tid == 0) { ctl[0] = 0u; ctl[1] = (unsigned)cap; ctl[2] = 0u; ctl[3] = 0u; }
  unsigned mask = 0u;
  for (int pass = 0; pass < 4; ++pass) { const int shift = 24 - 8 * pass;
    if (C.tid < 256) hist[C.tid] = 0u;
    __syncthreads();
    const unsigned prefix = ctl[0];
    for (int i = C.tid; i < n; i += NTHREADS) { const unsigned k = keys[i]; if ((k & mask) == prefix) atomicAdd((unsigned*)&hist[(k >> shift) & 255u], 1u); }
    __syncthreads();
    if (C.tid < 256) { const unsigned rem = ctl[1]; unsigned sfx = 0u;
      for (int b2 = 255; b2 >= C.tid; --b2) sfx += hist[b2];
      const unsigned nxt = sfx - hist[C.tid];
      if (sfx >= rem && nxt < rem) { ctl[0] = prefix | ((unsigned)C.tid << shift); ctl[1] = rem - nxt; } }
    mask |= 255u << shift;
    __syncthreads();
  }
  const unsigned thr = ctl[0], need_eq = ctl[1];
  for (int i = C.tid; i < n; i += NTHREADS) { const unsigned k = keys[i];
    int slot = -1;
    if (k > thr) slot = (int)atomicAdd((unsigned*)&ctl[2], 1u);
    else if (k == thr) { const unsigned t = atomicAdd((unsigned*)&ctl[3], 1u); if (t < need_eq) slot = cap - (int)need_eq + (int)t; }
    if (slot >= 0) { IDX[obase + slot] = g0 + i; SLOT[(size_t)(g0 + i) * 16 + e] = obase + slot; } }
  __syncthreads();
}
#define MFMA32(a, b, c) __builtin_amdgcn_mfma_f32_32x32x16_bf16((a), (b), (c), 0, 0, 0)
constexpr int AT_KROW = 208, AT_VROW = 144, AT_KBUF = 64 * AT_KROW, AT_VBUF = 64 * AT_VROW;
constexpr int AT_K0 = 0, AT_V0 = 2 * AT_KBUF, AT_OST = AT_V0 + 2 * AT_VBUF, AT_OROW = 144;
constexpr float AT_THR = 8.0f;
DI float max3f(float a, float b, float c) { float r; asm("v_max3_f32 %0, %1, %2, %3" : "=v"(r) : "v"(a), "v"(b), "v"(c)); return r; }

DI void attn_unit(const Ctx& C, int b, int h, int pq0, int nkt) {
  const bf16_t* QB = (const bf16_t*)(C.ws + WS_R2); const bf16_t* KBp = QB + (size_t)NB * NH * PP * 96; const bf16_t* VTp = KBp + (size_t)NB * NH * PP * 96;
  const bf16_t* Qh = QB + (size_t)(b * NH + h) * PP * 96; const bf16_t* Kh = KBp + (size_t)(b * NH + h) * PP * 96; const bf16_t* Vh = VTp + (size_t)(b * NH + h) * 64 * PP;
  bf16_t* MC = (bf16_t*)(C.ws + WS_R6);
  const int tid = C.tid, lane = C.lane, wave = C.wave, r32 = lane & 31, hi = lane >> 5;
  LAS unsigned char* lds = C.lds;
  bf16x8 qf[6];
  { const bf16_t* qrow = Qh + (size_t)(pq0 + wave * 32 + r32) * 96 + hi * 8;
#pragma unroll
    for (int d0 = 0; d0 < 6; ++d0) qf[d0] = *(const bf16x8*)(qrow + d0 * 16); }
  const int k0row = tid / 12, k0c = tid % 12, k1row = (tid + 512) / 12, k1c = (tid + 512) % 12;
  const unsigned k0dst = k0row * AT_KROW + k0c * 16, k1dst = k1row * AT_KROW + k1c * 16, vdst = (tid >> 3) * AT_VROW + (tid & 7) * 16;
  const bf16_t* vsrc = Vh + (size_t)(tid >> 3) * PP + (tid & 7) * 8;
  u32x4 sk0, sk1 = (u32x4){0u, 0u, 0u, 0u}, sv;
#define AT_LOAD(kt) do { const char* kb_ = (const char*)(Kh + (size_t)(kt) * 64 * 96); sk0 = *(const u32x4*)(kb_ + tid * 16); if (tid < 256) sk1 = *(const u32x4*)(kb_ + (tid + 512) * 16); sv = *(const u32x4*)(vsrc + (kt) * 64); } while (0)
#define AT_STORE(buf) do { *(LAS u32x4*)(lds + AT_K0 + (buf) * AT_KBUF + k0dst) = sk0; if (tid < 256) *(LAS u32x4*)(lds + AT_K0 + (buf) * AT_KBUF + k1dst) = sk1; *(LAS u32x4*)(lds + AT_V0 + (buf) * AT_VBUF + vdst) = sv; } while (0)
  AT_LOAD(0); AT_STORE(0);
  __syncthreads();
  f32x16 negm, o0, o1;
#pragma unroll
  for (int i = 0; i < 16; ++i) { negm[i] = 0.f; o0[i] = 0.f; o1[i] = 0.f; }
  float mhat = 0.f, lsum = 0.f;
  for (int kt = 0; kt < nkt; ++kt) {
    const int buf = kt & 1;
    if (kt + 1 < nkt) AT_LOAD(kt + 1);
    const LAS unsigned char* kb = lds + AT_K0 + buf * AT_KBUF + r32 * AT_KROW + hi * 16;
    const LAS unsigned char* vb = lds + AT_V0 + buf * AT_VBUF + r32 * AT_VROW + hi * 16;
    f32x16 p0, p1;
    bf16x8 kf[12];
#pragma unroll
    for (int d0 = 0; d0 < 6; ++d0) { kf[2 * d0] = *(const LAS bf16x8*)(kb + d0 * 32); kf[2 * d0 + 1] = *(const LAS bf16x8*)(kb + 32 * AT_KROW + d0 * 32); }
#pragma unroll
    for (int d0 = 0; d0 < 6; ++d0) {
      if (d0 == 0) { p0 = MFMA32(kf[0], qf[0], negm); p1 = MFMA32(kf[1], qf[0], negm); } else { p0 = MFMA32(kf[2 * d0], qf[d0], p0); p1 = MFMA32(kf[2 * d0 + 1], qf[d0], p1); } }
    bf16x8 vf[8];
#pragma unroll
    for (int s_ = 0; s_ < 4; ++s_) { vf[2 * s_] = *(const LAS bf16x8*)(vb + s_ * 32); vf[2 * s_ + 1] = *(const LAS bf16x8*)(vb + 32 * AT_VROW + s_ * 32); }
    asm volatile("s_nop 15\n\ts_nop 7" : "+v"(p0), "+v"(p1));
    float rm;
    { float a_ = max3f(p0[0], p0[1], p1[0]), b_ = max3f(p0[2], p0[3], p1[1]); a_ = max3f(a_, p1[2], p1[3]);
#pragma unroll
      for (int r = 4; r < 16; r += 4) { a_ = max3f(a_, p0[r], p0[r + 1]); b_ = max3f(b_, p0[r + 2], p0[r + 3]); a_ = max3f(a_, p1[r], p1[r + 1]); b_ = max3f(b_, p1[r + 2], p1[r + 3]); }
      rm = max3f(a_, b_, b_); }
    rm = half_max(rm);
    if (kt == 0 || __any(rm > AT_THR)) {
      const float dl = (kt == 0) ? rm : fmaxf(rm, 0.f);
      mhat += dl; const float f = (kt == 0) ? 1.f : __builtin_amdgcn_exp2f(-dl); lsum *= f;
#pragma unroll
      for (int i = 0; i < 16; ++i) { p0[i] -= dl; p1[i] -= dl; o0[i] *= f; o1[i] *= f; negm[i] = -mhat; }
    }
    float ps = 0.f;
#pragma unroll
    for (int i = 0; i < 16; ++i) { p0[i] = __builtin_amdgcn_exp2f(p0[i]); p1[i] = __builtin_amdgcn_exp2f(p1[i]); ps += p0[i] + p1[i]; }
    lsum += ps;
    u32x4 w0, w1, w2, w3;
    w0 = (u32x4){cvtpk(p0[0], p0[1]), cvtpk(p0[2], p0[3]), cvtpk(p0[4], p0[5]), cvtpk(p0[6], p0[7])};
    w1 = (u32x4){cvtpk(p0[8], p0[9]), cvtpk(p0[10], p0[11]), cvtpk(p0[12], p0[13]), cvtpk(p0[14], p0[15])};
    w2 = (u32x4){cvtpk(p1[0], p1[1]), cvtpk(p1[2], p1[3]), cvtpk(p1[4], p1[5]), cvtpk(p1[6], p1[7])};
    w3 = (u32x4){cvtpk(p1[8], p1[9]), cvtpk(p1[10], p1[11]), cvtpk(p1[12], p1[13]), cvtpk(p1[14], p1[15])};
    const bf16x8 pf0 = __builtin_bit_cast(bf16x8, w0), pf1 = __builtin_bit_cast(bf16x8, w1), pf2 = __builtin_bit_cast(bf16x8, w2), pf3 = __builtin_bit_cast(bf16x8, w3);
#define AT_PV(s, pf) do { o0 = MFMA32(vf[2 * (s)], pf, o0); o1 = MFMA32(vf[2 * (s) + 1], pf, o1); } while (0)
    AT_PV(0, pf0); AT_PV(1, pf1); AT_PV(2, pf2); AT_PV(3, pf3);
#undef AT_PV
    if (kt + 1 < nkt) AT_STORE(buf ^ 1);
    __syncthreads();
  }
#undef AT_LOAD
#undef AT_STORE
  lsum = half_sum(lsum);
  const float inv = 1.f / lsum;
  LAS bf16_t* stg = (LAS bf16_t*)(lds + AT_OST + wave * 32 * AT_OROW);
#pragma unroll
  for (int i = 0; i < 16; ++i) { const int d = (i & 3) + 8 * (i >> 2) + 4 * hi;
    stg[r32 * (AT_OROW / 2) + d] = f2bf(o0[i] * inv); stg[r32 * (AT_OROW / 2) + 32 + d] = f2bf(o1[i] * inv); }
  asm volatile("s_waitcnt lgkmcnt(0)" ::: "memory");
#pragma unroll
  for (int i = 0; i < 4; ++i) { const int piece = i * 64 + lane, row = piece >> 3, c = piece & 7;
    const u32x4 v = *(const LAS u32x4*)((const LAS unsigned char*)stg + row * AT_OROW + c * 16);
    *(u32x4*)(MC + (size_t)(b * PP + pq0 + wave * 32 + row) * DM + 384 + h * 64 + c * 8) = v; }
  __syncthreads();
}

constexpr int SC_CH = 32;
DI int scan_pos(int s, int d) { return d == 0 ? s : (s < CTX ? CTX - 1 - s : (PP - 1) - (s - CTX)); }
DI void scan_unit(const Ctx& C, int l, int unit) {
  const int chain = unit >> 1, half = unit & 1;
  const int b = chain / 12, h = (chain >> 1) % 6, d = chain & 1;
  const bf16_t* U = (const bf16_t*)(C.ws + WS_R1);
  const bf16_t* EW = (const bf16_t*)(C.ws + WS_R3); const bf16_t* AS = EW + (size_t)TT * 768;
  bf16_t* Y = (bf16_t*)(C.ws + WS_R5) + (size_t)d * TT * 384;
  const float* cw = inp(C, 12) + (size_t)l * 3 * 1152; const float* k_k = inp(C, 18) + l * 384; const float* k_a = inp(C, 19) + l * 384;
  const int lane = C.lane, wave = C.wave;
  LAS float* opsb = (LAS float*)C.lds;
  LAS float* ybuf = opsb + 2 * SC_CH * 384;
  constexpr int NCH = PP / SC_CH;
  if (wave >= 4) {
    const int pw = wave - 4;
    const int c = h * 64 + lane;
    const float cwr0 = cw[c], cwr1 = cw[1152 + c], cwr2 = cw[2304 + c];
    const float cwk0 = cw[384 + c], cwk1 = cw[1152 + 384 + c], cwk2 = cw[2304 + 384 + c];
    const float cwv0 = cw[768 + c], cwv1 = cw[1152 + 768 + c], cwv2 = cw[2304 + 768 + c];
    const float kkc = k_k[c], kac = k_a[c];
    for (int chunk = -1; chunk < NCH; ++chunk) {
      if (chunk >= 1) { const int cb = (chunk - 1) & 1;
#pragma unroll
        for (int i = 0; i < 4; ++i) { const int sl = pw * 8 + 2 * i + (lane >> 5), rw = lane & 31; const int p = scan_pos((chunk - 1) * SC_CH + sl, d);
          Y[(size_t)(b * PP + p) * 384 + h * 64 + half * 32 + rw] = f2bf(ybuf[(cb * SC_CH + sl) * 32 + rw]); } }
      if (chunk + 1 < NCH) { const int nb = (chunk + 1) & 1; const int s0 = (chunk + 1) * SC_CH;
#pragma unroll
        for (int hf = 0; hf < 2; ++hf) {
          unsigned short ur[4][3], uk[4][3], uv[4][3], uew[4], uas[4]; float ml[4], mr[4];
#pragma unroll
          for (int i = 0; i < 4; ++i) { const int sl = pw * 8 + hf * 4 + i; const int p = scan_pos(s0 + sl, d); const int g = b * PP + p;
            const bool hasl = (p != 0 && p != CTX), hasr = (p != CTX - 1 && p != PP - 1);
            ml[i] = hasl ? 1.f : 0.f; mr[i] = hasr ? 1.f : 0.f;
            const bf16_t* u0 = U + (size_t)g * UW + c; const bf16_t* ul = hasl ? u0 - UW : u0; const bf16_t* urr = hasr ? u0 + UW : u0;
            ur[i][0] = ul[0]; ur[i][1] = u0[0]; ur[i][2] = urr[0];
            uk[i][0] = ul[384]; uk[i][1] = u0[384]; uk[i][2] = urr[384];
            uv[i][0] = ul[768]; uv[i][1] = u0[768]; uv[i][2] = urr[768];
            uew[i] = EW[(size_t)g * 768 + d * 384 + c]; uas[i] = AS[(size_t)g * 768 + d * 384 + c]; }
#pragma unroll
          for (int i = 0; i < 4; ++i) { const int sl = pw * 8 + hf * 4 + i;
            const float r = bf2f(ur[i][1]) * cwr1 + ml[i] * bf2f(ur[i][0]) * cwr0 + mr[i] * bf2f(ur[i][2]) * cwr2;
            const float k = bf2f(uk[i][1]) * cwk1 + ml[i] * bf2f(uk[i][0]) * cwk0 + mr[i] * bf2f(uk[i][2]) * cwk2;
            const float v = bf2f(uv[i][1]) * cwv1 + ml[i] * bf2f(uv[i][0]) * cwv0 + mr[i] * bf2f(uv[i][2]) * cwv2;
            const float kr = k * kkc; const float nrm = sqrtf(wave_sum(kr * kr)); const float kk = kr / fmaxf(nrm, 1e-12f);
            const float ew = bf2f(uew[i]), a = bf2f(uas[i]);
            const float w = __expf(-ew); const float kd = k * (1.f + (a - 1.f) * kac);
            LAS float* o = opsb + (nb * SC_CH + sl) * 384 + lane;
            o[0] = r; o[64] = w; o[128] = kd; o[192] = v; o[256] = -kk; o[320] = kk * a; }
        } }
      __syncthreads();
    }
    { const int cb = (NCH - 1) & 1;
#pragma unroll
      for (int i = 0; i < 4; ++i) { const int sl = pw * 8 + 2 * i + (lane >> 5), rw = lane & 31; const int p = scan_pos((NCH - 1) * SC_CH + sl, d);
        Y[(size_t)(b * PP + p) * 384 + h * 64 + half * 32 + rw] = f2bf(ybuf[(cb * SC_CH + sl) * 32 + rw]); } }
  } else {
    const int rowl = wave * 8 + (lane >> 3), cg = lane & 7;
    const int vrow = half * 32 + rowl;
    f32x2 S[4];
#pragma unroll
    for (int j = 0; j < 4; ++j) S[j] = (f32x2){0.f, 0.f};
    __syncthreads();
    for (int chunk = 0; chunk < NCH; ++chunk) {
      const LAS float* ob = opsb + (chunk & 1) * SC_CH * 384;
      LAS float* yb = ybuf + (chunk & 1) * SC_CH * 32;
#define SC_LOADOPS(R0, R1, W0, W1, K0, K1, A0, A1, B0, B1, VV, slx) do { const LAS float* o_ = ob + (slx) * 384 + cg * 8; \
        R0 = *(const LAS f32x4*)(o_); R1 = *(const LAS f32x4*)(o_ + 4); W0 = *(const LAS f32x4*)(o_ + 64); W1 = *(const LAS f32x4*)(o_ + 68); \
        K0 = *(const LAS f32x4*)(o_ + 128); K1 = *(const LAS f32x4*)(o_ + 132); A0 = *(const LAS f32x4*)(o_ + 256); A1 = *(const LAS f32x4*)(o_ + 260); \
        B0 = *(const LAS f32x4*)(o_ + 320); B1 = *(const LAS f32x4*)(o_ + 324); VV = ob[(slx) * 384 + 192 + vrow]; } while (0)
#define SC_STEP(r0, r1, w0, w1, k0, k1, a0, a1, b0, b1, vv, YOUT) do { \
        f32x2 t = S[0] * (f32x2){a0.x, a0.y} + S[1] * (f32x2){a0.z, a0.w}; t = t + S[2] * (f32x2){a1.x, a1.y}; t = t + S[3] * (f32x2){a1.z, a1.w}; \
        float sa = t.x + t.y; \
        sa = dpp_add<0xB1>(sa); sa = dpp_add<0x4E>(sa); sa = dpp_add<0x141>(sa); \
        const f32x2 sa2 = (f32x2){sa, sa}, vv2 = (f32x2){vv, vv}; \
        S[0] = S[0] * (f32x2){w0.x, w0.y} + (sa2 * (f32x2){b0.x, b0.y} + vv2 * (f32x2){k0.x, k0.y}); \
        S[1] = S[1] * (f32x2){w0.z, w0.w} + (sa2 * (f32x2){b0.z, b0.w} + vv2 * (f32x2){k0.z, k0.w}); \
        S[2] = S[2] * (f32x2){w1.x, w1.y} + (sa2 * (f32x2){b1.x, b1.y} + vv2 * (f32x2){k1.x, k1.y}); \
        S[3] = S[3] * (f32x2){w1.z, w1.w} + (sa2 * (f32x2){b1.z, b1.w} + vv2 * (f32x2){k1.z, k1.w}); \
        f32x2 yy = S[0] * (f32x2){r0.x, r0.y} + S[1] * (f32x2){r0.z, r0.w}; yy = yy + S[2] * (f32x2){r1.x, r1.y}; yy = yy + S[3] * (f32x2){r1.z, r1.w}; \
        float y = yy.x + yy.y; \
        y = dpp_add<0xB1>(y); y = dpp_add<0x4E>(y); y = dpp_add<0x141>(y); YOUT = y; } while (0)
      f32x4 pr0, pr1, pw0, pw1, pk0, pk1, pa0, pa1, pb0, pb1; float pv;
      f32x4 qr0, qr1, qw0, qw1, qk0, qk1, qa0, qa1, qb0, qb1; float qv;
      SC_LOADOPS(pr0, pr1, pw0, pw1, pk0, pk1, pa0, pa1, pb0, pb1, pv, 0);
#pragma unroll 1
      for (int sg = 0; sg < SC_CH / 8; ++sg) {
        float ykeep = 0.f;
#pragma unroll
        for (int j = 0; j < 8; j += 2) { const int sl = sg * 8 + j; float y0, y1;
          SC_LOADOPS(qr0, qr1, qw0, qw1, qk0, qk1, qa0, qa1, qb0, qb1, qv, sl + 1);
          SC_STEP(pr0, pr1, pw0, pw1, pk0, pk1, pa0, pa1, pb0, pb1, pv, y0);
          SC_LOADOPS(pr0, pr1, pw0, pw1, pk0, pk1, pa0, pa1, pb0, pb1, pv, (sl + 2) & (SC_CH - 1));
          SC_STEP(qr0, qr1, qw0, qw1, qk0, qk1, qa0, qa1, qb0, qb1, qv, y1);
          ykeep = (cg == j) ? y0 : ykeep; ykeep = (cg == j + 1) ? y1 : ykeep; }
        yb[(sg * 8 + cg) * 32 + rowl] = ykeep;
      }
#undef SC_LOADOPS
#undef SC_STEP
      __syncthreads();
    }
  }
  __syncthreads();
}

DI void fft_unit(const Ctx& C, int seq, bool isctx) {
  const int N = isctx ? CTX : SEQ, logN = isctx ? 8 : 13, off = isctx ? 0 : CTX;
  const f32x2* src = (const f32x2*)(C.ws + WS_R4) + (size_t)seq * PP + off;
  const f32x2* TW = (const f32x2*)(C.ws + WS_TW);
  bf16_t* MC = (bf16_t*)(C.ws + WS_R6);
  LAS f32x2* x = (LAS f32x2*)C.lds;
  const int tid = C.tid;
  for (int i = tid; i < N; i += NTHREADS) x[i] = src[i];
  __syncthreads();
  const int twmul = SEQ / N;
  for (int s = 0; s < logN; ++s) { const int hb = logN - 1 - s, hh = 1 << hb;
    for (int j = tid; j < N / 2; j += NTHREADS) { const int blk = j >> hb, i = j & (hh - 1); const int i0 = (blk << (hb + 1)) + i, i1 = i0 + hh;
      const f32x2 a = x[i0], bb = x[i1]; const f32x2 tw = TW[(i << s) * twmul];
      const float dr = a.x - bb.x, di = a.y - bb.y;
      x[i0] = (f32x2){a.x + bb.x, a.y + bb.y}; x[i1] = (f32x2){dr * tw.x - di * tw.y, dr * tw.y + di * tw.x}; }
    __syncthreads(); }
  const float scale = rsqrtf(64.0f * (float)N);
  const int b = seq / 132, grp = (seq / 33) & 3, k2 = seq % 33;
  for (int pi = tid; pi < N; pi += NTHREADS) { const int k1 = (int)(__brev((unsigned)pi) >> (32 - logN));
    const bf16_t val = f2bf(x[pi].x * scale);
    MC[(size_t)(b * PP + off + k1) * DM + 768 + grp * 64 + k2] = val;
    if (k2 >= 1 && k2 <= 31) MC[(size_t)(b * PP + off + ((N - k1) & (N - 1))) * DM + 768 + grp * 64 + 64 - k2] = val; }
  __syncthreads();
}

constexpr int CK_ROW = 144, CK_SLOT = 64 * CK_ROW;
DI void ck_mma(f32x16& acc, const LAS unsigned char* A, int arow0, const LAS unsigned char* B, int brow0, int r32, int hi) {
  const LAS unsigned char* ap = A + (arow0 + r32) * CK_ROW + hi * 16; const LAS unsigned char* bp = B + (brow0 + r32) * CK_ROW + hi * 16;
#pragma unroll
  for (int kk = 0; kk < 4; ++kk) acc = MFMA32(*(const LAS bf16x8*)(ap + kk * 32), *(const LAS bf16x8*)(bp + kk * 32), acc);
}
DI void ck_store(const f32x16& acc, LAS unsigned char* Out, int arow0, int brow0, int r32, int hi) {
  LAS unsigned char* op = Out + (brow0 + r32) * CK_ROW + (arow0 + 4 * hi) * 2;
#pragma unroll
  for (int g = 0; g < 4; ++g) { u32x2 w; w.x = cvtpk(acc[4 * g], acc[4 * g + 1]); w.y = cvtpk(acc[4 * g + 2], acc[4 * g + 3]); *(LAS u32x2*)(op + g * 16) = w; }
}
#ifdef PROF_SEL
#define PROF_T0(k) unsigned long long pt0_##k = 0; if (PROF_SEL == (k)) pt0_##k = __builtin_amdgcn_s_memrealtime();
#define PROF_T1(k) if (PROF_SEL == (k) && chain == 0 && l == 0 && C.tid == PROF_TID) atomicAdd((unsigned*)(C.ws + WS_CTL) + 1024, (unsigned)(__builtin_amdgcn_s_memrealtime() - pt0_##k));
#else
#define PROF_T0(k)
#define PROF_T1(k)
#endif
#ifndef PROF_TID
#define PROF_TID 0
#endif
DI void scan_chain(const Ctx& C, int l, int chain) {
  PROF_T0(1)
  const int b = chain / 12, h = (chain >> 1) % 6, d = chain & 1;
  const bf16_t* U = (const bf16_t*)(C.ws + WS_R1);
  const bf16_t* EW = (const bf16_t*)(C.ws + WS_R3); const bf16_t* AS = EW + (size_t)TT * 768;
  bf16_t* Y = (bf16_t*)(C.ws + WS_R5) + (size_t)d * TT * 384;
  const float* cw = inp(C, 12) + (size_t)l * 3 * 1152; const float* k_k = inp(C, 18) + l * 384; const float* k_a = inp(C, 19) + l * 384;
  const int lane = C.lane, wave = C.wave, r32 = lane & 31, hi = lane >> 5;
  LAS unsigned char* L = C.lds;
#define SLOT(n) (L + (n) * CK_SLOT)
  LAS unsigned char* const sAT = SLOT(0); LAS unsigned char* const sRT = SLOT(1); LAS unsigned char* const sBT = SLOT(2); LAS unsigned char* const sKT = SLOT(3);
  LAS unsigned char* const sVT = SLOT(4); LAS unsigned char* const sBH = SLOT(5); LAS unsigned char* const sKH = SLOT(6); LAS unsigned char* const sSB = SLOT(7);
  LAS unsigned char* const sP0 = SLOT(8); LAS unsigned char* const sP0T = SLOT(9); LAS unsigned char* const sAAK = SLOT(10); LAS unsigned char* const sARB = SLOT(11);
  LAS unsigned char* const sARK = SLOT(12); LAS unsigned char* const sXa = SLOT(13); LAS unsigned char* const sXb = SLOT(14);
  LAS float* gamC = (LAS float*)SLOT(15); LAS float* wtot = gamC + 64;
  const int t4 = wave & 3, arow0 = (t4 >> 1) * 32, brow0 = (t4 & 1) * 32;
  const int hw = lane >> 5, q2 = (lane & 31) * 2, c0 = h * 64 + q2;
#define LD2(p_, o_) ((f32x2){(p_)[o_], (p_)[(o_) + 1]})
  const f32x2 cwr0 = LD2(cw, c0), cwr1 = LD2(cw, 1152 + c0), cwr2 = LD2(cw, 2304 + c0);
  const f32x2 cwk0 = LD2(cw, 384 + c0), cwk1 = LD2(cw, 1152 + 384 + c0), cwk2 = LD2(cw, 2304 + 384 + c0);
  const f32x2 cwv0 = LD2(cw, 768 + c0), cwv1 = LD2(cw, 1152 + 768 + c0), cwv2 = LD2(cw, 2304 + 768 + c0);
  const f32x2 kkc = LD2(k_k, c0), kac = LD2(k_a, c0);
#undef LD2
#define UNP(u_) ((f32x2){bflo(u_), bfhi(u_)})
  f32x16 xacc, sacc;
#pragma unroll
  for (int i = 0; i < 16; ++i) { xacc[i] = 0.f; sacc[i] = 0.f; }
  unsigned pr[6], pk[6], pv[6], pew[4], pas[4];
#define CK_PREFETCH(ci) do { const int p0w_ = scan_pos((ci) * 64 + wave * 8, d); const int sg_ = d == 0 ? 1 : -1; const int lo_ = p0w_ < CTX ? 0 : CTX, hi_ = p0w_ < CTX ? CTX - 1 : PP - 1; \
    const int p0h_ = p0w_ + sg_ * 4 * hw; \
    _Pragma("unroll") for (int q = 0; q < 6; ++q) { int pp_ = p0h_ + sg_ * (q - 1); pp_ = pp_ < lo_ ? lo_ : (pp_ > hi_ ? hi_ : pp_); const bf16_t* u_ = U + ((size_t)(b * PP + pp_) * UW + c0); \
      pr[q] = *(const unsigned*)(u_); pk[q] = *(const unsigned*)(u_ + 384); pv[q] = *(const unsigned*)(u_ + 768); } \
    _Pragma("unroll") for (int j = 0; j < 4; ++j) { const int pj_ = p0h_ + sg_ * j; const size_t o_ = (size_t)(b * PP + pj_) * 768 + d * 384 + c0; pew[j] = *(const unsigned*)(EW + o_); pas[j] = *(const unsigned*)(AS + o_); } } while (0)
  CK_PREFETCH(0);
  for (int ci = 0; ci < PP / 64; ++ci) {
    PROF_T0(2)
    PROF_T0(6)
    if (wave < 4) ck_store(sacc, sSB, arow0, brow0, r32, hi);
    f32x2 fr[4], fkd[4], fv[4], fkk[4], fal[4], flg[4];
    { const int p0w = scan_pos(ci * 64 + wave * 8, d); const int sg = d == 0 ? 1 : -1; const int lo = p0w < CTX ? 0 : CTX, hi_p = p0w < CTX ? CTX - 1 : PP - 1;
      const int p0h = p0w + sg * 4 * hw;
      f32x2 run = (f32x2){0.f, 0.f};
#pragma unroll
      for (int j = 0; j < 4; ++j) { const int pj = p0h + sg * j;
        const float ml = pj != lo ? 1.f : 0.f, mr = pj != hi_p ? 1.f : 0.f;
        const f32x2 rl = UNP(d == 0 ? pr[j] : pr[j + 2]), rr_ = UNP(d == 0 ? pr[j + 2] : pr[j]);
        const f32x2 kl = UNP(d == 0 ? pk[j] : pk[j + 2]), kr_ = UNP(d == 0 ? pk[j + 2] : pk[j]);
        const f32x2 vl = UNP(d == 0 ? pv[j] : pv[j + 2]), vr_ = UNP(d == 0 ? pv[j + 2] : pv[j]);
        const f32x2 r = UNP(pr[j + 1]) * cwr1 + (rl * cwr0) * ml + (rr_ * cwr2) * mr;
        const f32x2 k = UNP(pk[j + 1]) * cwk1 + (kl * cwk0) * ml + (kr_ * cwk2) * mr;
        const f32x2 v = UNP(pv[j + 1]) * cwv1 + (vl * cwv0) * ml + (vr_ * cwv2) * mr;
        const f32x2 kr = k * kkc;
        float x = kr.x * kr.x + kr.y * kr.y;
        x = dpp_add<0xB1>(x); x = dpp_add<0x4E>(x); x = dpp_add<0x141>(x); x = dpp_add<0x140>(x);
        const float t0 = rdlane(x, 0) + rdlane(x, 16), t1 = rdlane(x, 32) + rdlane(x, 48);
        const f32x2 kk = kr * __builtin_amdgcn_rsqf(fmaxf(hw ? t1 : t0, 1e-24f));
        const f32x2 al = UNP(pas[j]);
        run = run - UNP(pew[j]);
        fr[j] = r; fkd[j] = k * ((al - 1.f) * kac + 1.f); fv[j] = v; fkk[j] = kk; fal[j] = al; flg[j] = run; }
      *(LAS f32x2*)(wtot + (wave * 2 + hw) * 64 + q2) = run; }
    if (ci > 0) { const int s_ = C.tid >> 3, pc_ = C.tid & 7; const int p_ = scan_pos((ci - 1) * 64 + s_, d);
      *(u32x4*)(Y + (size_t)(b * PP + p_) * 384 + h * 64 + pc_ * 8) = *(const LAS u32x4*)(SLOT(8) + s_ * CK_ROW + pc_ * 16); }
    if (ci + 1 < PP / 64) CK_PREFETCH(ci + 1);
    __syncthreads();
    PROF_T1(6)
    PROF_T0(7)
    { f32x2 off = (f32x2){0.f, 0.f}, tot = (f32x2){0.f, 0.f}; const int seg = wave * 2 + hw;
#pragma unroll
      for (int w2 = 0; w2 < 16; ++w2) { const f32x2 t = *(const LAS f32x2*)(wtot + w2 * 64 + q2); off = off + ((w2 < seg) ? t : (f32x2){0.f, 0.f}); tot = tot + t; }
      const f32x2 eTot = (f32x2){__expf(tot.x), __expf(tot.y)};
      if (wave == 0 && hw == 0) *(LAS f32x2*)(gamC + q2) = eTot;
      f32x2 eGprev = (f32x2){__expf(off.x), __expf(off.y)};
      f32x2 tv[4], tbh[4], tkh[4];
      const int s0 = wave * 8 + hw * 4;
#pragma unroll
      for (int j = 0; j < 4; ++j) { const int s = s0 + j; const f32x2 Lc = off + flg[j];
        const f32x2 eG = (f32x2){__expf(Lc.x), __expf(Lc.y)}, eGp = eGprev, eGi = (f32x2){__builtin_amdgcn_rcpf(eG.x), __builtin_amdgcn_rcpf(eG.y)}, eGc = eTot * eGi; eGprev = eG;
        const f32x2 bb = fkk[j] * fal[j];
        const f32x2 xa = fkk[j] * eGp, xr = fr[j] * eG, xb = bb * eGi, xk = fkd[j] * eGi;
        *(LAS unsigned*)(sAT + s * CK_ROW + q2 * 2) = cvtpk(-xa.x, -xa.y);
        *(LAS unsigned*)(sRT + s * CK_ROW + q2 * 2) = cvtpk(xr.x, xr.y);
        *(LAS unsigned*)(sBT + s * CK_ROW + q2 * 2) = cvtpk(xb.x, xb.y);
        *(LAS unsigned*)(sKT + s * CK_ROW + q2 * 2) = cvtpk(xk.x, xk.y);
        tv[j] = fv[j]; tbh[j] = bb * eGc; tkh[j] = fkd[j] * eGc; }
#define PK4(T, comp) ((u32x2){cvtpk(T[0].comp, T[1].comp), cvtpk(T[2].comp, T[3].comp)})
      *(LAS u32x2*)(sVT + q2 * CK_ROW + s0 * 2) = PK4(tv, x); *(LAS u32x2*)(sVT + (q2 + 1) * CK_ROW + s0 * 2) = PK4(tv, y);
      *(LAS u32x2*)(sBH + q2 * CK_ROW + s0 * 2) = PK4(tbh, x); *(LAS u32x2*)(sBH + (q2 + 1) * CK_ROW + s0 * 2) = PK4(tbh, y);
      *(LAS u32x2*)(sKH + q2 * CK_ROW + s0 * 2) = PK4(tkh, x); *(LAS u32x2*)(sKH + (q2 + 1) * CK_ROW + s0 * 2) = PK4(tkh, y);
#undef PK4
    }
    __syncthreads();
    PROF_T1(2)
    PROF_T1(7)
    PROF_T0(3)
    { f32x16 z;
#pragma unroll
      for (int i = 0; i < 16; ++i) z[i] = 0.f;
      const int bi = brow0 + r32;
      if (wave < 4) {
        f32x16 t = z, u = z, w = z;
        ck_mma(t, sBT, arow0, sAT, brow0, r32, hi);
        ck_mma(u, sAT, arow0, sBT, brow0, r32, hi);
        ck_mma(w, sBT, arow0, sRT, brow0, r32, hi);
#pragma unroll
        for (int i = 0; i < 16; ++i) { const int ai = arow0 + (i & 3) + 8 * (i >> 2) + 4 * hi; t[i] = ai < bi ? t[i] : 0.f; u[i] = bi < ai ? u[i] : 0.f; w[i] = ai <= bi ? w[i] : 0.f; }
        ck_store(t, sP0, arow0, brow0, r32, hi); ck_store(u, sP0T, arow0, brow0, r32, hi); ck_store(w, sARB, arow0, brow0, r32, hi);
      } else {
        f32x16 t = z, u = z;
        ck_mma(t, sKT, arow0, sAT, brow0, r32, hi);
        ck_mma(u, sKT, arow0, sRT, brow0, r32, hi);
#pragma unroll
        for (int i = 0; i < 16; ++i) { const int ai = arow0 + (i & 3) + 8 * (i >> 2) + 4 * hi; t[i] = ai < bi ? t[i] : 0.f; u[i] = ai <= bi ? u[i] : 0.f; }
        ck_store(t, sAAK, arow0, brow0, r32, hi); ck_store(u, sARK, arow0, brow0, r32, hi);
      } }
    __syncthreads();
    PROF_T1(3)
    PROF_T0(4)
#define CK_SQUARE(Pin, PTin, Pout, PTout, needT) do { f32x16 t_, u_; _Pragma("unroll") for (int i = 0; i < 16; ++i) { t_[i] = 0.f; u_[i] = 0.f; } \
      ck_mma(t_, PTin, arow0, Pin, brow0, r32, hi);                    \
      if (needT) ck_mma(u_, Pin, arow0, PTin, brow0, r32, hi);         \
      ck_store(t_, Pout, arow0, brow0, r32, hi); if (needT) ck_store(u_, PTout, arow0, brow0, r32, hi); } while (0)
#define CK_XSTEP(Pj, Xin, Xout) do { ck_mma(xacc, Pj, arow0, Xin, brow0, r32, hi); ck_store(xacc, Xout, arow0, brow0, r32, hi); } while (0)
    if (wave < 4) CK_SQUARE(sP0, sP0T, SLOT(2), SLOT(3), true);
    else {
#pragma unroll
      for (int i = 0; i < 16; ++i) xacc[i] = 0.f;
      ck_mma(xacc, sAT, arow0, sSB, brow0, r32, hi); ck_mma(xacc, sAAK, arow0, sVT, brow0, r32, hi); ck_store(xacc, sXa, arow0, brow0, r32, hi); }
    __syncthreads();
    if (wave < 4) CK_SQUARE(SLOT(2), SLOT(3), SLOT(0), SLOT(10), true); else CK_XSTEP(sP0, sXa, sXb);
    __syncthreads();
    if (wave < 4) CK_SQUARE(SLOT(0), SLOT(10), SLOT(8), SLOT(9), true); else CK_XSTEP(SLOT(2), sXb, sXa);
    __syncthreads();
    if (wave < 4) CK_SQUARE(SLOT(8), SLOT(9), SLOT(2), SLOT(3), true); else CK_XSTEP(SLOT(0), sXa, sXb);
    __syncthreads();
    if (wave < 4) CK_SQUARE(SLOT(2), SLOT(3), SLOT(0), SLOT(10), false); else CK_XSTEP(SLOT(8), sXb, sXa);
    __syncthreads();
    f32x16 yacc;
    if (wave >= 4) CK_XSTEP(SLOT(2), sXa, sXb);
    else {
#pragma unroll
      for (int i = 0; i < 16; ++i) yacc[i] = 0.f;
      ck_mma(yacc, sSB, arow0, sRT, brow0, r32, hi); ck_mma(yacc, sVT, arow0, sARK, brow0, r32, hi); }
    __syncthreads();
    if (wave >= 4) CK_XSTEP(SLOT(0), sXb, sXa);
    else {
#pragma unroll
      for (int i = 0; i < 16; ++i) sacc[i] *= gamC[arow0 + (i & 3) + 8 * (i >> 2) + 4 * hi];
      ck_mma(sacc, sKH, arow0, sVT, brow0, r32, hi); }
    __syncthreads();
    PROF_T1(4)
    PROF_T0(5)
    if (wave < 4) {
      ck_mma(yacc, sXa, arow0, sARB, brow0, r32, hi); ck_mma(sacc, sBH, arow0, sXa, brow0, r32, hi);
      ck_store(yacc, SLOT(8), arow0, brow0, r32, hi);
    }
    __syncthreads();
    PROF_T1(5)
  }
  PROF_T1(1)
  { const int s_ = C.tid >> 3, pc_ = C.tid & 7; const int p_ = scan_pos((PP / 64 - 1) * 64 + s_, d);
    *(u32x4*)(Y + (size_t)(b * PP + p_) * 384 + h * 64 + pc_ * 8) = *(const LAS u32x4*)(SLOT(8) + s_ * CK_ROW + pc_ * 16); }
  __syncthreads();
#undef SLOT
#undef UNP
#undef CK_PREFETCH
#undef CK_SQUARE
#undef CK_XSTEP
}
DI void mix_phase(const Ctx& C0, int l, bool with_ctx, int rep = 0) {
  unsigned* ctr = (unsigned*)(C0.ws + WS_CTL) + 64 * (1 + l + 2 * rep);
  LAS int* slot = (LAS int*)(C0.lds + 147456 - 64);
    const int n_scan = 48;
#ifdef REP_ATT
  const int n_att = 1536;
#else
  const int n_att = 768;
#endif
  const int n_attc = with_ctx ? 24 : 0, n_fft = 528, n_fftc = with_ctx ? 528 : 0;
  const int total = n_scan + n_att + n_attc + n_fft + n_fftc;
  for (;;) {
    __syncthreads();
    if (C0.tid == 0) *slot = (int)atomicAdd(ctr, 1u);
    __syncthreads();
    int it = __builtin_amdgcn_readfirstlane(*slot);
    if (it >= total) break;
    Ctx C = C0; { int t_ = C0.tid; asm volatile("" : "+v"(t_)); C.tid = t_; C.lane = t_ & 63; C.wave = __builtin_amdgcn_readfirstlane(t_ >> 6); GAS unsigned char* w_ = (GAS unsigned char*)C0.ws; asm volatile("" : "+s"(w_), "+s"(it)); C.ws = (unsigned char*)w_; }
    if (it < n_scan) { scan_chain(C, l, it); continue; } it -= n_scan;
    if (it < n_att) { const int bh = (it % 768) / 32, qb = it % 32; attn_unit(C, bh / NH, bh % NH, CTX + qb * 256, PP / 64); continue; } it -= n_att;
    if (it < n_attc) { attn_unit(C, it / NH, it % NH, 0, CTX / 64); continue; } it -= n_attc;
    if (it < n_fft) { fft_unit(C, it, false); continue; } it -= n_fft;
    fft_unit(C, it, true);
  }
}
#define XB_TMO      128
#define XB_XCNT(j)  (256  + 64 * (j))
#define XB_XSUB(j)  (1280 + 64 * (j))
#define XB_XGEN(j)  (2304 + 64 * (j))
#define XB_TOP      3328
#define XB_TOPGEN   3392
#define XCD_BAR_WORDS 3456
#define XB_SPIN_CAP (1u << 18)

__device__ __forceinline__ unsigned xb_ld(unsigned* p)              { return __hip_atomic_load(p, __ATOMIC_RELAXED, __HIP_MEMORY_SCOPE_AGENT); }
__device__ __forceinline__ unsigned xb_add(unsigned* p, unsigned v) { return __hip_atomic_fetch_add(p, v, __ATOMIC_RELAXED, __HIP_MEMORY_SCOPE_AGENT); }
__device__ __forceinline__ unsigned xb_xcc_id() { return (unsigned)__builtin_amdgcn_s_getreg((3 << 11) | 20) & 0xFu; }
#define XB_SPIN(cond, bar) do { unsigned _sp = 0; while (cond) { __builtin_amdgcn_s_sleep(1); \
    if ((++_sp & 255u) == 0u) { if (xb_ld(&(bar)[XB_TMO])) break; if (_sp > XB_SPIN_CAP) { atomicAdd(&(bar)[XB_TMO], 1u); break; } } } } while (0)

struct XcdBarrier {
    unsigned* bar; unsigned x;
    volatile LAS unsigned* st;
};

__device__ __forceinline__ XcdBarrier xcd_barrier_post(unsigned* bar, volatile LAS unsigned* st) {
    XcdBarrier b; b.bar = bar; b.x = xb_xcc_id(); b.st = st;
    if (threadIdx.x == 0) (void)xb_add(&bar[XB_XCNT(b.x)], 1u);
    return b;
}
__device__ __forceinline__ void xcd_barrier_complete(unsigned* bar, unsigned x, unsigned& nloc, unsigned& nx) {
    const unsigned G = gridDim.x * gridDim.y * gridDim.z;
    unsigned sum, cnt, mine, sp = 0u;
    for (;;) {
        sum = 0u; cnt = 0u; mine = 0u;
#pragma unroll
        for (unsigned j = 0; j < 16; ++j) { const unsigned c = xb_ld(&bar[XB_XCNT(j)]); sum += c; cnt += (c > 0u) ? 1u : 0u; mine = (j == x) ? c : mine; }
        if (sum == G) break;
        __builtin_amdgcn_s_sleep(1);
        if ((++sp & 255u) == 0u) { if (xb_ld(&bar[XB_TMO])) break; if (sp > XB_SPIN_CAP) { atomicAdd(&bar[XB_TMO], 1u); break; } }
    }
    nloc = mine > 0u ? mine : 1u; nx = cnt > 0u ? cnt : 1u;
}

__device__ __forceinline__ void xcd_barrier(const XcdBarrier& b) {
    asm volatile("s_waitcnt vmcnt(0)" ::: "memory");
    __syncthreads();
    if (threadIdx.x == 0) {
        unsigned* bar = b.bar;
        __builtin_amdgcn_s_waitcnt(0);
        unsigned nloc = b.st[0], nx = b.st[1];
        if (nloc == 0u) { xcd_barrier_complete(bar, b.x, nloc, nx); b.st[0] = nloc; b.st[1] = nx; }
        const unsigned old = xb_add(&bar[XB_XSUB(b.x)], 1u);
        const unsigned gen = old / nloc;
        if (old + 1u == (gen + 1u) * nloc) {
            __builtin_amdgcn_fence(__ATOMIC_RELEASE, "agent");
            asm volatile("s_waitcnt vmcnt(0)" ::: "memory");
            const unsigned og = xb_add(&bar[XB_TOP], 1u);
            const unsigned tg = og / nx;
            if (og + 1u == (tg + 1u) * nx) xb_add(&bar[XB_TOPGEN], 1u);
            else XB_SPIN(xb_ld(&bar[XB_TOPGEN]) == tg, bar);
            __builtin_amdgcn_fence(__ATOMIC_ACQUIRE, "agent");
            xb_add(&bar[XB_XGEN(b.x)], 1u);
            asm volatile("s_waitcnt vmcnt(0)" ::: "memory");
        } else {
            XB_SPIN(xb_ld(&bar[XB_XGEN(b.x)]) == gen, bar);
            __builtin_amdgcn_fence(__ATOMIC_ACQUIRE, "agent");
            asm volatile("s_waitcnt vmcnt(0)" ::: "memory");
        }
    }
    __syncthreads();
}

constexpr int LDS_BYTES = 147456;
#ifndef REP_PHASE
#define REP_PHASE 0
#endif
#define NREP(k) ((REP_PHASE == (k)) ? 2 : 1)

#ifdef PROF_SEL
#define TPH0(k) unsigned long long tph_##k = 0; if (PROF_SEL == 100 + (k)) tph_##k = __builtin_amdgcn_s_memrealtime();
#define TPH1(k) if (PROF_SEL == 100 + (k) && blockIdx.x == 0 && threadIdx.x == 0) atomicAdd((unsigned*)(P.ws + WS_CTL) + 1024, (unsigned)(__builtin_amdgcn_s_memrealtime() - tph_##k));
#else
#define TPH0(k)
#define TPH1(k)
#endif
__global__ void __launch_bounds__(NTHREADS, 2) mk_fwd(Params P) {
  extern __shared__ __attribute__((aligned(16))) unsigned char lds_raw[];
  cg::grid_group grid = cg::this_grid();
  Ctx C; unsigned char* ws;
#define PH() do { const __attribute__((address_space(4))) char* kp_ = (const __attribute__((address_space(4))) char*)__builtin_amdgcn_kernarg_segment_ptr(); asm volatile("" : "+s"(kp_)); \
    int t_ = threadIdx.x; asm volatile("" : "+v"(t_)); \
    C.in = (const __attribute__((address_space(4))) cfptr*)kp_; C.out = (float*)(GAS float*)*(float* const __attribute__((address_space(4)))*)(kp_ + 256); C.ws = (unsigned char*)(GAS unsigned char*)*(unsigned char* const __attribute__((address_space(4)))*)(kp_ + 264); ws = C.ws; \
    C.lds = (LAS unsigned char*)lds_raw; C.ldsg = lds_raw; C.tid = t_; C.lane = t_ & 63; C.wave = __builtin_amdgcn_readfirstlane(t_ >> 6); int g_ = gridDim.x, b_ = blockIdx.x; asm volatile("" : "+s"(g_), "+s"(b_)); C.G = g_; C.bid = b_; } while (0)
#define R1 ((bf16_t*)(ws + WS_R1))
#define R2 ((bf16_t*)(ws + WS_R2))
#define R3 ((bf16_t*)(ws + WS_R3))
#define QB R2
#define KB (R2 + (size_t)NB * NH * PP * 96)
#define VT (R2 + (size_t)2 * NB * NH * PP * 96)
#define EW R3
#define AS (R3 + (size_t)TT * 768)
#define GG (R3 + (size_t)2 * TT * 768)
#define rq ((float*)(ws + WS_RSTD))
#define rkv (((float*)(ws + WS_RSTD)) + TT)
#define IDX ((int*)(ws + WS_IDX))

  { volatile LAS unsigned* xst = (volatile LAS unsigned*)((LAS unsigned char*)lds_raw + LDS_BYTES - 32);
    if (threadIdx.x == 0) { xst[0] = 0u; xst[1] = 0u; } }
  __syncthreads();
  (void)xcd_barrier_post((unsigned*)(P.ws + WS_CTL) + 4096, (volatile LAS unsigned*)((LAS unsigned char*)lds_raw + LDS_BYTES - 32));
#define GSYNC() do { XcdBarrier xb_; xb_.bar = (unsigned*)(C.ws + WS_CTL) + 4096; xb_.x = xb_xcc_id(); xb_.st = (volatile LAS unsigned*)((LAS unsigned char*)lds_raw + LDS_BYTES - 32); xcd_barrier(xb_); } while (0)
  { TPH0(12) for (int rep = 0; rep < NREP(12); ++rep) { PH(); phase0(C);
  grid.sync(); } TPH1(12) }
  PH(); phase0b(C);
  GSYNC();
  for (int l = 0; l < 2; ++l) {
    const bool last = (l == 1);
    { TPH0(1) PH(); if (l == 0) norm_pass(C, 0, 0, 0); else norm_pass(C, 1, 1, 0);
    GSYNC(); TPH1(1) }
    { TPH0(2) for (int rep = 0; rep < NREP(2); ++rep) { PH(); { pg8::Gemm g{R2, (const bf16_t*)(ws + WS_WIN) + (size_t)l * UW * DM, DM, DM}; pg8::StaticOrder S; S.init(TT, UW, C.G, C.bid);
      EpiU E{R1, UW}; pg8::gemm_phase(C.lds, C.tid, g, S, E); }
    GSYNC(); } TPH1(2) }
    { TPH0(3) for (int rep = 0; rep < NREP(3); ++rep) { PH(); prep_a(C, l);
    GSYNC(); } TPH1(3) }
    { TPH0(4) for (int rep = 0; rep < NREP(4); ++rep) { PH(); { pg8::Gemm g{R1 + 1152, (const bf16_t*)(ws + WS_WLW) + (size_t)l * 1536 * 128, UW, 128}; pg8::StaticOrder S; S.init(TT, 1536, C.G, C.bid);
      EpiLW E{EW, AS, inp(C, 13) + l * 768, inp(C, 15) + l * 768}; pg8::gemm_phase(C.lds, C.tid, g, S, E); }
    PH(); { pg8::Gemm g{R1 + 1280, (const bf16_t*)(ws + WS_WG) + (size_t)l * 512 * 256, UW, 256}; pg8::StaticOrder S; S.init(TT, 512, C.G, C.bid);
      EpiG E{GG}; pg8::gemm_phase(C.lds, C.tid, g, S, E); }
    PH(); { pg8::Gemm g{R1 + 1536, (const bf16_t*)(ws + WS_WQ) + (size_t)l * 768 * 256, UW, 256}; pg8::StaticOrder S; S.init(TT, 768, C.G, C.bid);
      EpiQ E{QB, rq, (const float*)(ws + WS_ROPE)}; pg8::gemm_phase(C.lds, C.tid, g, S, E); }
    PH(); { pg8::Gemm g{R1 + 1792, (const bf16_t*)(ws + WS_WKV) + (size_t)l * 768 * 128, UW, 128}; pg8::StaticOrder S; S.init(TT, 768, C.G, C.bid);
      EpiKV E{KB, VT, rkv}; pg8::gemm_phase(C.lds, C.tid, g, S, E); }
    GSYNC(); } TPH1(4) }
    { TPH0(5) for (int rep = 0; rep < NREP(5); ++rep) { PH(); mix_phase(C, l, !last, rep);
    GSYNC(); } TPH1(5) }
    { TPH0(6) for (int rep = 0; rep < NREP(6); ++rep) { PH(); post_pass(C, l, !last);
    GSYNC(); } TPH1(6) }
    { TPH0(7) for (int rep = 0; rep < NREP(7); ++rep) { PH(); { pg8::Gemm g{(const bf16_t*)(ws + WS_R6), (const bf16_t*)(ws + WS_WOUT) + (size_t)l * DM * DM, DM, DM}; pg8::StaticOrder S; S.init(TT, DM, C.G, C.bid);
      EpiPlain E{R1, DM}; pg8::gemm_phase(C.lds, C.tid, g, S, E); }
    GSYNC(); } TPH1(7) }
    { TPH0(8) PH(); n2_pass(C, l, !last);
    GSYNC(); TPH1(8) }
    { TPH0(9) for (int rep = 0; rep < NREP(9); ++rep) { PH(); { const int nprob = last ? 64 : 128;
      { TPH0(20) if (C.bid < nprob) topk_problem(C, C.bid); TPH1(20) }
      const int gt = C.bid * NTHREADS + C.tid, NGT = C.G * NTHREADS;
      for (int i = gt; i < NEXP * 256; i += NGT) { const int e = i >> 8, r = i & 255; const int row = e * RPE + 4096 + r; if (last || r >= 128) IDX[row] = 0; }
      { TPH0(21) convert_experts(C, l); TPH1(21) } }
    GSYNC(); } TPH1(9) }
    { TPH0(10) for (int rep = 0; rep < NREP(10); ++rep) { PH(); { pg8::Gemm g{R2, R3, DM, DM}; MoeOrder<true> S; S.init(last ? 16 : 17, 8, C.G, C.bid, IDX);
      EpiMoe1 E{(bf16_t*)(ws + WS_HID)}; pg8::gemm_phase(C.lds, C.tid, g, S, E); }
    GSYNC(); } TPH1(10) }
    { TPH0(11) for (int rep = 0; rep < NREP(11); ++rep) { PH(); { pg8::Gemm g{(const bf16_t*)(ws + WS_HID), R3 + (size_t)NEXP * 2048 * 1024, DM, DM}; MoeOrder<false> S; S.init(last ? 16 : 17, 4, C.G, C.bid, IDX);
      EpiMoe2 E{R1}; pg8::gemm_phase(C.lds, C.tid, g, S, E); }
    GSYNC(); } TPH1(11) }
  }
#ifdef EXTRA_SYNCS
  for (int i_ = 0; i_ < EXTRA_SYNCS; ++i_) GSYNC();
#endif
  { TPH0(13) PH(); norm_pass(C, 2, 0, 1); TPH1(13) }
#ifdef PROF_SEL
  GSYNC();
  if (blockIdx.x == 0 && threadIdx.x == 0) { const unsigned ticks = __hip_atomic_load((unsigned*)(P.ws + WS_CTL) + 1024, __ATOMIC_RELAXED, __HIP_MEMORY_SCOPE_AGENT) * PROF_MUL;
    const unsigned long long t0 = __builtin_amdgcn_s_memrealtime(); while (__builtin_amdgcn_s_memrealtime() - t0 < ticks) __builtin_amdgcn_s_sleep(4); }
#endif
}

extern "C" void kernel_launch(void* const* d_in, const int* in_sizes, int n_in, void* d_out, int out_size, void* d_ws, size_t ws_size, hipStream_t stream) {
  static int grid = 0;
  if (grid == 0) {
    int dev = 0, cus = 0, per_cu = 0;
    if (n_in != 32 || out_size != NB * SEQ * DM || ws_size < WS_END) { fprintf(stderr, "kernel_launch: unexpected shapes (n_in %d out %d ws %zu)\n", n_in, out_size, ws_size); grid = -1; return; }
    (void)hipGetDevice(&dev);
    (void)hipDeviceGetAttribute(&cus, hipDeviceAttributeMultiprocessorCount, dev);
    (void)hipFuncSetAttribute((const void*)mk_fwd, hipFuncAttributeMaxDynamicSharedMemorySize, LDS_BYTES);
    (void)hipOccupancyMaxActiveBlocksPerMultiprocessor(&per_cu, (const void*)mk_fwd, NTHREADS, LDS_BYTES);
    if (per_cu < 1) { fprintf(stderr, "kernel_launch: occupancy query reports %d blocks per CU\n", per_cu); grid = -1; return; }
    grid = cus;
  }
  if (grid < 0) return;
  (void)hipMemsetAsync((char*)d_ws + WS_CTL, 0, 32768, stream);
  Params p{};
  for (int i = 0; i < 32; ++i) p.in[i] = (const float*)d_in[i];
  p.out = (float*)d_out; p.ws = (unsigned char*)d_ws;
  void* args[] = {&p};
  hipError_t e = hipLaunchCooperativeKernel((const void*)mk_fwd, dim3(grid), dim3(NTHREADS), args, LDS_BYTES, stream);
  if (e != hipSuccess) fprintf(stderr, "cooperative launch failed: %s (grid %d)\n", hipGetErrorString(e), grid);
}
```

```cpp
#include <hip/hip_runtime.h>
#include <hip/hip_cooperative_groups.h>
#include <cstdio>
#include <cstdint>
namespace cg = cooperative_groups;

#define LAS __attribute__((address_space(3)))
typedef unsigned short bf16_t;
typedef short bf16x8 __attribute__((ext_vector_type(8)));
typedef float f32x4 __attribute__((ext_vector_type(4)));
typedef float f32x2 __attribute__((ext_vector_type(2)));
typedef float f32x16 __attribute__((ext_vector_type(16)));
typedef unsigned u32x4 __attribute__((ext_vector_type(4)));
typedef unsigned u32x2 __attribute__((ext_vector_type(2)));
typedef __bf16 bf16x2_t __attribute__((ext_vector_type(2)));
#define DI __device__ __forceinline__

constexpr int NB = 4, SEQ = 8192, CTX = 256, PP = SEQ + CTX  , TT = NB * PP  , DM = 1024;
constexpr int UW = 2304;
constexpr int NH = 6;
constexpr int NEXP = 16, RPE = 4352  ;
constexpr float NORM_EPS = 1e-6f, GN_EPS = 64e-5f;
constexpr float QSCALE = 0.10206207261596577f * 1.4426950408889634f;
constexpr int NWAVES = 8, NTHREADS = 512;

DI unsigned cvtpk(float lo, float hi) { f32x2 v = {lo, hi}; bf16x2_t b = __builtin_convertvector(v, bf16x2_t); return __builtin_bit_cast(unsigned, b); }
DI bf16_t f2bf(float f) { return (bf16_t)(cvtpk(f, 0.f) & 0xffffu); }
DI float bf2f(bf16_t b) { return __uint_as_float(((unsigned)b) << 16); }
DI float bflo(unsigned u) { return __uint_as_float(u << 16); }
DI float bfhi(unsigned u) { return __uint_as_float(u & 0xffff0000u); }
template <int CTRL> DI float dpp_add(float x) { return x + __builtin_bit_cast(float, __builtin_amdgcn_update_dpp(0, __builtin_bit_cast(int, x), CTRL, 0xf, 0xf, true)); }
DI float rdlane(float x, int l) { return __builtin_bit_cast(float, __builtin_amdgcn_readlane(__builtin_bit_cast(int, x), l)); }
DI float wave_sum(float x) {
  x = dpp_add<0xB1>(x); x = dpp_add<0x4E>(x); x = dpp_add<0x141>(x); x = dpp_add<0x140>(x);
  return (rdlane(x, 0) + rdlane(x, 16)) + (rdlane(x, 32) + rdlane(x, 48));
}
DI float swz_xor16(float x) { return __builtin_bit_cast(float, __builtin_amdgcn_ds_swizzle(__builtin_bit_cast(int, x), 0x401F)); }
DI float swz_xor8(float x) { return __builtin_bit_cast(float, __builtin_amdgcn_ds_swizzle(__builtin_bit_cast(int, x), 0x201F)); }
DI float half_max(float x) { auto r = __builtin_amdgcn_permlane32_swap(__float_as_uint(x), __float_as_uint(x), false, false); float o; asm("v_max_f32_e32 %0, %1, %2" : "=v"(o) : "v"(__uint_as_float(r[0])), "v"(__uint_as_float(r[1]))); return o; }
DI float half_sum(float x) { auto r = __builtin_amdgcn_permlane32_swap(__float_as_uint(x), __float_as_uint(x), false, false); return __uint_as_float(r[0]) + __uint_as_float(r[1]); }
DI float sigmoidf_(float x) { return 1.f / (1.f + __expf(-x)); }

namespace pg8 {
constexpr int BM = 256, BK = 64, HALF = 128, HTB = HALF * BK * 2, STAGE_BYTES = 8 * HTB, NXCD = 8, WGM = 8;
__host__ __device__ __forceinline__ int lds_byte(int r, int c) { const int st = (r >> 4) * 2 + (c >> 5), rr = r & 15, cc = c & 31, ob = rr * 64 + cc * 2; return st * 1024 + (ob ^ (((ob >> 9) & 1) << 5)); }
__host__ __device__ __forceinline__ void stage_rc(int b, int& R, int& C) { const int st = b / 1024, sb = b % 1024, swz = sb ^ (((sb >> 9) & 1) << 5); R = (st >> 1) * 16 + swz / 64; C = (st & 1) * 32 + (swz % 64) / 2; }
__host__ __device__ __forceinline__ int perm32(int rho) { const int n = rho >> 4, i = rho & 15; return 8 * (i >> 2) + 4 * n + (i & 3); }

struct Unit { int pm, pn; };
struct Gemm { const bf16_t* A; const bf16_t* Bt; int lda; int K; };

struct StaticOrder {
  int nM, nN, nwg, G, c;
  static constexpr bool GATHER = false;
  __device__ void init(int M, int N, int G_, int c_) { nM = M / BM; nN = N / BM; nwg = nM * nN; G = G_; c = c_; }
  __device__ bool next(int i, Unit& u) const {
    const long L = (long)i * G + c; if (L >= nwg) return false;
    int wgid = (int)L; { const int q = nwg / NXCD, r = nwg % NXCD, xcd = wgid % NXCD, off = wgid / NXCD; wgid = (xcd < r ? xcd * (q + 1) : r * (q + 1) + (xcd - r) * q) + off; }
    const int nig = WGM * nN, gid = wgid / nig, fm = gid * WGM, gsz = (nM - fm) < WGM ? (nM - fm) : WGM;
    u.pm = fm + ((wgid % nig) % gsz); u.pn = (wgid % nig) / gsz; return true;
  }
  __device__ int arow(const Unit&, int) const { return 0; }
};

template <class Epi, class Sched>
__device__ __forceinline__ void gemm_phase(LAS unsigned char* lds, const int tid, const Gemm g, const Sched& S, const Epi& E) {
  const int wid = __builtin_amdgcn_readfirstlane(tid >> 6), lane = tid & 63, wr = wid >> 2, wc = wid & 3, fr = lane & 15, fq = lane >> 4;
  int K_ = g.K, lda_ = g.lda; asm volatile("" : "+s"(K_), "+s"(lda_));
  const int K = K_, nt = K / BK, lda = lda_;
  unsigned voffB[2]; int RA[2], CA[2];
#pragma unroll
  for (int i = 0; i < 2; ++i) { int R, C; stage_rc(tid * 16 + i * 8192, R, C); const int Rb = Epi::PERM ? ((R & ~31) + perm32(R & 31)) : R;
    RA[i] = R; CA[i] = C; voffB[i] = (unsigned)(Rb * K + C) * 2u; }
  const size_t kstep = (size_t)(BK * 2);
  const size_t hstepB = (size_t)HALF * K * 2, tstepB = 2 * hstepB;
  const size_t tstepA = (size_t)BM * lda * 2;
  const unsigned ldsw = (unsigned)wid * 1024u;
  const int aoff = lds_byte(wr * 64 + fr, fq * 8), boff = lds_byte(wc * 32 + fr, fq * 8);
#define PG8_SA(b, h) (((b) * 2 + (h)) * HTB)
#define PG8_SB(b, h) ((4 + (b) * 2 + (h)) * HTB)
#define PG8_STAGE(bufoff, gbase, voff) do { _Pragma("unroll") for (int _i = 0; _i < 2; ++_i) \
        __builtin_amdgcn_global_load_lds((const unsigned*)((const char*)(gbase) + (voff)[_i]), (LAS unsigned*)(lds + (bufoff) + ldsw + _i * 8192), 16, 0, 0); } while (0)
#define PG8_LDA(dst, b, h) do { _Pragma("unroll") for (int m = 0; m < 4; ++m) _Pragma("unroll") for (int k = 0; k < 2; ++k) dst[m][k] = *(const LAS bf16x8*)(lds + PG8_SA(b, h) + aoff + m * 2048 + k * 1024); } while (0)
#define PG8_LDB(dst, b, h) do { _Pragma("unroll") for (int n = 0; n < 2; ++n) _Pragma("unroll") for (int k = 0; k < 2; ++k) dst[n][k] = *(const LAS bf16x8*)(lds + PG8_SB(b, h) + boff + n * 2048 + k * 1024); } while (0)
#define PG8_MMA(ai, bj, At, Bt) do { __builtin_amdgcn_s_setprio(1); _Pragma("unroll") for (int m = 0; m < 4; ++m) _Pragma("unroll") for (int n = 0; n < 2; ++n) _Pragma("unroll") for (int k = 0; k < 2; ++k) \
        acc[ai][bj][m][n] = __builtin_amdgcn_mfma_f32_16x16x32_bf16(Bt[n][k], At[m][k], acc[ai][bj][m][n], 0, 0, 0); __builtin_amdgcn_s_setprio(0); } while (0)
#define PG8_WAIT_V(n) asm volatile("s_waitcnt vmcnt(" #n ")" ::: "memory")
#define PG8_WAIT_L(n) asm volatile("s_waitcnt lgkmcnt(" #n ")" ::: "memory")
#define PG8_BAR __builtin_amdgcn_s_barrier()
#define PG8_SCHED __builtin_amdgcn_sched_barrier(0)
#define PG8_OFFS(dst, u) do { _Pragma("unroll") for (int _h = 0; _h < 2; ++_h) _Pragma("unroll") for (int _i = 0; _i < 2; ++_i) \
        dst[_h][_i] = Sched::GATHER ? (unsigned)((size_t)S.arow(u, _h * HALF + RA[_i]) * lda + CA[_i]) * 2u : (unsigned)((_h * HALF + RA[_i]) * lda + CA[_i]) * 2u; } while (0)
  Unit cur, nxt; int ui = 0;
  if (!S.next(0, cur)) return;
  f32x4 acc[2][2][4][2];
#pragma unroll
  for (int a = 0; a < 2; ++a)
#pragma unroll
    for (int b = 0; b < 2; ++b)
#pragma unroll
      for (int m = 0; m < 4; ++m)
#pragma unroll
        for (int n = 0; n < 2; ++n) acc[a][b][m][n] = (f32x4){0.f, 0.f, 0.f, 0.f};
  bf16x8 At[4][2], B0[2][2], B1[2][2];
  unsigned oAc[2][2], oAn[2][2];
  PG8_OFFS(oAc, cur);
  const char* cA = (const char*)g.A + (Sched::GATHER ? (size_t)0 : (size_t)cur.pm * tstepA); const char* cB = (const char*)g.Bt + (size_t)cur.pn * tstepB;
  PG8_STAGE(PG8_SB(0, 0), cB, voffB); PG8_STAGE(PG8_SB(0, 1), cB + hstepB, voffB); PG8_STAGE(PG8_SA(0, 0), cA, oAc[0]); PG8_STAGE(PG8_SA(0, 1), cA, oAc[1]);
  if (wr == 1) PG8_BAR;
  PG8_WAIT_V(2); PG8_BAR;
  PG8_STAGE(PG8_SB(1, 0), cB + kstep, voffB); PG8_STAGE(PG8_SA(1, 0), cA + kstep, oAc[0]); PG8_STAGE(PG8_SB(1, 1), cB + hstepB + kstep, voffB);
  PG8_WAIT_V(6); PG8_BAR;
  for (;;) {
    const bool has_next = S.next(ui + 1, nxt);
    if (has_next) { PG8_OFFS(oAn, nxt); }
    else {
#pragma unroll
      for (int _h = 0; _h < 2; ++_h)
#pragma unroll
        for (int _i = 0; _i < 2; ++_i) oAn[_h][_i] = oAc[_h][_i];
    }
    const char* nA = has_next ? (const char*)g.A + (Sched::GATHER ? (size_t)0 : (size_t)nxt.pm * tstepA) : cA; const char* nB = has_next ? (const char*)g.Bt + (size_t)nxt.pn * tstepB : cB;
    for (int t = 0; t < nt; t += 2) {
      const bool last = (t == nt - 2);
      const char* a1 = cA + (size_t)(t + 1) * kstep;
      const char* a2 = last ? nA : cA + (size_t)(t + 2) * kstep; const char* b2 = last ? nB : cB + (size_t)(t + 2) * kstep;
      const char* a3 = a2 + kstep; const char* b3 = b2 + kstep;
      unsigned o2[2][2];
#pragma unroll
      for (int _h = 0; _h < 2; ++_h)
#pragma unroll
        for (int _i = 0; _i < 2; ++_i) o2[_h][_i] = last ? oAn[_h][_i] : oAc[_h][_i];
      PG8_LDB(B0, 0, 0); PG8_LDB(B1, 0, 1); PG8_SCHED; PG8_LDA(At, 0, 0); PG8_STAGE(PG8_SA(1, 1), a1, oAc[1]);
      PG8_WAIT_V(8); PG8_WAIT_L(0); PG8_BAR; PG8_MMA(0, 0, At, B0); PG8_MMA(0, 1, At, B1); PG8_BAR; PG8_SCHED;
      PG8_LDA(At, 0, 1); PG8_STAGE(PG8_SB(0, 0), b2, voffB); PG8_STAGE(PG8_SB(0, 1), b2 + hstepB, voffB); PG8_STAGE(PG8_SA(0, 0), a2, o2[0]);
      PG8_WAIT_V(8); PG8_WAIT_L(0); PG8_BAR; PG8_MMA(1, 0, At, B0); PG8_MMA(1, 1, At, B1); PG8_BAR; PG8_SCHED;
      PG8_LDB(B0, 1, 0); PG8_LDB(B1, 1, 1); PG8_SCHED; PG8_LDA(At, 1, 0); PG8_STAGE(PG8_SA(0, 1), a2, o2[1]);
      PG8_WAIT_V(8); PG8_WAIT_L(0); PG8_BAR; PG8_MMA(0, 0, At, B0); PG8_MMA(0, 1, At, B1); PG8_BAR; PG8_SCHED;
      PG8_LDA(At, 1, 1); PG8_STAGE(PG8_SB(1, 0), b3, voffB); PG8_STAGE(PG8_SB(1, 1), b3 + hstepB, voffB); PG8_STAGE(PG8_SA(1, 0), a3, o2[0]);
      PG8_WAIT_V(8); PG8_WAIT_L(0); PG8_BAR; PG8_MMA(1, 0, At, B0); PG8_MMA(1, 1, At, B1); PG8_BAR; PG8_SCHED;
    }
    if (wr == 0) PG8_BAR;
    E(acc, cur, wr, wc, fr, fq);
    if (!has_next) break;
#pragma unroll
    for (int a = 0; a < 2; ++a)
#pragma unroll
      for (int b = 0; b < 2; ++b)
#pragma unroll
        for (int m = 0; m < 4; ++m)
#pragma unroll
          for (int n = 0; n < 2; ++n) acc[a][b][m][n] = (f32x4){0.f, 0.f, 0.f, 0.f};
    cur = nxt; cA = nA; cB = nB; ++ui;
#pragma unroll
    for (int _h = 0; _h < 2; ++_h)
#pragma unroll
      for (int _i = 0; _i < 2; ++_i) oAc[_h][_i] = oAn[_h][_i];
    if (wr == 1) PG8_BAR;
  }
  PG8_WAIT_V(0);
  PG8_BAR;
#undef PG8_SA
#undef PG8_SB
#undef PG8_STAGE
#undef PG8_LDA
#undef PG8_LDB
#undef PG8_MMA
#undef PG8_WAIT_V
#undef PG8_WAIT_L
#undef PG8_BAR
#undef PG8_SCHED
#undef PG8_OFFS
}
}
using pg8::Unit;
struct EpiU {
  static constexpr bool PERM = true;
  bf16_t* O; int ldc;
  DI void operator()(const f32x4 (&acc)[2][2][4][2], const Unit& u, int wr, int wc, int fr, int fq) const {
    const int row0 = u.pm * 256 + wr * 64 + fr;
#pragma unroll
    for (int ai = 0; ai < 2; ++ai)
#pragma unroll
      for (int m = 0; m < 4; ++m) { bf16_t* rowp = O + (size_t)(row0 + ai * 128 + m * 16) * ldc;
#pragma unroll
        for (int bj = 0; bj < 2; ++bj) { const int col = u.pn * 256 + bj * 128 + wc * 32 + 8 * fq;
          f32x4 v0 = acc[ai][bj][m][0], v1 = acc[ai][bj][m][1];
          if (col >= 1152 && col < 1216) {
#pragma unroll
            for (int j = 0; j < 4; ++j) { v0[j] = tanhf(v0[j]); v1[j] = tanhf(v1[j]); }
          } else if (col >= 1280 && col < 1536) {
#pragma unroll
            for (int j = 0; j < 4; ++j) { v0[j] = sigmoidf_(v0[j]); v1[j] = sigmoidf_(v1[j]); }
          }
          u32x4 w; w.x = cvtpk(v0[0], v0[1]); w.y = cvtpk(v0[2], v0[3]); w.z = cvtpk(v1[0], v1[1]); w.w = cvtpk(v1[2], v1[3]);
          *(u32x4*)(rowp + col) = w; } }
  }
};
struct EpiPlain {
  static constexpr bool PERM = true;
  bf16_t* O; int ldc;
  DI void operator()(const f32x4 (&acc)[2][2][4][2], const Unit& u, int wr, int wc, int fr, int fq) const {
    const int row0 = u.pm * 256 + wr * 64 + fr;
#pragma unroll
    for (int ai = 0; ai < 2; ++ai)
#pragma unroll
      for (int m = 0; m < 4; ++m) { bf16_t* rowp = O + (size_t)(row0 + ai * 128 + m * 16) * ldc;
#pragma unroll
        for (int bj = 0; bj < 2; ++bj) { const int col = u.pn * 256 + bj * 128 + wc * 32 + 8 * fq;
          const f32x4 v0 = acc[ai][bj][m][0], v1 = acc[ai][bj][m][1];
          u32x4 w; w.x = cvtpk(v0[0], v0[1]); w.y = cvtpk(v0[2], v0[3]); w.z = cvtpk(v1[0], v1[1]); w.w = cvtpk(v1[2], v1[3]);
          *(u32x4*)(rowp + col) = w; } }
  }
};
struct EpiLW {
  static constexpr bool PERM = true;
  bf16_t* EW; bf16_t* AS; const float* w0; const float* a0;
  DI void operator()(const f32x4 (&acc)[2][2][4][2], const Unit& u, int wr, int wc, int fr, int fq) const {
    const int row0 = u.pm * 256 + wr * 64 + fr;
    const bool isw = u.pn < 3;
    bf16_t* O = isw ? EW : AS; const float* bias = isw ? w0 : a0; const float sc = isw ? 0.6065306597126334f : 1.f;
    const int cb = (isw ? u.pn : u.pn - 3) * 256;
#pragma unroll
    for (int bj = 0; bj < 2; ++bj) { const int col = cb + bj * 128 + wc * 32 + 8 * fq;
      const f32x4 b0 = *(const f32x4*)(bias + col), b1 = *(const f32x4*)(bias + col + 4);
#pragma unroll
      for (int ai = 0; ai < 2; ++ai)
#pragma unroll
        for (int m = 0; m < 4; ++m) { bf16_t* rowp = O + (size_t)(row0 + ai * 128 + m * 16) * 768;
          f32x4 v0 = acc[ai][bj][m][0] + b0, v1 = acc[ai][bj][m][1] + b1;
#pragma unroll
          for (int j = 0; j < 4; ++j) { v0[j] = sc * sigmoidf_(v0[j]); v1[j] = sc * sigmoidf_(v1[j]); }
          u32x4 w; w.x = cvtpk(v0[0], v0[1]); w.y = cvtpk(v0[2], v0[3]); w.z = cvtpk(v1[0], v1[1]); w.w = cvtpk(v1[2], v1[3]);
          *(u32x4*)(rowp + col) = w; asm volatile("" ::: "memory"); } }
  }
};
struct EpiG {
  static constexpr bool PERM = true;
  bf16_t* G;
  DI void operator()(const f32x4 (&acc)[2][2][4][2], const Unit& u, int wr, int wc, int fr, int fq) const {
    const int row0 = u.pm * 256 + wr * 64 + fr;
#pragma unroll
    for (int bj = 0; bj < 2; ++bj) { const int col = u.pn * 256 + bj * 128 + wc * 32 + 8 * fq;
      if (col < 384) {
#pragma unroll
        for (int ai = 0; ai < 2; ++ai)
#pragma unroll
          for (int m = 0; m < 4; ++m) { bf16_t* rowp = G + (size_t)(row0 + ai * 128 + m * 16) * 384;
            const f32x4 v0 = acc[ai][bj][m][0], v1 = acc[ai][bj][m][1];
            u32x4 w; w.x = cvtpk(v0[0], v0[1]); w.y = cvtpk(v0[2], v0[3]); w.z = cvtpk(v1[0], v1[1]); w.w = cvtpk(v1[2], v1[3]);
            *(u32x4*)(rowp + col) = w; } } }
  }
};
struct EpiQ {
  static constexpr bool PERM = true;
  bf16_t* QB; const float* rstd; const float* rope;
  DI void operator()(const f32x4 (&acc)[2][2][4][2], const Unit& u, int wr, int wc, int fr, int fq) const {
    const int row0 = u.pm * 256 + wr * 64 + fr;
    const int b = (u.pm * 256) / PP;
#pragma unroll
    for (int bj = 0; bj < 2; ++bj) { const int col = u.pn * 256 + bj * 128 + wc * 32 + 8 * fq;
      const int hh = col / 96, dim = col - hh * 96;
      const bool isrope = dim >= 64;
#pragma unroll
      for (int ai = 0; ai < 2; ++ai)
#pragma unroll
        for (int m = 0; m < 4; ++m) { const int g = row0 + ai * 128 + m * 16; const int p = g - b * PP;
          const float s = rstd[g] * QSCALE;
          float v[8];
#pragma unroll
          for (int j = 0; j < 4; ++j) { v[j] = acc[ai][bj][m][0][j] * s; v[4 + j] = acc[ai][bj][m][1][j] * s; }
          if (isrope) {
            float o[8];
#pragma unroll
            for (int j = 0; j < 8; ++j) o[j] = swz_xor16(v[j]);
            if (p >= CTX) { const int li = p - CTX; const int pos = (fq & 2) ? (li & 63) : (li >> 6);
              const f32x2* rp = (const f32x2*)rope + pos * 8;
#pragma unroll
              for (int j = 0; j < 8; ++j) { const f32x2 cs = rp[j]; v[j] = (fq & 1) ? (v[j] * cs.x + o[j] * cs.y) : (v[j] * cs.x - o[j] * cs.y); } }
          }
          if (col < 576) { u32x4 w; w.x = cvtpk(v[0], v[1]); w.y = cvtpk(v[2], v[3]); w.z = cvtpk(v[4], v[5]); w.w = cvtpk(v[6], v[7]);
            *(u32x4*)(QB + ((size_t)(b * NH + hh) * PP + p) * 96 + dim) = w; }
          asm volatile("" ::: "memory"); }
    }
  }
};
DI int vperm(int p) { const int q = p & 15; return (p & ~15) | (((q >> 2) & 1) << 3) | ((q >> 3) << 2) | (q & 3); }
struct EpiKV {
  static constexpr bool PERM = true;
  bf16_t* KB; bf16_t* VT; const float* rstd;
  DI void operator()(const f32x4 (&acc)[2][2][4][2], const Unit& u, int wr, int wc, int fr, int fq) const {
    const int row0 = u.pm * 256 + wr * 64 + fr;
    const int b = (u.pm * 256) / PP;
#pragma unroll
    for (int bj = 0; bj < 2; ++bj) { const int col = u.pn * 256 + bj * 128 + wc * 32 + 8 * fq;
      const int hh = col >> 7, j0 = col & 127;
#pragma unroll
      for (int ai = 0; ai < 2; ++ai)
#pragma unroll
        for (int m = 0; m < 4; ++m) { const int g = row0 + ai * 128 + m * 16; const int p = g - b * PP;
          const float s = rstd[g];
          float v[8];
#pragma unroll
          for (int j = 0; j < 4; ++j) { v[j] = acc[ai][bj][m][0][j] * s; v[4 + j] = acc[ai][bj][m][1][j] * s; }
          if (j0 < 64) { u32x4 w; w.x = cvtpk(v[0], v[1]); w.y = cvtpk(v[2], v[3]); w.z = cvtpk(v[4], v[5]); w.w = cvtpk(v[6], v[7]);
            *(u32x4*)(KB + ((size_t)(b * NH + hh) * PP + p) * 96 + j0) = w; }
          else { bf16_t* vt = VT + ((size_t)(b * NH + hh) * 64 + (j0 - 64)) * PP + vperm(p);
#pragma unroll
            for (int j = 0; j < 8; ++j) vt[(size_t)j * PP] = f2bf(v[j]); }
          asm volatile("" ::: "memory"); }
    }
  }
};
struct EpiMoe1 {
  static constexpr bool PERM = false;
  bf16_t* HID;
  DI void operator()(const f32x4 (&acc)[2][2][4][2], const Unit& u, int wr, int wc, int fr, int fq) const {
    const int row0 = u.pm * 256 + wr * 64 + fr; const int pnl = u.pn & 7;
#pragma unroll
    for (int ai = 0; ai < 2; ++ai)
#pragma unroll
      for (int m = 0; m < 4; ++m) { bf16_t* rowp = HID + (size_t)(row0 + ai * 128 + m * 16) * 1024 + pnl * 128 + wc * 32 + 4 * fq;
#pragma unroll
        for (int n = 0; n < 2; ++n) { const f32x4 gv = acc[ai][0][m][n], uv = acc[ai][1][m][n]; float h[4];
#pragma unroll
          for (int j = 0; j < 4; ++j) h[j] = gv[j] * sigmoidf_(gv[j]) * uv[j];
          u32x2 w; w.x = cvtpk(h[0], h[1]); w.y = cvtpk(h[2], h[3]);
          *(u32x2*)(rowp + 16 * n) = w; } }
  }
};
struct EpiMoe2 {
  static constexpr bool PERM = true;
  bf16_t* O;
  DI void operator()(const f32x4 (&acc)[2][2][4][2], const Unit& u, int wr, int wc, int fr, int fq) const {
    const int row0 = u.pm * 256 + wr * 64 + fr; const int pnl = u.pn & 3;
#pragma unroll
    for (int ai = 0; ai < 2; ++ai)
#pragma unroll
      for (int m = 0; m < 4; ++m) { bf16_t* rowp = O + (size_t)(row0 + ai * 128 + m * 16) * 1024;
#pragma unroll
        for (int bj = 0; bj < 2; ++bj) { const int col = pnl * 256 + bj * 128 + wc * 32 + 8 * fq;
          const f32x4 v0 = acc[ai][bj][m][0], v1 = acc[ai][bj][m][1];
          u32x4 w; w.x = cvtpk(v0[0], v0[1]); w.y = cvtpk(v0[2], v0[3]); w.z = cvtpk(v1[0], v1[1]); w.w = cvtpk(v1[2], v1[3]);
          *(u32x4*)(rowp + col) = w; } }
  }
};
template <bool GATH> struct MoeOrder {
  static constexpr bool GATHER = GATH;
  int tpe, nN, nwg, G, c; const int* idx;
  __device__ void init(int tpe_, int nN_, int G_, int c_, const int* idx_) { tpe = tpe_; nN = nN_; nwg = NEXP * tpe * nN; G = G_; c = c_; idx = idx_; }
  __device__ bool next(int i, Unit& u) const {
    const long L = (long)i * G + c; if (L >= nwg) return false;
    const int per = tpe * nN, e = (int)L / per, rem = (int)L % per, pnl = rem / tpe, pml = rem % tpe;
    u.pm = e * 17 + pml; u.pn = e * nN + pnl; return true;
  }
  __device__ int arow(const Unit& u, int r) const { return idx[u.pm * 256 + r]; }
};

struct LatentOrder {
  pg8::StaticOrder S;
  static constexpr bool GATHER = false;
  __device__ void init(int N, int G_, int c_) { S.init(NB * (SEQ / 256) * 256, N, G_, c_); }
  __device__ bool next(int i, Unit& u) const { if (!S.next(i, u)) return false; u.pm = u.pm + u.pm / 32 + 1; return true; }
  __device__ int arow(const Unit&, int) const { return 0; }
};
constexpr size_t MiB = (size_t)1 << 20;
constexpr size_t WS_CTL = 0;
constexpr size_t WS_MODP = 1 * MiB;
constexpr size_t WS_MOD = 3 * MiB;
constexpr size_t WS_TW = 3 * MiB + 256 * 1024;
constexpr size_t WS_ROPE = 3 * MiB + 384 * 1024;
constexpr size_t WS_RSTD = 3 * MiB + 512 * 1024;
constexpr size_t WS_WIN = 4 * MiB;
constexpr size_t WS_WOUT = 13 * MiB;
constexpr size_t WS_WLW = 17 * MiB;
constexpr size_t WS_WG = 18 * MiB;
constexpr size_t WS_WQ = 19 * MiB;
constexpr size_t WS_WKV = 20 * MiB;
constexpr size_t WS_AFF = 21 * MiB;
constexpr size_t WS_IDX = 24 * MiB;
constexpr size_t WS_SLOT = 29 * MiB;
constexpr size_t WS_XCTX = 25 * MiB;
constexpr size_t WS_R1 = 36 * MiB;
constexpr size_t WS_R2 = 192 * MiB;
constexpr size_t WS_R3 = 292 * MiB;
constexpr size_t WS_R4 = 416 * MiB;
constexpr size_t WS_R5 = 452 * MiB;
constexpr size_t WS_R6 = 502 * MiB;
constexpr size_t WS_HID = 416 * MiB;
constexpr size_t WS_END = 568 * MiB;

struct Params {
  const float* in[32];
  float* out; unsigned char* ws;
};

typedef const float* cfptr;
struct Ctx {
  const __attribute__((address_space(4))) cfptr* in; float* out; unsigned char* ws;
  LAS unsigned char* lds; unsigned char* ldsg;
  int tid, lane, wave, G, bid;
};

#define GAS __attribute__((address_space(1)))
DI const float* inp(const Ctx& C, int k) { return (const float*)(const GAS float*)C.in[k]; }
DI const float* in_row(const Ctx& C, int g) { const int b = g / PP, p = g - b * PP; return p < CTX ? inp(C, 2) + ((size_t)b * CTX + p) * DM : inp(C, 0) + ((size_t)b * SEQ + (p - CTX)) * DM; }
DI float* xs_row(const Ctx& C, int g) { const int b = g / PP, p = g - b * PP; return p < CTX ? (float*)(C.ws + WS_XCTX) + ((size_t)b * CTX + p) * DM : C.out + ((size_t)b * SEQ + (p - CTX)) * DM; }
DI int mod_row(int g) { const int b = g / PP, p = g - b * PP; return p < CTX ? 4 : b; }
DI const float* modv(const Ctx& C, int l, int r, int j) { return (const float*)(C.ws + WS_MOD) + ((size_t)(l * 5 + r) * 6 + j) * DM; }

template <class RowMap>
DI void transpose_item(const float* W, int K, int N, bf16_t* WT, int ldk, LAS float* scr, int item, int lane, const RowMap& rm) {
  const int nblk = N / 32, kb = item / nblk, nb = item % nblk, k0 = 64 * kb, n0 = 32 * nb;
#pragma unroll 8
  for (int i = 0; i < 32; ++i) { const int kk = 2 * i + (lane >> 5); scr[kk * 33 + (lane & 31)] = W[(size_t)(k0 + kk) * N + n0 + (lane & 31)]; }
  asm volatile("s_waitcnt lgkmcnt(0)" ::: "memory");
  const int c = lane & 7;
#pragma unroll
  for (int j = 0; j < 4; ++j) { const int n = (lane >> 3) + 8 * j; const LAS float* s = scr + (8 * c) * 33 + n;
    u32x4 o; o.x = cvtpk(s[0 * 33], s[1 * 33]); o.y = cvtpk(s[2 * 33], s[3 * 33]); o.z = cvtpk(s[4 * 33], s[5 * 33]); o.w = cvtpk(s[6 * 33], s[7 * 33]);
    const int r = rm(n0 + n);
    if (r >= 0) *(u32x4*)(WT + (size_t)r * ldk + k0 + 8 * c) = o; }
  asm volatile("s_waitcnt lgkmcnt(0)" ::: "memory");
}
struct MapIn { DI int operator()(int n) const { return n < 1440 ? n : (n < 1856 ? n + 96 : -1); } };
struct MapId { DI int operator()(int n) const { return n; } };
struct MapGate { int up; DI int operator()(int f) const { return 256 * (f >> 7) + 128 * up + (f & 127); } };

DI void phase0(const Ctx& C, const int lsel, const int vbid, const int vG) {
  const int gw = vbid * NWAVES + C.wave, NGW = vG * NWAVES;
  const int gt = vbid * NTHREADS + C.tid, NGT = vG * NTHREADS;
  LAS float* scr = (LAS float*)(C.lds + C.wave * 16384);
  LAS f32x2* tw64p = (LAS f32x2*)(C.lds + 8 * 16384);
  if (C.tid < 64) { float s_, c_; sincospif((float)C.tid * (2.0f / 64.0f), &s_, &c_); tw64p[C.tid] = (f32x2){c_, s_}; }
  __syncthreads();
  {
    const float* cin = inp(C, 1); const float* cctx = inp(C, 3);
#define SIL(r_, k_) (*(LAS float*)(C.lds + 16384 * (r_) + 12288 + 4 * (k_)))
    for (int i = C.tid; i < 5 * DM; i += NTHREADS) { const float v = i < 4 * DM ? cin[i] : cctx[i - 4 * DM]; SIL(i >> 10, i & 1023) = v * sigmoidf_(v); }
    __syncthreads();
    for (int it = gw; it < 96 * 8; it += NGW) {
      const int l = lsel, r_ = it, cc = r_ / 8, kc = r_ % 8;
      const float* W = inp(C, 4) + (size_t)l * DM * 6144 + (size_t)(kc * 128) * 6144 + cc * 64 + C.lane;
      float a0 = 0.f, a1 = 0.f, a2 = 0.f, a3 = 0.f, a4 = 0.f;
#pragma unroll 16
      for (int k = 0; k < 128; ++k) { const float w = W[(size_t)k * 6144]; const int kk = kc * 128 + k;
        a0 += SIL(0, kk) * w; a1 += SIL(1, kk) * w; a2 += SIL(2, kk) * w; a3 += SIL(3, kk) * w; a4 += SIL(4, kk) * w; }
      float* P = (float*)(C.ws + WS_MODP) + ((size_t)(l * 8 + kc) * 5) * 6144 + cc * 64 + C.lane;
      P[0] = a0; P[6144] = a1; P[2 * 6144] = a2; P[3 * 6144] = a3; P[4 * 6144] = a4;
    }
#undef SIL
    __syncthreads();
  }
  { const int l = lsel;
    bf16_t* WT = (bf16_t*)(C.ws + WS_WIN) + (size_t)l * UW * DM;
    for (int i = gt; i < 192 * DM / 8; i += NGT) { const int r = i / (DM / 8), c8 = i % (DM / 8); const int row = r < 96 ? 1440 + r : 1952 + (r - 96);
      *(u32x4*)(WT + (size_t)row * DM + c8 * 8) = (u32x4){0u, 0u, 0u, 0u}; }
    for (int it = gw; it < 16 * 66; it += NGW) transpose_item(inp(C, 10) + (size_t)l * DM * 2112, DM, 2112, WT, DM, scr, it, C.lane, MapIn());
    for (int it = gw; it < 4 * DM; it += NGW) { const int g = it / DM, k = it % DM; const float* wrow = inp(C, 10) + (size_t)l * DM * 2112 + (size_t)k * 2112 + 1856 + 64 * g;
      const int c_ = C.lane, k2 = c_ <= 32 ? c_ : c_ - 32; float acc = 0.f;
      for (int n = 0; n < 64; ++n) { const f32x2 t_ = tw64p[(k2 * n) & 63]; acc += wrow[n] * (c_ <= 32 ? t_.x : t_.y); }
      WT[(size_t)(2048 + 64 * g + c_) * DM + k] = f2bf(acc); }
    bf16_t* WO = (bf16_t*)(C.ws + WS_WOUT) + (size_t)l * DM * DM;
    for (int it = gw; it < 12 * 32; it += NGW) transpose_item(inp(C, 11) + (size_t)l * DM * DM, 768, DM, WO, DM, scr, it, C.lane, MapId());
    const float* wf = inp(C, 27) + (size_t)l * 256 * 256; const float* wo = inp(C, 11) + (size_t)l * DM * DM + (size_t)768 * DM;
    for (int it = gw; it < 64 * 16; it += NGW) { const int kq = it / 16, nc = it % 16; const int n = nc * 64 + C.lane;
      float a0 = 0.f, a1 = 0.f, a2 = 0.f, a3 = 0.f;
#pragma unroll 4
      for (int j = 0; j < 256; ++j) { const float w = wo[(size_t)j * DM + n];
        a0 += wf[(kq * 4 + 0) * 256 + j] * w; a1 += wf[(kq * 4 + 1) * 256 + j] * w; a2 += wf[(kq * 4 + 2) * 256 + j] * w; a3 += wf[(kq * 4 + 3) * 256 + j] * w; }
      u32x2 o; o.x = cvtpk(a0, a1); o.y = cvtpk(a2, a3);
      *(u32x2*)(WO + (size_t)n * DM + 768 + kq * 4) = o; }
    bf16_t* WLW = (bf16_t*)(C.ws + WS_WLW) + (size_t)l * 1536 * 128;
    for (int i = gt; i < 1536 * 128; i += NGT) { const int n = i / 128, k = i % 128; float v = 0.f;
      if (n < 768) { if (k < 64) v = inp(C, 14)[((size_t)(l * 2 + n / 384) * 64 + k) * 384 + n % 384]; }
      else { const int n2 = n - 768; if (k >= 64) v = inp(C, 16)[((size_t)(l * 2 + n2 / 384) * 64 + (k - 64)) * 384 + n2 % 384]; }
      WLW[i] = f2bf(v); }
    bf16_t* WG = (bf16_t*)(C.ws + WS_WG) + (size_t)l * 512 * 256;
    for (int i = gt; i < 512 * 256; i += NGT) { const int n = i / 256, k = i % 256; float v = 0.f;
      if (n < 384 && k < 160) v = inp(C, 17)[((size_t)l * 160 + k) * 384 + n];
      WG[i] = f2bf(v); }
    bf16_t* WQ = (bf16_t*)(C.ws + WS_WQ) + (size_t)l * 768 * 256;
    for (int i = gt; i < 768 * 256; i += NGT) { const int n = i / 256, k = i % 256; float v = 0.f;
      if (n < 576) v = inp(C, 23)[l * 256 + k] * inp(C, 24)[((size_t)l * 256 + k) * 576 + n];
      WQ[i] = f2bf(v); }
    bf16_t* WKV = (bf16_t*)(C.ws + WS_WKV) + (size_t)l * 768 * 128;
    for (int i = gt; i < 768 * 128; i += NGT) { const int n = i / 128, k = i % 128;
      WKV[i] = f2bf(inp(C, 25)[l * 128 + k] * inp(C, 26)[((size_t)l * 128 + k) * 768 + n]); }
  }
  if (lsel == 0) for (int i = gt; i < 8192; i += NGT) { float s, c; sincospif((float)i * (2.0f / 8192.0f), &s, &c); ((f32x2*)(C.ws + WS_TW))[i] = (f32x2){c, -s}; }
  if (lsel == 0) for (int i = gt; i < 128 * 8; i += NGT) { const int pos = i / 8, j = i % 8; const float inv = powf(10000.0f, -(float)j / 8.0f); float s, c; sincosf((float)pos * inv, &s, &c); ((f32x2*)(C.ws + WS_ROPE))[i] = (f32x2){c, s}; }
}
DI void phase0b(const Ctx& C, const int l) {
  const int gt = C.bid * NTHREADS + C.tid, NGT = C.G * NTHREADS;
  for (int i = gt; i < 5 * 6144; i += NGT) { const int r = i / 6144, n = i % 6144;
    float s = inp(C, 5)[l * 6144 + n];
#pragma unroll
    for (int kc = 0; kc < 8; ++kc) s += ((const float*)(C.ws + WS_MODP))[((size_t)(l * 8 + kc) * 5 + r) * 6144 + n];
    ((float*)(C.ws + WS_MOD))[l * 5 * 6144 + i] = s; }
}

DI void convert_experts(const Ctx& C, int l) {
  LAS float* scr = (LAS float*)(C.lds + C.wave * 16384);
  bf16_t* WGU = (bf16_t*)(C.ws + WS_R3); bf16_t* WDN = WGU + (size_t)NEXP * 2048 * 1024;
  unsigned* ctr = (unsigned*)(C.ws + WS_CTL) + 64 * (8 + l);
  for (;;) { unsigned base = 0; if (C.lane == 0) base = atomicAdd(ctr, 8u); base = __builtin_amdgcn_readfirstlane(base);
    if (base >= NEXP * 3 * 512) break;
    for (int k = 0; k < 8; ++k) { const int it = base + k; const int e = it / 1536, r = it % 1536, mat = r / 512, sub = r % 512;
      const size_t woff = ((size_t)l * NEXP + e) * 1024 * 1024;
      if (mat == 0) transpose_item(inp(C, 29) + woff, 1024, 1024, WGU + (size_t)e * 2048 * 1024, 1024, scr, sub, C.lane, MapGate{0});
      else if (mat == 1) transpose_item(inp(C, 30) + woff, 1024, 1024, WGU + (size_t)e * 2048 * 1024, 1024, scr, sub, C.lane, MapGate{1});
      else transpose_item(inp(C, 31) + woff, 1024, 1024, WDN + (size_t)e * 1024 * 1024, 1024, scr, sub, C.lane, MapId()); } }
}

DI void norm_pass(const Ctx& C, int mode, int l, int lp) {
  const int gw = C.bid * NWAVES + C.wave, NGW = C.G * NWAVES, lane = C.lane;
  bf16_t* XN = (bf16_t*)(C.ws + WS_R2); const bf16_t* DOWN = (const bf16_t*)(C.ws + WS_R1); const int* SLOT = (const int*)(C.ws + WS_SLOT); const float* AFF = (const float*)(C.ws + WS_AFF);
  f32x4 vn[4]; int slotn = -1; float affn = 0.f;
#define NP_LOAD(gg) do { const f32x4* xr_ = (const f32x4*)(mode == 0 ? in_row(C, gg) : xs_row(C, gg)) + lane; _Pragma("unroll") for (int j = 0; j < 4; ++j) vn[j] = xr_[64 * j]; \
    if (mode != 0) { slotn = lane < 16 ? SLOT[(size_t)(gg) * 16 + lane] : -1; affn = lane < 16 ? AFF[(size_t)(gg) * 16 + lane] : 0.f; } } while (0)
  if (gw < TT) NP_LOAD(gw);
  for (int g = gw; g < TT; g += NGW) {
    const int mr = mod_row(g); const bool isctx = (mr == 4);
    f32x4 v[4]; const int myslot = slotn; const float myaff = affn;
#pragma unroll
    for (int j = 0; j < 4; ++j) v[j] = vn[j];
    const bool skip = (mode == 2 && isctx);
    f32x4 y[4], a5[4], g9[4], a0[4], a1[4], g6[4];
    if (!skip) {
      if (mode != 0) { const f32x4* m5 = (const f32x4*)modv(C, lp, mr, 5) + lane; const f32x4* gp = (const f32x4*)(inp(C, 9) + lp * DM) + lane;
#pragma unroll
        for (int j = 0; j < 4; ++j) { a5[j] = m5[64 * j]; g9[j] = gp[64 * j]; y[j] = (f32x4){0.f, 0.f, 0.f, 0.f}; } }
      if (mode != 2) { const f32x4* m0 = (const f32x4*)modv(C, l, mr, 0) + lane; const f32x4* m1 = (const f32x4*)modv(C, l, mr, 1) + lane; const f32x4* gp = (const f32x4*)(inp(C, 6) + l * DM) + lane;
#pragma unroll
        for (int j = 0; j < 4; ++j) { a0[j] = m0[64 * j]; a1[j] = m1[64 * j]; g6[j] = gp[64 * j]; } }
      if (mode != 0) {
        for (int e = 0; e < 16; ++e) { const int sl = __builtin_amdgcn_readlane(myslot, e);
          if (sl >= 0) { const float a = rdlane(myaff, e); const u32x2* dr = (const u32x2*)(DOWN + (size_t)sl * DM) + lane;
#pragma unroll
            for (int j = 0; j < 4; ++j) { const u32x2 w = dr[64 * j]; y[j] = y[j] + (f32x4){bflo(w.x), bfhi(w.x), bflo(w.y), bfhi(w.y)} * a; } } } }
    }
    if (g + NGW < TT) NP_LOAD(g + NGW);
    if (skip) continue;
    if (mode != 0) { f32x4* xr = (f32x4*)xs_row(C, g) + lane; float s = 0.f;
#pragma unroll
      for (int j = 0; j < 4; ++j) s += (y[j].x * y[j].x + y[j].y * y[j].y) + (y[j].z * y[j].z + y[j].w * y[j].w);
      const float rstd = rsqrtf(wave_sum(s) * (1.f / DM) + NORM_EPS);
#pragma unroll
      for (int j = 0; j < 4; ++j) { v[j] = v[j] + a5[j] * (y[j] * rstd * g9[j]); xr[64 * j] = v[j]; }
      if (mode == 2) continue; }
    float s = 0.f;
#pragma unroll
    for (int j = 0; j < 4; ++j) s += (v[j].x * v[j].x + v[j].y * v[j].y) + (v[j].z * v[j].z + v[j].w * v[j].w);
    const float rstd = rsqrtf(wave_sum(s) * (1.f / DM) + NORM_EPS);
    u32x2* o = (u32x2*)(XN + (size_t)g * DM) + lane;
#pragma unroll
    for (int j = 0; j < 4; ++j) { const f32x4 t = v[j] * rstd * g6[j] * (a1[j] + 1.0f) + a0[j]; u32x2 w; w.x = cvtpk(t.x, t.y); w.y = cvtpk(t.z, t.w); o[64 * j] = w; }
  }
#undef NP_LOAD
}

DI void prep_a(const Ctx& C, int l) {
  const bf16_t* U = (const bf16_t*)(C.ws + WS_R1);
  float* rq = (float*)(C.ws + WS_RSTD); float* rkv = rq + TT;
  bf16_t* KB = (bf16_t*)(C.ws + WS_R2) + (size_t)NB * NH * PP * 96;
  const f32x2* rope = (const f32x2*)(C.ws + WS_ROPE);
  const int lane = C.lane;
  LAS float* zrow = (LAS float*)(C.lds + C.wave * 1024);
  LAS f32x2* stage = (LAS f32x2*)(C.lds + 16384);
  LAS f32x2* tw64 = (LAS f32x2*)(C.lds + 16384 + 132 * 64 * 8);
  if (C.tid < 64) { float s, c; sincospif((float)C.tid * (2.0f / 64.0f), &s, &c); tw64[C.tid] = (f32x2){c, s}; }
  __syncthreads();
  for (int tile = C.bid; tile < TT / 64; tile += C.G) {
    const int g0 = tile * 64; const int b = g0 / PP, p0 = g0 - b * PP;
    for (int i = 0; i < 8; ++i) { const int tl = C.wave * 8 + i; const int g = g0 + tl; const int p = p0 + tl;
      const bf16_t* ur = U + (size_t)g * UW;
      { const u32x2 w = *((const u32x2*)(ur + 1536) + lane); const float a0 = bflo(w.x), a1 = bfhi(w.x), a2 = bflo(w.y), a3 = bfhi(w.y);
        const float s = wave_sum(a0 * a0 + a1 * a1 + a2 * a2 + a3 * a3); if (lane == 0) rq[g] = rsqrtf(s * (1.f / 256.f) + NORM_EPS); }
      { const unsigned w = *((const unsigned*)(ur + 1792) + lane); const float a0 = bflo(w), a1 = bfhi(w);
        const float s = wave_sum(a0 * a0 + a1 * a1); if (lane == 0) rkv[g] = rsqrtf(s * (1.f / 128.f) + NORM_EPS); }
      { float x = lane < 32 ? bf2f(ur[1920 + lane]) : 0.f; const float o = swz_xor8(x);
        if (p >= CTX && lane < 32) { const int li = p - CTX; const int pos = (lane & 16) ? (li & 63) : (li >> 6); const f32x2 cs = rope[pos * 8 + (lane & 7)];
          x = (lane & 8) ? (x * cs.x + o * cs.y) : (x * cs.x - o * cs.y); }
        if (lane < 32) { const bf16_t xb = f2bf(x);
#pragma unroll
          for (int hh = 0; hh < NH; ++hh) KB[((size_t)(b * NH + hh) * PP + p) * 96 + 64 + lane] = xb; } }
      { const u32x2 w = *((const u32x2*)(ur + 2048) + lane); *(LAS f32x4*)(zrow + lane * 4) = (f32x4){bflo(w.x), bfhi(w.x), bflo(w.y), bfhi(w.y)}; }
      asm volatile("s_waitcnt lgkmcnt(0)" ::: "memory");
      { const int grp = lane >> 4, kq = lane & 15; const LAS float* z = zrow + grp * 64;
        const float c0 = z[kq], c1 = z[kq + 16], s0 = kq == 0 ? 0.f : z[32 + kq], s1 = z[48 + kq];
        stage[(grp * 33 + kq) * 64 + tl] = (f32x2){c0, -s0}; stage[(grp * 33 + kq + 16) * 64 + tl] = (f32x2){c1, -s1};
        if (kq == 0) stage[(grp * 33 + 32) * 64 + tl] = (f32x2){z[32], 0.f}; }
      asm volatile("s_waitcnt lgkmcnt(0)" ::: "memory");
    }
    __syncthreads();
    f32x2* ZT = (f32x2*)(C.ws + WS_R4);
    for (int i = C.tid; i < 132 * 64; i += NTHREADS) { const int r = i >> 6, t = i & 63; ZT[((size_t)b * 132 + r) * PP + p0 + t] = stage[i]; }
    __syncthreads();
  }
}

DI void post_pass(const Ctx& C, int l, bool with_ctx) {
  const int gw = C.bid * NWAVES + C.wave, NGW = C.G * NWAVES, lane = C.lane;
  const bf16_t* U = (const bf16_t*)(C.ws + WS_R1);
  const bf16_t* AS = (const bf16_t*)(C.ws + WS_R3) + (size_t)TT * 768; const bf16_t* Gt = AS + (size_t)TT * 768;
  const bf16_t* Y0 = (const bf16_t*)(C.ws + WS_R5); const bf16_t* Y1 = Y0 + (size_t)TT * 384;
  bf16_t* MC = (bf16_t*)(C.ws + WS_R6);
  const float* cw = inp(C, 12) + (size_t)l * 3 * 1152; const float* k_a = inp(C, 19) + l * 384; const float* r_k = inp(C, 20) + l * 384;
  const float* lw = inp(C, 21) + l * 384; const float* lb = inp(C, 22) + l * 384;
  for (int g = gw; g < TT; g += NGW) {
    const int b = g / PP, p = g - b * PP; if (p < CTX && !with_ctx) continue;
    const float ml = (p != 0 && p != CTX) ? 1.f : 0.f, mr = (p != CTX - 1 && p != PP - 1) ? 1.f : 0.f;
    const bf16_t* u0 = U + (size_t)g * UW; const bf16_t* ul = ml != 0.f ? u0 - UW : u0; const bf16_t* ur_ = mr != 0.f ? u0 + UW : u0;
    unsigned short xu[6][3][3], y0[6], y1[6], a0[6], a1[6], gg[6];
#pragma unroll
    for (int hh = 0; hh < NH; ++hh) { const int c = hh * 64 + lane;
#pragma unroll
      for (int q = 0; q < 3; ++q) { xu[hh][q][0] = ul[q * 384 + c]; xu[hh][q][1] = u0[q * 384 + c]; xu[hh][q][2] = ur_[q * 384 + c]; }
      y0[hh] = Y0[(size_t)g * 384 + c]; y1[hh] = Y1[(size_t)g * 384 + c]; a0[hh] = AS[(size_t)g * 768 + c]; a1[hh] = AS[(size_t)g * 768 + 384 + c]; gg[hh] = Gt[(size_t)g * 384 + c]; }
#pragma unroll
    for (int hh = 0; hh < NH; ++hh) { const int c = hh * 64 + lane;
      float rkv[3];
#pragma unroll
      for (int q = 0; q < 3; ++q) { const int col = q * 384 + c; rkv[q] = bf2f(xu[hh][q][1]) * cw[1152 + col] + ml * bf2f(xu[hh][q][0]) * cw[col] + mr * bf2f(xu[hh][q][2]) * cw[2 * 1152 + col]; }
      const float y = bf2f(y0[hh]) + bf2f(y1[hh]);
      const float mu = wave_sum(y) * (1.f / 64.f); const float dv = y - mu; const float var = wave_sum(dv * dv) * (1.f / 64.f);
      const float yn = dv * rsqrtf(var + GN_EPS) * lw[c] + lb[c];
      const float al0 = bf2f(a0[hh]), al1 = bf2f(a1[hh]); const float ka = k_a[c];
      const float kd0 = rkv[1] * (1.f + (al0 - 1.f) * ka), kd1 = rkv[1] * (1.f + (al1 - 1.f) * ka);
      const float bonus = wave_sum(rkv[0] * (kd0 + kd1) * r_k[c]);
      const float o = (yn + bonus * rkv[2]) * bf2f(gg[hh]);
      MC[(size_t)g * DM + c] = f2bf(o); }
  }
}

DI void n2_pass(const Ctx& C, int l, bool with_ctx) {
  const int gw = C.bid * NWAVES + C.wave, NGW = C.G * NWAVES, lane = C.lane;
  const bf16_t* O = (const bf16_t*)(C.ws + WS_R1); bf16_t* TN = (bf16_t*)(C.ws + WS_R2); float* AFF = (float*)(C.ws + WS_AFF); int* SLOT = (int*)(C.ws + WS_SLOT);
  LAS float* wr = (LAS float*)C.lds; const float* wrg = inp(C, 28) + (size_t)l * DM * NEXP;
  for (int i = C.tid; i < DM * NEXP; i += NTHREADS) wr[(i & 15) * DM + (i >> 4)] = wrg[i];
  __syncthreads();
  f32x4 vn[4]; u32x2 on[4];
#define N2_LOAD(gg) do { const f32x4* xr_ = (const f32x4*)(l == 0 ? in_row(C, gg) : xs_row(C, gg)) + lane; const u32x2* or_ = (const u32x2*)(O + (size_t)(gg) * DM) + lane; \
    _Pragma("unroll") for (int j = 0; j < 4; ++j) { vn[j] = xr_[64 * j]; on[j] = or_[64 * j]; } } while (0)
  if (gw < TT) N2_LOAD(gw);
  for (int g = gw; g < TT; g += NGW) {
    const int mr = mod_row(g);
    f32x4 v[4], o[4]; float s = 0.f;
#pragma unroll
    for (int j = 0; j < 4; ++j) { v[j] = vn[j]; const u32x2 w = on[j]; o[j] = (f32x4){bflo(w.x), bfhi(w.x), bflo(w.y), bfhi(w.y)};
      s += (o[j].x * o[j].x + o[j].y * o[j].y) + (o[j].z * o[j].z + o[j].w * o[j].w); }
    const bool skip = (mr == 4 && !with_ctx);
    f32x4 a2[4], g7[4], a3[4], a4[4], g8[4];
    if (!skip) { const f32x4* m2 = (const f32x4*)modv(C, l, mr, 2) + lane; const f32x4* gp = (const f32x4*)(inp(C, 7) + l * DM) + lane;
      const f32x4* m3 = (const f32x4*)modv(C, l, mr, 3) + lane; const f32x4* m4 = (const f32x4*)modv(C, l, mr, 4) + lane; const f32x4* gq = (const f32x4*)(inp(C, 8) + l * DM) + lane;
#pragma unroll
      for (int j = 0; j < 4; ++j) { a2[j] = m2[64 * j]; g7[j] = gp[64 * j]; a3[j] = m3[64 * j]; a4[j] = m4[64 * j]; g8[j] = gq[64 * j]; } }
    if (g + NGW < TT) N2_LOAD(g + NGW);
    if (skip) continue;
    float rstd = rsqrtf(wave_sum(s) * (1.f / DM) + NORM_EPS);
    { f32x4* xo = (f32x4*)xs_row(C, g) + lane;
      s = 0.f;
#pragma unroll
      for (int j = 0; j < 4; ++j) { v[j] = v[j] + a2[j] * (o[j] * rstd * g7[j]); xo[64 * j] = v[j]; s += (v[j].x * v[j].x + v[j].y * v[j].y) + (v[j].z * v[j].z + v[j].w * v[j].w); } }
    rstd = rsqrtf(wave_sum(s) * (1.f / DM) + NORM_EPS);
    u32x2* to = (u32x2*)(TN + (size_t)g * DM) + lane;
    float lg[16];
#pragma unroll
    for (int e = 0; e < 16; ++e) lg[e] = 0.f;
#pragma unroll
    for (int j = 0; j < 4; ++j) { const f32x4 t = v[j] * rstd * g8[j] * (a4[j] + 1.0f) + a3[j]; u32x2 w; w.x = cvtpk(t.x, t.y); w.y = cvtpk(t.z, t.w); to[64 * j] = w;
#pragma unroll
      for (int e = 0; e < 16; ++e) { const f32x4 ww = *(const LAS f32x4*)(wr + e * DM + 256 * j + 4 * lane); lg[e] += (t.x * ww.x + t.y * ww.y) + (t.z * ww.z + t.w * ww.w); if ((e & 3) == 3) asm volatile("" ::: "memory"); } }
    float mx = -1e30f;
#pragma unroll
    for (int e = 0; e < 16; ++e) { lg[e] = wave_sum(lg[e]); mx = fmaxf(mx, lg[e]); }
    float den = 0.f;
#pragma unroll
    for (int e = 0; e < 16; ++e) { lg[e] = __expf(lg[e] - mx); den += lg[e]; }
    const float inv = 1.f / den;
    float mine = 0.f;
#pragma unroll
    for (int e = 0; e < 16; ++e) mine = (lane == e) ? lg[e] * inv : mine;
    if (lane < 16) { AFF[(size_t)g * 16 + lane] = mine; SLOT[(size_t)g * 16 + lane] = -1; }
  }
#undef N2_LOAD
  __syncthreads();
}

DI void topk_problem(const Ctx& C, int q) {
  const bool isctx = q >= 64; const int qq = q & 63, b = qq >> 4, e = qq & 15;
  const int n = isctx ? CTX : SEQ, cap = isctx ? 32 : 1024; const int g0 = b * PP + (isctx ? 0 : CTX);
  const float* AFF = (const float*)(C.ws + WS_AFF);
  int* IDX = (int*)(C.ws + WS_IDX); int* SLOT = (int*)(C.ws + WS_SLOT);
  const int obase = e * RPE + (isctx ? 4096 + b * 32 : b * 1024);
  LAS unsigned* keys = (LAS unsigned*)C.lds; LAS unsigned* hist = keys + 8192; LAS unsigned* ctl = hist + 256;
  for (int i = C.tid; i < n; i += NTHREADS) keys[i] = __float_as_uint(AFF[(size_t)(g0 + i) * 16 + e]);
  if (C.tid == 0) { ctl[0] = 0u; ctl[1] = (unsigned)cap; ctl[2] = 0u; ctl[3] = 0u; }
  unsigned mask = 0u;
  for (int pass = 0; pass < 4; ++pass) { const int shift = 24 - 8 * pass;
    if (C.tid < 256) hist[C.tid] = 0u;
    __syncthreads();
    const unsigned prefix = ctl[0];
    for (int i = C.tid; i < n; i += NTHREADS) { const unsigned k = keys[i]; if ((k & mask) == prefix) atomicAdd((unsigned*)&hist[(k >> shift) & 255u], 1u); }
    __syncthreads();
    if (C.tid < 256) { const unsigned rem = ctl[1]; unsigned sfx = 0u;
      for (int b2 = 255; b2 >= C.tid; --b2) sfx += hist[b2];
      const unsigned nxt = sfx - hist[C.tid];
      if (sfx >= rem && nxt < rem) { ctl[0] = prefix | ((unsigned)C.tid << shift); ctl[1] = rem - nxt; } }
    mask |= 255u << shift;
    __syncthreads();
  }
  const unsigned thr = ctl[0], need_eq = ctl[1];
  for (int i = C.tid; i < n; i += NTHREADS) { const unsigned k = keys[i];
    int slot = -1;
    if (k > thr) slot = (int)atomicAdd((unsigned*)&ctl[2], 1u);
    else if (k == thr) { const unsigned t = atomicAdd((unsigned*)&ctl[3], 1u); if (t < need_eq) slot = cap - (int)need_eq + (int)t; }
    if (slot >= 0) { IDX[obase + slot] = g0 + i; SLOT[(size_t)(g0 + i) * 16 + e] = obase + slot; } }
  __syncthreads();
}
#define MFMA32(a, b, c) __builtin_amdgcn_mfma_f32_32x32x16_bf16((a), (b), (c), 0, 0, 0)
constexpr int AT_KROW = 208, AT_VROW = 144, AT_KBUF = 64 * AT_KROW, AT_VBUF = 64 * AT_VROW;
constexpr int AT_K0 = 0, AT_V0 = 2 * AT_KBUF, AT_OST = AT_V0 + 2 * AT_VBUF, AT_OROW = 144;
constexpr float AT_THR = 8.0f;
DI float max3f(float a, float b, float c) { float r; asm("v_max3_f32 %0, %1, %2, %3" : "=v"(r) : "v"(a), "v"(b), "v"(c)); return r; }

DI void attn_unit(const Ctx& C, int b, int h, int pq0, int nkt) {
  const bf16_t* QB = (const bf16_t*)(C.ws + WS_R2); const bf16_t* KBp = QB + (size_t)NB * NH * PP * 96; const bf16_t* VTp = KBp + (size_t)NB * NH * PP * 96;
  const bf16_t* Qh = QB + (size_t)(b * NH + h) * PP * 96; const bf16_t* Kh = KBp + (size_t)(b * NH + h) * PP * 96; const bf16_t* Vh = VTp + (size_t)(b * NH + h) * 64 * PP;
  bf16_t* MC = (bf16_t*)(C.ws + WS_R6);
  const int tid = C.tid, lane = C.lane, wave = C.wave, r32 = lane & 31, hi = lane >> 5;
  LAS unsigned char* lds = C.lds;
  bf16x8 qf[6];
  { const bf16_t* qrow = Qh + (size_t)(pq0 + wave * 32 + r32) * 96 + hi * 8;
#pragma unroll
    for (int d0 = 0; d0 < 6; ++d0) qf[d0] = *(const bf16x8*)(qrow + d0 * 16); }
  const int k0row = tid / 12, k0c = tid % 12, k1row = (tid + 512) / 12, k1c = (tid + 512) % 12;
  const unsigned k0dst = k0row * AT_KROW + k0c * 16, k1dst = k1row * AT_KROW + k1c * 16, vdst = (tid >> 3) * AT_VROW + (tid & 7) * 16;
  const bf16_t* vsrc = Vh + (size_t)(tid >> 3) * PP + (tid & 7) * 8;
  u32x4 sk0, sk1 = (u32x4){0u, 0u, 0u, 0u}, sv;
#define AT_LOAD(kt) do { const char* kb_ = (const char*)(Kh + (size_t)(kt) * 64 * 96); sk0 = *(const u32x4*)(kb_ + tid * 16); if (tid < 256) sk1 = *(const u32x4*)(kb_ + (tid + 512) * 16); sv = *(const u32x4*)(vsrc + (kt) * 64); } while (0)
#define AT_STORE(buf) do { *(LAS u32x4*)(lds + AT_K0 + (buf) * AT_KBUF + k0dst) = sk0; if (tid < 256) *(LAS u32x4*)(lds + AT_K0 + (buf) * AT_KBUF + k1dst) = sk1; *(LAS u32x4*)(lds + AT_V0 + (buf) * AT_VBUF + vdst) = sv; } while (0)
  AT_LOAD(0); AT_STORE(0);
  __syncthreads();
  f32x16 negm, o0, o1;
#pragma unroll
  for (int i = 0; i < 16; ++i) { negm[i] = 0.f; o0[i] = 0.f; o1[i] = 0.f; }
  float mhat = 0.f, lsum = 0.f;
  for (int kt = 0; kt < nkt; ++kt) {
    const int buf = kt & 1;
    if (kt + 1 < nkt) AT_LOAD(kt + 1);
    const LAS unsigned char* kb = lds + AT_K0 + buf * AT_KBUF + r32 * AT_KROW + hi * 16;
    const LAS unsigned char* vb = lds + AT_V0 + buf * AT_VBUF + r32 * AT_VROW + hi * 16;
    f32x16 p0, p1;
    bf16x8 kf[12];
#pragma unroll
    for (int d0 = 0; d0 < 6; ++d0) { kf[2 * d0] = *(const LAS bf16x8*)(kb + d0 * 32); kf[2 * d0 + 1] = *(const LAS bf16x8*)(kb + 32 * AT_KROW + d0 * 32); }
#pragma unroll
    for (int d0 = 0; d0 < 6; ++d0) {
      if (d0 == 0) { p0 = MFMA32(kf[0], qf[0], negm); p1 = MFMA32(kf[1], qf[0], negm); } else { p0 = MFMA32(kf[2 * d0], qf[d0], p0); p1 = MFMA32(kf[2 * d0 + 1], qf[d0], p1); } }
    bf16x8 vf[8];
#pragma unroll
    for (int s_ = 0; s_ < 4; ++s_) { vf[2 * s_] = *(const LAS bf16x8*)(vb + s_ * 32); vf[2 * s_ + 1] = *(const LAS bf16x8*)(vb + 32 * AT_VROW + s_ * 32); }
    asm volatile("s_nop 15\n\ts_nop 7" : "+v"(p0), "+v"(p1));
    float rm;
    { float a_ = max3f(p0[0], p0[1], p1[0]), b_ = max3f(p0[2], p0[3], p1[1]); a_ = max3f(a_, p1[2], p1[3]);
#pragma unroll
      for (int r = 4; r < 16; r += 4) { a_ = max3f(a_, p0[r], p0[r + 1]); b_ = max3f(b_, p0[r + 2], p0[r + 3]); a_ = max3f(a_, p1[r], p1[r + 1]); b_ = max3f(b_, p1[r + 2], p1[r + 3]); }
      rm = max3f(a_, b_, b_); }
    rm = half_max(rm);
    if (kt == 0 || __any(rm > AT_THR)) {
      const float dl = (kt == 0) ? rm : fmaxf(rm, 0.f);
      mhat += dl; const float f = (kt == 0) ? 1.f : __builtin_amdgcn_exp2f(-dl); lsum *= f;
#pragma unroll
      for (int i = 0; i < 16; ++i) { p0[i] -= dl; p1[i] -= dl; o0[i] *= f; o1[i] *= f; negm[i] = -mhat; }
    }
    float ps = 0.f;
#pragma unroll
    for (int i = 0; i < 16; ++i) { p0[i] = __builtin_amdgcn_exp2f(p0[i]); p1[i] = __builtin_amdgcn_exp2f(p1[i]); ps += p0[i] + p1[i]; }
    lsum += ps;
    u32x4 w0, w1, w2, w3;
    w0 = (u32x4){cvtpk(p0[0], p0[1]), cvtpk(p0[2], p0[3]), cvtpk(p0[4], p0[5]), cvtpk(p0[6], p0[7])};
    w1 = (u32x4){cvtpk(p0[8], p0[9]), cvtpk(p0[10], p0[11]), cvtpk(p0[12], p0[13]), cvtpk(p0[14], p0[15])};
    w2 = (u32x4){cvtpk(p1[0], p1[1]), cvtpk(p1[2], p1[3]), cvtpk(p1[4], p1[5]), cvtpk(p1[6], p1[7])};
    w3 = (u32x4){cvtpk(p1[8], p1[9]), cvtpk(p1[10], p1[11]), cvtpk(p1[12], p1[13]), cvtpk(p1[14], p1[15])};
    const bf16x8 pf0 = __builtin_bit_cast(bf16x8, w0), pf1 = __builtin_bit_cast(bf16x8, w1), pf2 = __builtin_bit_cast(bf16x8, w2), pf3 = __builtin_bit_cast(bf16x8, w3);
#define AT_PV(s, pf) do { o0 = MFMA32(vf[2 * (s)], pf, o0); o1 = MFMA32(vf[2 * (s) + 1], pf, o1); } while (0)
    AT_PV(0, pf0); AT_PV(1, pf1); AT_PV(2, pf2); AT_PV(3, pf3);
#undef AT_PV
    if (kt + 1 < nkt) AT_STORE(buf ^ 1);
    __syncthreads();
  }
#undef AT_LOAD
#undef AT_STORE
  lsum = half_sum(lsum);
  const float inv = 1.f / lsum;
  LAS bf16_t* stg = (LAS bf16_t*)(lds + AT_OST + wave * 32 * AT_OROW);
#pragma unroll
  for (int i = 0; i < 16; ++i) { const int d = (i & 3) + 8 * (i >> 2) + 4 * hi;
    stg[r32 * (AT_OROW / 2) + d] = f2bf(o0[i] * inv); stg[r32 * (AT_OROW / 2) + 32 + d] = f2bf(o1[i] * inv); }
  asm volatile("s_waitcnt lgkmcnt(0)" ::: "memory");
#pragma unroll
  for (int i = 0; i < 4; ++i) { const int piece = i * 64 + lane, row = piece >> 3, c = piece & 7;
    const u32x4 v = *(const LAS u32x4*)((const LAS unsigned char*)stg + row * AT_OROW + c * 16);
    *(u32x4*)(MC + (size_t)(b * PP + pq0 + wave * 32 + row) * DM + 384 + h * 64 + c * 8) = v; }
  __syncthreads();
}

constexpr int SC_CH = 32;
DI int scan_pos(int s, int d) { return d == 0 ? s : (s < CTX ? CTX - 1 - s : (PP - 1) - (s - CTX)); }
DI void scan_unit(const Ctx& C, int l, int unit) {
  const int chain = unit >> 1, half = unit & 1;
  const int b = chain / 12, h = (chain >> 1) % 6, d = chain & 1;
  const bf16_t* U = (const bf16_t*)(C.ws + WS_R1);
  const bf16_t* EW = (const bf16_t*)(C.ws + WS_R3); const bf16_t* AS = EW + (size_t)TT * 768;
  bf16_t* Y = (bf16_t*)(C.ws + WS_R5) + (size_t)d * TT * 384;
  const float* cw = inp(C, 12) + (size_t)l * 3 * 1152; const float* k_k = inp(C, 18) + l * 384; const float* k_a = inp(C, 19) + l * 384;
  const int lane = C.lane, wave = C.wave;
  LAS float* opsb = (LAS float*)C.lds;
  LAS float* ybuf = opsb + 2 * SC_CH * 384;
  constexpr int NCH = PP / SC_CH;
  if (wave >= 4) {
    const int pw = wave - 4;
    const int c = h * 64 + lane;
    const float cwr0 = cw[c], cwr1 = cw[1152 + c], cwr2 = cw[2304 + c];
    const float cwk0 = cw[384 + c], cwk1 = cw[1152 + 384 + c], cwk2 = cw[2304 + 384 + c];
    const float cwv0 = cw[768 + c], cwv1 = cw[1152 + 768 + c], cwv2 = cw[2304 + 768 + c];
    const float kkc = k_k[c], kac = k_a[c];
    for (int chunk = -1; chunk < NCH; ++chunk) {
      if (chunk >= 1) { const int cb = (chunk - 1) & 1;
#pragma unroll
        for (int i = 0; i < 4; ++i) { const int sl = pw * 8 + 2 * i + (lane >> 5), rw = lane & 31; const int p = scan_pos((chunk - 1) * SC_CH + sl, d);
          Y[(size_t)(b * PP + p) * 384 + h * 64 + half * 32 + rw] = f2bf(ybuf[(cb * SC_CH + sl) * 32 + rw]); } }
      if (chunk + 1 < NCH) { const int nb = (chunk + 1) & 1; const int s0 = (chunk + 1) * SC_CH;
#pragma unroll
        for (int hf = 0; hf < 2; ++hf) {
          unsigned short ur[4][3], uk[4][3], uv[4][3], uew[4], uas[4]; float ml[4], mr[4];
#pragma unroll
          for (int i = 0; i < 4; ++i) { const int sl = pw * 8 + hf * 4 + i; const int p = scan_pos(s0 + sl, d); const int g = b * PP + p;
            const bool hasl = (p != 0 && p != CTX), hasr = (p != CTX - 1 && p != PP - 1);
            ml[i] = hasl ? 1.f : 0.f; mr[i] = hasr ? 1.f : 0.f;
            const bf16_t* u0 = U + (size_t)g * UW + c; const bf16_t* ul = hasl ? u0 - UW : u0; const bf16_t* urr = hasr ? u0 + UW : u0;
            ur[i][0] = ul[0]; ur[i][1] = u0[0]; ur[i][2] = urr[0];
            uk[i][0] = ul[384]; uk[i][1] = u0[384]; uk[i][2] = urr[384];
            uv[i][0] = ul[768]; uv[i][1] = u0[768]; uv[i][2] = urr[768];
            uew[i] = EW[(size_t)g * 768 + d * 384 + c]; uas[i] = AS[(size_t)g * 768 + d * 384 + c]; }
#pragma unroll
          for (int i = 0; i < 4; ++i) { const int sl = pw * 8 + hf * 4 + i;
            const float r = bf2f(ur[i][1]) * cwr1 + ml[i] * bf2f(ur[i][0]) * cwr0 + mr[i] * bf2f(ur[i][2]) * cwr2;
            const float k = bf2f(uk[i][1]) * cwk1 + ml[i] * bf2f(uk[i][0]) * cwk0 + mr[i] * bf2f(uk[i][2]) * cwk2;
            const float v = bf2f(uv[i][1]) * cwv1 + ml[i] * bf2f(uv[i][0]) * cwv0 + mr[i] * bf2f(uv[i][2]) * cwv2;
            const float kr = k * kkc; const float nrm = sqrtf(wave_sum(kr * kr)); const float kk = kr / fmaxf(nrm, 1e-12f);
            const float ew = bf2f(uew[i]), a = bf2f(uas[i]);
            const float w = __expf(-ew); const float kd = k * (1.f + (a - 1.f) * kac);
            LAS float* o = opsb + (nb * SC_CH + sl) * 384 + lane;
            o[0] = r; o[64] = w; o[128] = kd; o[192] = v; o[256] = -kk; o[320] = kk * a; }
        } }
      __syncthreads();
    }
    { const int cb = (NCH - 1) & 1;
#pragma unroll
      for (int i = 0; i < 4; ++i) { const int sl = pw * 8 + 2 * i + (lane >> 5), rw = lane & 31; const int p = scan_pos((NCH - 1) * SC_CH + sl, d);
        Y[(size_t)(b * PP + p) * 384 + h * 64 + half * 32 + rw] = f2bf(ybuf[(cb * SC_CH + sl) * 32 + rw]); } }
  } else {
    const int rowl = wave * 8 + (lane >> 3), cg = lane & 7;
    const int vrow = half * 32 + rowl;
    f32x2 S[4];
#pragma unroll
    for (int j = 0; j < 4; ++j) S[j] = (f32x2){0.f, 0.f};
    __syncthreads();
    for (int chunk = 0; chunk < NCH; ++chunk) {
      const LAS float* ob = opsb + (chunk & 1) * SC_CH * 384;
      LAS float* yb = ybuf + (chunk & 1) * SC_CH * 32;
#define SC_LOADOPS(R0, R1, W0, W1, K0, K1, A0, A1, B0, B1, VV, slx) do { const LAS float* o_ = ob + (slx) * 384 + cg * 8; \
        R0 = *(const LAS f32x4*)(o_); R1 = *(const LAS f32x4*)(o_ + 4); W0 = *(const LAS f32x4*)(o_ + 64); W1 = *(const LAS f32x4*)(o_ + 68); \
        K0 = *(const LAS f32x4*)(o_ + 128); K1 = *(const LAS f32x4*)(o_ + 132); A0 = *(const LAS f32x4*)(o_ + 256); A1 = *(const LAS f32x4*)(o_ + 260); \
        B0 = *(const LAS f32x4*)(o_ + 320); B1 = *(const LAS f32x4*)(o_ + 324); VV = ob[(slx) * 384 + 192 + vrow]; } while (0)
#define SC_STEP(r0, r1, w0, w1, k0, k1, a0, a1, b0, b1, vv, YOUT) do { \
        f32x2 t = S[0] * (f32x2){a0.x, a0.y} + S[1] * (f32x2){a0.z, a0.w}; t = t + S[2] * (f32x2){a1.x, a1.y}; t = t + S[3] * (f32x2){a1.z, a1.w}; \
        float sa = t.x + t.y; \
        sa = dpp_add<0xB1>(sa); sa = dpp_add<0x4E>(sa); sa = dpp_add<0x141>(sa); \
        const f32x2 sa2 = (f32x2){sa, sa}, vv2 = (f32x2){vv, vv}; \
        S[0] = S[0] * (f32x2){w0.x, w0.y} + (sa2 * (f32x2){b0.x, b0.y} + vv2 * (f32x2){k0.x, k0.y}); \
        S[1] = S[1] * (f32x2){w0.z, w0.w} + (sa2 * (f32x2){b0.z, b0.w} + vv2 * (f32x2){k0.z, k0.w}); \
        S[2] = S[2] * (f32x2){w1.x, w1.y} + (sa2 * (f32x2){b1.x, b1.y} + vv2 * (f32x2){k1.x, k1.y}); \
        S[3] = S[3] * (f32x2){w1.z, w1.w} + (sa2 * (f32x2){b1.z, b1.w} + vv2 * (f32x2){k1.z, k1.w}); \
        f32x2 yy = S[0] * (f32x2){r0.x, r0.y} + S[1] * (f32x2){r0.z, r0.w}; yy = yy + S[2] * (f32x2){r1.x, r1.y}; yy = yy + S[3] * (f32x2){r1.z, r1.w}; \
        float y = yy.x + yy.y; \
        y = dpp_add<0xB1>(y); y = dpp_add<0x4E>(y); y = dpp_add<0x141>(y); YOUT = y; } while (0)
      f32x4 pr0, pr1, pw0, pw1, pk0, pk1, pa0, pa1, pb0, pb1; float pv;
      f32x4 qr0, qr1, qw0, qw1, qk0, qk1, qa0, qa1, qb0, qb1; float qv;
      SC_LOADOPS(pr0, pr1, pw0, pw1, pk0, pk1, pa0, pa1, pb0, pb1, pv, 0);
#pragma unroll 1
      for (int sg = 0; sg < SC_CH / 8; ++sg) {
        float ykeep = 0.f;
#pragma unroll
        for (int j = 0; j < 8; j += 2) { const int sl = sg * 8 + j; float y0, y1;
          SC_LOADOPS(qr0, qr1, qw0, qw1, qk0, qk1, qa0, qa1, qb0, qb1, qv, sl + 1);
          SC_STEP(pr0, pr1, pw0, pw1, pk0, pk1, pa0, pa1, pb0, pb1, pv, y0);
          SC_LOADOPS(pr0, pr1, pw0, pw1, pk0, pk1, pa0, pa1, pb0, pb1, pv, (sl + 2) & (SC_CH - 1));
          SC_STEP(qr0, qr1, qw0, qw1, qk0, qk1, qa0, qa1, qb0, qb1, qv, y1);
          ykeep = (cg == j) ? y0 : ykeep; ykeep = (cg == j + 1) ? y1 : ykeep; }
        yb[(sg * 8 + cg) * 32 + rowl] = ykeep;
      }
#undef SC_LOADOPS
#undef SC_STEP
      __syncthreads();
    }
  }
  __syncthreads();
}

DI void fft_unit(const Ctx& C, int seq, bool isctx) {
  const int N = isctx ? CTX : SEQ, logN = isctx ? 8 : 13, off = isctx ? 0 : CTX;
  const f32x2* src = (const f32x2*)(C.ws + WS_R4) + (size_t)seq * PP + off;
  const f32x2* TW = (const f32x2*)(C.ws + WS_TW);
  bf16_t* MC = (bf16_t*)(C.ws + WS_R6);
  LAS f32x2* x = (LAS f32x2*)C.lds;
  const int tid = C.tid;
  for (int i = tid; i < N; i += NTHREADS) x[i] = src[i];
  __syncthreads();
  const int twmul = SEQ / N;
  for (int s = 0; s < logN; ++s) { const int hb = logN - 1 - s, hh = 1 << hb;
    for (int j = tid; j < N / 2; j += NTHREADS) { const int blk = j >> hb, i = j & (hh - 1); const int i0 = (blk << (hb + 1)) + i, i1 = i0 + hh;
      const f32x2 a = x[i0], bb = x[i1]; const f32x2 tw = TW[(i << s) * twmul];
      const float dr = a.x - bb.x, di = a.y - bb.y;
      x[i0] = (f32x2){a.x + bb.x, a.y + bb.y}; x[i1] = (f32x2){dr * tw.x - di * tw.y, dr * tw.y + di * tw.x}; }
    __syncthreads(); }
  const float scale = rsqrtf(64.0f * (float)N);
  const int b = seq / 132, grp = (seq / 33) & 3, k2 = seq % 33;
  for (int pi = tid; pi < N; pi += NTHREADS) { const int k1 = (int)(__brev((unsigned)pi) >> (32 - logN));
    const bf16_t val = f2bf(x[pi].x * scale);
    MC[(size_t)(b * PP + off + k1) * DM + 768 + grp * 64 + k2] = val;
    if (k2 >= 1 && k2 <= 31) MC[(size_t)(b * PP + off + ((N - k1) & (N - 1))) * DM + 768 + grp * 64 + 64 - k2] = val; }
  __syncthreads();
}

constexpr int CK_ROW = 144, CK_SLOT = 64 * CK_ROW;
DI void ck_mma(f32x16& acc, const LAS unsigned char* A, int arow0, const LAS unsigned char* B, int brow0, int r32, int hi) {
  const LAS unsigned char* ap = A + (arow0 + r32) * CK_ROW + hi * 16; const LAS unsigned char* bp = B + (brow0 + r32) * CK_ROW + hi * 16;
#pragma unroll
  for (int kk = 0; kk < 4; ++kk) acc = MFMA32(*(const LAS bf16x8*)(ap + kk * 32), *(const LAS bf16x8*)(bp + kk * 32), acc);
}
DI void ck_store(const f32x16& acc, LAS unsigned char* Out, int arow0, int brow0, int r32, int hi) {
  LAS unsigned char* op = Out + (brow0 + r32) * CK_ROW + (arow0 + 4 * hi) * 2;
#pragma unroll
  for (int g = 0; g < 4; ++g) { u32x2 w; w.x = cvtpk(acc[4 * g], acc[4 * g + 1]); w.y = cvtpk(acc[4 * g + 2], acc[4 * g + 3]); *(LAS u32x2*)(op + g * 16) = w; }
}
#ifdef PROF_SEL
#define PROF_T0(k) unsigned long long pt0_##k = 0; if (PROF_SEL == (k)) pt0_##k = __builtin_amdgcn_s_memrealtime();
#define PROF_T1(k) if (PROF_SEL == (k) && chain == 0 && l == 0 && C.tid == PROF_TID) atomicAdd((unsigned*)(C.ws + WS_CTL) + 1024, (unsigned)(__builtin_amdgcn_s_memrealtime() - pt0_##k));
#else
#define PROF_T0(k)
#define PROF_T1(k)
#endif
#ifndef PROF_TID
#define PROF_TID 0
#endif
DI void scan_chain(const Ctx& C, int l, int chain) {
  PROF_T0(1)
  const int b = chain / 12, h = (chain >> 1) % 6, d = chain & 1;
  const bf16_t* U = (const bf16_t*)(C.ws + WS_R1);
  const bf16_t* EW = (const bf16_t*)(C.ws + WS_R3); const bf16_t* AS = EW + (size_t)TT * 768;
  bf16_t* Y = (bf16_t*)(C.ws + WS_R5) + (size_t)d * TT * 384;
  const float* cw = inp(C, 12) + (size_t)l * 3 * 1152; const float* k_k = inp(C, 18) + l * 384; const float* k_a = inp(C, 19) + l * 384;
  const int lane = C.lane, wave = C.wave, r32 = lane & 31, hi = lane >> 5;
  LAS unsigned char* L = C.lds;
#define SLOT(n) (L + (n) * CK_SLOT)
  LAS unsigned char* const sAT = SLOT(0); LAS unsigned char* const sRT = SLOT(1); LAS unsigned char* const sBT = SLOT(2); LAS unsigned char* const sKT = SLOT(3);
  LAS unsigned char* const sVT = SLOT(4); LAS unsigned char* const sBH = SLOT(5); LAS unsigned char* const sKH = SLOT(6); LAS unsigned char* const sSB = SLOT(7);
  LAS unsigned char* const sP0 = SLOT(8); LAS unsigned char* const sP0T = SLOT(9); LAS unsigned char* const sAAK = SLOT(10); LAS unsigned char* const sARB = SLOT(11);
  LAS unsigned char* const sARK = SLOT(12); LAS unsigned char* const sXa = SLOT(13); LAS unsigned char* const sXb = SLOT(14);
  LAS float* gamC = (LAS float*)SLOT(15); LAS float* wtot = gamC + 64;
  const int t4 = wave & 3, arow0 = (t4 >> 1) * 32, brow0 = (t4 & 1) * 32;
  const int hw = lane >> 5, q2 = (lane & 31) * 2, c0 = h * 64 + q2;
#define LD2(p_, o_) ((f32x2){(p_)[o_], (p_)[(o_) + 1]})
  const f32x2 cwr0 = LD2(cw, c0), cwr1 = LD2(cw, 1152 + c0), cwr2 = LD2(cw, 2304 + c0);
  const f32x2 cwk0 = LD2(cw, 384 + c0), cwk1 = LD2(cw, 1152 + 384 + c0), cwk2 = LD2(cw, 2304 + 384 + c0);
  const f32x2 cwv0 = LD2(cw, 768 + c0), cwv1 = LD2(cw, 1152 + 768 + c0), cwv2 = LD2(cw, 2304 + 768 + c0);
  const f32x2 kkc = LD2(k_k, c0), kac = LD2(k_a, c0);
#undef LD2
#define UNP(u_) ((f32x2){bflo(u_), bfhi(u_)})
  f32x16 xacc, sacc;
#pragma unroll
  for (int i = 0; i < 16; ++i) { xacc[i] = 0.f; sacc[i] = 0.f; }
  unsigned pr[6], pk[6], pv[6], pew[4], pas[4];
#define CK_PREFETCH(ci) do { const int p0w_ = scan_pos((ci) * 64 + wave * 8, d); const int sg_ = d == 0 ? 1 : -1; const int lo_ = p0w_ < CTX ? 0 : CTX, hi_ = p0w_ < CTX ? CTX - 1 : PP - 1; \
    const int p0h_ = p0w_ + sg_ * 4 * hw; \
    _Pragma("unroll") for (int q = 0; q < 6; ++q) { int pp_ = p0h_ + sg_ * (q - 1); pp_ = pp_ < lo_ ? lo_ : (pp_ > hi_ ? hi_ : pp_); const bf16_t* u_ = U + ((size_t)(b * PP + pp_) * UW + c0); \
      pr[q] = *(const unsigned*)(u_); pk[q] = *(const unsigned*)(u_ + 384); pv[q] = *(const unsigned*)(u_ + 768); } \
    _Pragma("unroll") for (int j = 0; j < 4; ++j) { const int pj_ = p0h_ + sg_ * j; const size_t o_ = (size_t)(b * PP + pj_) * 768 + d * 384 + c0; pew[j] = *(const unsigned*)(EW + o_); pas[j] = *(const unsigned*)(AS + o_); } } while (0)
  CK_PREFETCH(0);
  for (int ci = 0; ci < PP / 64; ++ci) {
    PROF_T0(2)
    PROF_T0(6)
    if (wave < 4) ck_store(sacc, sSB, arow0, brow0, r32, hi);
    f32x2 fr[4], fkd[4], fv[4], fkk[4], fal[4], flg[4];
    { const int p0w = scan_pos(ci * 64 + wave * 8, d); const int sg = d == 0 ? 1 : -1; const int lo = p0w < CTX ? 0 : CTX, hi_p = p0w < CTX ? CTX - 1 : PP - 1;
      const int p0h = p0w + sg * 4 * hw;
      f32x2 run = (f32x2){0.f, 0.f};
#pragma unroll
      for (int j = 0; j < 4; ++j) { const int pj = p0h + sg * j;
        const float ml = pj != lo ? 1.f : 0.f, mr = pj != hi_p ? 1.f : 0.f;
        const f32x2 rl = UNP(d == 0 ? pr[j] : pr[j + 2]), rr_ = UNP(d == 0 ? pr[j + 2] : pr[j]);
        const f32x2 kl = UNP(d == 0 ? pk[j] : pk[j + 2]), kr_ = UNP(d == 0 ? pk[j + 2] : pk[j]);
        const f32x2 vl = UNP(d == 0 ? pv[j] : pv[j + 2]), vr_ = UNP(d == 0 ? pv[j + 2] : pv[j]);
        const f32x2 r = UNP(pr[j + 1]) * cwr1 + (rl * cwr0) * ml + (rr_ * cwr2) * mr;
        const f32x2 k = UNP(pk[j + 1]) * cwk1 + (kl * cwk0) * ml + (kr_ * cwk2) * mr;
        const f32x2 v = UNP(pv[j + 1]) * cwv1 + (vl * cwv0) * ml + (vr_ * cwv2) * mr;
        const f32x2 kr = k * kkc;
        float x = kr.x * kr.x + kr.y * kr.y;
        x = dpp_add<0xB1>(x); x = dpp_add<0x4E>(x); x = dpp_add<0x141>(x); x = dpp_add<0x140>(x);
        const float t0 = rdlane(x, 0) + rdlane(x, 16), t1 = rdlane(x, 32) + rdlane(x, 48);
        const f32x2 kk = kr * __builtin_amdgcn_rsqf(fmaxf(hw ? t1 : t0, 1e-24f));
        const f32x2 al = UNP(pas[j]);
        run = run - UNP(pew[j]);
        fr[j] = r; fkd[j] = k * ((al - 1.f) * kac + 1.f); fv[j] = v; fkk[j] = kk; fal[j] = al; flg[j] = run; }
      *(LAS f32x2*)(wtot + (wave * 2 + hw) * 64 + q2) = run; }
    if (ci > 0) { const int s_ = C.tid >> 3, pc_ = C.tid & 7; const int p_ = scan_pos((ci - 1) * 64 + s_, d);
      *(u32x4*)(Y + (size_t)(b * PP + p_) * 384 + h * 64 + pc_ * 8) = *(const LAS u32x4*)(SLOT(8) + s_ * CK_ROW + pc_ * 16); }
    if (ci + 1 < PP / 64) CK_PREFETCH(ci + 1);
    __syncthreads();
    PROF_T1(6)
    PROF_T0(7)
    { f32x2 off = (f32x2){0.f, 0.f}, tot = (f32x2){0.f, 0.f}; const int seg = wave * 2 + hw;
#pragma unroll
      for (int w2 = 0; w2 < 16; ++w2) { const f32x2 t = *(const LAS f32x2*)(wtot + w2 * 64 + q2); off = off + ((w2 < seg) ? t : (f32x2){0.f, 0.f}); tot = tot + t; }
      const f32x2 eTot = (f32x2){__expf(tot.x), __expf(tot.y)};
      if (wave == 0 && hw == 0) *(LAS f32x2*)(gamC + q2) = eTot;
      f32x2 eGprev = (f32x2){__expf(off.x), __expf(off.y)};
      f32x2 tv[4], tbh[4], tkh[4];
      const int s0 = wave * 8 + hw * 4;
#pragma unroll
      for (int j = 0; j < 4; ++j) { const int s = s0 + j; const f32x2 Lc = off + flg[j];
        const f32x2 eG = (f32x2){__expf(Lc.x), __expf(Lc.y)}, eGp = eGprev, eGi = (f32x2){__builtin_amdgcn_rcpf(eG.x), __builtin_amdgcn_rcpf(eG.y)}, eGc = eTot * eGi; eGprev = eG;
        const f32x2 bb = fkk[j] * fal[j];
        const f32x2 xa = fkk[j] * eGp, xr = fr[j] * eG, xb = bb * eGi, xk = fkd[j] * eGi;
        *(LAS unsigned*)(sAT + s * CK_ROW + q2 * 2) = cvtpk(-xa.x, -xa.y);
        *(LAS unsigned*)(sRT + s * CK_ROW + q2 * 2) = cvtpk(xr.x, xr.y);
        *(LAS unsigned*)(sBT + s * CK_ROW + q2 * 2) = cvtpk(xb.x, xb.y);
        *(LAS unsigned*)(sKT + s * CK_ROW + q2 * 2) = cvtpk(xk.x, xk.y);
        tv[j] = fv[j]; tbh[j] = bb * eGc; tkh[j] = fkd[j] * eGc; }
#define PK4(T, comp) ((u32x2){cvtpk(T[0].comp, T[1].comp), cvtpk(T[2].comp, T[3].comp)})
      *(LAS u32x2*)(sVT + q2 * CK_ROW + s0 * 2) = PK4(tv, x); *(LAS u32x2*)(sVT + (q2 + 1) * CK_ROW + s0 * 2) = PK4(tv, y);
      *(LAS u32x2*)(sBH + q2 * CK_ROW + s0 * 2) = PK4(tbh, x); *(LAS u32x2*)(sBH + (q2 + 1) * CK_ROW + s0 * 2) = PK4(tbh, y);
      *(LAS u32x2*)(sKH + q2 * CK_ROW + s0 * 2) = PK4(tkh, x); *(LAS u32x2*)(sKH + (q2 + 1) * CK_ROW + s0 * 2) = PK4(tkh, y);
#undef PK4
    }
    __syncthreads();
    PROF_T1(2)
    PROF_T1(7)
    PROF_T0(3)
    { f32x16 z;
#pragma unroll
      for (int i = 0; i < 16; ++i) z[i] = 0.f;
      const int bi = brow0 + r32;
      if (wave < 4) {
        f32x16 t = z, u = z, w = z;
        ck_mma(t, sBT, arow0, sAT, brow0, r32, hi);
        ck_mma(u, sAT, arow0, sBT, brow0, r32, hi);
        ck_mma(w, sBT, arow0, sRT, brow0, r32, hi);
#pragma unroll
        for (int i = 0; i < 16; ++i) { const int ai = arow0 + (i & 3) + 8 * (i >> 2) + 4 * hi; t[i] = ai < bi ? t[i] : 0.f; u[i] = bi < ai ? u[i] : 0.f; w[i] = ai <= bi ? w[i] : 0.f; }
        ck_store(t, sP0, arow0, brow0, r32, hi); ck_store(u, sP0T, arow0, brow0, r32, hi); ck_store(w, sARB, arow0, brow0, r32, hi);
      } else {
        f32x16 t = z, u = z;
        ck_mma(t, sKT, arow0, sAT, brow0, r32, hi);
        ck_mma(u, sKT, arow0, sRT, brow0, r32, hi);
#pragma unroll
        for (int i = 0; i < 16; ++i) { const int ai = arow0 + (i & 3) + 8 * (i >> 2) + 4 * hi; t[i] = ai < bi ? t[i] : 0.f; u[i] = ai <= bi ? u[i] : 0.f; }
        ck_store(t, sAAK, arow0, brow0, r32, hi); ck_store(u, sARK, arow0, brow0, r32, hi);
      } }
    __syncthreads();
    PROF_T1(3)
    PROF_T0(4)
#define CK_SQUARE(Pin, PTin, Pout, PTout, needT) do { f32x16 t_, u_; _Pragma("unroll") for (int i = 0; i < 16; ++i) { t_[i] = 0.f; u_[i] = 0.f; } \
      ck_mma(t_, PTin, arow0, Pin, brow0, r32, hi);                    \
      if (needT) ck_mma(u_, Pin, arow0, PTin, brow0, r32, hi);         \
      ck_store(t_, Pout, arow0, brow0, r32, hi); if (needT) ck_store(u_, PTout, arow0, brow0, r32, hi); } while (0)
#define CK_XSTEP(Pj, Xin, Xout) do { ck_mma(xacc, Pj, arow0, Xin, brow0, r32, hi); ck_store(xacc, Xout, arow0, brow0, r32, hi); } while (0)
    if (wave < 4) CK_SQUARE(sP0, sP0T, SLOT(2), SLOT(3), true);
    else {
#pragma unroll
      for (int i = 0; i < 16; ++i) xacc[i] = 0.f;
      ck_mma(xacc, sAT, arow0, sSB, brow0, r32, hi); ck_mma(xacc, sAAK, arow0, sVT, brow0, r32, hi); ck_store(xacc, sXa, arow0, brow0, r32, hi); }
    __syncthreads();
    if (wave < 4) CK_SQUARE(SLOT(2), SLOT(3), SLOT(0), SLOT(10), true); else CK_XSTEP(sP0, sXa, sXb);
    __syncthreads();
    if (wave < 4) CK_SQUARE(SLOT(0), SLOT(10), SLOT(8), SLOT(9), true); else CK_XSTEP(SLOT(2), sXb, sXa);
    __syncthreads();
    if (wave < 4) CK_SQUARE(SLOT(8), SLOT(9), SLOT(2), SLOT(3), true); else CK_XSTEP(SLOT(0), sXa, sXb);
    __syncthreads();
    if (wave < 4) CK_SQUARE(SLOT(2), SLOT(3), SLOT(0), SLOT(10), false); else CK_XSTEP(SLOT(8), sXb, sXa);
    __syncthreads();
    f32x16 yacc;
    if (wave >= 4) CK_XSTEP(SLOT(2), sXa, sXb);
    else {
#pragma unroll
      for (int i = 0; i < 16; ++i) yacc[i] = 0.f;
      ck_mma(yacc, sSB, arow0, sRT, brow0, r32, hi); ck_mma(yacc, sVT, arow0, sARK, brow0, r32, hi); }
    __syncthreads();
    if (wave >= 4) CK_XSTEP(SLOT(0), sXb, sXa);
    else {
#pragma unroll
      for (int i = 0; i < 16; ++i) sacc[i] *= gamC[arow0 + (i & 3) + 8 * (i >> 2) + 4 * hi];
      ck_mma(sacc, sKH, arow0, sVT, brow0, r32, hi); }
    __syncthreads();
    PROF_T1(4)
    PROF_T0(5)
    if (wave < 4) {
      ck_mma(yacc, sXa, arow0, sARB, brow0, r32, hi); ck_mma(sacc, sBH, arow0, sXa, brow0, r32, hi);
      ck_store(yacc, SLOT(8), arow0, brow0, r32, hi);
    }
    __syncthreads();
    PROF_T1(5)
  }
  PROF_T1(1)
  { const int s_ = C.tid >> 3, pc_ = C.tid & 7; const int p_ = scan_pos((PP / 64 - 1) * 64 + s_, d);
    *(u32x4*)(Y + (size_t)(b * PP + p_) * 384 + h * 64 + pc_ * 8) = *(const LAS u32x4*)(SLOT(8) + s_ * CK_ROW + pc_ * 16); }
  __syncthreads();
#undef SLOT
#undef UNP
#undef CK_PREFETCH
#undef CK_SQUARE
#undef CK_XSTEP
}
DI void mix_phase(const Ctx& C0, int l, bool with_ctx, int rep = 0) {
  unsigned* ctr = (unsigned*)(C0.ws + WS_CTL) + 64 * (1 + l + 2 * rep);
  LAS int* slot = (LAS int*)(C0.lds + 147456 - 64);
    const int n_scan = 48;
#ifdef REP_ATT
  const int n_att = 1536;
#else
  const int n_att = 768;
#endif
  const int n_attc = with_ctx ? 24 : 0, n_fft = 528, n_fftc = with_ctx ? 528 : 0;
  const int total = n_scan + n_att + n_attc + n_fft + n_fftc;
  for (;;) {
    __syncthreads();
    if (C0.tid == 0) *slot = (int)atomicAdd(ctr, 1u);
    __syncthreads();
    int it = __builtin_amdgcn_readfirstlane(*slot);
    if (it >= total) break;
    Ctx C = C0; { int t_ = C0.tid; asm volatile("" : "+v"(t_)); C.tid = t_; C.lane = t_ & 63; C.wave = __builtin_amdgcn_readfirstlane(t_ >> 6); GAS unsigned char* w_ = (GAS unsigned char*)C0.ws; asm volatile("" : "+s"(w_), "+s"(it)); C.ws = (unsigned char*)w_; }
    if (it < n_scan) { scan_chain(C, l, it); continue; } it -= n_scan;
    if (it < n_att) { const int bh = (it % 768) / 32, qb = it % 32; attn_unit(C, bh / NH, bh % NH, CTX + qb * 256, PP / 64); continue; } it -= n_att;
    if (it < n_attc) { attn_unit(C, it / NH, it % NH, 0, CTX / 64); continue; } it -= n_attc;
    if (it < n_fft) { fft_unit(C, it, false); continue; } it -= n_fft;
    fft_unit(C, it, true);
  }
  if (l == 0) { unsigned* ctr2 = (unsigned*)(C0.ws + WS_CTL) + 64 * 12;
    for (;;) { __syncthreads(); if (C0.tid == 0) *slot = (int)atomicAdd(ctr2, 1u); __syncthreads();
      const int vb = __builtin_amdgcn_readfirstlane(*slot); if (vb >= 256) break;
      phase0(C0, 1, vb, 256); __syncthreads(); } }
}
#define XB_TMO      128
#define XB_XCNT(j)  (256  + 64 * (j))
#define XB_XSUB(j)  (1280 + 64 * (j))
#define XB_XGEN(j)  (2304 + 64 * (j))
#define XB_TOP      3328
#define XB_TOPGEN   3392
#define XCD_BAR_WORDS 3456
#define XB_SPIN_CAP (1u << 18)

__device__ __forceinline__ unsigned xb_ld(unsigned* p)              { return __hip_atomic_load(p, __ATOMIC_RELAXED, __HIP_MEMORY_SCOPE_AGENT); }
__device__ __forceinline__ unsigned xb_add(unsigned* p, unsigned v) { return __hip_atomic_fetch_add(p, v, __ATOMIC_RELAXED, __HIP_MEMORY_SCOPE_AGENT); }
__device__ __forceinline__ unsigned xb_xcc_id() { return (unsigned)__builtin_amdgcn_s_getreg((3 << 11) | 20) & 0xFu; }
#define XB_SPIN(cond, bar) do { unsigned _sp = 0; while (cond) { __builtin_amdgcn_s_sleep(1); \
    if ((++_sp & 255u) == 0u) { if (xb_ld(&(bar)[XB_TMO])) break; if (_sp > XB_SPIN_CAP) { atomicAdd(&(bar)[XB_TMO], 1u); break; } } } } while (0)

struct XcdBarrier {
    unsigned* bar; unsigned x;
    volatile LAS unsigned* st;
};

__device__ __forceinline__ XcdBarrier xcd_barrier_post(unsigned* bar, volatile LAS unsigned* st) {
    XcdBarrier b; b.bar = bar; b.x = xb_xcc_id(); b.st = st;
    if (threadIdx.x == 0) (void)xb_add(&bar[XB_XCNT(b.x)], 1u);
    return b;
}
__device__ __forceinline__ void xcd_barrier_complete(unsigned* bar, unsigned x, unsigned& nloc, unsigned& nx) {
    const unsigned G = gridDim.x * gridDim.y * gridDim.z;
    unsigned sum, cnt, mine, sp = 0u;
    for (;;) {
        sum = 0u; cnt = 0u; mine = 0u;
#pragma unroll
        for (unsigned j = 0; j < 16; ++j) { const unsigned c = xb_ld(&bar[XB_XCNT(j)]); sum += c; cnt += (c > 0u) ? 1u : 0u; mine = (j == x) ? c : mine; }
        if (sum == G) break;
        __builtin_amdgcn_s_sleep(1);
        if ((++sp & 255u) == 0u) { if (xb_ld(&bar[XB_TMO])) break; if (sp > XB_SPIN_CAP) { atomicAdd(&bar[XB_TMO], 1u); break; } }
    }
    nloc = mine > 0u ? mine : 1u; nx = cnt > 0u ? cnt : 1u;
}

__device__ __forceinline__ void xcd_barrier(const XcdBarrier& b, const bool leader  ) {
    asm volatile("s_waitcnt vmcnt(0)" ::: "memory");
    __syncthreads();
    if (leader) {
        unsigned* bar = b.bar;
        __builtin_amdgcn_s_waitcnt(0);
        unsigned nloc = b.st[0], nx = b.st[1];
        if (nloc == 0u) { xcd_barrier_complete(bar, b.x, nloc, nx); b.st[0] = nloc; b.st[1] = nx; }
        const unsigned old = xb_add(&bar[XB_XSUB(b.x)], 1u);
        const unsigned gen = old / nloc;
        if (old + 1u == (gen + 1u) * nloc) {
            __builtin_amdgcn_fence(__ATOMIC_RELEASE, "agent");
            asm volatile("s_waitcnt vmcnt(0)" ::: "memory");
            const unsigned og = xb_add(&bar[XB_TOP], 1u);
            const unsigned tg = og / nx;
            if (og + 1u == (tg + 1u) * nx) xb_add(&bar[XB_TOPGEN], 1u);
            else XB_SPIN(xb_ld(&bar[XB_TOPGEN]) == tg, bar);
            __builtin_amdgcn_fence(__ATOMIC_ACQUIRE, "agent");
            xb_add(&bar[XB_XGEN(b.x)], 1u);
            asm volatile("s_waitcnt vmcnt(0)" ::: "memory");
        } else {
            XB_SPIN(xb_ld(&bar[XB_XGEN(b.x)]) == gen, bar);
            __builtin_amdgcn_fence(__ATOMIC_ACQUIRE, "agent");
            asm volatile("s_waitcnt vmcnt(0)" ::: "memory");
        }
    }
    __syncthreads();
}

constexpr int LDS_BYTES = 147456;
#ifndef REP_PHASE
#define REP_PHASE 0
#endif
#define NREP(k) ((REP_PHASE == (k)) ? 2 : 1)

#ifdef PROF_SEL
#define TPH0(k) unsigned long long tph_##k = 0; if (PROF_SEL == 100 + (k)) tph_##k = __builtin_amdgcn_s_memrealtime();
#define TPH1(k) if (PROF_SEL == 100 + (k) && blockIdx.x == 0 && threadIdx.x == 0) atomicAdd((unsigned*)(P.ws + WS_CTL) + 1024, (unsigned)(__builtin_amdgcn_s_memrealtime() - tph_##k));
#else
#define TPH0(k)
#define TPH1(k)
#endif
__global__ void __launch_bounds__(NTHREADS, 2) mk_fwd(Params P) {
  extern __shared__ __attribute__((aligned(16))) unsigned char lds_raw[];
  cg::grid_group grid = cg::this_grid();
  Ctx C; unsigned char* ws;
  const int wave0_ = __builtin_amdgcn_readfirstlane((int)threadIdx.x >> 6);
#define PH() do { const __attribute__((address_space(4))) char* kp_ = (const __attribute__((address_space(4))) char*)__builtin_amdgcn_kernarg_segment_ptr(); asm volatile("" : "+s"(kp_)); \
    unsigned m_ = ~0u; asm volatile("" : "+s"(m_)); int t_ = wave0_ * 64 + (int)__builtin_amdgcn_mbcnt_hi(m_, __builtin_amdgcn_mbcnt_lo(m_, 0u)); asm volatile("" : "+v"(t_));     \
    C.in = (const __attribute__((address_space(4))) cfptr*)kp_; C.out = (float*)(GAS float*)*(float* const __attribute__((address_space(4)))*)(kp_ + 256); C.ws = (unsigned char*)(GAS unsigned char*)*(unsigned char* const __attribute__((address_space(4)))*)(kp_ + 264); ws = C.ws; \
    C.lds = (LAS unsigned char*)lds_raw; C.ldsg = lds_raw; C.tid = t_; C.lane = t_ & 63; C.wave = __builtin_amdgcn_readfirstlane(t_ >> 6); int g_ = gridDim.x, b_ = blockIdx.x; asm volatile("" : "+s"(g_), "+s"(b_)); C.G = g_; C.bid = b_; } while (0)
#define R1 ((bf16_t*)(ws + WS_R1))
#define R2 ((bf16_t*)(ws + WS_R2))
#define R3 ((bf16_t*)(ws + WS_R3))
#define QB R2
#define KB (R2 + (size_t)NB * NH * PP * 96)
#define VT (R2 + (size_t)2 * NB * NH * PP * 96)
#define EW R3
#define AS (R3 + (size_t)TT * 768)
#define GG (R3 + (size_t)2 * TT * 768)
#define rq ((float*)(ws + WS_RSTD))
#define rkv (((float*)(ws + WS_RSTD)) + TT)
#define IDX ((int*)(ws + WS_IDX))

  { volatile LAS unsigned* xst = (volatile LAS unsigned*)((LAS unsigned char*)lds_raw + LDS_BYTES - 32);
    if (threadIdx.x == 0) { xst[0] = 0u; xst[1] = 0u; } }
  __syncthreads();
  (void)xcd_barrier_post((unsigned*)(P.ws + WS_CTL) + 4096, (volatile LAS unsigned*)((LAS unsigned char*)lds_raw + LDS_BYTES - 32));
#define GSYNC() do { XcdBarrier xb_; xb_.bar = (unsigned*)(C.ws + WS_CTL) + 4096; xb_.x = xb_xcc_id(); xb_.st = (volatile LAS unsigned*)((LAS unsigned char*)lds_raw + LDS_BYTES - 32); xcd_barrier(xb_, C.tid == 0); } while (0)
  { TPH0(12) for (int rep = 0; rep < NREP(12); ++rep) { PH(); phase0(C, 0, C.bid, C.G);
  grid.sync(); } TPH1(12) }
  PH(); phase0b(C, 0);
  GSYNC();
  for (int l = 0; l < 2; ++l) {
    const bool last = (l == 1);
    { TPH0(1) PH(); if (l == 0) norm_pass(C, 0, 0, 0); else norm_pass(C, 1, 1, 0);
    GSYNC(); TPH1(1) }
    { TPH0(2) for (int rep = 0; rep < NREP(2); ++rep) { PH(); { pg8::Gemm g{R2, (const bf16_t*)(ws + WS_WIN) + (size_t)l * UW * DM, DM, DM}; pg8::StaticOrder S; S.init(TT, UW, C.G, C.bid);
      EpiU E{R1, UW}; pg8::gemm_phase(C.lds, C.tid, g, S, E); }
    GSYNC(); } TPH1(2) }
    { TPH0(3) for (int rep = 0; rep < NREP(3); ++rep) { PH(); prep_a(C, l);
    GSYNC(); } TPH1(3) }
    { TPH0(4) for (int rep = 0; rep < NREP(4); ++rep) { PH(); { pg8::Gemm g{R1 + 1152, (const bf16_t*)(ws + WS_WLW) + (size_t)l * 1536 * 128, UW, 128}; pg8::StaticOrder S; S.init(TT, 1536, C.G, C.bid);
      EpiLW E{EW, AS, inp(C, 13) + l * 768, inp(C, 15) + l * 768}; pg8::gemm_phase(C.lds, C.tid, g, S, E); }
    PH(); { pg8::Gemm g{R1 + 1280, (const bf16_t*)(ws + WS_WG) + (size_t)l * 512 * 256, UW, 256}; pg8::StaticOrder S; S.init(TT, 512, C.G, C.bid);
      EpiG E{GG}; pg8::gemm_phase(C.lds, C.tid, g, S, E); }
    PH(); { pg8::Gemm g{R1 + 1536, (const bf16_t*)(ws + WS_WQ) + (size_t)l * 768 * 256, UW, 256}; pg8::StaticOrder S; S.init(TT, 768, C.G, C.bid);
      EpiQ E{QB, rq, (const float*)(ws + WS_ROPE)}; pg8::gemm_phase(C.lds, C.tid, g, S, E); }
    PH(); { pg8::Gemm g{R1 + 1792, (const bf16_t*)(ws + WS_WKV) + (size_t)l * 768 * 128, UW, 128}; pg8::StaticOrder S; S.init(TT, 768, C.G, C.bid);
      EpiKV E{KB, VT, rkv}; pg8::gemm_phase(C.lds, C.tid, g, S, E); }
    GSYNC(); } TPH1(4) }
    { TPH0(5) for (int rep = 0; rep < NREP(5); ++rep) { PH(); mix_phase(C, l, !last, rep);
    GSYNC(); } TPH1(5) }
    { TPH0(6) for (int rep = 0; rep < NREP(6); ++rep) { PH(); post_pass(C, l, !last);
    GSYNC(); } TPH1(6) }
    { TPH0(7) for (int rep = 0; rep < NREP(7); ++rep) { PH(); { pg8::Gemm g{(const bf16_t*)(ws + WS_R6), (const bf16_t*)(ws + WS_WOUT) + (size_t)l * DM * DM, DM, DM}; EpiPlain E{R1, DM};
      if (!last) { pg8::StaticOrder S; S.init(TT, DM, C.G, C.bid); pg8::gemm_phase(C.lds, C.tid, g, S, E); }
      else { LatentOrder S; S.init(DM, C.G, C.bid); pg8::gemm_phase(C.lds, C.tid, g, S, E); } }
    GSYNC(); } TPH1(7) }
    { TPH0(8) PH(); n2_pass(C, l, !last);
    GSYNC(); TPH1(8) }
    { TPH0(9) for (int rep = 0; rep < NREP(9); ++rep) { PH(); { const int nprob = last ? 64 : 128;
      { TPH0(20) if (C.bid < nprob) topk_problem(C, C.bid); TPH1(20) }
      const int gt = C.bid * NTHREADS + C.tid, NGT = C.G * NTHREADS;
      for (int i = gt; i < NEXP * 256; i += NGT) { const int e = i >> 8, r = i & 255; const int row = e * RPE + 4096 + r; if (last || r >= 128) IDX[row] = 0; }
      if (!last) phase0b(C, 1);
      { TPH0(21) convert_experts(C, l); TPH1(21) } }
    GSYNC(); } TPH1(9) }
    { TPH0(10) for (int rep = 0; rep < NREP(10); ++rep) { PH(); { pg8::Gemm g{R2, R3, DM, DM}; MoeOrder<true> S; S.init(last ? 16 : 17, 8, C.G, C.bid, IDX);
      EpiMoe1 E{(bf16_t*)(ws + WS_HID)}; pg8::gemm_phase(C.lds, C.tid, g, S, E); }
    GSYNC(); } TPH1(10) }
    { TPH0(11) for (int rep = 0; rep < NREP(11); ++rep) { PH(); { pg8::Gemm g{(const bf16_t*)(ws + WS_HID), R3 + (size_t)NEXP * 2048 * 1024, DM, DM}; MoeOrder<false> S; S.init(last ? 16 : 17, 4, C.G, C.bid, IDX);
      EpiMoe2 E{R1}; pg8::gemm_phase(C.lds, C.tid, g, S, E); }
    GSYNC(); } TPH1(11) }
  }
#ifdef EXTRA_SYNCS
  for (int i_ = 0; i_ < EXTRA_SYNCS; ++i_) GSYNC();
#endif
  { TPH0(13) PH(); norm_pass(C, 2, 0, 1); TPH1(13) }
#ifdef PROF_SEL
  GSYNC();
  if (blockIdx.x == 0 && threadIdx.x == 0) { const unsigned ticks = __hip_atomic_load((unsigned*)(P.ws + WS_CTL) + 1024, __ATOMIC_RELAXED, __HIP_MEMORY_SCOPE_AGENT) * PROF_MUL;
    const unsigned long long t0 = __builtin_amdgcn_s_memrealtime(); while (__builtin_amdgcn_s_memrealtime() - t0 < ticks) __builtin_amdgcn_s_sleep(4); }
#endif
}

extern "C" void kernel_launch(void* const* d_in, const int* in_sizes, int n_in, void* d_out, int out_size, void* d_ws, size_t ws_size, hipStream_t stream) {
  static int grid = 0;
  if (grid == 0) {
    int dev = 0, cus = 0, per_cu = 0;
    if (n_in != 32 || out_size != NB * SEQ * DM || ws_size < WS_END) { fprintf(stderr, "kernel_launch: unexpected shapes (n_in %d out %d ws %zu)\n", n_in, out_size, ws_size); grid = -1; return; }
    (void)hipGetDevice(&dev);
    (void)hipDeviceGetAttribute(&cus, hipDeviceAttributeMultiprocessorCount, dev);
    (void)hipFuncSetAttribute((const void*)mk_fwd, hipFuncAttributeMaxDynamicSharedMemorySize, LDS_BYTES);
    (void)hipOccupancyMaxActiveBlocksPerMultiprocessor(&per_cu, (const void*)mk_fwd, NTHREADS, LDS_BYTES);
    if (per_cu < 1) { fprintf(stderr, "kernel_launch: occupancy query reports %d blocks per CU\n", per_cu); grid = -1; return; }
    grid = cus;
  }
  if (grid < 0) return;
  (void)hipMemsetAsync((char*)d_ws + WS_CTL, 0, 32768, stream);
  Params p{};
  for (int i = 0; i < 32; ++i) p.in[i] = (const float*)d_in[i];
  p.out = (float*)d_out; p.ws = (unsigned char*)d_ws;
  void* args[] = {&p};
  hipError_t e = hipLaunchCooperativeKernel((const void*)mk_fwd, dim3(grid), dim3(NTHREADS), args, LDS_BYTES, stream);
  if (e != hipSuccess) fprintf(stderr, "cooperative launch failed: %s (grid %d)\n", hipGetErrorString(e), grid);
}
```

```cpp
#include <hip/hip_runtime.h>
#include <hip/hip_cooperative_groups.h>
#include <cstdio>
#include <cstdint>
namespace cg = cooperative_groups;

#define LAS __attribute__((address_space(3)))
typedef unsigned short bf16_t;
typedef short bf16x8 __attribute__((ext_vector_type(8)));
typedef float f32x4 __attribute__((ext_vector_type(4)));
typedef float f32x2 __attribute__((ext_vector_type(2)));
typedef float f32x16 __attribute__((ext_vector_type(16)));
typedef unsigned u32x4 __attribute__((ext_vector_type(4)));
typedef unsigned u32x2 __attribute__((ext_vector_type(2)));
typedef __bf16 bf16x2_t __attribute__((ext_vector_type(2)));
#define DI __device__ __forceinline__

constexpr int NB = 4, SEQ = 8192, CTX = 256, PP = SEQ + CTX  , TT = NB * PP  , DM = 1024;
constexpr int UW = 2304;
constexpr int HW2 = 1152;
constexpr int NH = 6;
constexpr int NEXP = 16, RPE = 4352  ;
constexpr float NORM_EPS = 1e-6f, GN_EPS = 64e-5f;
constexpr float QSCALE = 0.10206207261596577f * 1.4426950408889634f;
constexpr int NWAVES = 8, NTHREADS = 512;

DI unsigned cvtpk(float lo, float hi) { f32x2 v = {lo, hi}; bf16x2_t b = __builtin_convertvector(v, bf16x2_t); return __builtin_bit_cast(unsigned, b); }
DI bf16_t f2bf(float f) { return (bf16_t)(cvtpk(f, 0.f) & 0xffffu); }
DI float bf2f(bf16_t b) { return __uint_as_float(((unsigned)b) << 16); }
DI float bflo(unsigned u) { return __uint_as_float(u << 16); }
DI float bfhi(unsigned u) { return __uint_as_float(u & 0xffff0000u); }
template <int CTRL> DI float dpp_add(float x) { return x + __builtin_bit_cast(float, __builtin_amdgcn_update_dpp(0, __builtin_bit_cast(int, x), CTRL, 0xf, 0xf, true)); }
DI float rdlane(float x, int l) { return __builtin_bit_cast(float, __builtin_amdgcn_readlane(__builtin_bit_cast(int, x), l)); }
DI float wave_sum(float x) {
  x = dpp_add<0xB1>(x); x = dpp_add<0x4E>(x); x = dpp_add<0x141>(x); x = dpp_add<0x140>(x);
  return (rdlane(x, 0) + rdlane(x, 16)) + (rdlane(x, 32) + rdlane(x, 48));
}
DI float swz_xor16(float x) { return __builtin_bit_cast(float, __builtin_amdgcn_ds_swizzle(__builtin_bit_cast(int, x), 0x401F)); }
DI float swz_xor8(float x) { return __builtin_bit_cast(float, __builtin_amdgcn_ds_swizzle(__builtin_bit_cast(int, x), 0x201F)); }
DI float half_max(float x) { auto r = __builtin_amdgcn_permlane32_swap(__float_as_uint(x), __float_as_uint(x), false, false); float o; asm("v_max_f32_e32 %0, %1, %2" : "=v"(o) : "v"(__uint_as_float(r[0])), "v"(__uint_as_float(r[1]))); return o; }
DI float half_sum(float x) { auto r = __builtin_amdgcn_permlane32_swap(__float_as_uint(x), __float_as_uint(x), false, false); return __uint_as_float(r[0]) + __uint_as_float(r[1]); }
DI float sigmoidf_(float x) { return 1.f / (1.f + __expf(-x)); }

namespace pg8 {
constexpr int BM = 256, BK = 64, HALF = 128, HTB = HALF * BK * 2, STAGE_BYTES = 8 * HTB, NXCD = 8, WGM = 8;
__host__ __device__ __forceinline__ int lds_byte(int r, int c) { const int st = (r >> 4) * 2 + (c >> 5), rr = r & 15, cc = c & 31, ob = rr * 64 + cc * 2; return st * 1024 + (ob ^ (((ob >> 9) & 1) << 5)); }
__host__ __device__ __forceinline__ void stage_rc(int b, int& R, int& C) { const int st = b / 1024, sb = b % 1024, swz = sb ^ (((sb >> 9) & 1) << 5); R = (st >> 1) * 16 + swz / 64; C = (st & 1) * 32 + (swz % 64) / 2; }
__host__ __device__ __forceinline__ int perm32(int rho) { const int n = rho >> 4, i = rho & 15; return 8 * (i >> 2) + 4 * n + (i & 3); }

struct Unit { int pm, pn; };
struct Gemm { const bf16_t* A; const bf16_t* Bt; int lda; int K; };

struct StaticOrder {
  int nM, nN, nwg, G, c;
  static constexpr bool GATHER = false;
  __device__ void init(int M, int N, int G_, int c_) { nM = M / BM; nN = N / BM; nwg = nM * nN; G = G_; c = c_; }
  __device__ bool next(int i, Unit& u) const {
    const long L = (long)i * G + c; if (L >= nwg) return false;
    int wgid = (int)L; { const int q = nwg / NXCD, r = nwg % NXCD, xcd = wgid % NXCD, off = wgid / NXCD; wgid = (xcd < r ? xcd * (q + 1) : r * (q + 1) + (xcd - r) * q) + off; }
    const int nig = WGM * nN, gid = wgid / nig, fm = gid * WGM, gsz = (nM - fm) < WGM ? (nM - fm) : WGM;
    u.pm = fm + ((wgid % nig) % gsz); u.pn = (wgid % nig) / gsz; return true;
  }
  __device__ int arow(const Unit&, int) const { return 0; }
};

template <class Epi, class Sched>
__device__ __forceinline__ void gemm_phase(LAS unsigned char* lds, const int tid, const Gemm g, const Sched& S, const Epi& E) {
  const int wid = __builtin_amdgcn_readfirstlane(tid >> 6), lane = tid & 63, wr = wid >> 2, wc = wid & 3, fr = lane & 15, fq = lane >> 4;
  int K_ = g.K, lda_ = g.lda; asm volatile("" : "+s"(K_), "+s"(lda_));
  const int K = K_, nt = K / BK, lda = lda_;
  unsigned voffB[2]; int RA[2], CA[2];
#pragma unroll
  for (int i = 0; i < 2; ++i) { int R, C; stage_rc(tid * 16 + i * 8192, R, C); const int Rb = Epi::PERM ? ((R & ~31) + perm32(R & 31)) : R;
    RA[i] = R; CA[i] = C; voffB[i] = (unsigned)(Rb * K + C) * 2u; }
  const size_t kstep = (size_t)(BK * 2);
  const size_t hstepB = (size_t)HALF * K * 2, tstepB = 2 * hstepB;
  const size_t tstepA = (size_t)BM * lda * 2;
  const unsigned ldsw = (unsigned)wid * 1024u;
  const int aoff = lds_byte(wr * 64 + fr, fq * 8), boff = lds_byte(wc * 32 + fr, fq * 8);
#define PG8_SA(b, h) (((b) * 2 + (h)) * HTB)
#define PG8_SB(b, h) ((4 + (b) * 2 + (h)) * HTB)
#define PG8_STAGE(bufoff, gbase, voff) do { _Pragma("unroll") for (int _i = 0; _i < 2; ++_i) \
        __builtin_amdgcn_global_load_lds((const unsigned*)((const char*)(gbase) + (voff)[_i]), (LAS unsigned*)(lds + (bufoff) + ldsw + _i * 8192), 16, 0, 0); } while (0)
#define PG8_LDA(dst, b, h) do { _Pragma("unroll") for (int m = 0; m < 4; ++m) _Pragma("unroll") for (int k = 0; k < 2; ++k) dst[m][k] = *(const LAS bf16x8*)(lds + PG8_SA(b, h) + aoff + m * 2048 + k * 1024); } while (0)
#define PG8_LDB(dst, b, h) do { _Pragma("unroll") for (int n = 0; n < 2; ++n) _Pragma("unroll") for (int k = 0; k < 2; ++k) dst[n][k] = *(const LAS bf16x8*)(lds + PG8_SB(b, h) + boff + n * 2048 + k * 1024); } while (0)
#define PG8_MMA(ai, bj, At, Bt) do { __builtin_amdgcn_s_setprio(1); _Pragma("unroll") for (int m = 0; m < 4; ++m) _Pragma("unroll") for (int n = 0; n < 2; ++n) _Pragma("unroll") for (int k = 0; k < 2; ++k) \
        acc[ai][bj][m][n] = __builtin_amdgcn_mfma_f32_16x16x32_bf16(Bt[n][k], At[m][k], acc[ai][bj][m][n], 0, 0, 0); __builtin_amdgcn_s_setprio(0); } while (0)
#define PG8_WAIT_V(n) asm volatile("s_waitcnt vmcnt(" #n ")" ::: "memory")
#define PG8_WAIT_L(n) asm volatile("s_waitcnt lgkmcnt(" #n ")" ::: "memory")
#define PG8_BAR __builtin_amdgcn_s_barrier()
#define PG8_SCHED __builtin_amdgcn_sched_barrier(0)
#define PG8_OFFS(dst, u) do { _Pragma("unroll") for (int _h = 0; _h < 2; ++_h) _Pragma("unroll") for (int _i = 0; _i < 2; ++_i) \
        dst[_h][_i] = Sched::GATHER ? (unsigned)((size_t)S.arow(u, _h * HALF + RA[_i]) * lda + CA[_i]) * 2u : (unsigned)((_h * HALF + RA[_i]) * lda + CA[_i]) * 2u; } while (0)
  Unit cur, nxt; int ui = 0;
  if (!S.next(0, cur)) return;
  f32x4 acc[2][2][4][2];
#pragma unroll
  for (int a = 0; a < 2; ++a)
#pragma unroll
    for (int b = 0; b < 2; ++b)
#pragma unroll
      for (int m = 0; m < 4; ++m)
#pragma unroll
        for (int n = 0; n < 2; ++n) acc[a][b][m][n] = (f32x4){0.f, 0.f, 0.f, 0.f};
  bf16x8 At[4][2], B0[2][2], B1[2][2];
  unsigned oAc[2][2], oAn[2][2];
  PG8_OFFS(oAc, cur);
  const char* cA = (const char*)g.A + (Sched::GATHER ? (size_t)0 : (size_t)cur.pm * tstepA); const char* cB = (const char*)g.Bt + (size_t)cur.pn * tstepB;
  PG8_STAGE(PG8_SB(0, 0), cB, voffB); PG8_STAGE(PG8_SB(0, 1), cB + hstepB, voffB); PG8_STAGE(PG8_SA(0, 0), cA, oAc[0]); PG8_STAGE(PG8_SA(0, 1), cA, oAc[1]);
  if (wr == 1) PG8_BAR;
  PG8_WAIT_V(2); PG8_BAR;
  PG8_STAGE(PG8_SB(1, 0), cB + kstep, voffB); PG8_STAGE(PG8_SA(1, 0), cA + kstep, oAc[0]); PG8_STAGE(PG8_SB(1, 1), cB + hstepB + kstep, voffB);
  PG8_WAIT_V(6); PG8_BAR;
  for (;;) {
    const bool has_next = S.next(ui + 1, nxt);
    if (has_next) { PG8_OFFS(oAn, nxt); }
    else {
#pragma unroll
      for (int _h = 0; _h < 2; ++_h)
#pragma unroll
        for (int _i = 0; _i < 2; ++_i) oAn[_h][_i] = oAc[_h][_i];
    }
    const char* nA = has_next ? (const char*)g.A + (Sched::GATHER ? (size_t)0 : (size_t)nxt.pm * tstepA) : cA; const char* nB = has_next ? (const char*)g.Bt + (size_t)nxt.pn * tstepB : cB;
    for (int t = 0; t < nt; t += 2) {
      const bool last = (t == nt - 2);
      const char* a1 = cA + (size_t)(t + 1) * kstep;
      const char* a2 = last ? nA : cA + (size_t)(t + 2) * kstep; const char* b2 = last ? nB : cB + (size_t)(t + 2) * kstep;
      const char* a3 = a2 + kstep; const char* b3 = b2 + kstep;
      unsigned o2[2][2];
#pragma unroll
      for (int _h = 0; _h < 2; ++_h)
#pragma unroll
        for (int _i = 0; _i < 2; ++_i) o2[_h][_i] = last ? oAn[_h][_i] : oAc[_h][_i];
      PG8_LDB(B0, 0, 0); PG8_LDB(B1, 0, 1); PG8_SCHED; PG8_LDA(At, 0, 0); PG8_STAGE(PG8_SA(1, 1), a1, oAc[1]);
      PG8_WAIT_V(8); PG8_WAIT_L(0); PG8_BAR; PG8_MMA(0, 0, At, B0); PG8_MMA(0, 1, At, B1); PG8_BAR; PG8_SCHED;
      PG8_LDA(At, 0, 1); PG8_STAGE(PG8_SB(0, 0), b2, voffB); PG8_STAGE(PG8_SB(0, 1), b2 + hstepB, voffB); PG8_STAGE(PG8_SA(0, 0), a2, o2[0]);
      PG8_WAIT_V(8); PG8_WAIT_L(0); PG8_BAR; PG8_MMA(1, 0, At, B0); PG8_MMA(1, 1, At, B1); PG8_BAR; PG8_SCHED;
      PG8_LDB(B0, 1, 0); PG8_LDB(B1, 1, 1); PG8_SCHED; PG8_LDA(At, 1, 0); PG8_STAGE(PG8_SA(0, 1), a2, o2[1]);
      PG8_WAIT_V(8); PG8_WAIT_L(0); PG8_BAR; PG8_MMA(0, 0, At, B0); PG8_MMA(0, 1, At, B1); PG8_BAR; PG8_SCHED;
      PG8_LDA(At, 1, 1); PG8_STAGE(PG8_SB(1, 0), b3, voffB); PG8_STAGE(PG8_SB(1, 1), b3 + hstepB, voffB); PG8_STAGE(PG8_SA(1, 0), a3, o2[0]);
      PG8_WAIT_V(8); PG8_WAIT_L(0); PG8_BAR; PG8_MMA(1, 0, At, B0); PG8_MMA(1, 1, At, B1); PG8_BAR; PG8_SCHED;
    }
    if (wr == 0) PG8_BAR;
    E(acc, cur, wr, wc, fr, fq);
    if (!has_next) break;
#pragma unroll
    for (int a = 0; a < 2; ++a)
#pragma unroll
      for (int b = 0; b < 2; ++b)
#pragma unroll
        for (int m = 0; m < 4; ++m)
#pragma unroll
          for (int n = 0; n < 2; ++n) acc[a][b][m][n] = (f32x4){0.f, 0.f, 0.f, 0.f};
    cur = nxt; cA = nA; cB = nB; ++ui;
#pragma unroll
    for (int _h = 0; _h < 2; ++_h)
#pragma unroll
      for (int _i = 0; _i < 2; ++_i) oAc[_h][_i] = oAn[_h][_i];
    if (wr == 1) PG8_BAR;
  }
  PG8_WAIT_V(0);
  PG8_BAR;
#undef PG8_SA
#undef PG8_SB
#undef PG8_STAGE
#undef PG8_LDA
#undef PG8_LDB
#undef PG8_MMA
#undef PG8_WAIT_V
#undef PG8_WAIT_L
#undef PG8_BAR
#undef PG8_SCHED
#undef PG8_OFFS
}
}
using pg8::Unit;
struct EpiU {
  static constexpr bool PERM = true;
  bf16_t* RKV; bf16_t* REST;
  DI void operator()(const f32x4 (&acc)[2][2][4][2], const Unit& u, int wr, int wc, int fr, int fq) const {
    const int row0 = u.pm * 256 + wr * 64 + fr;
#pragma unroll
    for (int ai = 0; ai < 2; ++ai)
#pragma unroll
      for (int m = 0; m < 4; ++m) { const size_t ro = (size_t)(row0 + ai * 128 + m * 16) * HW2;
#pragma unroll
        for (int bj = 0; bj < 2; ++bj) { const int col = u.pn * 256 + bj * 128 + wc * 32 + 8 * fq;
          f32x4 v0 = acc[ai][bj][m][0], v1 = acc[ai][bj][m][1];
          if (col >= 1152 && col < 1216) {
#pragma unroll
            for (int j = 0; j < 4; ++j) { v0[j] = tanhf(v0[j]); v1[j] = tanhf(v1[j]); }
          } else if (col >= 1280 && col < 1536) {
#pragma unroll
            for (int j = 0; j < 4; ++j) { v0[j] = sigmoidf_(v0[j]); v1[j] = sigmoidf_(v1[j]); }
          }
          u32x4 w; w.x = cvtpk(v0[0], v0[1]); w.y = cvtpk(v0[2], v0[3]); w.z = cvtpk(v1[0], v1[1]); w.w = cvtpk(v1[2], v1[3]);
          *(u32x4*)((col < HW2 ? RKV + col : REST + (col - HW2)) + ro) = w; } }
  }
};
struct EpiPlain {
  static constexpr bool PERM = true;
  bf16_t* O; int ldc;
  DI void operator()(const f32x4 (&acc)[2][2][4][2], const Unit& u, int wr, int wc, int fr, int fq) const {
    const int row0 = u.pm * 256 + wr * 64 + fr;
#pragma unroll
    for (int ai = 0; ai < 2; ++ai)
#pragma unroll
      for (int m = 0; m < 4; ++m) { bf16_t* rowp = O + (size_t)(row0 + ai * 128 + m * 16) * ldc;
#pragma unroll
        for (int bj = 0; bj < 2; ++bj) { const int col = u.pn * 256 + bj * 128 + wc * 32 + 8 * fq;
          const f32x4 v0 = acc[ai][bj][m][0], v1 = acc[ai][bj][m][1];
          u32x4 w; w.x = cvtpk(v0[0], v0[1]); w.y = cvtpk(v0[2], v0[3]); w.z = cvtpk(v1[0], v1[1]); w.w = cvtpk(v1[2], v1[3]);
          *(u32x4*)(rowp + col) = w; } }
  }
};
struct EpiLW {
  static constexpr bool PERM = true;
  bf16_t* EW; bf16_t* AS; const float* w0; const float* a0;
  DI void operator()(const f32x4 (&acc)[2][2][4][2], const Unit& u, int wr, int wc, int fr, int fq) const {
    const int row0 = u.pm * 256 + wr * 64 + fr;
    const bool isw = u.pn < 3;
    bf16_t* O = isw ? EW : AS; const float* bias = isw ? w0 : a0; const float sc = isw ? 0.6065306597126334f : 1.f;
    const int cb = (isw ? u.pn : u.pn - 3) * 256;
#pragma unroll
    for (int bj = 0; bj < 2; ++bj) { const int col = cb + bj * 128 + wc * 32 + 8 * fq;
      const f32x4 b0 = *(const f32x4*)(bias + col), b1 = *(const f32x4*)(bias + col + 4);
#pragma unroll
      for (int ai = 0; ai < 2; ++ai)
#pragma unroll
        for (int m = 0; m < 4; ++m) { bf16_t* rowp = O + (size_t)(row0 + ai * 128 + m * 16) * 768;
          f32x4 v0 = acc[ai][bj][m][0] + b0, v1 = acc[ai][bj][m][1] + b1;
#pragma unroll
          for (int j = 0; j < 4; ++j) { v0[j] = sc * sigmoidf_(v0[j]); v1[j] = sc * sigmoidf_(v1[j]); }
          u32x4 w; w.x = cvtpk(v0[0], v0[1]); w.y = cvtpk(v0[2], v0[3]); w.z = cvtpk(v1[0], v1[1]); w.w = cvtpk(v1[2], v1[3]);
          *(u32x4*)(rowp + col) = w; asm volatile("" ::: "memory"); } }
  }
};
struct EpiG {
  static constexpr bool PERM = true;
  bf16_t* G;
  DI void operator()(const f32x4 (&acc)[2][2][4][2], const Unit& u, int wr, int wc, int fr, int fq) const {
    const int row0 = u.pm * 256 + wr * 64 + fr;
#pragma unroll
    for (int bj = 0; bj < 2; ++bj) { const int col = u.pn * 256 + bj * 128 + wc * 32 + 8 * fq;
      if (col < 384) {
#pragma unroll
        for (int ai = 0; ai < 2; ++ai)
#pragma unroll
          for (int m = 0; m < 4; ++m) { bf16_t* rowp = G + (size_t)(row0 + ai * 128 + m * 16) * 384;
            const f32x4 v0 = acc[ai][bj][m][0], v1 = acc[ai][bj][m][1];
            u32x4 w; w.x = cvtpk(v0[0], v0[1]); w.y = cvtpk(v0[2], v0[3]); w.z = cvtpk(v1[0], v1[1]); w.w = cvtpk(v1[2], v1[3]);
            *(u32x4*)(rowp + col) = w; } } }
  }
};
struct EpiQ {
  static constexpr bool PERM = true;
  bf16_t* QB; const float* rstd; const float* rope;
  DI void operator()(const f32x4 (&acc)[2][2][4][2], const Unit& u, int wr, int wc, int fr, int fq) const {
    const int row0 = u.pm * 256 + wr * 64 + fr;
    const int b = (u.pm * 256) / PP;
#pragma unroll
    for (int bj = 0; bj < 2; ++bj) { const int col = u.pn * 256 + bj * 128 + wc * 32 + 8 * fq;
      const int hh = col / 96, dim = col - hh * 96;
      const bool isrope = dim >= 64;
#pragma unroll
      for (int ai = 0; ai < 2; ++ai)
#pragma unroll
        for (int m = 0; m < 4; ++m) { const int g = row0 + ai * 128 + m * 16; const int p = g - b * PP;
          const float s = rstd[g] * QSCALE;
          float v[8];
#pragma unroll
          for (int j = 0; j < 4; ++j) { v[j] = acc[ai][bj][m][0][j] * s; v[4 + j] = acc[ai][bj][m][1][j] * s; }
          if (isrope) {
            float o[8];
#pragma unroll
            for (int j = 0; j < 8; ++j) o[j] = swz_xor16(v[j]);
            if (p >= CTX) { const int li = p - CTX; const int pos = (fq & 2) ? (li & 63) : (li >> 6);
              const f32x2* rp = (const f32x2*)rope + pos * 8;
#pragma unroll
              for (int j = 0; j < 8; ++j) { const f32x2 cs = rp[j]; v[j] = (fq & 1) ? (v[j] * cs.x + o[j] * cs.y) : (v[j] * cs.x - o[j] * cs.y); } }
          }
          if (col < 576) { u32x4 w; w.x = cvtpk(v[0], v[1]); w.y = cvtpk(v[2], v[3]); w.z = cvtpk(v[4], v[5]); w.w = cvtpk(v[6], v[7]);
            *(u32x4*)(QB + ((size_t)(b * NH + hh) * PP + p) * 96 + dim) = w; }
          asm volatile("" ::: "memory"); }
    }
  }
};
DI int vperm(int p) { const int q = p & 15; return (p & ~15) | (((q >> 2) & 1) << 3) | ((q >> 3) << 2) | (q & 3); }
struct EpiKV {
  static constexpr bool PERM = true;
  bf16_t* KB; bf16_t* VT; const float* rstd;
  DI void operator()(const f32x4 (&acc)[2][2][4][2], const Unit& u, int wr, int wc, int fr, int fq) const {
    const int row0 = u.pm * 256 + wr * 64 + fr;
    const int b = (u.pm * 256) / PP;
#pragma unroll
    for (int bj = 0; bj < 2; ++bj) { const int col = u.pn * 256 + bj * 128 + wc * 32 + 8 * fq;
      const int hh = col >> 7, j0 = col & 127;
#pragma unroll
      for (int ai = 0; ai < 2; ++ai)
#pragma unroll
        for (int m = 0; m < 4; ++m) { const int g = row0 + ai * 128 + m * 16; const int p = g - b * PP;
          const float s = rstd[g];
          float v[8];
#pragma unroll
          for (int j = 0; j < 4; ++j) { v[j] = acc[ai][bj][m][0][j] * s; v[4 + j] = acc[ai][bj][m][1][j] * s; }
          if (j0 < 64) { u32x4 w; w.x = cvtpk(v[0], v[1]); w.y = cvtpk(v[2], v[3]); w.z = cvtpk(v[4], v[5]); w.w = cvtpk(v[6], v[7]);
            *(u32x4*)(KB + ((size_t)(b * NH + hh) * PP + p) * 96 + j0) = w; }
          else { bf16_t* vt = VT + ((size_t)(b * NH + hh) * 64 + (j0 - 64)) * PP + vperm(p);
#pragma unroll
            for (int j = 0; j < 8; ++j) vt[(size_t)j * PP] = f2bf(v[j]); }
          asm volatile("" ::: "memory"); }
    }
  }
};
struct EpiMoe1 {
  static constexpr bool PERM = false;
  bf16_t* HID;
  DI void operator()(const f32x4 (&acc)[2][2][4][2], const Unit& u, int wr, int wc, int fr, int fq) const {
    const int row0 = u.pm * 256 + wr * 64 + fr; const int pnl = u.pn & 7;
#pragma unroll
    for (int ai = 0; ai < 2; ++ai)
#pragma unroll
      for (int m = 0; m < 4; ++m) { bf16_t* rowp = HID + (size_t)(row0 + ai * 128 + m * 16) * 1024 + pnl * 128 + wc * 32 + 4 * fq;
#pragma unroll
        for (int n = 0; n < 2; ++n) { const f32x4 gv = acc[ai][0][m][n], uv = acc[ai][1][m][n]; float h[4];
#pragma unroll
          for (int j = 0; j < 4; ++j) h[j] = gv[j] * sigmoidf_(gv[j]) * uv[j];
          u32x2 w; w.x = cvtpk(h[0], h[1]); w.y = cvtpk(h[2], h[3]);
          *(u32x2*)(rowp + 16 * n) = w; } }
  }
};
struct EpiMoe2 {
  static constexpr bool PERM = true;
  bf16_t* O;
  DI void operator()(const f32x4 (&acc)[2][2][4][2], const Unit& u, int wr, int wc, int fr, int fq) const {
    const int row0 = u.pm * 256 + wr * 64 + fr; const int pnl = u.pn & 3;
#pragma unroll
    for (int ai = 0; ai < 2; ++ai)
#pragma unroll
      for (int m = 0; m < 4; ++m) { bf16_t* rowp = O + (size_t)(row0 + ai * 128 + m * 16) * 1024;
#pragma unroll
        for (int bj = 0; bj < 2; ++bj) { const int col = pnl * 256 + bj * 128 + wc * 32 + 8 * fq;
          const f32x4 v0 = acc[ai][bj][m][0], v1 = acc[ai][bj][m][1];
          u32x4 w; w.x = cvtpk(v0[0], v0[1]); w.y = cvtpk(v0[2], v0[3]); w.z = cvtpk(v1[0], v1[1]); w.w = cvtpk(v1[2], v1[3]);
          *(u32x4*)(rowp + col) = w; } }
  }
};
template <bool GATH> struct MoeOrder {
  static constexpr bool GATHER = GATH;
  int tpe, nN, nwg, G, c; const int* idx;
  __device__ void init(int tpe_, int nN_, int G_, int c_, const int* idx_) { tpe = tpe_; nN = nN_; nwg = NEXP * tpe * nN; G = G_; c = c_; idx = idx_; }
  __device__ bool next(int i, Unit& u) const {
    const long L = (long)i * G + c; if (L >= nwg) return false;
    const int per = tpe * nN, e = (int)L / per, rem = (int)L % per, pnl = rem / tpe, pml = rem % tpe;
    u.pm = e * 17 + pml; u.pn = e * nN + pnl; return true;
  }
  __device__ int arow(const Unit& u, int r) const { return idx[u.pm * 256 + r]; }
};

struct LatentOrder {
  pg8::StaticOrder S;
  static constexpr bool GATHER = false;
  __device__ void init(int N, int G_, int c_) { S.init(NB * (SEQ / 256) * 256, N, G_, c_); }
  __device__ bool next(int i, Unit& u) const { if (!S.next(i, u)) return false; u.pm = u.pm + u.pm / 32 + 1; return true; }
  __device__ int arow(const Unit&, int) const { return 0; }
};
constexpr size_t MiB = (size_t)1 << 20;
constexpr size_t WS_CTL = 0;
constexpr size_t WS_MODP = 1 * MiB;
constexpr size_t WS_MOD = 3 * MiB;
constexpr size_t WS_TW = 3 * MiB + 256 * 1024;
constexpr size_t WS_ROPE = 3 * MiB + 384 * 1024;
constexpr size_t WS_RSTD = 3 * MiB + 512 * 1024;
constexpr size_t WS_WIN = 4 * MiB;
constexpr size_t WS_WOUT = 13 * MiB;
constexpr size_t WS_WLW = 17 * MiB;
constexpr size_t WS_WG = 18 * MiB;
constexpr size_t WS_WQ = 19 * MiB;
constexpr size_t WS_WKV = 20 * MiB;
constexpr size_t WS_AFF = 21 * MiB;
constexpr size_t WS_IDX = 24 * MiB;
constexpr size_t WS_SLOT = 29 * MiB;
constexpr size_t WS_INV = 32 * MiB;
constexpr size_t WS_XCTX = 25 * MiB;
constexpr size_t WS_R1 = 36 * MiB;
constexpr size_t WS_R2 = 192 * MiB;
constexpr size_t WS_R3 = 292 * MiB;
constexpr size_t WS_R4 = 416 * MiB;
constexpr size_t WS_R5 = 452 * MiB;
constexpr size_t WS_R6 = 502 * MiB;
constexpr size_t WS_HID = 416 * MiB;
constexpr size_t WS_END = 568 * MiB;

struct Params {
  const float* in[32];
  float* out; unsigned char* ws;
};

typedef const float* cfptr;
struct Ctx {
  const __attribute__((address_space(4))) cfptr* in; float* out; unsigned char* ws;
  LAS unsigned char* lds; unsigned char* ldsg;
  int tid, lane, wave, G, bid;
};

#define GAS __attribute__((address_space(1)))
DI const float* inp(const Ctx& C, int k) { return (const float*)(const GAS float*)C.in[k]; }
DI const float* in_row(const Ctx& C, int g) { const int b = g / PP, p = g - b * PP; return p < CTX ? inp(C, 2) + ((size_t)b * CTX + p) * DM : inp(C, 0) + ((size_t)b * SEQ + (p - CTX)) * DM; }
DI float* xs_row(const Ctx& C, int g) { const int b = g / PP, p = g - b * PP; return p < CTX ? (float*)(C.ws + WS_XCTX) + ((size_t)b * CTX + p) * DM : C.out + ((size_t)b * SEQ + (p - CTX)) * DM; }
DI int mod_row(int g) { const int b = g / PP, p = g - b * PP; return p < CTX ? 4 : b; }
DI const float* modv(const Ctx& C, int l, int r, int j) { return (const float*)(C.ws + WS_MOD) + ((size_t)(l * 5 + r) * 6 + j) * DM; }

template <class RowMap>
DI void transpose_item(const float* W, int K, int N, bf16_t* WT, int ldk, LAS float* scr, int item, int lane, const RowMap& rm) {
  const int nblk = N / 32, kb = item / nblk, nb = item % nblk, k0 = 64 * kb, n0 = 32 * nb;
  f32x4 v[8]; const int rr = lane >> 3, c4 = (lane & 7) * 4;
#pragma unroll
  for (int i = 0; i < 8; ++i) v[i] = *(const f32x4*)(W + (size_t)(k0 + 8 * i + rr) * N + n0 + c4);
#pragma unroll
  for (int i = 0; i < 8; ++i) *(LAS f32x4*)(scr + (8 * i + rr) * 36 + c4) = v[i];
  asm volatile("s_waitcnt lgkmcnt(0)" ::: "memory");
  const int c = lane & 7;
#pragma unroll
  for (int j = 0; j < 4; ++j) { const int n = (lane >> 3) + 8 * j; const LAS float* s = scr + (8 * c) * 36 + n;
    u32x4 o; o.x = cvtpk(s[0 * 36], s[1 * 36]); o.y = cvtpk(s[2 * 36], s[3 * 36]); o.z = cvtpk(s[4 * 36], s[5 * 36]); o.w = cvtpk(s[6 * 36], s[7 * 36]);
    const int r = rm(n0 + n);
    if (r >= 0) *(u32x4*)(WT + (size_t)r * ldk + k0 + 8 * c) = o; }
  asm volatile("s_waitcnt lgkmcnt(0)" ::: "memory");
}
struct MapIn { DI int operator()(int n) const { return n < 1440 ? n : (n < 1856 ? n + 96 : -1); } };
struct MapId { DI int operator()(int n) const { return n; } };
struct MapGate { int up; DI int operator()(int f) const { return 256 * (f >> 7) + 128 * up + (f & 127); } };

DI void phase0(const Ctx& C, const int lsel, const int vbid, const int vG) {
  const int gw = vbid * NWAVES + C.wave, NGW = vG * NWAVES;
  const int gt = vbid * NTHREADS + C.tid, NGT = vG * NTHREADS;
  LAS float* scr = (LAS float*)(C.lds + C.wave * 16384);
  LAS f32x2* tw64p = (LAS f32x2*)(C.lds + 8 * 16384);
  if (C.tid < 64) { float s_, c_; sincospif((float)C.tid * (2.0f / 64.0f), &s_, &c_); tw64p[C.tid] = (f32x2){c_, s_}; }
  __syncthreads();
  {
    const float* cin = inp(C, 1); const float* cctx = inp(C, 3);
#define SIL(r_, k_) (*(LAS float*)(C.lds + 16384 * (r_) + 12288 + 4 * (k_)))
    for (int i = C.tid; i < 5 * DM; i += NTHREADS) { const float v = i < 4 * DM ? cin[i] : cctx[i - 4 * DM]; SIL(i >> 10, i & 1023) = v * sigmoidf_(v); }
    __syncthreads();
    for (int it = gw; it < 96 * 8; it += NGW) {
      const int l = lsel, r_ = it, cc = r_ / 8, kc = r_ % 8;
      const float* W = inp(C, 4) + (size_t)l * DM * 6144 + (size_t)(kc * 128) * 6144 + cc * 64 + C.lane;
      float a0 = 0.f, a1 = 0.f, a2 = 0.f, a3 = 0.f, a4 = 0.f;
#pragma unroll 16
      for (int k = 0; k < 128; ++k) { const float w = W[(size_t)k * 6144]; const int kk = kc * 128 + k;
        a0 += SIL(0, kk) * w; a1 += SIL(1, kk) * w; a2 += SIL(2, kk) * w; a3 += SIL(3, kk) * w; a4 += SIL(4, kk) * w; }
      float* P = (float*)(C.ws + WS_MODP) + ((size_t)(l * 8 + kc) * 5) * 6144 + cc * 64 + C.lane;
      P[0] = a0; P[6144] = a1; P[2 * 6144] = a2; P[3 * 6144] = a3; P[4 * 6144] = a4;
    }
#undef SIL
    __syncthreads();
  }
  { const int l = lsel;
    bf16_t* WT = (bf16_t*)(C.ws + WS_WIN) + (size_t)l * UW * DM;
    for (int i = gt; i < 192 * DM / 8; i += NGT) { const int r = i / (DM / 8), c8 = i % (DM / 8); const int row = r < 96 ? 1440 + r : 1952 + (r - 96);
      *(u32x4*)(WT + (size_t)row * DM + c8 * 8) = (u32x4){0u, 0u, 0u, 0u}; }
    for (int it = gw; it < 16 * 66; it += NGW) transpose_item(inp(C, 10) + (size_t)l * DM * 2112, DM, 2112, WT, DM, scr, it, C.lane, MapIn());
    for (int it = gw; it < 4 * DM; it += NGW) { const int g = it / DM, k = it % DM; const float* wrow = inp(C, 10) + (size_t)l * DM * 2112 + (size_t)k * 2112 + 1856 + 64 * g;
      const int c_ = C.lane, k2 = c_ <= 32 ? c_ : c_ - 32; float acc = 0.f;
      for (int n = 0; n < 64; ++n) { const f32x2 t_ = tw64p[(k2 * n) & 63]; acc += wrow[n] * (c_ <= 32 ? t_.x : t_.y); }
      WT[(size_t)(2048 + 64 * g + c_) * DM + k] = f2bf(acc); }
    bf16_t* WO = (bf16_t*)(C.ws + WS_WOUT) + (size_t)l * DM * DM;
    for (int it = gw; it < 12 * 32; it += NGW) transpose_item(inp(C, 11) + (size_t)l * DM * DM, 768, DM, WO, DM, scr, it, C.lane, MapId());
    const float* wf = inp(C, 27) + (size_t)l * 256 * 256; const float* wo = inp(C, 11) + (size_t)l * DM * DM + (size_t)768 * DM;
    for (int it = gw; it < 64 * 16; it += NGW) { const int kq = it / 16, nc = it % 16; const int n = nc * 64 + C.lane;
      float a0 = 0.f, a1 = 0.f, a2 = 0.f, a3 = 0.f;
#pragma unroll 16
      for (int j = 0; j < 256; ++j) { const float w = wo[(size_t)j * DM + n];
        a0 += wf[(kq * 4 + 0) * 256 + j] * w; a1 += wf[(kq * 4 + 1) * 256 + j] * w; a2 += wf[(kq * 4 + 2) * 256 + j] * w; a3 += wf[(kq * 4 + 3) * 256 + j] * w; }
      u32x2 o; o.x = cvtpk(a0, a1); o.y = cvtpk(a2, a3);
      *(u32x2*)(WO + (size_t)n * DM + 768 + kq * 4) = o; }
    bf16_t* WLW = (bf16_t*)(C.ws + WS_WLW) + (size_t)l * 1536 * 128;
    for (int i = gt; i < 1536 * 128; i += NGT) { const int n = i / 128, k = i % 128; float v = 0.f;
      if (n < 768) { if (k < 64) v = inp(C, 14)[((size_t)(l * 2 + n / 384) * 64 + k) * 384 + n % 384]; }
      else { const int n2 = n - 768; if (k >= 64) v = inp(C, 16)[((size_t)(l * 2 + n2 / 384) * 64 + (k - 64)) * 384 + n2 % 384]; }
      WLW[i] = f2bf(v); }
    bf16_t* WG = (bf16_t*)(C.ws + WS_WG) + (size_t)l * 512 * 256;
    for (int i = gt; i < 512 * 256; i += NGT) { const int n = i / 256, k = i % 256; float v = 0.f;
      if (n < 384 && k < 160) v = inp(C, 17)[((size_t)l * 160 + k) * 384 + n];
      WG[i] = f2bf(v); }
    bf16_t* WQ = (bf16_t*)(C.ws + WS_WQ) + (size_t)l * 768 * 256;
    for (int i = gt; i < 768 * 256; i += NGT) { const int n = i / 256, k = i % 256; float v = 0.f;
      if (n < 576) v = inp(C, 23)[l * 256 + k] * inp(C, 24)[((size_t)l * 256 + k) * 576 + n];
      WQ[i] = f2bf(v); }
    bf16_t* WKV = (bf16_t*)(C.ws + WS_WKV) + (size_t)l * 768 * 128;
    for (int i = gt; i < 768 * 128; i += NGT) { const int n = i / 128, k = i % 128;
      WKV[i] = f2bf(inp(C, 25)[l * 128 + k] * inp(C, 26)[((size_t)l * 128 + k) * 768 + n]); }
  }
  if (lsel == 0) for (int i = gt; i < 8192; i += NGT) { float s, c; sincospif((float)i * (2.0f / 8192.0f), &s, &c); ((f32x2*)(C.ws + WS_TW))[i] = (f32x2){c, -s}; }
  if (lsel == 0) for (int i = gt; i < 128 * 8; i += NGT) { const int pos = i / 8, j = i % 8; const float inv = powf(10000.0f, -(float)j / 8.0f); float s, c; sincosf((float)pos * inv, &s, &c); ((f32x2*)(C.ws + WS_ROPE))[i] = (f32x2){c, s}; }
}
DI void phase0b(const Ctx& C, const int l) {
  const int gt = C.bid * NTHREADS + C.tid, NGT = C.G * NTHREADS;
  for (int i = gt; i < 5 * 6144; i += NGT) { const int r = i / 6144, n = i % 6144;
    float s = inp(C, 5)[l * 6144 + n];
#pragma unroll
    for (int kc = 0; kc < 8; ++kc) s += ((const float*)(C.ws + WS_MODP))[((size_t)(l * 8 + kc) * 5 + r) * 6144 + n];
    ((float*)(C.ws + WS_MOD))[l * 5 * 6144 + i] = s; }
}

DI void convert_experts(const Ctx& C, int l) {
  LAS float* scr = (LAS float*)(C.lds + C.wave * 16384);
  bf16_t* WGU = (bf16_t*)(C.ws + WS_R3); bf16_t* WDN = WGU + (size_t)NEXP * 2048 * 1024;
  unsigned* ctr = (unsigned*)(C.ws + WS_CTL) + 64 * (8 + l);
  for (;;) { unsigned base = 0; if (C.lane == 0) base = atomicAdd(ctr, 8u); base = __builtin_amdgcn_readfirstlane(base);
    if (base >= NEXP * 3 * 512) break;
    for (int k = 0; k < 8; ++k) { const int it = base + k; const int e = it / 1536, r = it % 1536, mat = r / 512, sub = r % 512;
      const size_t woff = ((size_t)l * NEXP + e) * 1024 * 1024;
      if (mat == 0) transpose_item(inp(C, 29) + woff, 1024, 1024, WGU + (size_t)e * 2048 * 1024, 1024, scr, sub, C.lane, MapGate{0});
      else if (mat == 1) transpose_item(inp(C, 30) + woff, 1024, 1024, WGU + (size_t)e * 2048 * 1024, 1024, scr, sub, C.lane, MapGate{1});
      else transpose_item(inp(C, 31) + woff, 1024, 1024, WDN + (size_t)e * 1024 * 1024, 1024, scr, sub, C.lane, MapId()); } }
}

DI void norm_pass(const Ctx& C, int mode, int l, int lp) {
  const int gw = C.bid * NWAVES + C.wave, NGW = C.G * NWAVES, lane = C.lane;
  bf16_t* XN = (bf16_t*)(C.ws + WS_R2); const bf16_t* DOWN = (const bf16_t*)(C.ws + WS_R1); const int* SLOT = (const int*)(C.ws + WS_SLOT); const float* AFF = (const float*)(C.ws + WS_AFF);
  f32x4 vn[4]; int slotn = -1; float affn = 0.f;
#define NP_LOAD(gg) do { const f32x4* xr_ = (const f32x4*)(mode == 0 ? in_row(C, gg) : xs_row(C, gg)) + lane; _Pragma("unroll") for (int j = 0; j < 4; ++j) vn[j] = xr_[64 * j]; \
    if (mode != 0) { slotn = lane < 16 ? SLOT[(size_t)(gg) * 16 + lane] : -1; affn = lane < 16 ? AFF[(size_t)(gg) * 16 + lane] : 0.f; } } while (0)
  if (gw < TT) NP_LOAD(gw);
  for (int g = gw; g < TT; g += NGW) {
    const int mr = mod_row(g); const bool isctx = (mr == 4);
    f32x4 v[4]; const int myslot = slotn; const float myaff = affn;
#pragma unroll
    for (int j = 0; j < 4; ++j) v[j] = vn[j];
    const bool skip = (mode == 2 && isctx);
    f32x4 y[4], a5[4], g9[4], a0[4], a1[4], g6[4];
    if (!skip) {
      if (mode != 0) { const f32x4* m5 = (const f32x4*)modv(C, lp, mr, 5) + lane; const f32x4* gp = (const f32x4*)(inp(C, 9) + lp * DM) + lane;
#pragma unroll
        for (int j = 0; j < 4; ++j) { a5[j] = m5[64 * j]; g9[j] = gp[64 * j]; y[j] = (f32x4){0.f, 0.f, 0.f, 0.f}; } }
      if (mode != 2) { const f32x4* m0 = (const f32x4*)modv(C, l, mr, 0) + lane; const f32x4* m1 = (const f32x4*)modv(C, l, mr, 1) + lane; const f32x4* gp = (const f32x4*)(inp(C, 6) + l * DM) + lane;
#pragma unroll
        for (int j = 0; j < 4; ++j) { a0[j] = m0[64 * j]; a1[j] = m1[64 * j]; g6[j] = gp[64 * j]; } }
      if (mode != 0) {
        for (int e = 0; e < 16; ++e) { const int sl = __builtin_amdgcn_readlane(myslot, e);
          if (sl >= 0) { const float a = rdlane(myaff, e); const u32x2* dr = (const u32x2*)(DOWN + (size_t)sl * DM) + lane;
#pragma unroll
            for (int j = 0; j < 4; ++j) { const u32x2 w = dr[64 * j]; y[j] = y[j] + (f32x4){bflo(w.x), bfhi(w.x), bflo(w.y), bfhi(w.y)} * a; } } } }
    }
    if (g + NGW < TT) NP_LOAD(g + NGW);
    if (skip) continue;
    if (mode != 0) { f32x4* xr = (f32x4*)xs_row(C, g) + lane; float s = 0.f;
#pragma unroll
      for (int j = 0; j < 4; ++j) s += (y[j].x * y[j].x + y[j].y * y[j].y) + (y[j].z * y[j].z + y[j].w * y[j].w);
      const float rstd = rsqrtf(wave_sum(s) * (1.f / DM) + NORM_EPS);
#pragma unroll
      for (int j = 0; j < 4; ++j) { v[j] = v[j] + a5[j] * (y[j] * rstd * g9[j]); xr[64 * j] = v[j]; }
      if (mode == 2) continue; }
    float s = 0.f;
#pragma unroll
    for (int j = 0; j < 4; ++j) s += (v[j].x * v[j].x + v[j].y * v[j].y) + (v[j].z * v[j].z + v[j].w * v[j].w);
    const float rstd = rsqrtf(wave_sum(s) * (1.f / DM) + NORM_EPS);
    u32x2* o = (u32x2*)(XN + (size_t)g * DM) + lane;
#pragma unroll
    for (int j = 0; j < 4; ++j) { const f32x4 t = v[j] * rstd * g6[j] * (a1[j] + 1.0f) + a0[j]; u32x2 w; w.x = cvtpk(t.x, t.y); w.y = cvtpk(t.z, t.w); o[64 * j] = w; }
  }
#undef NP_LOAD
}

DI void prep_a(const Ctx& C, int l) {
  const bf16_t* U = (const bf16_t*)(C.ws + WS_R1) + (size_t)TT * HW2;
  float* rq = (float*)(C.ws + WS_RSTD); float* rkv = rq + TT;
  bf16_t* KB = (bf16_t*)(C.ws + WS_R2) + (size_t)NB * NH * PP * 96;
  const f32x2* rope = (const f32x2*)(C.ws + WS_ROPE);
  const int lane = C.lane;
  LAS float* zrow = (LAS float*)(C.lds + C.wave * 1024);
  LAS f32x2* stage = (LAS f32x2*)(C.lds + 16384);
  LAS f32x2* tw64 = (LAS f32x2*)(C.lds + 16384 + 132 * 64 * 8);
  if (C.tid < 64) { float s, c; sincospif((float)C.tid * (2.0f / 64.0f), &s, &c); tw64[C.tid] = (f32x2){c, s}; }
  __syncthreads();
  for (int tile = C.bid; tile < TT / 64; tile += C.G) {
    const int g0 = tile * 64; const int b = g0 / PP, p0 = g0 - b * PP;
    for (int i = 0; i < 8; ++i) { const int tl = C.wave * 8 + i; const int g = g0 + tl; const int p = p0 + tl;
      const bf16_t* ur = U + (size_t)g * HW2;
      { const u32x2 w = *((const u32x2*)(ur + 384) + lane); const float a0 = bflo(w.x), a1 = bfhi(w.x), a2 = bflo(w.y), a3 = bfhi(w.y);
        const float s = wave_sum(a0 * a0 + a1 * a1 + a2 * a2 + a3 * a3); if (lane == 0) rq[g] = rsqrtf(s * (1.f / 256.f) + NORM_EPS); }
      { const unsigned w = *((const unsigned*)(ur + 640) + lane); const float a0 = bflo(w), a1 = bfhi(w);
        const float s = wave_sum(a0 * a0 + a1 * a1); if (lane == 0) rkv[g] = rsqrtf(s * (1.f / 128.f) + NORM_EPS); }
      { float x = lane < 32 ? bf2f(ur[768 + lane]) : 0.f; const float o = swz_xor8(x);
        if (p >= CTX && lane < 32) { const int li = p - CTX; const int pos = (lane & 16) ? (li & 63) : (li >> 6); const f32x2 cs = rope[pos * 8 + (lane & 7)];
          x = (lane & 8) ? (x * cs.x + o * cs.y) : (x * cs.x - o * cs.y); }
        if (lane < 32) { const bf16_t xb = f2bf(x);
#pragma unroll
          for (int hh = 0; hh < NH; ++hh) KB[((size_t)(b * NH + hh) * PP + p) * 96 + 64 + lane] = xb; } }
      { const u32x2 w = *((const u32x2*)(ur + 896) + lane); *(LAS f32x4*)(zrow + lane * 4) = (f32x4){bflo(w.x), bfhi(w.x), bflo(w.y), bfhi(w.y)}; }
      asm volatile("s_waitcnt lgkmcnt(0)" ::: "memory");
      { const int grp = lane >> 4, kq = lane & 15; const LAS float* z = zrow + grp * 64;
        const float c0 = z[kq], c1 = z[kq + 16], s0 = kq == 0 ? 0.f : z[32 + kq], s1 = z[48 + kq];
        stage[(grp * 33 + kq) * 64 + tl] = (f32x2){c0, -s0}; stage[(grp * 33 + kq + 16) * 64 + tl] = (f32x2){c1, -s1};
        if (kq == 0) stage[(grp * 33 + 32) * 64 + tl] = (f32x2){z[32], 0.f}; }
      asm volatile("s_waitcnt lgkmcnt(0)" ::: "memory");
    }
    __syncthreads();
    f32x2* ZT = (f32x2*)(C.ws + WS_R4);
    for (int i = C.tid; i < 132 * 64; i += NTHREADS) { const int r = i >> 6, t = i & 63; ZT[((size_t)b * 132 + r) * PP + p0 + t] = stage[i]; }
    __syncthreads();
  }
}

DI void conv_pass(const Ctx& C, int l) {
  const int gw = C.bid * NWAVES + C.wave, NGW = C.G * NWAVES, lane = C.lane;
  const bf16_t* RKV = (const bf16_t*)(C.ws + WS_R1); bf16_t* REST = (bf16_t*)(C.ws + WS_R1) + (size_t)TT * HW2; float* INV = (float*)(C.ws + WS_INV);
  const float* cw = inp(C, 12) + (size_t)l * 3 * 1152; const float* k_k = inp(C, 18) + l * 384;
  f32x2 cw0[9], cw1[9], cw2[9], kk2[3];
#pragma unroll
  for (int j = 0; j < 9; ++j) { const int c = 2 * (lane + 64 * j); cw0[j] = (f32x2){cw[c], cw[c + 1]}; cw1[j] = (f32x2){cw[1152 + c], cw[1152 + c + 1]}; cw2[j] = (f32x2){cw[2304 + c], cw[2304 + c + 1]};
    if (j >= 3 && j < 6) kk2[j - 3] = (f32x2){k_k[c - 384], k_k[c - 384 + 1]}; }
  unsigned xn[9][3];
#define CV_LOAD(gg) do { const int b_ = (gg) / PP, p_ = (gg) - b_ * PP; const bool hl_ = (p_ != 0 && p_ != CTX), hr_ = (p_ != CTX - 1 && p_ != PP - 1); \
    const unsigned* u0_ = (const unsigned*)(RKV + (size_t)(gg) * HW2) + lane; const unsigned* ul_ = hl_ ? u0_ - HW2 / 2 : u0_; const unsigned* ur_ = hr_ ? u0_ + HW2 / 2 : u0_; \
    _Pragma("unroll") for (int j = 0; j < 9; ++j) { xn[j][0] = ul_[64 * j]; xn[j][1] = u0_[64 * j]; xn[j][2] = ur_[64 * j]; } } while (0)
  if (gw < TT) CV_LOAD(gw);
  for (int g = gw; g < TT; g += NGW) {
    const int b = g / PP, p = g - b * PP; const float ml = (p != 0 && p != CTX) ? 1.f : 0.f, mr = (p != CTX - 1 && p != PP - 1) ? 1.f : 0.f;
    unsigned x[9][3];
#pragma unroll
    for (int j = 0; j < 9; ++j) { x[j][0] = xn[j][0]; x[j][1] = xn[j][1]; x[j][2] = xn[j][2]; }
    if (g + NGW < TT) CV_LOAD(g + NGW);
    unsigned* o = (unsigned*)(REST + (size_t)g * HW2) + lane;
#pragma unroll
    for (int j = 0; j < 9; ++j) {
      const f32x2 y = (f32x2){bflo(x[j][1]), bfhi(x[j][1])} * cw1[j] + ((f32x2){bflo(x[j][0]), bfhi(x[j][0])} * cw0[j]) * ml + ((f32x2){bflo(x[j][2]), bfhi(x[j][2])} * cw2[j]) * mr;
      o[64 * j] = cvtpk(y.x, y.y);
      if (j >= 3 && j < 6) { const float a0 = y.x * kk2[j - 3].x, a1 = y.y * kk2[j - 3].y;
        float t = a0 * a0 + a1 * a1; t = dpp_add<0xB1>(t); t = dpp_add<0x4E>(t); t = dpp_add<0x141>(t); t = dpp_add<0x140>(t);
        const float t0 = rdlane(t, 0) + rdlane(t, 16), t1 = rdlane(t, 32) + rdlane(t, 48);
        if (lane == 0) INV[(size_t)g * 6 + 2 * (j - 3)] = __builtin_amdgcn_rsqf(fmaxf(t0, 1e-24f));
        if (lane == 32) INV[(size_t)g * 6 + 2 * (j - 3) + 1] = __builtin_amdgcn_rsqf(fmaxf(t1, 1e-24f)); } }
  }
#undef CV_LOAD
}

DI void post_pass(const Ctx& C, int l, bool with_ctx) {
  const int gw = C.bid * NWAVES + C.wave, NGW = C.G * NWAVES, lane = C.lane;
  const bf16_t* U = (const bf16_t*)(C.ws + WS_R1) + (size_t)TT * HW2;
  const bf16_t* AS = (const bf16_t*)(C.ws + WS_R3) + (size_t)TT * 768; const bf16_t* Gt = AS + (size_t)TT * 768;
  const bf16_t* Y0 = (const bf16_t*)(C.ws + WS_R5); const bf16_t* Y1 = Y0 + (size_t)TT * 384;
  bf16_t* MC = (bf16_t*)(C.ws + WS_R6);
  const float* cw = inp(C, 12) + (size_t)l * 3 * 1152; const float* k_a = inp(C, 19) + l * 384; const float* r_k = inp(C, 20) + l * 384;
  const float* lw = inp(C, 21) + l * 384; const float* lb = inp(C, 22) + l * 384;
  float c_lw[6], c_lb[6], c_ka[6], c_rk[6];
#pragma unroll
  for (int hh = 0; hh < NH; ++hh) { const int c = hh * 64 + lane; c_lw[hh] = lw[c]; c_lb[hh] = lb[c]; c_ka[hh] = k_a[c]; c_rk[hh] = r_k[c]; }
  unsigned short nxu[6][3], ny0[6], ny1[6], na0[6], na1[6], ngg[6];
#define PP_LOAD(gg_) do { const bf16_t* u0_ = U + (size_t)(gg_) * HW2; _Pragma("unroll") for (int hh = 0; hh < NH; ++hh) { const int c = hh * 64 + lane; \
      _Pragma("unroll") for (int q = 0; q < 3; ++q) nxu[hh][q] = u0_[q * 384 + c]; \
      ny0[hh] = Y0[(size_t)(gg_) * 384 + c]; ny1[hh] = Y1[(size_t)(gg_) * 384 + c]; na0[hh] = AS[(size_t)(gg_) * 768 + c]; na1[hh] = AS[(size_t)(gg_) * 768 + 384 + c]; ngg[hh] = Gt[(size_t)(gg_) * 384 + c]; } } while (0)
  if (gw < TT) PP_LOAD(gw);
  for (int g = gw; g < TT; g += NGW) {
    const int b = g / PP, p = g - b * PP;
    unsigned short xu[6][3], y0[6], y1[6], a0[6], a1[6], gg[6];
#pragma unroll
    for (int hh = 0; hh < NH; ++hh) { xu[hh][0] = nxu[hh][0]; xu[hh][1] = nxu[hh][1]; xu[hh][2] = nxu[hh][2]; y0[hh] = ny0[hh]; y1[hh] = ny1[hh]; a0[hh] = na0[hh]; a1[hh] = na1[hh]; gg[hh] = ngg[hh]; }
    if (g + NGW < TT) PP_LOAD(g + NGW);
    if (p < CTX && !with_ctx) continue;
#pragma unroll
    for (int hh = 0; hh < NH; ++hh) { const int c = hh * 64 + lane;
      float rkv[3];
#pragma unroll
      for (int q = 0; q < 3; ++q) rkv[q] = bf2f(xu[hh][q]);
      const float y = bf2f(y0[hh]) + bf2f(y1[hh]);
      const float mu = wave_sum(y) * (1.f / 64.f); const float dv = y - mu; const float var = wave_sum(dv * dv) * (1.f / 64.f);
      const float yn = dv * rsqrtf(var + GN_EPS) * c_lw[hh] + c_lb[hh];
      const float al0 = bf2f(a0[hh]), al1 = bf2f(a1[hh]); const float ka = c_ka[hh];
      const float kd0 = rkv[1] * (1.f + (al0 - 1.f) * ka), kd1 = rkv[1] * (1.f + (al1 - 1.f) * ka);
      const float bonus = wave_sum(rkv[0] * (kd0 + kd1) * c_rk[hh]);
      const float o = (yn + bonus * rkv[2]) * bf2f(gg[hh]);
      MC[(size_t)g * DM + c] = f2bf(o); }
  }
#undef PP_LOAD
}

DI void n2_pass(const Ctx& C, int l, bool with_ctx) {
  const int gw = C.bid * NWAVES + C.wave, NGW = C.G * NWAVES, lane = C.lane;
  const bf16_t* O = (const bf16_t*)(C.ws + WS_R1); bf16_t* TN = (bf16_t*)(C.ws + WS_R2); float* AFF = (float*)(C.ws + WS_AFF); int* SLOT = (int*)(C.ws + WS_SLOT);
  LAS float* wr = (LAS float*)C.lds; const float* wrg = inp(C, 28) + (size_t)l * DM * NEXP;
  for (int i = C.tid; i < DM * NEXP; i += NTHREADS) wr[(i & 15) * DM + (i >> 4)] = wrg[i];
  __syncthreads();
  f32x4 vn[4]; u32x2 on[4];
#define N2_LOAD(gg) do { const f32x4* xr_ = (const f32x4*)(l == 0 ? in_row(C, gg) : xs_row(C, gg)) + lane; const u32x2* or_ = (const u32x2*)(O + (size_t)(gg) * DM) + lane; \
    _Pragma("unroll") for (int j = 0; j < 4; ++j) { vn[j] = xr_[64 * j]; on[j] = or_[64 * j]; } } while (0)
  if (gw < TT) N2_LOAD(gw);
  for (int g = gw; g < TT; g += NGW) {
    const int mr = mod_row(g);
    f32x4 v[4], o[4]; float s = 0.f;
#pragma unroll
    for (int j = 0; j < 4; ++j) { v[j] = vn[j]; const u32x2 w = on[j]; o[j] = (f32x4){bflo(w.x), bfhi(w.x), bflo(w.y), bfhi(w.y)};
      s += (o[j].x * o[j].x + o[j].y * o[j].y) + (o[j].z * o[j].z + o[j].w * o[j].w); }
    const bool skip = (mr == 4 && !with_ctx);
    f32x4 a2[4], g7[4], a3[4], a4[4], g8[4];
    if (!skip) { const f32x4* m2 = (const f32x4*)modv(C, l, mr, 2) + lane; const f32x4* gp = (const f32x4*)(inp(C, 7) + l * DM) + lane;
      const f32x4* m3 = (const f32x4*)modv(C, l, mr, 3) + lane; const f32x4* m4 = (const f32x4*)modv(C, l, mr, 4) + lane; const f32x4* gq = (const f32x4*)(inp(C, 8) + l * DM) + lane;
#pragma unroll
      for (int j = 0; j < 4; ++j) { a2[j] = m2[64 * j]; g7[j] = gp[64 * j]; a3[j] = m3[64 * j]; a4[j] = m4[64 * j]; g8[j] = gq[64 * j]; } }
    if (g + NGW < TT) N2_LOAD(g + NGW);
    if (skip) continue;
    float rstd = rsqrtf(wave_sum(s) * (1.f / DM) + NORM_EPS);
    { f32x4* xo = (f32x4*)xs_row(C, g) + lane;
      s = 0.f;
#pragma unroll
      for (int j = 0; j < 4; ++j) { v[j] = v[j] + a2[j] * (o[j] * rstd * g7[j]); xo[64 * j] = v[j]; s += (v[j].x * v[j].x + v[j].y * v[j].y) + (v[j].z * v[j].z + v[j].w * v[j].w); } }
    rstd = rsqrtf(wave_sum(s) * (1.f / DM) + NORM_EPS);
    u32x2* to = (u32x2*)(TN + (size_t)g * DM) + lane;
    float lg[16];
#pragma unroll
    for (int e = 0; e < 16; ++e) lg[e] = 0.f;
#pragma unroll
    for (int j = 0; j < 4; ++j) { const f32x4 t = v[j] * rstd * g8[j] * (a4[j] + 1.0f) + a3[j]; u32x2 w; w.x = cvtpk(t.x, t.y); w.y = cvtpk(t.z, t.w); to[64 * j] = w;
#pragma unroll
      for (int e = 0; e < 16; ++e) { const f32x4 ww = *(const LAS f32x4*)(wr + e * DM + 256 * j + 4 * lane); lg[e] += (t.x * ww.x + t.y * ww.y) + (t.z * ww.z + t.w * ww.w); if ((e & 3) == 3) asm volatile("" ::: "memory"); } }
    float mx = -1e30f;
#pragma unroll
    for (int e = 0; e < 16; ++e) { lg[e] = wave_sum(lg[e]); mx = fmaxf(mx, lg[e]); }
    float den = 0.f;
#pragma unroll
    for (int e = 0; e < 16; ++e) { lg[e] = __expf(lg[e] - mx); den += lg[e]; }
    const float inv = 1.f / den;
    float mine = 0.f;
#pragma unroll
    for (int e = 0; e < 16; ++e) mine = (lane == e) ? lg[e] * inv : mine;
    if (lane < 16) { AFF[(size_t)g * 16 + lane] = mine; SLOT[(size_t)g * 16 + lane] = -1; }
  }
#undef N2_LOAD
  __syncthreads();
}

DI void topk_problem(const Ctx& C, int q) {
  const bool isctx = q >= 64; const int qq = q & 63, b = qq >> 4, e = qq & 15;
  const int n = isctx ? CTX : SEQ, cap = isctx ? 32 : 1024; const int g0 = b * PP + (isctx ? 0 : CTX);
  const float* AFF = (const float*)(C.ws + WS_AFF);
  int* IDX = (int*)(C.ws + WS_IDX); int* SLOT = (int*)(C.ws + WS_SLOT);
  const int obase = e * RPE + (isctx ? 4096 + b * 32 : b * 1024);
  LAS unsigned* keys = (LAS unsigned*)C.lds; LAS unsigned* hist = keys + 8192; LAS unsigned* ctl = hist + 256;
  for (int i = C.tid; i < n; i += NTHREADS) keys[i] = __float_as_uint(AFF[(size_t)(g0 + i) * 16 + e]);
  if (C.tid == 0) { ctl[0] = 0u; ctl[1] = (unsigned)cap; ctl[2] = 0u; ctl[3] = 0u; }
  unsigned mask = 0u;
  for (int pass = 0; pass < 4; ++pass) { const int shift = 24 - 8 * pass;
    if (C.tid < 256) hist[C.tid] = 0u;
    __syncthreads();
    const unsigned prefix = ctl[0];
    for (int i = C.tid; i < n; i += NTHREADS) { const unsigned k = keys[i]; if ((k & mask) == prefix) atomicAdd((unsigned*)&hist[(k >> shift) & 255u], 1u); }
    __syncthreads();
    if (C.tid < 256) { const unsigned rem = ctl[1]; unsigned sfx = 0u;
      for (int b2 = 255; b2 >= C.tid; --b2) sfx += hist[b2];
      const unsigned nxt = sfx - hist[C.tid];
      if (sfx >= rem && nxt < rem) { ctl[0] = prefix | ((unsigned)C.tid << shift); ctl[1] = rem - nxt; } }
    mask |= 255u << shift;
    __syncthreads();
  }
  const unsigned thr = ctl[0], need_eq = ctl[1];
  for (int i = C.tid; i < n; i += NTHREADS) { const unsigned k = keys[i];
    int slot = -1;
    if (k > thr) slot = (int)atomicAdd((unsigned*)&ctl[2], 1u);
    else if (k == thr) { const unsigned t = atomicAdd((unsigned*)&ctl[3], 1u); if (t < need_eq) slot = cap - (int)need_eq + (int)t; }
    if (slot >= 0) { IDX[obase + slot] = g0 + i; SLOT[(size_t)(g0 + i) * 16 + e] = obase + slot; } }
  __syncthreads();
}
#define MFMA32(a, b, c) __builtin_amdgcn_mfma_f32_32x32x16_bf16((a), (b), (c), 0, 0, 0)
constexpr int AT_KROW = 208, AT_VROW = 144, AT_KBUF = 64 * AT_KROW, AT_VBUF = 64 * AT_VROW;
constexpr int AT_K0 = 0, AT_V0 = 2 * AT_KBUF, AT_OST = AT_V0 + 2 * AT_VBUF, AT_OROW = 144;
constexpr float AT_THR = 8.0f;
DI float max3f(float a, float b, float c) { float r; asm("v_max3_f32 %0, %1, %2, %3" : "=v"(r) : "v"(a), "v"(b), "v"(c)); return r; }

DI void attn_unit(const Ctx& C, int b, int h, int pq0, int nkt) {
  const bf16_t* QB = (const bf16_t*)(C.ws + WS_R2); const bf16_t* KBp = QB + (size_t)NB * NH * PP * 96; const bf16_t* VTp = KBp + (size_t)NB * NH * PP * 96;
  const bf16_t* Qh = QB + (size_t)(b * NH + h) * PP * 96; const bf16_t* Kh = KBp + (size_t)(b * NH + h) * PP * 96; const bf16_t* Vh = VTp + (size_t)(b * NH + h) * 64 * PP;
  bf16_t* MC = (bf16_t*)(C.ws + WS_R6);
  const int tid = C.tid, lane = C.lane, wave = C.wave, r32 = lane & 31, hi = lane >> 5;
  LAS unsigned char* lds = C.lds;
  bf16x8 qf[6];
  { const bf16_t* qrow = Qh + (size_t)(pq0 + wave * 32 + r32) * 96 + hi * 8;
#pragma unroll
    for (int d0 = 0; d0 < 6; ++d0) qf[d0] = *(const bf16x8*)(qrow + d0 * 16); }
  const int k0row = tid / 12, k0c = tid % 12, k1row = (tid + 512) / 12, k1c = (tid + 512) % 12;
  const unsigned k0dst = k0row * AT_KROW + k0c * 16, k1dst = k1row * AT_KROW + k1c * 16, vdst = (tid >> 3) * AT_VROW + (tid & 7) * 16;
  const bf16_t* vsrc = Vh + (size_t)(tid >> 3) * PP + (tid & 7) * 8;
  u32x4 sk0, sk1 = (u32x4){0u, 0u, 0u, 0u}, sv;
#define AT_LOAD(kt) do { const char* kb_ = (const char*)(Kh + (size_t)(kt) * 64 * 96); sk0 = *(const u32x4*)(kb_ + tid * 16); if (tid < 256) sk1 = *(const u32x4*)(kb_ + (tid + 512) * 16); sv = *(const u32x4*)(vsrc + (kt) * 64); } while (0)
#define AT_STORE(buf) do { *(LAS u32x4*)(lds + AT_K0 + (buf) * AT_KBUF + k0dst) = sk0; if (tid < 256) *(LAS u32x4*)(lds + AT_K0 + (buf) * AT_KBUF + k1dst) = sk1; *(LAS u32x4*)(lds + AT_V0 + (buf) * AT_VBUF + vdst) = sv; } while (0)
  AT_LOAD(0); AT_STORE(0);
  __syncthreads();
  f32x16 negm, o0, o1;
#pragma unroll
  for (int i = 0; i < 16; ++i) { negm[i] = 0.f; o0[i] = 0.f; o1[i] = 0.f; }
  float mhat = 0.f, lsum = 0.f;
  for (int kt = 0; kt < nkt; ++kt) {
    const int buf = kt & 1;
    if (kt + 1 < nkt) AT_LOAD(kt + 1);
    const LAS unsigned char* kb = lds + AT_K0 + buf * AT_KBUF + r32 * AT_KROW + hi * 16;
    const LAS unsigned char* vb = lds + AT_V0 + buf * AT_VBUF + r32 * AT_VROW + hi * 16;
    f32x16 p0, p1;
    bf16x8 kf[12];
#pragma unroll
    for (int d0 = 0; d0 < 6; ++d0) { kf[2 * d0] = *(const LAS bf16x8*)(kb + d0 * 32); kf[2 * d0 + 1] = *(const LAS bf16x8*)(kb + 32 * AT_KROW + d0 * 32); }
#pragma unroll
    for (int d0 = 0; d0 < 6; ++d0) {
      if (d0 == 0) { p0 = MFMA32(kf[0], qf[0], negm); p1 = MFMA32(kf[1], qf[0], negm); } else { p0 = MFMA32(kf[2 * d0], qf[d0], p0); p1 = MFMA32(kf[2 * d0 + 1], qf[d0], p1); } }
    bf16x8 vf[8];
#pragma unroll
    for (int s_ = 0; s_ < 4; ++s_) { vf[2 * s_] = *(const LAS bf16x8*)(vb + s_ * 32); vf[2 * s_ + 1] = *(const LAS bf16x8*)(vb + 32 * AT_VROW + s_ * 32); }
    asm volatile("s_nop 15\n\ts_nop 7" : "+v"(p0), "+v"(p1));
    float rm;
    { float a_ = max3f(p0[0], p0[1], p1[0]), b_ = max3f(p0[2], p0[3], p1[1]); a_ = max3f(a_, p1[2], p1[3]);
#pragma unroll
      for (int r = 4; r < 16; r += 4) { a_ = max3f(a_, p0[r], p0[r + 1]); b_ = max3f(b_, p0[r + 2], p0[r + 3]); a_ = max3f(a_, p1[r], p1[r + 1]); b_ = max3f(b_, p1[r + 2], p1[r + 3]); }
      rm = max3f(a_, b_, b_); }
    rm = half_max(rm);
    if (kt == 0 || __any(rm > AT_THR)) {
      const float dl = (kt == 0) ? rm : fmaxf(rm, 0.f);
      mhat += dl; const float f = (kt == 0) ? 1.f : __builtin_amdgcn_exp2f(-dl); lsum *= f;
#pragma unroll
      for (int i = 0; i < 16; ++i) { p0[i] -= dl; p1[i] -= dl; o0[i] *= f; o1[i] *= f; negm[i] = -mhat; }
    }
    float ps = 0.f;
#pragma unroll
    for (int i = 0; i < 16; ++i) { p0[i] = __builtin_amdgcn_exp2f(p0[i]); p1[i] = __builtin_amdgcn_exp2f(p1[i]); ps += p0[i] + p1[i]; }
    lsum += ps;
    u32x4 w0, w1, w2, w3;
    w0 = (u32x4){cvtpk(p0[0], p0[1]), cvtpk(p0[2], p0[3]), cvtpk(p0[4], p0[5]), cvtpk(p0[6], p0[7])};
    w1 = (u32x4){cvtpk(p0[8], p0[9]), cvtpk(p0[10], p0[11]), cvtpk(p0[12], p0[13]), cvtpk(p0[14], p0[15])};
    w2 = (u32x4){cvtpk(p1[0], p1[1]), cvtpk(p1[2], p1[3]), cvtpk(p1[4], p1[5]), cvtpk(p1[6], p1[7])};
    w3 = (u32x4){cvtpk(p1[8], p1[9]), cvtpk(p1[10], p1[11]), cvtpk(p1[12], p1[13]), cvtpk(p1[14], p1[15])};
    const bf16x8 pf0 = __builtin_bit_cast(bf16x8, w0), pf1 = __builtin_bit_cast(bf16x8, w1), pf2 = __builtin_bit_cast(bf16x8, w2), pf3 = __builtin_bit_cast(bf16x8, w3);
#define AT_PV(s, pf) do { o0 = MFMA32(vf[2 * (s)], pf, o0); o1 = MFMA32(vf[2 * (s) + 1], pf, o1); } while (0)
    AT_PV(0, pf0); AT_PV(1, pf1); AT_PV(2, pf2); AT_PV(3, pf3);
#undef AT_PV
    if (kt + 1 < nkt) AT_STORE(buf ^ 1);
    __syncthreads();
  }
#undef AT_LOAD
#undef AT_STORE
  lsum = half_sum(lsum);
  const float inv = 1.f / lsum;
  LAS bf16_t* stg = (LAS bf16_t*)(lds + AT_OST + wave * 32 * AT_OROW);
#pragma unroll
  for (int i = 0; i < 16; ++i) { const int d = (i & 3) + 8 * (i >> 2) + 4 * hi;
    stg[r32 * (AT_OROW / 2) + d] = f2bf(o0[i] * inv); stg[r32 * (AT_OROW / 2) + 32 + d] = f2bf(o1[i] * inv); }
  asm volatile("s_waitcnt lgkmcnt(0)" ::: "memory");
#pragma unroll
  for (int i = 0; i < 4; ++i) { const int piece = i * 64 + lane, row = piece >> 3, c = piece & 7;
    const u32x4 v = *(const LAS u32x4*)((const LAS unsigned char*)stg + row * AT_OROW + c * 16);
    *(u32x4*)(MC + (size_t)(b * PP + pq0 + wave * 32 + row) * DM + 384 + h * 64 + c * 8) = v; }
  __syncthreads();
}

constexpr int SC_CH = 32;
DI int scan_pos(int s, int d) { return d == 0 ? s : (s < CTX ? CTX - 1 - s : (PP - 1) - (s - CTX)); }
DI void scan_unit(const Ctx& C, int l, int unit) {
  const int chain = unit >> 1, half = unit & 1;
  const int b = chain / 12, h = (chain >> 1) % 6, d = chain & 1;
  const bf16_t* U = (const bf16_t*)(C.ws + WS_R1);
  const bf16_t* EW = (const bf16_t*)(C.ws + WS_R3); const bf16_t* AS = EW + (size_t)TT * 768;
  bf16_t* Y = (bf16_t*)(C.ws + WS_R5) + (size_t)d * TT * 384;
  const float* cw = inp(C, 12) + (size_t)l * 3 * 1152; const float* k_k = inp(C, 18) + l * 384; const float* k_a = inp(C, 19) + l * 384;
  const int lane = C.lane, wave = C.wave;
  LAS float* opsb = (LAS float*)C.lds;
  LAS float* ybuf = opsb + 2 * SC_CH * 384;
  constexpr int NCH = PP / SC_CH;
  if (wave >= 4) {
    const int pw = wave - 4;
    const int c = h * 64 + lane;
    const float cwr0 = cw[c], cwr1 = cw[1152 + c], cwr2 = cw[2304 + c];
    const float cwk0 = cw[384 + c], cwk1 = cw[1152 + 384 + c], cwk2 = cw[2304 + 384 + c];
    const float cwv0 = cw[768 + c], cwv1 = cw[1152 + 768 + c], cwv2 = cw[2304 + 768 + c];
    const float kkc = k_k[c], kac = k_a[c];
    for (int chunk = -1; chunk < NCH; ++chunk) {
      if (chunk >= 1) { const int cb = (chunk - 1) & 1;
#pragma unroll
        for (int i = 0; i < 4; ++i) { const int sl = pw * 8 + 2 * i + (lane >> 5), rw = lane & 31; const int p = scan_pos((chunk - 1) * SC_CH + sl, d);
          Y[(size_t)(b * PP + p) * 384 + h * 64 + half * 32 + rw] = f2bf(ybuf[(cb * SC_CH + sl) * 32 + rw]); } }
      if (chunk + 1 < NCH) { const int nb = (chunk + 1) & 1; const int s0 = (chunk + 1) * SC_CH;
#pragma unroll
        for (int hf = 0; hf < 2; ++hf) {
          unsigned short ur[4][3], uk[4][3], uv[4][3], uew[4], uas[4]; float ml[4], mr[4];
#pragma unroll
          for (int i = 0; i < 4; ++i) { const int sl = pw * 8 + hf * 4 + i; const int p = scan_pos(s0 + sl, d); const int g = b * PP + p;
            const bool hasl = (p != 0 && p != CTX), hasr = (p != CTX - 1 && p != PP - 1);
            ml[i] = hasl ? 1.f : 0.f; mr[i] = hasr ? 1.f : 0.f;
            const bf16_t* u0 = U + (size_t)g * UW + c; const bf16_t* ul = hasl ? u0 - UW : u0; const bf16_t* urr = hasr ? u0 + UW : u0;
            ur[i][0] = ul[0]; ur[i][1] = u0[0]; ur[i][2] = urr[0];
            uk[i][0] = ul[384]; uk[i][1] = u0[384]; uk[i][2] = urr[384];
            uv[i][0] = ul[768]; uv[i][1] = u0[768]; uv[i][2] = urr[768];
            uew[i] = EW[(size_t)g * 768 + d * 384 + c]; uas[i] = AS[(size_t)g * 768 + d * 384 + c]; }
#pragma unroll
          for (int i = 0; i < 4; ++i) { const int sl = pw * 8 + hf * 4 + i;
            const float r = bf2f(ur[i][1]) * cwr1 + ml[i] * bf2f(ur[i][0]) * cwr0 + mr[i] * bf2f(ur[i][2]) * cwr2;
            const float k = bf2f(uk[i][1]) * cwk1 + ml[i] * bf2f(uk[i][0]) * cwk0 + mr[i] * bf2f(uk[i][2]) * cwk2;
            const float v = bf2f(uv[i][1]) * cwv1 + ml[i] * bf2f(uv[i][0]) * cwv0 + mr[i] * bf2f(uv[i][2]) * cwv2;
            const float kr = k * kkc; const float nrm = sqrtf(wave_sum(kr * kr)); const float kk = kr / fmaxf(nrm, 1e-12f);
            const float ew = bf2f(uew[i]), a = bf2f(uas[i]);
            const float w = __expf(-ew); const float kd = k * (1.f + (a - 1.f) * kac);
            LAS float* o = opsb + (nb * SC_CH + sl) * 384 + lane;
            o[0] = r; o[64] = w; o[128] = kd; o[192] = v; o[256] = -kk; o[320] = kk * a; }
        } }
      __syncthreads();
    }
    { const int cb = (NCH - 1) & 1;
#pragma unroll
      for (int i = 0; i < 4; ++i) { const int sl = pw * 8 + 2 * i + (lane >> 5), rw = lane & 31; const int p = scan_pos((NCH - 1) * SC_CH + sl, d);
        Y[(size_t)(b * PP + p) * 384 + h * 64 + half * 32 + rw] = f2bf(ybuf[(cb * SC_CH + sl) * 32 + rw]); } }
  } else {
    const int rowl = wave * 8 + (lane >> 3), cg = lane & 7;
    const int vrow = half * 32 + rowl;
    f32x2 S[4];
#pragma unroll
    for (int j = 0; j < 4; ++j) S[j] = (f32x2){0.f, 0.f};
    __syncthreads();
    for (int chunk = 0; chunk < NCH; ++chunk) {
      const LAS float* ob = opsb + (chunk & 1) * SC_CH * 384;
      LAS float* yb = ybuf + (chunk & 1) * SC_CH * 32;
#define SC_LOADOPS(R0, R1, W0, W1, K0, K1, A0, A1, B0, B1, VV, slx) do { const LAS float* o_ = ob + (slx) * 384 + cg * 8; \
        R0 = *(const LAS f32x4*)(o_); R1 = *(const LAS f32x4*)(o_ + 4); W0 = *(const LAS f32x4*)(o_ + 64); W1 = *(const LAS f32x4*)(o_ + 68); \
        K0 = *(const LAS f32x4*)(o_ + 128); K1 = *(const LAS f32x4*)(o_ + 132); A0 = *(const LAS f32x4*)(o_ + 256); A1 = *(const LAS f32x4*)(o_ + 260); \
        B0 = *(const LAS f32x4*)(o_ + 320); B1 = *(const LAS f32x4*)(o_ + 324); VV = ob[(slx) * 384 + 192 + vrow]; } while (0)
#define SC_STEP(r0, r1, w0, w1, k0, k1, a0, a1, b0, b1, vv, YOUT) do { \
        f32x2 t = S[0] * (f32x2){a0.x, a0.y} + S[1] * (f32x2){a0.z, a0.w}; t = t + S[2] * (f32x2){a1.x, a1.y}; t = t + S[3] * (f32x2){a1.z, a1.w}; \
        float sa = t.x + t.y; \
        sa = dpp_add<0xB1>(sa); sa = dpp_add<0x4E>(sa); sa = dpp_add<0x141>(sa); \
        const f32x2 sa2 = (f32x2){sa, sa}, vv2 = (f32x2){vv, vv}; \
        S[0] = S[0] * (f32x2){w0.x, w0.y} + (sa2 * (f32x2){b0.x, b0.y} + vv2 * (f32x2){k0.x, k0.y}); \
        S[1] = S[1] * (f32x2){w0.z, w0.w} + (sa2 * (f32x2){b0.z, b0.w} + vv2 * (f32x2){k0.z, k0.w}); \
        S[2] = S[2] * (f32x2){w1.x, w1.y} + (sa2 * (f32x2){b1.x, b1.y} + vv2 * (f32x2){k1.x, k1.y}); \
        S[3] = S[3] * (f32x2){w1.z, w1.w} + (sa2 * (f32x2){b1.z, b1.w} + vv2 * (f32x2){k1.z, k1.w}); \
        f32x2 yy = S[0] * (f32x2){r0.x, r0.y} + S[1] * (f32x2){r0.z, r0.w}; yy = yy + S[2] * (f32x2){r1.x, r1.y}; yy = yy + S[3] * (f32x2){r1.z, r1.w}; \
        float y = yy.x + yy.y; \
        y = dpp_add<0xB1>(y); y = dpp_add<0x4E>(y); y = dpp_add<0x141>(y); YOUT = y; } while (0)
      f32x4 pr0, pr1, pw0, pw1, pk0, pk1, pa0, pa1, pb0, pb1; float pv;
      f32x4 qr0, qr1, qw0, qw1, qk0, qk1, qa0, qa1, qb0, qb1; float qv;
      SC_LOADOPS(pr0, pr1, pw0, pw1, pk0, pk1, pa0, pa1, pb0, pb1, pv, 0);
#pragma unroll 1
      for (int sg = 0; sg < SC_CH / 8; ++sg) {
        float ykeep = 0.f;
#pragma unroll
        for (int j = 0; j < 8; j += 2) { const int sl = sg * 8 + j; float y0, y1;
          SC_LOADOPS(qr0, qr1, qw0, qw1, qk0, qk1, qa0, qa1, qb0, qb1, qv, sl + 1);
          SC_STEP(pr0, pr1, pw0, pw1, pk0, pk1, pa0, pa1, pb0, pb1, pv, y0);
          SC_LOADOPS(pr0, pr1, pw0, pw1, pk0, pk1, pa0, pa1, pb0, pb1, pv, (sl + 2) & (SC_CH - 1));
          SC_STEP(qr0, qr1, qw0, qw1, qk0, qk1, qa0, qa1, qb0, qb1, qv, y1);
          ykeep = (cg == j) ? y0 : ykeep; ykeep = (cg == j + 1) ? y1 : ykeep; }
        yb[(sg * 8 + cg) * 32 + rowl] = ykeep;
      }
#undef SC_LOADOPS
#undef SC_STEP
      __syncthreads();
    }
  }
  __syncthreads();
}

DI void fft_unit(const Ctx& C, int seq, bool isctx) {
  const int N = isctx ? CTX : SEQ, logN = isctx ? 8 : 13, off = isctx ? 0 : CTX;
  const f32x2* src = (const f32x2*)(C.ws + WS_R4) + (size_t)seq * PP + off;
  const f32x2* TW = (const f32x2*)(C.ws + WS_TW);
  bf16_t* MC = (bf16_t*)(C.ws + WS_R6);
  LAS f32x2* x = (LAS f32x2*)C.lds;
  const int tid = C.tid;
  for (int i = tid; i < N; i += NTHREADS) x[i] = src[i];
  __syncthreads();
  const int twmul = SEQ / N;
  for (int s = 0; s < logN; ++s) { const int hb = logN - 1 - s, hh = 1 << hb;
    for (int j = tid; j < N / 2; j += NTHREADS) { const int blk = j >> hb, i = j & (hh - 1); const int i0 = (blk << (hb + 1)) + i, i1 = i0 + hh;
      const f32x2 a = x[i0], bb = x[i1]; const f32x2 tw = TW[(i << s) * twmul];
      const float dr = a.x - bb.x, di = a.y - bb.y;
      x[i0] = (f32x2){a.x + bb.x, a.y + bb.y}; x[i1] = (f32x2){dr * tw.x - di * tw.y, dr * tw.y + di * tw.x}; }
    __syncthreads(); }
  const float scale = rsqrtf(64.0f * (float)N);
  const int b = seq / 132, grp = (seq / 33) & 3, k2 = seq % 33;
  for (int pi = tid; pi < N; pi += NTHREADS) { const int k1 = (int)(__brev((unsigned)pi) >> (32 - logN));
    const bf16_t val = f2bf(x[pi].x * scale);
    MC[(size_t)(b * PP + off + k1) * DM + 768 + grp * 64 + k2] = val;
    if (k2 >= 1 && k2 <= 31) MC[(size_t)(b * PP + off + ((N - k1) & (N - 1))) * DM + 768 + grp * 64 + 64 - k2] = val; }
  __syncthreads();
}

constexpr int CK_ROW = 144, CK_SLOT = 64 * CK_ROW;
DI void ck_mma(f32x16& acc, const LAS unsigned char* A, int arow0, const LAS unsigned char* B, int brow0, int r32, int hi) {
  const LAS unsigned char* ap = A + (arow0 + r32) * CK_ROW + hi * 16; const LAS unsigned char* bp = B + (brow0 + r32) * CK_ROW + hi * 16;
#pragma unroll
  for (int kk = 0; kk < 4; ++kk) acc = MFMA32(*(const LAS bf16x8*)(ap + kk * 32), *(const LAS bf16x8*)(bp + kk * 32), acc);
}
typedef short v4i16_t __attribute__((ext_vector_type(4)));
DI void ck_mma_trA(f32x16& acc, const LAS unsigned char* T, int arow0, const LAS unsigned char* B, int brow0, int lane, int r32, int hi) {
  const int q = (lane & 15) >> 2, p = lane & 3, blk = (lane >> 4) & 1;
  const LAS unsigned char* tp = T + (8 * hi + q) * CK_ROW + (arow0 + 16 * blk) * 2 + 8 * p; const LAS unsigned char* bp = B + (brow0 + r32) * CK_ROW + hi * 16;
#pragma unroll
  for (int kk = 0; kk < 4; ++kk) {
    const v4i16_t lo = __builtin_amdgcn_ds_read_tr16_b64_v4i16((LAS v4i16_t*)(tp + kk * 16 * CK_ROW)), hi4 = __builtin_amdgcn_ds_read_tr16_b64_v4i16((LAS v4i16_t*)(tp + kk * 16 * CK_ROW + 4 * CK_ROW));
    const bf16x8 a = (bf16x8){lo[0], lo[1], lo[2], lo[3], hi4[0], hi4[1], hi4[2], hi4[3]};
    acc = MFMA32(a, *(const LAS bf16x8*)(bp + kk * 32), acc); }
}
DI void ck_store(const f32x16& acc, LAS unsigned char* Out, int arow0, int brow0, int r32, int hi) {
  LAS unsigned char* op = Out + (brow0 + r32) * CK_ROW + (arow0 + 4 * hi) * 2;
#pragma unroll
  for (int g = 0; g < 4; ++g) { u32x2 w; w.x = cvtpk(acc[4 * g], acc[4 * g + 1]); w.y = cvtpk(acc[4 * g + 2], acc[4 * g + 3]); *(LAS u32x2*)(op + g * 16) = w; }
}
#ifndef PROF_TID
#define PROF_TID 0
#endif
#ifndef PROF_CHAIN
#define PROF_CHAIN 0
#endif
#ifndef PROF_LAYER
#define PROF_LAYER 0
#endif
#ifdef PROF_SEL
#define PROF_T0(k) if (PROF_SEL == (k) && C.tid == PROF_TID) *(LAS unsigned long long*)(C.lds + 147456 - 128) = __builtin_amdgcn_s_memrealtime();
#define PROF_T1(k) if (PROF_SEL == (k) && chain == PROF_CHAIN && l == 0 && C.tid == PROF_TID) atomicAdd((unsigned*)(C.ws + WS_CTL) + 1024, (unsigned)(__builtin_amdgcn_s_memrealtime() - *(LAS unsigned long long*)(C.lds + 147456 - 128)));
#else
#define PROF_T0(k)
#define PROF_T1(k)
#endif
DI void scan_chain(const Ctx& C, int l, int chain) {
  PROF_T0(1)
#ifdef PROF_SEL
  if (PROF_SEL == 8 && C.tid == 0) *(LAS unsigned long long*)(C.lds + 147456 - 128) = __builtin_amdgcn_s_memrealtime();
  if ((PROF_SEL == 10 || PROF_SEL == 11) && C.tid == 0) *(LAS unsigned*)(C.lds + 147456 - 112) = 0u;
#endif
  const int b = chain / 12, h = (chain >> 1) % 6, d = chain & 1;
  const bf16_t* U = (const bf16_t*)(C.ws + WS_R1) + (size_t)TT * HW2;
  const float* INV = (const float*)(C.ws + WS_INV);
  const bf16_t* EW = (const bf16_t*)(C.ws + WS_R3); const bf16_t* AS = EW + (size_t)TT * 768;
  bf16_t* Y = (bf16_t*)(C.ws + WS_R5) + (size_t)d * TT * 384;
  const float* cw = inp(C, 12) + (size_t)l * 3 * 1152; const float* k_k = inp(C, 18) + l * 384; const float* k_a = inp(C, 19) + l * 384;
  const int lane = C.lane, wave = C.wave, r32 = lane & 31, hi = lane >> 5;
  LAS unsigned char* L = C.lds;
#define SLOT(n) (L + (n) * CK_SLOT)
  LAS unsigned char* const sAT = SLOT(0); LAS unsigned char* const sRT = SLOT(1); LAS unsigned char* const sBT = SLOT(2); LAS unsigned char* const sKT = SLOT(3);
  LAS unsigned char* const sVT = SLOT(4); LAS unsigned char* const sBH = SLOT(5); LAS unsigned char* const sKH = SLOT(6); LAS unsigned char* const sSB = SLOT(7);
  LAS unsigned char* const sP0 = SLOT(8); LAS unsigned char* const sP0T = SLOT(9); LAS unsigned char* const sAAK = SLOT(10); LAS unsigned char* const sARB = SLOT(11);
  LAS unsigned char* const sARK = SLOT(12); LAS unsigned char* const sXa = SLOT(13); LAS unsigned char* const sXb = SLOT(14);
  LAS float* gamC = (LAS float*)SLOT(15); LAS float* wtot = gamC + 64;
  const int t4 = wave & 3, arow0 = (t4 >> 1) * 32, brow0 = (t4 & 1) * 32;
  const int hw = lane >> 5, q2 = (lane & 31) * 2, c0 = h * 64 + q2;
  const f32x2 kkc = (f32x2){k_k[c0], k_k[c0 + 1]}, kac = (f32x2){k_a[c0], k_a[c0 + 1]};
#define UNP(u_) ((f32x2){bflo(u_), bfhi(u_)})
  f32x16 xacc, sacc;
#pragma unroll
  for (int i = 0; i < 16; ++i) { xacc[i] = 0.f; sacc[i] = 0.f; }
  unsigned pr[4], pk[4], pv[4], pew[4], pas[4]; float pin[4];
#define CK_PREFETCH(ci) do { const int p0w_ = scan_pos((ci) * 64 + wave * 8, d); const int sg_ = d == 0 ? 1 : -1; const int p0h_ = p0w_ + sg_ * 4 * hw; \
    _Pragma("unroll") for (int j = 0; j < 4; ++j) { const int g_ = b * PP + p0h_ + sg_ * j; const bf16_t* u_ = U + ((size_t)g_ * HW2 + c0); \
      pr[j] = *(const unsigned*)(u_); pk[j] = *(const unsigned*)(u_ + 384); pv[j] = *(const unsigned*)(u_ + 768); \
      const size_t o_ = (size_t)g_ * 768 + d * 384 + c0; pew[j] = *(const unsigned*)(EW + o_); pas[j] = *(const unsigned*)(AS + o_); pin[j] = INV[(size_t)g_ * 6 + h]; } } while (0)
  CK_PREFETCH(0);
  for (int ci = 0; ci < PP / 64; ++ci) {
    PROF_T0(2)
    PROF_T0(6)
    PROF_T0(12)
#ifdef PROF_SEL
    unsigned long long q0_ = 0; if (PROF_SEL == 10 && C.tid == 0) q0_ = __builtin_amdgcn_s_memrealtime();
#endif
    if (wave < 4) ck_store(sacc, sSB, arow0, brow0, r32, hi);
    f32x2 fr[4], fkd[4], fv[4], fkk[4], fal[4], flg[4];
    { f32x2 run = (f32x2){0.f, 0.f};
#pragma unroll
      for (int j = 0; j < 4; ++j) {
        const f32x2 k = UNP(pk[j]); const f32x2 al = UNP(pas[j]);
        run = run - UNP(pew[j]);
        fr[j] = UNP(pr[j]); fkd[j] = k * ((al - 1.f) * kac + 1.f); fv[j] = UNP(pv[j]); fkk[j] = (k * kkc) * pin[j]; fal[j] = al; flg[j] = run; }
      *(LAS f32x2*)(wtot + (wave * 2 + hw) * 64 + q2) = run; }
    PROF_T1(12)
    if (ci > 0) { const int s_ = C.tid >> 3, pc_ = C.tid & 7; const int p_ = scan_pos((ci - 1) * 64 + s_, d);
      *(u32x4*)(Y + (size_t)(b * PP + p_) * 384 + h * 64 + pc_ * 8) = *(const LAS u32x4*)(SLOT(8) + s_ * CK_ROW + pc_ * 16); }
    if (ci + 1 < PP / 64) CK_PREFETCH(ci + 1);
    __syncthreads();
#ifdef PROF_SEL
    if (PROF_SEL == 10 && C.tid == 0) *(LAS unsigned*)(C.lds + 147456 - 112) += (unsigned)(__builtin_amdgcn_s_memrealtime() - q0_);
#endif
    PROF_T1(6)
    PROF_T0(7)
    { f32x2 off = (f32x2){0.f, 0.f}, tot = (f32x2){0.f, 0.f}; const int seg = wave * 2 + hw;
#pragma unroll
      for (int w2 = 0; w2 < 16; ++w2) { const f32x2 t = *(const LAS f32x2*)(wtot + w2 * 64 + q2); off = off + ((w2 < seg) ? t : (f32x2){0.f, 0.f}); tot = tot + t; }
      const f32x2 eTot = (f32x2){__expf(tot.x), __expf(tot.y)};
      if (wave == 0 && hw == 0) *(LAS f32x2*)(gamC + q2) = eTot;
      f32x2 eGprev = (f32x2){__expf(off.x), __expf(off.y)};
      f32x2 tv[4], tbh[4], tkh[4];
      const int s0 = wave * 8 + hw * 4;
#pragma unroll
      for (int j = 0; j < 4; ++j) { const int s = s0 + j; const f32x2 Lc = off + flg[j];
        const f32x2 eG = (f32x2){__expf(Lc.x), __expf(Lc.y)}, eGp = eGprev, eGi = (f32x2){__builtin_amdgcn_rcpf(eG.x), __builtin_amdgcn_rcpf(eG.y)}, eGc = eTot * eGi; eGprev = eG;
        const f32x2 bb = fkk[j] * fal[j];
        const f32x2 xa = fkk[j] * eGp, xr = fr[j] * eG, xb = bb * eGi, xk = fkd[j] * eGi;
        *(LAS unsigned*)(sAT + s * CK_ROW + q2 * 2) = cvtpk(-xa.x, -xa.y);
        *(LAS unsigned*)(sRT + s * CK_ROW + q2 * 2) = cvtpk(xr.x, xr.y);
        *(LAS unsigned*)(sBT + s * CK_ROW + q2 * 2) = cvtpk(xb.x, xb.y);
        *(LAS unsigned*)(sKT + s * CK_ROW + q2 * 2) = cvtpk(xk.x, xk.y);
        tv[j] = fv[j]; tbh[j] = bb * eGc; tkh[j] = fkd[j] * eGc; }
#define PK4(T, comp) ((u32x2){cvtpk(T[0].comp, T[1].comp), cvtpk(T[2].comp, T[3].comp)})
      *(LAS u32x2*)(sVT + q2 * CK_ROW + s0 * 2) = PK4(tv, x); *(LAS u32x2*)(sVT + (q2 + 1) * CK_ROW + s0 * 2) = PK4(tv, y);
      *(LAS u32x2*)(sBH + q2 * CK_ROW + s0 * 2) = PK4(tbh, x); *(LAS u32x2*)(sBH + (q2 + 1) * CK_ROW + s0 * 2) = PK4(tbh, y);
      *(LAS u32x2*)(sKH + q2 * CK_ROW + s0 * 2) = PK4(tkh, x); *(LAS u32x2*)(sKH + (q2 + 1) * CK_ROW + s0 * 2) = PK4(tkh, y);
#undef PK4
    }
    __syncthreads();
    PROF_T1(2)
    PROF_T1(7)
#ifdef PROF_SEL
    unsigned long long q1_ = 0; if (PROF_SEL == 11 && C.tid == 0) q1_ = __builtin_amdgcn_s_memrealtime();
#endif
    PROF_T0(3)
    { f32x16 z;
#pragma unroll
      for (int i = 0; i < 16; ++i) z[i] = 0.f;
      const int bi = brow0 + r32;
      if (wave < 4) {
        f32x16 t = z, w = z;
        ck_mma(t, sBT, arow0, sAT, brow0, r32, hi);
        ck_mma(w, sBT, arow0, sRT, brow0, r32, hi);
#pragma unroll
        for (int i = 0; i < 16; ++i) { const int ai = arow0 + (i & 3) + 8 * (i >> 2) + 4 * hi; t[i] = ai < bi ? t[i] : 0.f; w[i] = ai <= bi ? w[i] : 0.f; }
        ck_store(t, sP0, arow0, brow0, r32, hi); ck_store(w, sARB, arow0, brow0, r32, hi);
      } else {
        f32x16 t = z, u = z;
        ck_mma(t, sKT, arow0, sAT, brow0, r32, hi);
        ck_mma(u, sKT, arow0, sRT, brow0, r32, hi);
#pragma unroll
        for (int i = 0; i < 16; ++i) { const int ai = arow0 + (i & 3) + 8 * (i >> 2) + 4 * hi; t[i] = ai < bi ? t[i] : 0.f; u[i] = ai <= bi ? u[i] : 0.f; }
        ck_store(t, sAAK, arow0, brow0, r32, hi); ck_store(u, sARK, arow0, brow0, r32, hi);
      } }
    __syncthreads();
    PROF_T1(3)
    PROF_T0(4)
#define CK_SQUARE(Pin, Pout) do { f32x16 t_; _Pragma("unroll") for (int i = 0; i < 16; ++i) t_[i] = 0.f; \
      ck_mma_trA(t_, Pin, arow0, Pin, brow0, lane, r32, hi);            \
      ck_store(t_, Pout, arow0, brow0, r32, hi); } while (0)
#define CK_XSTEP(Pj, Xin, Xout) do { ck_mma(xacc, Pj, arow0, Xin, brow0, r32, hi); ck_store(xacc, Xout, arow0, brow0, r32, hi); } while (0)
    if (wave < 4) CK_SQUARE(sP0, SLOT(2));
    else {
#pragma unroll
      for (int i = 0; i < 16; ++i) xacc[i] = 0.f;
      ck_mma(xacc, sAT, arow0, sSB, brow0, r32, hi); ck_mma(xacc, sAAK, arow0, sVT, brow0, r32, hi); ck_store(xacc, sXa, arow0, brow0, r32, hi); }
    __syncthreads();
    if (wave < 4) CK_SQUARE(SLOT(2), SLOT(0)); else CK_XSTEP(sP0, sXa, sXb);
    __syncthreads();
    if (wave < 4) CK_SQUARE(SLOT(0), SLOT(8)); else CK_XSTEP(SLOT(2), sXb, sXa);
    __syncthreads();
    if (wave < 4) CK_SQUARE(SLOT(8), SLOT(2)); else CK_XSTEP(SLOT(0), sXa, sXb);
    __syncthreads();
    if (wave < 4) CK_SQUARE(SLOT(2), SLOT(0)); else CK_XSTEP(SLOT(8), sXb, sXa);
    __syncthreads();
    f32x16 yacc;
    if (wave >= 4) CK_XSTEP(SLOT(2), sXa, sXb);
    else {
#pragma unroll
      for (int i = 0; i < 16; ++i) yacc[i] = 0.f;
      ck_mma(yacc, sSB, arow0, sRT, brow0, r32, hi); ck_mma(yacc, sVT, arow0, sARK, brow0, r32, hi); }
    __syncthreads();
    if (wave >= 4) CK_XSTEP(SLOT(0), sXb, sXa);
    else {
#pragma unroll
      for (int i = 0; i < 16; ++i) sacc[i] *= gamC[arow0 + (i & 3) + 8 * (i >> 2) + 4 * hi];
      ck_mma(sacc, sKH, arow0, sVT, brow0, r32, hi); }
    __syncthreads();
    PROF_T1(4)
    PROF_T0(5)
    if (wave < 4) {
      ck_mma(yacc, sXa, arow0, sARB, brow0, r32, hi); ck_mma(sacc, sBH, arow0, sXa, brow0, r32, hi);
      ck_store(yacc, SLOT(8), arow0, brow0, r32, hi);
    }
    __syncthreads();
    PROF_T1(5)
#ifdef PROF_SEL
    if (PROF_SEL == 11 && C.tid == 0) *(LAS unsigned*)(C.lds + 147456 - 112) += (unsigned)(__builtin_amdgcn_s_memrealtime() - q1_);
#endif
  }
  PROF_T1(1)
#ifdef PROF_SEL
  if ((PROF_SEL == 10 || PROF_SEL == 11) && l == PROF_LAYER && C.tid == 0) atomicMax((unsigned*)(C.ws + WS_CTL) + 1024, *(LAS unsigned*)(C.lds + 147456 - 112));
  if (PROF_SEL == 8 && C.tid == 0) atomicMax((unsigned*)(C.ws + WS_CTL) + 1024, (unsigned)(__builtin_amdgcn_s_memrealtime() - *(LAS unsigned long long*)(C.lds + 147456 - 128)));
#endif
  { const int s_ = C.tid >> 3, pc_ = C.tid & 7; const int p_ = scan_pos((PP / 64 - 1) * 64 + s_, d);
    *(u32x4*)(Y + (size_t)(b * PP + p_) * 384 + h * 64 + pc_ * 8) = *(const LAS u32x4*)(SLOT(8) + s_ * CK_ROW + pc_ * 16); }
  __syncthreads();
#undef SLOT
#undef UNP
#undef CK_PREFETCH
#undef CK_SQUARE
#undef CK_XSTEP
}
DI void mix_phase(const Ctx& C0, int l, bool with_ctx, int rep = 0) {
  unsigned* ctr = (unsigned*)(C0.ws + WS_CTL) + 64 * (1 + l + 2 * rep);
  LAS int* slot = (LAS int*)(C0.lds + 147456 - 64);
    const int n_scan = 48;
#ifdef REP_ATT
  const int n_att = 1536;
#else
  const int n_att = 768;
#endif
  const int n_attc = with_ctx ? 24 : 0, n_fft = 528, n_fftc = with_ctx ? 528 : 0;
  const int total = n_scan + n_att + n_attc + n_fft + n_fftc;
  for (;;) {
    __syncthreads();
    if (C0.tid == 0) *slot = (int)atomicAdd(ctr, 1u);
    __syncthreads();
    int it = __builtin_amdgcn_readfirstlane(*slot);
    if (it >= total) break;
    Ctx C = C0; { int t_ = C0.tid; asm volatile("" : "+v"(t_)); C.tid = t_; C.lane = t_ & 63; C.wave = __builtin_amdgcn_readfirstlane(t_ >> 6); GAS unsigned char* w_ = (GAS unsigned char*)C0.ws; asm volatile("" : "+s"(w_), "+s"(it)); C.ws = (unsigned char*)w_; }
    if (it < n_scan) { scan_chain(C, l, it); continue; } it -= n_scan;
    if (it < n_att) { const int bh = (it % 768) / 32, qb = it % 32; attn_unit(C, bh / NH, bh % NH, CTX + qb * 256, PP / 64); continue; } it -= n_att;
    if (it < n_attc) { attn_unit(C, it / NH, it % NH, 0, CTX / 64); continue; } it -= n_attc;
    if (it < n_fft) { fft_unit(C, it, false); continue; } it -= n_fft;
    fft_unit(C, it, true);
  }
  if (l == 0) { unsigned* ctr2 = (unsigned*)(C0.ws + WS_CTL) + 64 * 12;
    for (;;) { __syncthreads(); if (C0.tid == 0) *slot = (int)atomicAdd(ctr2, 1u); __syncthreads();
      const int vb = __builtin_amdgcn_readfirstlane(*slot); if (vb >= 256) break;
      phase0(C0, 1, vb, 256); __syncthreads(); } }
}
#define XB_TMO      128
#define XB_XCNT(j)  (256  + 64 * (j))
#define XB_XSUB(j)  (1280 + 64 * (j))
#define XB_XGEN(j)  (2304 + 64 * (j))
#define XB_TOP      3328
#define XB_TOPGEN   3392
#define XCD_BAR_WORDS 3456
#define XB_SPIN_CAP (1u << 18)

__device__ __forceinline__ unsigned xb_ld(unsigned* p)              { return __hip_atomic_load(p, __ATOMIC_RELAXED, __HIP_MEMORY_SCOPE_AGENT); }
__device__ __forceinline__ unsigned xb_add(unsigned* p, unsigned v) { return __hip_atomic_fetch_add(p, v, __ATOMIC_RELAXED, __HIP_MEMORY_SCOPE_AGENT); }
__device__ __forceinline__ unsigned xb_xcc_id() { return (unsigned)__builtin_amdgcn_s_getreg((3 << 11) | 20) & 0xFu; }
#define XB_SPIN(cond, bar) do { unsigned _sp = 0; while (cond) { __builtin_amdgcn_s_sleep(1); \
    if ((++_sp & 255u) == 0u) { if (xb_ld(&(bar)[XB_TMO])) break; if (_sp > XB_SPIN_CAP) { atomicAdd(&(bar)[XB_TMO], 1u); break; } } } } while (0)

struct XcdBarrier {
    unsigned* bar; unsigned x;
    volatile LAS unsigned* st;
};

__device__ __forceinline__ XcdBarrier xcd_barrier_post(unsigned* bar, volatile LAS unsigned* st) {
    XcdBarrier b; b.bar = bar; b.x = xb_xcc_id(); b.st = st;
    if (threadIdx.x == 0) (void)xb_add(&bar[XB_XCNT(b.x)], 1u);
    return b;
}
__device__ __forceinline__ void xcd_barrier_complete(unsigned* bar, unsigned x, unsigned& nloc, unsigned& nx) {
    const unsigned G = gridDim.x * gridDim.y * gridDim.z;
    unsigned sum, cnt, mine, sp = 0u;
    for (;;) {
        sum = 0u; cnt = 0u; mine = 0u;
#pragma unroll
        for (unsigned j = 0; j < 16; ++j) { const unsigned c = xb_ld(&bar[XB_XCNT(j)]); sum += c; cnt += (c > 0u) ? 1u : 0u; mine = (j == x) ? c : mine; }
        if (sum == G) break;
        __builtin_amdgcn_s_sleep(1);
        if ((++sp & 255u) == 0u) { if (xb_ld(&bar[XB_TMO])) break; if (sp > XB_SPIN_CAP) { atomicAdd(&bar[XB_TMO], 1u); break; } }
    }
    nloc = mine > 0u ? mine : 1u; nx = cnt > 0u ? cnt : 1u;
}

__device__ __forceinline__ void xcd_barrier(const XcdBarrier& b, const bool leader  ) {
    asm volatile("s_waitcnt vmcnt(0)" ::: "memory");
    __syncthreads();
    if (leader) {
        unsigned* bar = b.bar;
        __builtin_amdgcn_s_waitcnt(0);
        unsigned nloc = b.st[0], nx = b.st[1];
        if (nloc == 0u) { xcd_barrier_complete(bar, b.x, nloc, nx); b.st[0] = nloc; b.st[1] = nx; }
        const unsigned old = xb_add(&bar[XB_XSUB(b.x)], 1u);
        const unsigned gen = old / nloc;
        if (old + 1u == (gen + 1u) * nloc) {
            __builtin_amdgcn_fence(__ATOMIC_RELEASE, "agent");
            asm volatile("s_waitcnt vmcnt(0)" ::: "memory");
            const unsigned og = xb_add(&bar[XB_TOP], 1u);
            const unsigned tg = og / nx;
            if (og + 1u == (tg + 1u) * nx) xb_add(&bar[XB_TOPGEN], 1u);
            else XB_SPIN(xb_ld(&bar[XB_TOPGEN]) == tg, bar);
            __builtin_amdgcn_fence(__ATOMIC_ACQUIRE, "agent");
            xb_add(&bar[XB_XGEN(b.x)], 1u);
            asm volatile("s_waitcnt vmcnt(0)" ::: "memory");
        } else {
            XB_SPIN(xb_ld(&bar[XB_XGEN(b.x)]) == gen, bar);
            __builtin_amdgcn_fence(__ATOMIC_ACQUIRE, "agent");
            asm volatile("s_waitcnt vmcnt(0)" ::: "memory");
        }
    }
    __syncthreads();
}

constexpr int LDS_BYTES = 147456;
#ifndef REP_PHASE
#define REP_PHASE 0
#endif
#define NREP(k) ((REP_PHASE == (k)) ? 2 : 1)

#ifdef PROF_SEL
#define TPH0(k) unsigned long long tph_##k = 0; if (PROF_SEL == 100 + (k)) tph_##k = __builtin_amdgcn_s_memrealtime();
#define TPH1(k) if (PROF_SEL == 100 + (k) && C.bid == 0 && C.tid == 0) atomicAdd((unsigned*)(P.ws + WS_CTL) + 1024, (unsigned)(__builtin_amdgcn_s_memrealtime() - tph_##k));
#else
#define TPH0(k)
#define TPH1(k)
#endif
__global__ void __launch_bounds__(NTHREADS, 2) mk_fwd(Params P) {
  extern __shared__ __attribute__((aligned(16))) unsigned char lds_raw[];
  cg::grid_group grid = cg::this_grid();
  Ctx C; unsigned char* ws;
  const int wave0_ = __builtin_amdgcn_readfirstlane((int)threadIdx.x >> 6);
#define PH() do { const __attribute__((address_space(4))) char* kp_ = (const __attribute__((address_space(4))) char*)__builtin_amdgcn_kernarg_segment_ptr(); asm volatile("" : "+s"(kp_)); \
    unsigned m_ = ~0u; asm volatile("" : "+s"(m_)); int t_ = wave0_ * 64 + (int)__builtin_amdgcn_mbcnt_hi(m_, __builtin_amdgcn_mbcnt_lo(m_, 0u)); asm volatile("" : "+v"(t_));     \
    C.in = (const __attribute__((address_space(4))) cfptr*)kp_; C.out = (float*)(GAS float*)*(float* const __attribute__((address_space(4)))*)(kp_ + 256); C.ws = (unsigned char*)(GAS unsigned char*)*(unsigned char* const __attribute__((address_space(4)))*)(kp_ + 264); ws = C.ws; \
    C.lds = (LAS unsigned char*)lds_raw; C.ldsg = lds_raw; C.tid = t_; C.lane = t_ & 63; C.wave = __builtin_amdgcn_readfirstlane(t_ >> 6); int g_ = gridDim.x, b_ = blockIdx.x; asm volatile("" : "+s"(g_), "+s"(b_)); C.G = g_; C.bid = b_; } while (0)
#define R1 ((bf16_t*)(ws + WS_R1))
#define R2 ((bf16_t*)(ws + WS_R2))
#define R3 ((bf16_t*)(ws + WS_R3))
#define QB R2
#define KB (R2 + (size_t)NB * NH * PP * 96)
#define VT (R2 + (size_t)2 * NB * NH * PP * 96)
#define EW R3
#define AS (R3 + (size_t)TT * 768)
#define GG (R3 + (size_t)2 * TT * 768)
#define rq ((float*)(ws + WS_RSTD))
#define rkv (((float*)(ws + WS_RSTD)) + TT)
#define IDX ((int*)(ws + WS_IDX))

  { volatile LAS unsigned* xst = (volatile LAS unsigned*)((LAS unsigned char*)lds_raw + LDS_BYTES - 32);
    if (threadIdx.x == 0) { xst[0] = 0u; xst[1] = 0u; } }
  __syncthreads();
  (void)xcd_barrier_post((unsigned*)(P.ws + WS_CTL) + 4096, (volatile LAS unsigned*)((LAS unsigned char*)lds_raw + LDS_BYTES - 32));
#define GSYNC() do { XcdBarrier xb_; xb_.bar = (unsigned*)(C.ws + WS_CTL) + 4096; xb_.x = xb_xcc_id(); xb_.st = (volatile LAS unsigned*)((LAS unsigned char*)lds_raw + LDS_BYTES - 32); xcd_barrier(xb_, C.tid == 0); } while (0)
  { TPH0(12) for (int rep = 0; rep < NREP(12); ++rep) { PH(); phase0(C, 0, C.bid, C.G);
  grid.sync(); } TPH1(12) }
  PH(); phase0b(C, 0);
  GSYNC();
  for (int l = 0; l < 2; ++l) {
    const bool last = (l == 1);
    { TPH0(1) PH(); if (l == 0) norm_pass(C, 0, 0, 0); else norm_pass(C, 1, 1, 0);
    GSYNC(); TPH1(1) }
    { TPH0(2) for (int rep = 0; rep < NREP(2); ++rep) { PH(); { pg8::Gemm g{R2, (const bf16_t*)(ws + WS_WIN) + (size_t)l * UW * DM, DM, DM}; pg8::StaticOrder S; S.init(TT, UW, C.G, C.bid);
      EpiU E{R1, R1 + (size_t)TT * HW2}; pg8::gemm_phase(C.lds, C.tid, g, S, E); }
    GSYNC(); } TPH1(2) }
    { TPH0(3) for (int rep = 0; rep < NREP(3); ++rep) { PH(); prep_a(C, l);
    GSYNC(); } TPH1(3) }
    { TPH0(4) for (int rep = 0; rep < NREP(4); ++rep) { PH(); { pg8::Gemm g{R1 + (size_t)TT * HW2, (const bf16_t*)(ws + WS_WLW) + (size_t)l * 1536 * 128, HW2, 128}; pg8::StaticOrder S; S.init(TT, 1536, C.G, C.bid);
      EpiLW E{EW, AS, inp(C, 13) + l * 768, inp(C, 15) + l * 768}; pg8::gemm_phase(C.lds, C.tid, g, S, E); }
    PH(); { pg8::Gemm g{R1 + (size_t)TT * HW2 + 128, (const bf16_t*)(ws + WS_WG) + (size_t)l * 512 * 256, HW2, 256}; pg8::StaticOrder S; S.init(TT, 512, C.G, C.bid);
      EpiG E{GG}; pg8::gemm_phase(C.lds, C.tid, g, S, E); }
    PH(); { pg8::Gemm g{R1 + (size_t)TT * HW2 + 384, (const bf16_t*)(ws + WS_WQ) + (size_t)l * 768 * 256, HW2, 256}; pg8::StaticOrder S; S.init(TT, 768, C.G, C.bid);
      EpiQ E{QB, rq, (const float*)(ws + WS_ROPE)}; pg8::gemm_phase(C.lds, C.tid, g, S, E); }
    PH(); { pg8::Gemm g{R1 + (size_t)TT * HW2 + 640, (const bf16_t*)(ws + WS_WKV) + (size_t)l * 768 * 128, HW2, 128}; pg8::StaticOrder S; S.init(TT, 768, C.G, C.bid);
      EpiKV E{KB, VT, rkv}; pg8::gemm_phase(C.lds, C.tid, g, S, E); }
    GSYNC(); } TPH1(4) }
    { TPH0(14) PH(); conv_pass(C, l);
    GSYNC(); TPH1(14) }
    { TPH0(5) for (int rep = 0; rep < NREP(5); ++rep) { PH(); mix_phase(C, l, !last, rep);
    GSYNC(); } TPH1(5) }
    { TPH0(6) for (int rep = 0; rep < NREP(6); ++rep) { PH(); post_pass(C, l, !last);
    GSYNC(); } TPH1(6) }
    { TPH0(7) for (int rep = 0; rep < NREP(7); ++rep) { PH(); { pg8::Gemm g{(const bf16_t*)(ws + WS_R6), (const bf16_t*)(ws + WS_WOUT) + (size_t)l * DM * DM, DM, DM}; EpiPlain E{R1, DM};
      if (!last) { pg8::StaticOrder S; S.init(TT, DM, C.G, C.bid); pg8::gemm_phase(C.lds, C.tid, g, S, E); }
      else { LatentOrder S; S.init(DM, C.G, C.bid); pg8::gemm_phase(C.lds, C.tid, g, S, E); } }
    GSYNC(); } TPH1(7) }
    { TPH0(8) PH(); n2_pass(C, l, !last);
    GSYNC(); TPH1(8) }
    { TPH0(9) for (int rep = 0; rep < NREP(9); ++rep) { PH(); { const int nprob = last ? 64 : 128;
      { TPH0(20) if (C.bid < nprob) topk_problem(C, C.bid); TPH1(20) }
      const int gt = C.bid * NTHREADS + C.tid, NGT = C.G * NTHREADS;
      for (int i = gt; i < NEXP * 256; i += NGT) { const int e = i >> 8, r = i & 255; const int row = e * RPE + 4096 + r; if (last || r >= 128) IDX[row] = 0; }
      if (!last) phase0b(C, 1);
      { TPH0(21) convert_experts(C, l); TPH1(21) } }
    GSYNC(); } TPH1(9) }
    { TPH0(10) for (int rep = 0; rep < NREP(10); ++rep) { PH(); { pg8::Gemm g{R2, R3, DM, DM}; MoeOrder<true> S; S.init(last ? 16 : 17, 8, C.G, C.bid, IDX);
      EpiMoe1 E{(bf16_t*)(ws + WS_HID)}; pg8::gemm_phase(C.lds, C.tid, g, S, E); }
    GSYNC(); } TPH1(10) }
    { TPH0(11) for (int rep = 0; rep < NREP(11); ++rep) { PH(); { pg8::Gemm g{(const bf16_t*)(ws + WS_HID), R3 + (size_t)NEXP * 2048 * 1024, DM, DM}; MoeOrder<false> S; S.init(last ? 16 : 17, 4, C.G, C.bid, IDX);
      EpiMoe2 E{R1}; pg8::gemm_phase(C.lds, C.tid, g, S, E); }
    GSYNC(); } TPH1(11) }
  }
#ifdef EXTRA_SYNCS
  for (int i_ = 0; i_ < EXTRA_SYNCS; ++i_) GSYNC();
#endif
  { TPH0(13) PH(); norm_pass(C, 2, 0, 1); TPH1(13) }
#ifdef PROF_SEL
  GSYNC();
  PH(); if (C.bid == 0 && C.tid == 0) { const unsigned ticks = __hip_atomic_load((unsigned*)(P.ws + WS_CTL) + 1024, __ATOMIC_RELAXED, __HIP_MEMORY_SCOPE_AGENT) * PROF_MUL;
    const unsigned long long t0 = __builtin_amdgcn_s_memrealtime(); while (__builtin_amdgcn_s_memrealtime() - t0 < ticks) __builtin_amdgcn_s_sleep(4); }
#endif
}

extern "C" void kernel_launch(void* const* d_in, const int* in_sizes, int n_in, void* d_out, int out_size, void* d_ws, size_t ws_size, hipStream_t stream) {
  static int grid = 0;
  if (grid == 0) {
    int dev = 0, cus = 0, per_cu = 0;
    if (n_in != 32 || out_size != NB * SEQ * DM || ws_size < WS_END) { fprintf(stderr, "kernel_launch: unexpected shapes (n_in %d out %d ws %zu)\n", n_in, out_size, ws_size); grid = -1; return; }
    (void)hipGetDevice(&dev);
    (void)hipDeviceGetAttribute(&cus, hipDeviceAttributeMultiprocessorCount, dev);
    (void)hipFuncSetAttribute((const void*)mk_fwd, hipFuncAttributeMaxDynamicSharedMemorySize, LDS_BYTES);
    (void)hipOccupancyMaxActiveBlocksPerMultiprocessor(&per_cu, (const void*)mk_fwd, NTHREADS, LDS_BYTES);
    if (per_cu < 1) { fprintf(stderr, "kernel_launch: occupancy query reports %d blocks per CU\n", per_cu); grid = -1; return; }
    grid = cus;
  }
  if (grid < 0) return;
  (void)hipMemsetAsync((char*)d_ws + WS_CTL, 0, 32768, stream);
  Params p{};
  for (int i = 0; i < 32; ++i) p.in[i] = (const float*)d_in[i];
  p.out = (float*)d_out; p.ws = (unsigned char*)d_ws;
  void* args[] = {&p};
  hipError_t e = hipLaunchCooperativeKernel((const void*)mk_fwd, dim3(grid), dim3(NTHREADS), args, LDS_BYTES, stream);
  if (e != hipSuccess) fprintf(stderr, "cooperative launch failed: %s (grid %d)\n", hipGetErrorString(e), grid);
}
```

```cpp
#include <hip/hip_runtime.h>
#include <hip/hip_cooperative_groups.h>
#include <cstdio>
#include <cstdint>
namespace cg = cooperative_groups;

#define LAS __attribute__((address_space(3)))
typedef unsigned short bf16_t;
typedef short bf16x8 __attribute__((ext_vector_type(8)));
typedef float f32x4 __attribute__((ext_vector_type(4)));
typedef float f32x2 __attribute__((ext_vector_type(2)));
typedef float f32x16 __attribute__((ext_vector_type(16)));
typedef unsigned u32x4 __attribute__((ext_vector_type(4)));
typedef unsigned u32x2 __attribute__((ext_vector_type(2)));
typedef __bf16 bf16x2_t __attribute__((ext_vector_type(2)));
#define DI __device__ __forceinline__

constexpr int NB = 4, SEQ = 8192, CTX = 256, PP = SEQ + CTX  , TT = NB * PP  , DM = 1024;
constexpr int UW = 2304;
constexpr int HW2 = 1152;
constexpr int NH = 6;
constexpr int NEXP = 16, RPE = 4352  ;
constexpr float NORM_EPS = 1e-6f, GN_EPS = 64e-5f;
constexpr float QSCALE = 0.10206207261596577f * 1.4426950408889634f;
constexpr int NWAVES = 8, NTHREADS = 512;

DI unsigned cvtpk(float lo, float hi) { f32x2 v = {lo, hi}; bf16x2_t b = __builtin_convertvector(v, bf16x2_t); return __builtin_bit_cast(unsigned, b); }
DI bf16_t f2bf(float f) { return (bf16_t)(cvtpk(f, 0.f) & 0xffffu); }
DI float bf2f(bf16_t b) { return __uint_as_float(((unsigned)b) << 16); }
DI float bflo(unsigned u) { return __uint_as_float(u << 16); }
DI float bfhi(unsigned u) { return __uint_as_float(u & 0xffff0000u); }
template <int CTRL> DI float dpp_add(float x) { return x + __builtin_bit_cast(float, __builtin_amdgcn_update_dpp(0, __builtin_bit_cast(int, x), CTRL, 0xf, 0xf, true)); }
DI float rdlane(float x, int l) { return __builtin_bit_cast(float, __builtin_amdgcn_readlane(__builtin_bit_cast(int, x), l)); }
DI float wave_sum(float x) {
  x = dpp_add<0xB1>(x); x = dpp_add<0x4E>(x); x = dpp_add<0x141>(x); x = dpp_add<0x140>(x);
  return (rdlane(x, 0) + rdlane(x, 16)) + (rdlane(x, 32) + rdlane(x, 48));
}
DI float swz_xor16(float x) { return __builtin_bit_cast(float, __builtin_amdgcn_ds_swizzle(__builtin_bit_cast(int, x), 0x401F)); }
DI float swz_xor8(float x) { return __builtin_bit_cast(float, __builtin_amdgcn_ds_swizzle(__builtin_bit_cast(int, x), 0x201F)); }
DI float half_max(float x) { auto r = __builtin_amdgcn_permlane32_swap(__float_as_uint(x), __float_as_uint(x), false, false); float o; asm("v_max_f32_e32 %0, %1, %2" : "=v"(o) : "v"(__uint_as_float(r[0])), "v"(__uint_as_float(r[1]))); return o; }
DI float half_sum(float x) { auto r = __builtin_amdgcn_permlane32_swap(__float_as_uint(x), __float_as_uint(x), false, false); return __uint_as_float(r[0]) + __uint_as_float(r[1]); }
DI float sigmoidf_(float x) { return __builtin_amdgcn_rcpf(1.f + __expf(-x)); }
typedef int i32x4 __attribute__((ext_vector_type(4)));
typedef int i32x8 __attribute__((ext_vector_type(8)));
typedef float f32x8 __attribute__((ext_vector_type(8)));
DI unsigned pk4_fp8(float a, float b, float c, float d) {
  a = __builtin_amdgcn_fmed3f(a, -448.f, 448.f); b = __builtin_amdgcn_fmed3f(b, -448.f, 448.f); c = __builtin_amdgcn_fmed3f(c, -448.f, 448.f); d = __builtin_amdgcn_fmed3f(d, -448.f, 448.f);
  int w = 0; w = __builtin_amdgcn_cvt_pk_fp8_f32(a, b, w, false); w = __builtin_amdgcn_cvt_pk_fp8_f32(c, d, w, true); return (unsigned)w; }
constexpr float F8_WSCALE = 32.f, F8_HSCALE = 4.f;

namespace pg8 {
constexpr int BM = 256, BK = 64, HALF = 128, HTB = HALF * BK * 2, STAGE_BYTES = 8 * HTB, NXCD = 8, WGM = 8;
__host__ __device__ __forceinline__ int lds_byte(int r, int c) { const int st = (r >> 4) * 2 + (c >> 5), rr = r & 15, cc = c & 31, ob = rr * 64 + cc * 2; return st * 1024 + (ob ^ (((ob >> 9) & 1) << 5)); }
__host__ __device__ __forceinline__ void stage_rc(int b, int& R, int& C) { const int st = b / 1024, sb = b % 1024, swz = sb ^ (((sb >> 9) & 1) << 5); R = (st >> 1) * 16 + swz / 64; C = (st & 1) * 32 + (swz % 64) / 2; }
__host__ __device__ __forceinline__ int perm32(int rho) { const int n = rho >> 4, i = rho & 15; return 8 * (i >> 2) + 4 * n + (i & 3); }

struct Unit { int pm, pn; };
template <class E, class = void> struct IsF8 { static constexpr bool v = false; };
template <class E> struct IsF8<E, decltype((void)E::F8)> { static constexpr bool v = E::F8; };
struct Gemm { const bf16_t* A; const bf16_t* Bt; int lda; int K; };

struct StaticOrder {
  int nM, nN, nwg, G, c;
  static constexpr bool GATHER = false;
  __device__ void init(int M, int N, int G_, int c_) { nM = M / BM; nN = N / BM; nwg = nM * nN; G = G_; c = c_; }
  __device__ bool next(int i, Unit& u) const {
    const long L = (long)i * G + c; if (L >= nwg) return false;
    int wgid = (int)L; { const int q = nwg / NXCD, r = nwg % NXCD, xcd = wgid % NXCD, off = wgid / NXCD; wgid = (xcd < r ? xcd * (q + 1) : r * (q + 1) + (xcd - r) * q) + off; }
    const int nig = WGM * nN, gid = wgid / nig, fm = gid * WGM, gsz = (nM - fm) < WGM ? (nM - fm) : WGM;
    u.pm = fm + ((wgid % nig) % gsz); u.pn = (wgid % nig) / gsz; return true;
  }
  __device__ int arow(const Unit&, int) const { return 0; }
};

template <class Epi, class Sched>
__device__ __forceinline__ void gemm_phase(LAS unsigned char* lds, const int tid, const Gemm g, const Sched& S, const Epi& E) {
  const int wid = __builtin_amdgcn_readfirstlane(tid >> 6), lane = tid & 63, wr = wid >> 2, wc = wid & 3, fr = lane & 15, fq = lane >> 4;
  int K_ = g.K, lda_ = g.lda; asm volatile("" : "+s"(K_), "+s"(lda_));
  const int K = K_, nt = K / BK, lda = lda_;
  unsigned voffB[2]; int RA[2], CA[2];
#pragma unroll
  for (int i = 0; i < 2; ++i) { int R, C; stage_rc(tid * 16 + i * 8192, R, C); const int Rb = Epi::PERM ? ((R & ~31) + perm32(R & 31)) : R;
    RA[i] = R; CA[i] = C; voffB[i] = (unsigned)(Rb * K + C) * 2u; }
  int f8sc = 0x7F7F7F7F; asm volatile("" : "+v"(f8sc));
  const size_t kstep = (size_t)(BK * 2);
  const size_t hstepB = (size_t)HALF * K * 2, tstepB = 2 * hstepB;
  const size_t tstepA = (size_t)BM * lda * 2;
  const unsigned ldsw = (unsigned)wid * 1024u;
  const int aoff = lds_byte(wr * 64 + fr, fq * 8), boff = lds_byte(wc * 32 + fr, fq * 8);
#define PG8_SA(b, h) (((b) * 2 + (h)) * HTB)
#define PG8_SB(b, h) ((4 + (b) * 2 + (h)) * HTB)
#define PG8_STAGE(bufoff, gbase, voff) do { _Pragma("unroll") for (int _i = 0; _i < 2; ++_i) \
        __builtin_amdgcn_global_load_lds((const unsigned*)((const char*)(gbase) + (voff)[_i]), (LAS unsigned*)(lds + (bufoff) + ldsw + _i * 8192), 16, 0, 0); } while (0)
  const unsigned ldsu = (unsigned)(__UINTPTR_TYPE__)lds;
#define PG8_LDA(dst, b, h) do { if constexpr (IsF8<Epi>::v) { const unsigned a_ = ldsu + PG8_SA(b, h) + aoff; \
        asm volatile("ds_read_b128 v[224:227], %4\n\tds_read_b128 v[228:231], %4 offset:1024\n\tds_read_b128 v[232:235], %4 offset:2048\n\tds_read_b128 v[236:239], %4 offset:3072\n\t" \
                     "ds_read_b128 v[240:243], %4 offset:4096\n\tds_read_b128 v[244:247], %4 offset:5120\n\tds_read_b128 v[248:251], %4 offset:6144\n\tds_read_b128 v[252:255], %4 offset:7168" \
                     : "=&{v[224:231]}"(dst##8[0]), "=&{v[232:239]}"(dst##8[1]), "=&{v[240:247]}"(dst##8[2]), "=&{v[248:255]}"(dst##8[3]) : "v"(a_) : "memory"); } \
      else { _Pragma("unroll") for (int m = 0; m < 4; ++m) _Pragma("unroll") for (int k = 0; k < 2; ++k) dst[m][k] = *(const LAS bf16x8*)(lds + PG8_SA(b, h) + aoff + m * 2048 + k * 1024); } } while (0)
#define F8LDB_B0(a_) asm volatile("ds_read_b128 v[192:195], %2\n\tds_read_b128 v[196:199], %2 offset:1024\n\tds_read_b128 v[200:203], %2 offset:2048\n\tds_read_b128 v[204:207], %2 offset:3072" \
                     : "=&{v[192:199]}"(B08[0]), "=&{v[200:207]}"(B08[1]) : "v"(a_) : "memory")
#define F8LDB_B1(a_) asm volatile("ds_read_b128 v[208:211], %2\n\tds_read_b128 v[212:215], %2 offset:1024\n\tds_read_b128 v[216:219], %2 offset:2048\n\tds_read_b128 v[220:223], %2 offset:3072" \
                     : "=&{v[208:215]}"(B18[0]), "=&{v[216:223]}"(B18[1]) : "v"(a_) : "memory")
#define PG8_LDB(dst, b, h) do { if constexpr (IsF8<Epi>::v) { const unsigned a_ = ldsu + PG8_SB(b, h) + boff; F8LDB_##dst(a_); } \
      else { _Pragma("unroll") for (int n = 0; n < 2; ++n) _Pragma("unroll") for (int k = 0; k < 2; ++k) dst[n][k] = *(const LAS bf16x8*)(lds + PG8_SB(b, h) + boff + n * 2048 + k * 1024); } } while (0)
#define F8_MF(c, bq, am) "v_mfma_scale_f32_16x16x128_f8f6f4 %" #c ", %" #bq ", %" #am ", %" #c ", %14, %14 op_sel_hi:[0,0,0]\n\t"
#define F8MMA(ai, bj, R0, R1, Bv) asm volatile(F8_MF(0, 12, 8) F8_MF(1, 13, 8) F8_MF(2, 12, 9) F8_MF(3, 13, 9) F8_MF(4, 12, 10) F8_MF(5, 13, 10) F8_MF(6, 12, 11) F8_MF(7, 13, 11) \
        : "+v"(acc[ai][bj][0][0]), "+v"(acc[ai][bj][0][1]), "+v"(acc[ai][bj][1][0]), "+v"(acc[ai][bj][1][1]), "+v"(acc[ai][bj][2][0]), "+v"(acc[ai][bj][2][1]), "+v"(acc[ai][bj][3][0]), "+v"(acc[ai][bj][3][1]) \
        : "{v[224:231]}"(At8[0]), "{v[232:239]}"(At8[1]), "{v[240:247]}"(At8[2]), "{v[248:255]}"(At8[3]), R0(Bv[0]), R1(Bv[1]), "v"(f8sc))
#define F8MMA_B0(ai, bj) F8MMA(ai, bj, "{v[192:199]}", "{v[200:207]}", B08)
#define F8MMA_B1(ai, bj) F8MMA(ai, bj, "{v[208:215]}", "{v[216:223]}", B18)
#define PG8_MMA(ai, bj, At, Bt) do { __builtin_amdgcn_s_setprio(1); if constexpr (IsF8<Epi>::v) { F8MMA_##Bt(ai, bj); } \
        else { _Pragma("unroll") for (int m = 0; m < 4; ++m) _Pragma("unroll") for (int n = 0; n < 2; ++n) _Pragma("unroll") for (int k = 0; k < 2; ++k) \
          acc[ai][bj][m][n] = __builtin_amdgcn_mfma_f32_16x16x32_bf16(Bt[n][k], At[m][k], acc[ai][bj][m][n], 0, 0, 0); } \
        __builtin_amdgcn_s_setprio(0); } while (0)
#define PG8_WAIT_V(n) asm volatile("s_waitcnt vmcnt(" #n ")" ::: "memory")
#define PG8_WAIT_L(n) asm volatile("s_waitcnt lgkmcnt(" #n ")" ::: "memory")
#define PG8_BAR __builtin_amdgcn_s_barrier()
#define PG8_SCHED __builtin_amdgcn_sched_barrier(0)
#define PG8_OFFS(dst, u) do { _Pragma("unroll") for (int _h = 0; _h < 2; ++_h) _Pragma("unroll") for (int _i = 0; _i < 2; ++_i) \
        dst[_h][_i] = Sched::GATHER ? (unsigned)((size_t)S.arow(u, _h * HALF + RA[_i]) * lda + CA[_i]) * 2u : (unsigned)((_h * HALF + RA[_i]) * lda + CA[_i]) * 2u; } while (0)
  Unit cur, nxt; int ui = 0;
  if (!S.next(0, cur)) return;
  f32x4 acc[2][2][4][2];
#pragma unroll
  for (int a = 0; a < 2; ++a)
#pragma unroll
    for (int b = 0; b < 2; ++b)
#pragma unroll
      for (int m = 0; m < 4; ++m)
#pragma unroll
        for (int n = 0; n < 2; ++n) acc[a][b][m][n] = (f32x4){0.f, 0.f, 0.f, 0.f};
  bf16x8 At[4][2], B0[2][2], B1[2][2];
  i32x8 At8[4], B08[2], B18[2];
  unsigned oAc[2][2], oAn[2][2];
  PG8_OFFS(oAc, cur);
  const char* cA = (const char*)g.A + (Sched::GATHER ? (size_t)0 : (size_t)cur.pm * tstepA); const char* cB = (const char*)g.Bt + (size_t)cur.pn * tstepB;
  PG8_STAGE(PG8_SB(0, 0), cB, voffB); PG8_STAGE(PG8_SB(0, 1), cB + hstepB, voffB); PG8_STAGE(PG8_SA(0, 0), cA, oAc[0]); PG8_STAGE(PG8_SA(0, 1), cA, oAc[1]);
  if (wr == 1) PG8_BAR;
  PG8_WAIT_V(2); PG8_BAR;
  PG8_STAGE(PG8_SB(1, 0), cB + kstep, voffB); PG8_STAGE(PG8_SA(1, 0), cA + kstep, oAc[0]); PG8_STAGE(PG8_SB(1, 1), cB + hstepB + kstep, voffB);
  PG8_WAIT_V(6); PG8_BAR;
  for (;;) {
    const bool has_next = S.next(ui + 1, nxt);
    if (has_next) { PG8_OFFS(oAn, nxt); }
    else {
#pragma unroll
      for (int _h = 0; _h < 2; ++_h)
#pragma unroll
        for (int _i = 0; _i < 2; ++_i) oAn[_h][_i] = oAc[_h][_i];
    }
    const char* nA = has_next ? (const char*)g.A + (Sched::GATHER ? (size_t)0 : (size_t)nxt.pm * tstepA) : cA; const char* nB = has_next ? (const char*)g.Bt + (size_t)nxt.pn * tstepB : cB;
    for (int t = 0; t < nt; t += 2) {
      const bool last = (t == nt - 2);
      const char* a1 = cA + (size_t)(t + 1) * kstep;
      const char* a2 = last ? nA : cA + (size_t)(t + 2) * kstep; const char* b2 = last ? nB : cB + (size_t)(t + 2) * kstep;
      const char* a3 = a2 + kstep; const char* b3 = b2 + kstep;
      unsigned o2[2][2];
#pragma unroll
      for (int _h = 0; _h < 2; ++_h)
#pragma unroll
        for (int _i = 0; _i < 2; ++_i) o2[_h][_i] = last ? oAn[_h][_i] : oAc[_h][_i];
      PG8_LDB(B0, 0, 0); PG8_LDB(B1, 0, 1); PG8_SCHED; PG8_LDA(At, 0, 0); PG8_STAGE(PG8_SA(1, 1), a1, oAc[1]);
      PG8_WAIT_V(8); PG8_WAIT_L(0); PG8_BAR; PG8_MMA(0, 0, At, B0); PG8_MMA(0, 1, At, B1); PG8_BAR; PG8_SCHED;
      PG8_LDA(At, 0, 1); PG8_STAGE(PG8_SB(0, 0), b2, voffB); PG8_STAGE(PG8_SB(0, 1), b2 + hstepB, voffB); PG8_STAGE(PG8_SA(0, 0), a2, o2[0]);
      PG8_WAIT_V(8); PG8_WAIT_L(0); PG8_BAR; PG8_MMA(1, 0, At, B0); PG8_MMA(1, 1, At, B1); PG8_BAR; PG8_SCHED;
      PG8_LDB(B0, 1, 0); PG8_LDB(B1, 1, 1); PG8_SCHED; PG8_LDA(At, 1, 0); PG8_STAGE(PG8_SA(0, 1), a2, o2[1]);
      PG8_WAIT_V(8); PG8_WAIT_L(0); PG8_BAR; PG8_MMA(0, 0, At, B0); PG8_MMA(0, 1, At, B1); PG8_BAR; PG8_SCHED;
      PG8_LDA(At, 1, 1); PG8_STAGE(PG8_SB(1, 0), b3, voffB); PG8_STAGE(PG8_SB(1, 1), b3 + hstepB, voffB); PG8_STAGE(PG8_SA(1, 0), a3, o2[0]);
      PG8_WAIT_V(8); PG8_WAIT_L(0); PG8_BAR; PG8_MMA(1, 0, At, B0); PG8_MMA(1, 1, At, B1); PG8_BAR; PG8_SCHED;
    }
    if (wr == 0) PG8_BAR;
    if constexpr (IsF8<Epi>::v) asm volatile("s_nop 15\n\ts_nop 15" ::: "memory");
    E(acc, cur, wr, wc, fr, fq);
    if (!has_next) break;
#pragma unroll
    for (int a = 0; a < 2; ++a)
#pragma unroll
      for (int b = 0; b < 2; ++b)
#pragma unroll
        for (int m = 0; m < 4; ++m)
#pragma unroll
          for (int n = 0; n < 2; ++n) acc[a][b][m][n] = (f32x4){0.f, 0.f, 0.f, 0.f};
    cur = nxt; cA = nA; cB = nB; ++ui;
#pragma unroll
    for (int _h = 0; _h < 2; ++_h)
#pragma unroll
      for (int _i = 0; _i < 2; ++_i) oAc[_h][_i] = oAn[_h][_i];
    if (wr == 1) PG8_BAR;
  }
  PG8_WAIT_V(0);
  PG8_BAR;
#undef PG8_SA
#undef PG8_SB
#undef PG8_STAGE
#undef PG8_LDA
#undef PG8_LDB
#undef PG8_MMA
#undef PG8_WAIT_V
#undef PG8_WAIT_L
#undef PG8_BAR
#undef PG8_SCHED
#undef PG8_OFFS
#undef F8LDB_B1
#undef F8LDB_B0
#undef F8MMA_B1
#undef F8MMA_B0
#undef F8MMA
#undef F8_MF
}
}
using pg8::Unit;
struct EpiU {
  static constexpr bool PERM = true;
  bf16_t* RKV; bf16_t* REST;
  DI void operator()(const f32x4 (&acc)[2][2][4][2], const Unit& u, int wr, int wc, int fr, int fq) const {
    const int row0 = u.pm * 256 + wr * 64 + fr;
#pragma unroll
    for (int ai = 0; ai < 2; ++ai)
#pragma unroll
      for (int m = 0; m < 4; ++m) { const size_t ro = (size_t)(row0 + ai * 128 + m * 16) * HW2;
#pragma unroll
        for (int bj = 0; bj < 2; ++bj) { const int col = u.pn * 256 + bj * 128 + wc * 32 + 8 * fq;
          f32x4 v0 = acc[ai][bj][m][0], v1 = acc[ai][bj][m][1];
          if (col >= 1152 && col < 1216) {
#pragma unroll
            for (int j = 0; j < 4; ++j) { v0[j] = tanhf(v0[j]); v1[j] = tanhf(v1[j]); }
          } else if (col >= 1280 && col < 1536) {
#pragma unroll
            for (int j = 0; j < 4; ++j) { v0[j] = sigmoidf_(v0[j]); v1[j] = sigmoidf_(v1[j]); }
          }
          u32x4 w; w.x = cvtpk(v0[0], v0[1]); w.y = cvtpk(v0[2], v0[3]); w.z = cvtpk(v1[0], v1[1]); w.w = cvtpk(v1[2], v1[3]);
          *(u32x4*)((col < HW2 ? RKV + col : REST + (col - HW2)) + ro) = w; } }
  }
};
struct EpiPlain {
  static constexpr bool PERM = true;
  bf16_t* O; int ldc;
  DI void operator()(const f32x4 (&acc)[2][2][4][2], const Unit& u, int wr, int wc, int fr, int fq) const {
    const int row0 = u.pm * 256 + wr * 64 + fr;
#pragma unroll
    for (int ai = 0; ai < 2; ++ai)
#pragma unroll
      for (int m = 0; m < 4; ++m) { bf16_t* rowp = O + (size_t)(row0 + ai * 128 + m * 16) * ldc;
#pragma unroll
        for (int bj = 0; bj < 2; ++bj) { const int col = u.pn * 256 + bj * 128 + wc * 32 + 8 * fq;
          const f32x4 v0 = acc[ai][bj][m][0], v1 = acc[ai][bj][m][1];
          u32x4 w; w.x = cvtpk(v0[0], v0[1]); w.y = cvtpk(v0[2], v0[3]); w.z = cvtpk(v1[0], v1[1]); w.w = cvtpk(v1[2], v1[3]);
          *(u32x4*)(rowp + col) = w; } }
  }
};
struct EpiLW {
  static constexpr bool PERM = true;
  bf16_t* EW; bf16_t* AS; const float* w0; const float* a0;
  DI void operator()(const f32x4 (&acc)[2][2][4][2], const Unit& u, int wr, int wc, int fr, int fq) const {
    const int row0 = u.pm * 256 + wr * 64 + fr;
    const bool isw = u.pn < 3;
    bf16_t* O = isw ? EW : AS; const float* bias = isw ? w0 : a0; const float sc = isw ? 0.6065306597126334f : 1.f;
    const int cb = (isw ? u.pn : u.pn - 3) * 256;
#pragma unroll
    for (int bj = 0; bj < 2; ++bj) { const int col = cb + bj * 128 + wc * 32 + 8 * fq;
      const f32x4 b0 = *(const f32x4*)(bias + col), b1 = *(const f32x4*)(bias + col + 4);
#pragma unroll
      for (int ai = 0; ai < 2; ++ai)
#pragma unroll
        for (int m = 0; m < 4; ++m) { bf16_t* rowp = O + (size_t)(row0 + ai * 128 + m * 16) * 768;
          f32x4 v0 = acc[ai][bj][m][0] + b0, v1 = acc[ai][bj][m][1] + b1;
#pragma unroll
          for (int j = 0; j < 4; ++j) { v0[j] = sc * sigmoidf_(v0[j]); v1[j] = sc * sigmoidf_(v1[j]); }
          u32x4 w; w.x = cvtpk(v0[0], v0[1]); w.y = cvtpk(v0[2], v0[3]); w.z = cvtpk(v1[0], v1[1]); w.w = cvtpk(v1[2], v1[3]);
          *(u32x4*)(rowp + col) = w; asm volatile("" ::: "memory"); } }
  }
};
struct EpiG {
  static constexpr bool PERM = true;
  bf16_t* G;
  DI void operator()(const f32x4 (&acc)[2][2][4][2], const Unit& u, int wr, int wc, int fr, int fq) const {
    const int row0 = u.pm * 256 + wr * 64 + fr;
#pragma unroll
    for (int bj = 0; bj < 2; ++bj) { const int col = u.pn * 256 + bj * 128 + wc * 32 + 8 * fq;
      if (col < 384) {
#pragma unroll
        for (int ai = 0; ai < 2; ++ai)
#pragma unroll
          for (int m = 0; m < 4; ++m) { bf16_t* rowp = G + (size_t)(row0 + ai * 128 + m * 16) * 384;
            const f32x4 v0 = acc[ai][bj][m][0], v1 = acc[ai][bj][m][1];
            u32x4 w; w.x = cvtpk(v0[0], v0[1]); w.y = cvtpk(v0[2], v0[3]); w.z = cvtpk(v1[0], v1[1]); w.w = cvtpk(v1[2], v1[3]);
            *(u32x4*)(rowp + col) = w; } } }
  }
};
struct EpiQ {
  static constexpr bool PERM = true;
  bf16_t* QB; const float* rstd; const float* rope;
  DI void operator()(const f32x4 (&acc)[2][2][4][2], const Unit& u, int wr, int wc, int fr, int fq) const {
    const int row0 = u.pm * 256 + wr * 64 + fr;
    const int b = (u.pm * 256) / PP;
#pragma unroll
    for (int bj = 0; bj < 2; ++bj) { const int col = u.pn * 256 + bj * 128 + wc * 32 + 8 * fq;
      const int hh = col / 96, dim = col - hh * 96;
      const bool isrope = dim >= 64;
#pragma unroll
      for (int ai = 0; ai < 2; ++ai)
#pragma unroll
        for (int m = 0; m < 4; ++m) { const int g = row0 + ai * 128 + m * 16; const int p = g - b * PP;
          const float s = rstd[g] * QSCALE;
          float v[8];
#pragma unroll
          for (int j = 0; j < 4; ++j) { v[j] = acc[ai][bj][m][0][j] * s; v[4 + j] = acc[ai][bj][m][1][j] * s; }
          if (isrope) {
            float o[8];
#pragma unroll
            for (int j = 0; j < 8; ++j) o[j] = swz_xor16(v[j]);
            if (p >= CTX) { const int li = p - CTX; const int pos = (fq & 2) ? (li & 63) : (li >> 6);
              const f32x2* rp = (const f32x2*)rope + pos * 8;
#pragma unroll
              for (int j = 0; j < 8; ++j) { const f32x2 cs = rp[j]; v[j] = (fq & 1) ? (v[j] * cs.x + o[j] * cs.y) : (v[j] * cs.x - o[j] * cs.y); } }
          }
          if (col < 576) { u32x4 w; w.x = cvtpk(v[0], v[1]); w.y = cvtpk(v[2], v[3]); w.z = cvtpk(v[4], v[5]); w.w = cvtpk(v[6], v[7]);
            *(u32x4*)(QB + ((size_t)(b * NH + hh) * PP + p) * 96 + dim) = w; }
          asm volatile("" ::: "memory"); }
    }
  }
};
DI int vperm(int p) { const int q = p & 15; return (p & ~15) | (((q >> 2) & 1) << 3) | ((q >> 3) << 2) | (q & 3); }
struct EpiKV {
  static constexpr bool PERM = true;
  bf16_t* KB; bf16_t* VT; const float* rstd;
  DI void operator()(const f32x4 (&acc)[2][2][4][2], const Unit& u, int wr, int wc, int fr, int fq) const {
    const int row0 = u.pm * 256 + wr * 64 + fr;
    const int b = (u.pm * 256) / PP;
#pragma unroll
    for (int bj = 0; bj < 2; ++bj) { const int col = u.pn * 256 + bj * 128 + wc * 32 + 8 * fq;
      const int hh = col >> 7, j0 = col & 127;
#pragma unroll
      for (int ai = 0; ai < 2; ++ai)
#pragma unroll
        for (int m = 0; m < 4; ++m) { const int g = row0 + ai * 128 + m * 16; const int p = g - b * PP;
          const float s = rstd[g];
          float v[8];
#pragma unroll
          for (int j = 0; j < 4; ++j) { v[j] = acc[ai][bj][m][0][j] * s; v[4 + j] = acc[ai][bj][m][1][j] * s; }
          if (j0 < 64) { u32x4 w; w.x = cvtpk(v[0], v[1]); w.y = cvtpk(v[2], v[3]); w.z = cvtpk(v[4], v[5]); w.w = cvtpk(v[6], v[7]);
            *(u32x4*)(KB + ((size_t)(b * NH + hh) * PP + p) * 96 + j0) = w; }
          else { bf16_t* vt = VT + ((size_t)(b * NH + hh) * 64 + (j0 - 64)) * PP + vperm(p);
#pragma unroll
            for (int j = 0; j < 8; ++j) vt[(size_t)j * PP] = f2bf(v[j]); }
          asm volatile("" ::: "memory"); }
    }
  }
};
struct EpiMoe1 {
  static constexpr bool PERM = true;
  static constexpr bool F8 = true;
  unsigned char* HID;
  DI void operator()(const f32x4 (&acc)[2][2][4][2], const Unit& u, int wr, int wc, int fr, int fq) const {
    const int row0 = u.pm * 256 + wr * 64 + fr; const int pnl = u.pn & 7;
    constexpr float IS = 1.f / F8_WSCALE;
#pragma unroll
    for (int ai = 0; ai < 2; ++ai)
#pragma unroll
      for (int m = 0; m < 4; ++m) { unsigned char* rowp = HID + (size_t)(row0 + ai * 128 + m * 16) * 1024 + pnl * 128 + wc * 32 + 8 * fq;
        u32x2 w;
#pragma unroll
        for (int n = 0; n < 2; ++n) { const f32x4 gv = acc[ai][0][m][n] * IS, uv = acc[ai][1][m][n] * (IS * F8_HSCALE); float h[4];
#pragma unroll
          for (int j = 0; j < 4; ++j) h[j] = gv[j] * __builtin_amdgcn_rcpf(1.f + __expf(-gv[j])) * uv[j];
          const unsigned q = pk4_fp8(h[0], h[1], h[2], h[3]); if (n == 0) w.x = q; else w.y = q; }
        *(u32x2*)rowp = w; }
  }
};
struct EpiMoe2 {
  static constexpr bool PERM = true;
  static constexpr bool F8 = true;
  bf16_t* O;
  DI void operator()(const f32x4 (&acc)[2][2][4][2], const Unit& u, int wr, int wc, int fr, int fq) const {
    const int row0 = u.pm * 256 + wr * 64 + fr; const int pnl = u.pn & 3;
    constexpr float IS = 1.f / (F8_WSCALE * F8_HSCALE);
#pragma unroll
    for (int ai = 0; ai < 2; ++ai)
#pragma unroll
      for (int m = 0; m < 4; ++m) { bf16_t* rowp = O + (size_t)(row0 + ai * 128 + m * 16) * 1024;
#pragma unroll
        for (int bj = 0; bj < 2; ++bj) { const int col = pnl * 256 + bj * 128 + wc * 32 + 8 * fq;
          const f32x4 v0 = acc[ai][bj][m][0] * IS, v1 = acc[ai][bj][m][1] * IS;
          u32x4 w; w.x = cvtpk(v0[0], v0[1]); w.y = cvtpk(v0[2], v0[3]); w.z = cvtpk(v1[0], v1[1]); w.w = cvtpk(v1[2], v1[3]);
          *(u32x4*)(rowp + col) = w; } }
  }
};
template <bool GATH> struct MoeOrder {
  static constexpr bool GATHER = GATH;
  int tpe, nN, nwg, G, c; const int* idx;
  __device__ void init(int tpe_, int nN_, int G_, int c_, const int* idx_) { tpe = tpe_; nN = nN_; nwg = NEXP * tpe * nN; G = G_; c = c_; idx = idx_; }
  __device__ bool next(int i, Unit& u) const {
    const int cx = (G % 8 == 0) ? (c % 8) * (G / 8) + c / 8 : c;
    const long L = (long)i * G + cx; if (L >= nwg) return false;
    const int per = tpe * nN, e = (int)L / per, rem = (int)L % per, pnl = rem / tpe, pml = rem % tpe;
    u.pm = e * 17 + pml; u.pn = e * nN + pnl; return true;
  }
  __device__ int arow(const Unit& u, int r) const { return idx[u.pm * 256 + r]; }
};

struct LatentOrder {
  pg8::StaticOrder S;
  static constexpr bool GATHER = false;
  __device__ void init(int N, int G_, int c_) { S.init(NB * (SEQ / 256) * 256, N, G_, c_); }
  __device__ bool next(int i, Unit& u) const { if (!S.next(i, u)) return false; u.pm = u.pm + u.pm / 32 + 1; return true; }
  __device__ int arow(const Unit&, int) const { return 0; }
};
constexpr size_t MiB = (size_t)1 << 20;
constexpr size_t WS_CTL = 0;
constexpr size_t WS_MODP = 1 * MiB;
constexpr size_t WS_MOD = 3 * MiB;
constexpr size_t WS_TW = 3 * MiB + 256 * 1024;
constexpr size_t WS_ROPE = 3 * MiB + 384 * 1024;
constexpr size_t WS_RSTD = 3 * MiB + 512 * 1024;
constexpr size_t WS_WIN = 4 * MiB;
constexpr size_t WS_WOUT = 13 * MiB;
constexpr size_t WS_WLW = 17 * MiB;
constexpr size_t WS_WG = 18 * MiB;
constexpr size_t WS_WQ = 19 * MiB;
constexpr size_t WS_WKV = 20 * MiB;
constexpr size_t WS_AFF = 21 * MiB;
constexpr size_t WS_IDX = 24 * MiB;
constexpr size_t WS_SLOT = 29 * MiB;
constexpr size_t WS_INV = 32 * MiB;
constexpr size_t WS_XCTX = 25 * MiB;
constexpr size_t WS_R1 = 36 * MiB;
constexpr size_t WS_R2 = 192 * MiB;
constexpr size_t WS_R3 = 292 * MiB;
constexpr size_t WS_R4 = 416 * MiB;
constexpr size_t WS_R5 = 452 * MiB;
constexpr size_t WS_R6 = 502 * MiB;
constexpr size_t WS_HID = 416 * MiB;
constexpr size_t WS_END = 568 * MiB;
constexpr size_t WEXP_OFF = 66 * MiB;

struct Params {
  const float* in[32];
  float* out; unsigned char* ws;
};

typedef const float* cfptr;
struct Ctx {
  const __attribute__((address_space(4))) cfptr* in; float* out; unsigned char* ws;
  LAS unsigned char* lds; unsigned char* ldsg;
  int tid, lane, wave, G, bid;
};

#define GAS __attribute__((address_space(1)))
DI const float* inp(const Ctx& C, int k) { return (const float*)(const GAS float*)C.in[k]; }
DI const float* in_row(const Ctx& C, int g) { const int b = g / PP, p = g - b * PP; return p < CTX ? inp(C, 2) + ((size_t)b * CTX + p) * DM : inp(C, 0) + ((size_t)b * SEQ + (p - CTX)) * DM; }
DI bf16_t* xs_row(const Ctx& C, int g, bool alt) { return (alt ? (bf16_t*)(C.ws + WS_R2 + 34 * MiB) : (bf16_t*)C.out) + (size_t)g * DM; }
DI float* out_row(const Ctx& C, int g) { const int b = g / PP, p = g - b * PP; return C.out + ((size_t)b * SEQ + (p - CTX)) * DM; }
DI f32x4 unpk4(float lo, float hi) { const unsigned a = __float_as_uint(lo), b = __float_as_uint(hi); return (f32x4){bflo(a), bfhi(a), bflo(b), bfhi(b)}; }
DI int mod_row(int g) { const int b = g / PP, p = g - b * PP; return p < CTX ? 4 : b; }
DI const float* modv(const Ctx& C, int l, int r, int j) { return (const float*)(C.ws + WS_MOD) + ((size_t)(l * 5 + r) * 6 + j) * DM; }

template <class RowMap>
DI void transpose_item(const float* W, int K, int N, bf16_t* WT, int ldk, LAS float* scr, int item, int lane, const RowMap& rm) {
  const int nblk = N / 32, kb = item / nblk, nb = item % nblk, k0 = 64 * kb, n0 = 32 * nb;
  f32x4 v[8]; const int rr = lane >> 3, c4 = (lane & 7) * 4;
#pragma unroll
  for (int i = 0; i < 8; ++i) v[i] = *(const f32x4*)(W + (size_t)(k0 + 8 * i + rr) * N + n0 + c4);
#pragma unroll
  for (int i = 0; i < 8; ++i) *(LAS f32x4*)(scr + (8 * i + rr) * 36 + c4) = v[i];
  asm volatile("s_waitcnt lgkmcnt(0)" ::: "memory");
  const int c = lane & 7;
#pragma unroll
  for (int j = 0; j < 4; ++j) { const int n = (lane >> 3) + 8 * j; const LAS float* s = scr + (8 * c) * 36 + n;
    u32x4 o; o.x = cvtpk(s[0 * 36], s[1 * 36]); o.y = cvtpk(s[2 * 36], s[3 * 36]); o.z = cvtpk(s[4 * 36], s[5 * 36]); o.w = cvtpk(s[6 * 36], s[7 * 36]);
    const int r = rm(n0 + n);
    if (r >= 0) *(u32x4*)(WT + (size_t)r * ldk + k0 + 8 * c) = o; }
  asm volatile("s_waitcnt lgkmcnt(0)" ::: "memory");
}
template <class RowMap>
DI void transpose_item8(const float* W, int K, int N, unsigned char* WT, int ldk, LAS float* scr, int item, int lane, const RowMap& rm, float scale) {
  const int nblk = N / 32, kb = item / nblk, nb = item % nblk, k0 = 64 * kb, n0 = 32 * nb;
  f32x4 v[8]; const int rr = lane >> 3, c4 = (lane & 7) * 4;
#pragma unroll
  for (int i = 0; i < 8; ++i) v[i] = *(const f32x4*)(W + (size_t)(k0 + 8 * i + rr) * N + n0 + c4);
#pragma unroll
  for (int i = 0; i < 8; ++i) *(LAS f32x4*)(scr + (8 * i + rr) * 36 + c4) = v[i] * scale;
  asm volatile("s_waitcnt lgkmcnt(0)" ::: "memory");
  const int c = lane & 7;
#pragma unroll
  for (int j = 0; j < 4; ++j) { const int n = (lane >> 3) + 8 * j; const LAS float* s = scr + (8 * c) * 36 + n;
    u32x2 o; o.x = pk4_fp8(s[0 * 36], s[1 * 36], s[2 * 36], s[3 * 36]); o.y = pk4_fp8(s[4 * 36], s[5 * 36], s[6 * 36], s[7 * 36]);
    const int r = rm(n0 + n);
    if (r >= 0) *(u32x2*)(WT + (size_t)r * ldk + k0 + 8 * c) = o; }
  asm volatile("s_waitcnt lgkmcnt(0)" ::: "memory");
}
struct MapIn { DI int operator()(int n) const { return n < 1440 ? n : (n < 1856 ? n + 96 : -1); } };
struct MapId { DI int operator()(int n) const { return n; } };
struct MapGate { int up; DI int operator()(int f) const { return 256 * (f >> 7) + 128 * up + (f & 127); } };

DI void phase0(const Ctx& C, const int lsel, const int vbid, const int vG) {
  const int gw = vbid * NWAVES + C.wave, NGW = vG * NWAVES;
  const int gt = vbid * NTHREADS + C.tid, NGT = vG * NTHREADS;
  LAS float* scr = (LAS float*)(C.lds + C.wave * 16384);
  LAS f32x2* tw64p = (LAS f32x2*)(C.lds + 8 * 16384);
  if (C.tid < 64) { float s_, c_; sincospif((float)C.tid * (2.0f / 64.0f), &s_, &c_); tw64p[C.tid] = (f32x2){c_, s_}; }
  __syncthreads();
  {
    const float* cin = inp(C, 1); const float* cctx = inp(C, 3);
#define SIL(r_, k_) (*(LAS float*)(C.lds + 16384 * (r_) + 12288 + 4 * (k_)))
    for (int i = C.tid; i < 5 * DM; i += NTHREADS) { const float v = i < 4 * DM ? cin[i] : cctx[i - 4 * DM]; SIL(i >> 10, i & 1023) = v * sigmoidf_(v); }
    __syncthreads();
    for (int it = gw; it < 96 * 8; it += NGW) {
      const int l = lsel, r_ = it, cc = r_ / 8, kc = r_ % 8;
      const float* W = inp(C, 4) + (size_t)l * DM * 6144 + (size_t)(kc * 128) * 6144 + cc * 64 + C.lane;
      float a0 = 0.f, a1 = 0.f, a2 = 0.f, a3 = 0.f, a4 = 0.f;
#pragma unroll 32
      for (int k = 0; k < 128; ++k) { const float w = W[(size_t)k * 6144]; const int kk = kc * 128 + k;
        a0 += SIL(0, kk) * w; a1 += SIL(1, kk) * w; a2 += SIL(2, kk) * w; a3 += SIL(3, kk) * w; a4 += SIL(4, kk) * w; }
      float* P = (float*)(C.ws + WS_MODP) + ((size_t)(l * 8 + kc) * 5) * 6144 + cc * 64 + C.lane;
      P[0] = a0; P[6144] = a1; P[2 * 6144] = a2; P[3 * 6144] = a3; P[4 * 6144] = a4;
    }
#undef SIL
    __syncthreads();
  }
  { const int l = lsel;
    bf16_t* WT = (bf16_t*)(C.ws + WS_WIN) + (size_t)l * UW * DM;
    for (int i = gt; i < 192 * DM / 8; i += NGT) { const int r = i / (DM / 8), c8 = i % (DM / 8); const int row = r < 96 ? 1440 + r : 1952 + (r - 96);
      unsigned z_ = 0u; asm volatile("" : "+v"(z_));
      *(u32x4*)(WT + (size_t)row * DM + c8 * 8) = (u32x4){z_, z_, z_, z_}; }
    for (int it = gw; it < 16 * 66; it += NGW) transpose_item(inp(C, 10) + (size_t)l * DM * 2112, DM, 2112, WT, DM, scr, it, C.lane, MapIn());
    for (int it = gw; it < 4 * DM; it += NGW) { const int g = it / DM, k = it % DM; const float* wrow = inp(C, 10) + (size_t)l * DM * 2112 + (size_t)k * 2112 + 1856 + 64 * g;
      const int c_ = C.lane, k2 = c_ <= 32 ? c_ : c_ - 32; float acc = 0.f;
      const float wv_ = wrow[C.lane];
#pragma unroll 16
      for (int n = 0; n < 64; ++n) { const f32x2 t_ = tw64p[(k2 * n) & 63]; acc += rdlane(wv_, n) * (c_ <= 32 ? t_.x : t_.y); }
      WT[(size_t)(2048 + 64 * g + c_) * DM + k] = f2bf(acc); }
    bf16_t* WO = (bf16_t*)(C.ws + WS_WOUT) + (size_t)l * DM * DM;
    for (int it = gw; it < 12 * 32; it += NGW) transpose_item(inp(C, 11) + (size_t)l * DM * DM, 768, DM, WO, DM, scr, it, C.lane, MapId());
    const float* wf = inp(C, 27) + (size_t)l * 256 * 256; const float* wo = inp(C, 11) + (size_t)l * DM * DM + (size_t)768 * DM;
    for (int it = gw; it < 64 * 16; it += NGW) { const int kq = it / 16, nc = it % 16; const int n = nc * 64 + C.lane;
      float a0 = 0.f, a1 = 0.f, a2 = 0.f, a3 = 0.f;
      float wfv[4][4];
#pragma unroll
      for (int q = 0; q < 4; ++q)
#pragma unroll
        for (int jj = 0; jj < 4; ++jj) wfv[q][jj] = wf[(kq * 4 + q) * 256 + jj * 64 + C.lane];
#pragma unroll
      for (int jj = 0; jj < 4; ++jj) {
#pragma unroll 16
        for (int jl = 0; jl < 64; ++jl) { const float w = wo[(size_t)(jj * 64 + jl) * DM + n];
          a0 += rdlane(wfv[0][jj], jl) * w; a1 += rdlane(wfv[1][jj], jl) * w; a2 += rdlane(wfv[2][jj], jl) * w; a3 += rdlane(wfv[3][jj], jl) * w; } }
      u32x2 o; o.x = cvtpk(a0, a1); o.y = cvtpk(a2, a3);
      *(u32x2*)(WO + (size_t)n * DM + 768 + kq * 4) = o; }
    bf16_t* WLW = (bf16_t*)(C.ws + WS_WLW) + (size_t)l * 1536 * 128;
    for (int i = gt; i < 1536 * 128; i += NGT) { const int n = i / 128, k = i % 128; float v = 0.f;
      if (n < 768) { if (k < 64) v = inp(C, 14)[((size_t)(l * 2 + n / 384) * 64 + k) * 384 + n % 384]; }
      else { const int n2 = n - 768; if (k >= 64) v = inp(C, 16)[((size_t)(l * 2 + n2 / 384) * 64 + (k - 64)) * 384 + n2 % 384]; }
      WLW[i] = f2bf(v); }
    bf16_t* WG = (bf16_t*)(C.ws + WS_WG) + (size_t)l * 512 * 256;
    for (int i = gt; i < 512 * 256; i += NGT) { const int n = i / 256, k = i % 256; float v = 0.f;
      if (n < 384 && k < 160) v = inp(C, 17)[((size_t)l * 160 + k) * 384 + n];
      WG[i] = f2bf(v); }
    bf16_t* WQ = (bf16_t*)(C.ws + WS_WQ) + (size_t)l * 768 * 256;
    for (int i = gt; i < 768 * 256; i += NGT) { const int n = i / 256, k = i % 256; float v = 0.f;
      if (n < 576) v = inp(C, 23)[l * 256 + k] * inp(C, 24)[((size_t)l * 256 + k) * 576 + n];
      WQ[i] = f2bf(v); }
    bf16_t* WKV = (bf16_t*)(C.ws + WS_WKV) + (size_t)l * 768 * 128;
    for (int i = gt; i < 768 * 128; i += NGT) { const int n = i / 128, k = i % 128;
      WKV[i] = f2bf(inp(C, 25)[l * 128 + k] * inp(C, 26)[((size_t)l * 128 + k) * 768 + n]); }
  }
  if (lsel == 0) for (int i = gt; i < 8192; i += NGT) { float s, c; sincospif((float)i * (2.0f / 8192.0f), &s, &c); ((f32x2*)(C.ws + WS_TW))[i] = (f32x2){c, -s}; }
  if (lsel == 0) for (int i = gt; i < 128 * 8; i += NGT) { const int pos = i / 8, j = i % 8; const float inv = powf(10000.0f, -(float)j / 8.0f); float s, c; sincosf((float)pos * inv, &s, &c); ((f32x2*)(C.ws + WS_ROPE))[i] = (f32x2){c, s}; }
}
DI void phase0b(const Ctx& C, const int l) {
  const int gt = C.bid * NTHREADS + C.tid, NGT = C.G * NTHREADS;
  for (int i = gt; i < 5 * 6144; i += NGT) { const int r = i / 6144, n = i % 6144;
    float s = inp(C, 5)[l * 6144 + n];
#pragma unroll
    for (int kc = 0; kc < 8; ++kc) s += ((const float*)(C.ws + WS_MODP))[((size_t)(l * 8 + kc) * 5 + r) * 6144 + n];
    ((float*)(C.ws + WS_MOD))[l * 5 * 6144 + i] = s; }
}

DI void convert_experts(const Ctx& C, int l) {
  LAS float* scr = (LAS float*)(C.lds + C.wave * 16384);
  unsigned char* WGU = (unsigned char*)C.out + WEXP_OFF; unsigned char* WDN = WGU + (size_t)NEXP * 2048 * 1024;
  unsigned* ctr = (unsigned*)(C.ws + WS_CTL) + 64 * (8 + l);
  const int lane = C.lane, rr = lane >> 3, c4 = (lane & 7) * 4, cc = lane & 7;
  for (;;) { unsigned base = 0; if (lane == 0) base = atomicAdd(ctr, 4u); base = __builtin_amdgcn_readfirstlane(base);
    if (base >= NEXP * 3 * 512) break;
    const int e = base / 1536, r = base % 1536, mat = r / 512, sub0 = r % 512;
    const float* W = (mat == 0 ? inp(C, 29) : mat == 1 ? inp(C, 30) : inp(C, 31)) + ((size_t)l * NEXP + e) * 1024 * 1024;
    unsigned char* WT = mat < 2 ? WGU + (size_t)e * 2048 * 1024 : WDN + (size_t)e * 1024 * 1024;
    f32x4 v[2][8];
#define CE_LOAD(it_, S_) do { const int kb_ = (it_) >> 5, nb_ = (it_) & 31; _Pragma("unroll") for (int i = 0; i < 8; ++i) v[S_][i] = *(const f32x4*)(W + (size_t)(64 * kb_ + 8 * i + rr) * 1024 + 32 * nb_ + c4); } while (0)
    CE_LOAD(sub0, 0);
#pragma unroll
    for (int k = 0; k < 4; ++k) { const int it = sub0 + k; const int k0 = 64 * (it >> 5), n0 = 32 * (it & 31);
      if (k + 1 < 4) CE_LOAD(it + 1, (k + 1) & 1);
#pragma unroll
      for (int i = 0; i < 8; ++i) *(LAS f32x4*)(scr + (8 * i + rr) * 36 + c4) = v[k & 1][i] * F8_WSCALE;
      asm volatile("s_waitcnt lgkmcnt(0)" ::: "memory");
#pragma unroll
      for (int j = 0; j < 4; ++j) { const int n = (lane >> 3) + 8 * j; const LAS float* sp = scr + (8 * cc) * 36 + n;
        u32x2 o; o.x = pk4_fp8(sp[0 * 36], sp[1 * 36], sp[2 * 36], sp[3 * 36]); o.y = pk4_fp8(sp[4 * 36], sp[5 * 36], sp[6 * 36], sp[7 * 36]);
        const int f = n0 + n; const int row = mat == 2 ? f : 256 * (f >> 7) + 128 * mat + (f & 127);
        *(u32x2*)(WT + (size_t)row * 1024 + k0 + 8 * cc) = o; }
      asm volatile("s_waitcnt lgkmcnt(0)" ::: "memory"); }
#undef CE_LOAD
  }
}

DI void norm_pass(const Ctx& C, int mode, int l, int lp) {
  const int gw = C.bid * NWAVES + C.wave, NGW = C.G * NWAVES, lane = C.lane;
  bf16_t* XN = (bf16_t*)(C.ws + WS_R2); const bf16_t* DOWN = (const bf16_t*)(C.ws + WS_R1); const int* SLOT = (const int*)(C.ws + WS_SLOT); const float* AFF = (const float*)(C.ws + WS_AFF);
  f32x4 vn[4]; int slotn = -1; float affn = 0.f;
#define NP_LOAD(gg) do { if (mode == 0) { const f32x4* xr_ = (const f32x4*)in_row(C, gg) + lane; _Pragma("unroll") for (int j = 0; j < 4; ++j) vn[j] = xr_[64 * j]; } \
      else { const u32x2* xr_ = (const u32x2*)xs_row(C, gg, mode == 2) + lane; _Pragma("unroll") for (int j = 0; j < 4; ++j) { const u32x2 w_ = xr_[64 * j]; vn[j].x = __uint_as_float(w_.x); vn[j].y = __uint_as_float(w_.y); } } \
    if (mode != 0) { slotn = lane < 16 ? SLOT[(size_t)(gg) * 16 + lane] : -1; affn = lane < 16 ? AFF[(size_t)(gg) * 16 + lane] : 0.f; } } while (0)
  if (gw < TT) NP_LOAD(gw);
  for (int g = gw; g < TT; g += NGW) {
    const int mr = mod_row(g); const bool isctx = (mr == 4);
    f32x4 v[4]; const int myslot = slotn; const float myaff = affn;
#pragma unroll
    for (int j = 0; j < 4; ++j) v[j] = mode == 0 ? vn[j] : unpk4(vn[j].x, vn[j].y);
    const bool skip = (mode == 2 && isctx);
    f32x4 y[4], a5[4], g9[4], a0[4], a1[4], g6[4];
    if (!skip) {
      if (mode != 0) { const f32x4* m5 = (const f32x4*)modv(C, lp, mr, 5) + lane; const f32x4* gp = (const f32x4*)(inp(C, 9) + lp * DM) + lane;
#pragma unroll
        for (int j = 0; j < 4; ++j) { a5[j] = m5[64 * j]; g9[j] = gp[64 * j]; y[j] = (f32x4){0.f, 0.f, 0.f, 0.f}; } }
      if (mode != 2) { const f32x4* m0 = (const f32x4*)modv(C, l, mr, 0) + lane; const f32x4* m1 = (const f32x4*)modv(C, l, mr, 1) + lane; const f32x4* gp = (const f32x4*)(inp(C, 6) + l * DM) + lane;
#pragma unroll
        for (int j = 0; j < 4; ++j) { a0[j] = m0[64 * j]; a1[j] = m1[64 * j]; g6[j] = gp[64 * j]; } }
      if (mode != 0) {
        unsigned hm = (unsigned)__builtin_amdgcn_ballot_w64(lane < 16 && myslot >= 0) & 0xffffu;
        while (hm != 0u) {
          u32x2 wq[4][4]; float aq[4]; bool vq[4];
#pragma unroll
          for (int k = 0; k < 4; ++k) { vq[k] = hm != 0u;
            if (vq[k]) { const int e = __builtin_ctz(hm); hm &= hm - 1u; const int sl = __builtin_amdgcn_readlane(myslot, e); aq[k] = rdlane(myaff, e);
              const u32x2* dr = (const u32x2*)(DOWN + (size_t)sl * DM) + lane;
#pragma unroll
              for (int j = 0; j < 4; ++j) wq[k][j] = dr[64 * j]; } }
#pragma unroll
          for (int k = 0; k < 4; ++k) if (vq[k]) {
#pragma unroll
            for (int j = 0; j < 4; ++j) { const u32x2 w = wq[k][j]; y[j] = y[j] + (f32x4){bflo(w.x), bfhi(w.x), bflo(w.y), bfhi(w.y)} * aq[k]; } }
        } }
    }
    if (g + NGW < TT) NP_LOAD(g + NGW);
    if (skip) continue;
    if (mode != 0) { float s = 0.f;
#pragma unroll
      for (int j = 0; j < 4; ++j) s += (y[j].x * y[j].x + y[j].y * y[j].y) + (y[j].z * y[j].z + y[j].w * y[j].w);
      const float rstd = rsqrtf(wave_sum(s) * (1.f / DM) + NORM_EPS);
#pragma unroll
      for (int j = 0; j < 4; ++j) v[j] = v[j] + a5[j] * (y[j] * rstd * g9[j]);
      if (mode == 2) { f32x4* xo = (f32x4*)out_row(C, g) + lane;
#pragma unroll
        for (int j = 0; j < 4; ++j) xo[64 * j] = v[j];
        continue; }
      u32x2* xw = (u32x2*)xs_row(C, g, false) + lane;
#pragma unroll
      for (int j = 0; j < 4; ++j) { u32x2 w; w.x = cvtpk(v[j].x, v[j].y); w.y = cvtpk(v[j].z, v[j].w); xw[64 * j] = w; } }
    float s = 0.f;
#pragma unroll
    for (int j = 0; j < 4; ++j) s += (v[j].x * v[j].x + v[j].y * v[j].y) + (v[j].z * v[j].z + v[j].w * v[j].w);
    const float rstd = rsqrtf(wave_sum(s) * (1.f / DM) + NORM_EPS);
    u32x2* o = (u32x2*)(XN + (size_t)g * DM) + lane;
#pragma unroll
    for (int j = 0; j < 4; ++j) { const f32x4 t = v[j] * rstd * g6[j] * (a1[j] + 1.0f) + a0[j]; u32x2 w; w.x = cvtpk(t.x, t.y); w.y = cvtpk(t.z, t.w); o[64 * j] = w; }
  }
#undef NP_LOAD
}

DI void prep_a(const Ctx& C, int l) {
  const bf16_t* U = (const bf16_t*)(C.ws + WS_R1) + (size_t)TT * HW2;
  float* rq = (float*)(C.ws + WS_RSTD); float* rkv = rq + TT;
  bf16_t* KB = (bf16_t*)(C.ws + WS_R2) + (size_t)NB * NH * PP * 96;
  const f32x2* rope = (const f32x2*)(C.ws + WS_ROPE);
  const int lane = C.lane;
  LAS float* zrow = (LAS float*)(C.lds + C.wave * 1024);
  LAS f32x2* stage = (LAS f32x2*)(C.lds + 16384);
  LAS f32x2* tw64 = (LAS f32x2*)(C.lds + 16384 + 132 * 64 * 8);
  if (C.tid < 64) { float s, c; sincospif((float)C.tid * (2.0f / 64.0f), &s, &c); tw64[C.tid] = (f32x2){c, s}; }
  __syncthreads();
  for (int tile = C.bid; tile < TT / 64; tile += C.G) {
    const int g0 = tile * 64; const int b = g0 / PP, p0 = g0 - b * PP;
    u32x2 wq_[8], wz_[8]; unsigned wkv_[8]; bf16_t wkr_[8];
#pragma unroll
    for (int i = 0; i < 8; ++i) { const bf16_t* ur = U + (size_t)(g0 + C.wave * 8 + i) * HW2;
      wq_[i] = *((const u32x2*)(ur + 384) + lane); wkv_[i] = *((const unsigned*)(ur + 640) + lane); wkr_[i] = ur[768 + (lane & 31)]; wz_[i] = *((const u32x2*)(ur + 896) + lane); }
#pragma unroll
    for (int i = 0; i < 8; ++i) { const int tl = C.wave * 8 + i; const int g = g0 + tl; const int p = p0 + tl;
      { const u32x2 w = wq_[i]; const float a0 = bflo(w.x), a1 = bfhi(w.x), a2 = bflo(w.y), a3 = bfhi(w.y);
        const float s = wave_sum(a0 * a0 + a1 * a1 + a2 * a2 + a3 * a3); if (lane == 0) rq[g] = rsqrtf(s * (1.f / 256.f) + NORM_EPS); }
      { const unsigned w = wkv_[i]; const float a0 = bflo(w), a1 = bfhi(w);
        const float s = wave_sum(a0 * a0 + a1 * a1); if (lane == 0) rkv[g] = rsqrtf(s * (1.f / 128.f) + NORM_EPS); }
      { float x = lane < 32 ? bf2f(wkr_[i]) : 0.f; const float o = swz_xor8(x);
        if (p >= CTX && lane < 32) { const int li = p - CTX; const int pos = (lane & 16) ? (li & 63) : (li >> 6); const f32x2 cs = rope[pos * 8 + (lane & 7)];
          x = (lane & 8) ? (x * cs.x + o * cs.y) : (x * cs.x - o * cs.y); }
        if (lane < 32) { const bf16_t xb = f2bf(x);
#pragma unroll
          for (int hh = 0; hh < NH; ++hh) KB[((size_t)(b * NH + hh) * PP + p) * 96 + 64 + lane] = xb; } }
      { const u32x2 w = wz_[i]; *(LAS f32x4*)(zrow + lane * 4) = (f32x4){bflo(w.x), bfhi(w.x), bflo(w.y), bfhi(w.y)}; }
      asm volatile("s_waitcnt lgkmcnt(0)" ::: "memory");
      { const int grp = lane >> 4, kq = lane & 15; const LAS float* z = zrow + grp * 64;
        const float c0 = z[kq], c1 = z[kq + 16], s0 = kq == 0 ? 0.f : z[32 + kq], s1 = z[48 + kq];
        stage[(grp * 33 + kq) * 64 + tl] = (f32x2){c0, -s0}; stage[(grp * 33 + kq + 16) * 64 + tl] = (f32x2){c1, -s1};
        if (kq == 0) stage[(grp * 33 + 32) * 64 + tl] = (f32x2){z[32], 0.f}; }
      asm volatile("s_waitcnt lgkmcnt(0)" ::: "memory");
    }
    __syncthreads();
    f32x2* ZT = (f32x2*)(C.ws + WS_R4);
    for (int i = C.tid; i < 132 * 64; i += NTHREADS) { const int r = i >> 6, t = i & 63; ZT[((size_t)b * 132 + r) * PP + p0 + t] = stage[i]; }
    __syncthreads();
  }
}

DI void conv_pass(const Ctx& C, int l) {
  const int gw = C.bid * NWAVES + C.wave, NGW = C.G * NWAVES, lane = C.lane;
  const bf16_t* RKV = (const bf16_t*)(C.ws + WS_R1); bf16_t* REST = (bf16_t*)(C.ws + WS_R1) + (size_t)TT * HW2; float* INV = (float*)(C.ws + WS_INV);
  const float* cw = inp(C, 12) + (size_t)l * 3 * 1152; const float* k_k = inp(C, 18) + l * 384;
  f32x2 cw0[9], cw1[9], cw2[9], kk2[3];
#pragma unroll
  for (int j = 0; j < 9; ++j) { const int c = 2 * (lane + 64 * j); cw0[j] = (f32x2){cw[c], cw[c + 1]}; cw1[j] = (f32x2){cw[1152 + c], cw[1152 + c + 1]}; cw2[j] = (f32x2){cw[2304 + c], cw[2304 + c + 1]};
    if (j >= 3 && j < 6) kk2[j - 3] = (f32x2){k_k[c - 384], k_k[c - 384 + 1]}; }
  unsigned xn[9][3];
#define CV_LOAD(gg) do { const int b_ = (gg) / PP, p_ = (gg) - b_ * PP; const bool hl_ = (p_ != 0 && p_ != CTX), hr_ = (p_ != CTX - 1 && p_ != PP - 1); \
    const unsigned* u0_ = (const unsigned*)(RKV + (size_t)(gg) * HW2) + lane; const unsigned* ul_ = hl_ ? u0_ - HW2 / 2 : u0_; const unsigned* ur_ = hr_ ? u0_ + HW2 / 2 : u0_; \
    _Pragma("unroll") for (int j = 0; j < 9; ++j) { xn[j][0] = ul_[64 * j]; xn[j][1] = u0_[64 * j]; xn[j][2] = ur_[64 * j]; } } while (0)
  if (gw < TT) CV_LOAD(gw);
  for (int g = gw; g < TT; g += NGW) {
    const int b = g / PP, p = g - b * PP; const float ml = (p != 0 && p != CTX) ? 1.f : 0.f, mr = (p != CTX - 1 && p != PP - 1) ? 1.f : 0.f;
    unsigned x[9][3];
#pragma unroll
    for (int j = 0; j < 9; ++j) { x[j][0] = xn[j][0]; x[j][1] = xn[j][1]; x[j][2] = xn[j][2]; }
    if (g + NGW < TT) CV_LOAD(g + NGW);
    unsigned* o = (unsigned*)(REST + (size_t)g * HW2) + lane;
#pragma unroll
    for (int j = 0; j < 9; ++j) {
      const f32x2 y = (f32x2){bflo(x[j][1]), bfhi(x[j][1])} * cw1[j] + ((f32x2){bflo(x[j][0]), bfhi(x[j][0])} * cw0[j]) * ml + ((f32x2){bflo(x[j][2]), bfhi(x[j][2])} * cw2[j]) * mr;
      o[64 * j] = cvtpk(y.x, y.y);
      if (j >= 3 && j < 6) { const float a0 = y.x * kk2[j - 3].x, a1 = y.y * kk2[j - 3].y;
        float t = a0 * a0 + a1 * a1; t = dpp_add<0xB1>(t); t = dpp_add<0x4E>(t); t = dpp_add<0x141>(t); t = dpp_add<0x140>(t);
        const float t0 = rdlane(t, 0) + rdlane(t, 16), t1 = rdlane(t, 32) + rdlane(t, 48);
        if (lane == 0) INV[(size_t)g * 6 + 2 * (j - 3)] = __builtin_amdgcn_rsqf(fmaxf(t0, 1e-24f));
        if (lane == 32) INV[(size_t)g * 6 + 2 * (j - 3) + 1] = __builtin_amdgcn_rsqf(fmaxf(t1, 1e-24f)); } }
  }
#undef CV_LOAD
}

DI void post_pass(const Ctx& C, int l, bool with_ctx) {
  const int gw = C.bid * NWAVES + C.wave, NGW = C.G * NWAVES, lane = C.lane;
  const bf16_t* U = (const bf16_t*)(C.ws + WS_R1) + (size_t)TT * HW2;
  const bf16_t* AS = (const bf16_t*)(C.ws + WS_R3) + (size_t)TT * 768; const bf16_t* Gt = AS + (size_t)TT * 768;
  const bf16_t* Y0 = (const bf16_t*)(C.ws + WS_R5); const bf16_t* Y1 = Y0 + (size_t)TT * 384;
  bf16_t* MC = (bf16_t*)(C.ws + WS_R6);
  const float* cw = inp(C, 12) + (size_t)l * 3 * 1152; const float* k_a = inp(C, 19) + l * 384; const float* r_k = inp(C, 20) + l * 384;
  const float* lw = inp(C, 21) + l * 384; const float* lb = inp(C, 22) + l * 384;
  float c_lw[6], c_lb[6], c_ka[6], c_rk[6];
#pragma unroll
  for (int hh = 0; hh < NH; ++hh) { const int c = hh * 64 + lane; c_lw[hh] = lw[c]; c_lb[hh] = lb[c]; c_ka[hh] = k_a[c]; c_rk[hh] = r_k[c]; }
  unsigned short nxu[6][3], ny0[6], ny1[6], na0[6], na1[6], ngg[6];
#define PP_LOAD(gg_) do { const bf16_t* u0_ = U + (size_t)(gg_) * HW2; _Pragma("unroll") for (int hh = 0; hh < NH; ++hh) { const int c = hh * 64 + lane; \
      _Pragma("unroll") for (int q = 0; q < 3; ++q) nxu[hh][q] = u0_[q * 384 + c]; \
      ny0[hh] = Y0[(size_t)(gg_) * 384 + c]; ny1[hh] = Y1[(size_t)(gg_) * 384 + c]; na0[hh] = AS[(size_t)(gg_) * 768 + c]; na1[hh] = AS[(size_t)(gg_) * 768 + 384 + c]; ngg[hh] = Gt[(size_t)(gg_) * 384 + c]; } } while (0)
  if (gw < TT) PP_LOAD(gw);
  for (int g = gw; g < TT; g += NGW) {
    const int b = g / PP, p = g - b * PP;
    unsigned short xu[6][3], y0[6], y1[6], a0[6], a1[6], gg[6];
#pragma unroll
    for (int hh = 0; hh < NH; ++hh) { xu[hh][0] = nxu[hh][0]; xu[hh][1] = nxu[hh][1]; xu[hh][2] = nxu[hh][2]; y0[hh] = ny0[hh]; y1[hh] = ny1[hh]; a0[hh] = na0[hh]; a1[hh] = na1[hh]; gg[hh] = ngg[hh]; }
    if (g + NGW < TT) PP_LOAD(g + NGW);
    if (p < CTX && !with_ctx) continue;
#pragma unroll
    for (int hh = 0; hh < NH; ++hh) { const int c = hh * 64 + lane;
      float rkv[3];
#pragma unroll
      for (int q = 0; q < 3; ++q) rkv[q] = bf2f(xu[hh][q]);
      const float y = bf2f(y0[hh]) + bf2f(y1[hh]);
      const float mu = wave_sum(y) * (1.f / 64.f); const float dv = y - mu; const float var = wave_sum(dv * dv) * (1.f / 64.f);
      const float yn = dv * rsqrtf(var + GN_EPS) * c_lw[hh] + c_lb[hh];
      const float al0 = bf2f(a0[hh]), al1 = bf2f(a1[hh]); const float ka = c_ka[hh];
      const float kd0 = rkv[1] * (1.f + (al0 - 1.f) * ka), kd1 = rkv[1] * (1.f + (al1 - 1.f) * ka);
      const float bonus = wave_sum(rkv[0] * (kd0 + kd1) * c_rk[hh]);
      const float o = (yn + bonus * rkv[2]) * bf2f(gg[hh]);
      MC[(size_t)g * DM + c] = f2bf(o); }
  }
#undef PP_LOAD
}

DI void n2_pass(const Ctx& C, int l, bool with_ctx) {
  const int gw = C.bid * NWAVES + C.wave, NGW = C.G * NWAVES, lane = C.lane;
  const bf16_t* O = (const bf16_t*)(C.ws + WS_R1); unsigned char* TN = (unsigned char*)(C.ws + WS_R2); float* AFF = (float*)(C.ws + WS_AFF); int* SLOT = (int*)(C.ws + WS_SLOT);
  LAS float* wr = (LAS float*)C.lds; const float* wrg = inp(C, 28) + (size_t)l * DM * NEXP;
  for (int i = C.tid; i < DM * NEXP; i += NTHREADS) wr[(i & 15) * DM + (i >> 4)] = wrg[i];
  __syncthreads();
  f32x4 vn2[2][4]; u32x2 on2[2][4];
#define N2_LOAD(gg, S_) do { const u32x2* or_ = (const u32x2*)(O + (size_t)(gg) * DM) + lane; \
    if (l == 0) { const f32x4* xr_ = (const f32x4*)in_row(C, gg) + lane; _Pragma("unroll") for (int j = 0; j < 4; ++j) vn2[S_][j] = xr_[64 * j]; } \
    else { const u32x2* xr_ = (const u32x2*)xs_row(C, gg, false) + lane; _Pragma("unroll") for (int j = 0; j < 4; ++j) { const u32x2 w_ = xr_[64 * j]; vn2[S_][j].x = __uint_as_float(w_.x); vn2[S_][j].y = __uint_as_float(w_.y); } } \
    _Pragma("unroll") for (int j = 0; j < 4; ++j) on2[S_][j] = or_[64 * j]; } while (0)
  if (gw < TT) N2_LOAD(gw, 0);
  if (gw + NGW < TT) N2_LOAD(gw + NGW, 1);
  for (int g2 = gw; g2 < TT; g2 += 2 * NGW) {
#pragma unroll
  for (int SET = 0; SET < 2; ++SET) { const int g = g2 + SET * NGW; if (g >= TT) break;
    f32x4 vn[4]; u32x2 on[4];
#pragma unroll
    for (int j = 0; j < 4; ++j) { vn[j] = vn2[SET][j]; on[j] = on2[SET][j]; }
    const int mr = mod_row(g);
    f32x4 v[4], o[4]; float s = 0.f;
#pragma unroll
    for (int j = 0; j < 4; ++j) { v[j] = l == 0 ? vn[j] : unpk4(vn[j].x, vn[j].y); const u32x2 w = on[j]; o[j] = (f32x4){bflo(w.x), bfhi(w.x), bflo(w.y), bfhi(w.y)};
      s += (o[j].x * o[j].x + o[j].y * o[j].y) + (o[j].z * o[j].z + o[j].w * o[j].w); }
    const bool skip = (mr == 4 && !with_ctx);
    f32x4 a2[4], g7[4], a3[4], a4[4], g8[4];
    if (!skip) { const f32x4* m2 = (const f32x4*)modv(C, l, mr, 2) + lane; const f32x4* gp = (const f32x4*)(inp(C, 7) + l * DM) + lane;
      const f32x4* m3 = (const f32x4*)modv(C, l, mr, 3) + lane; const f32x4* m4 = (const f32x4*)modv(C, l, mr, 4) + lane; const f32x4* gq = (const f32x4*)(inp(C, 8) + l * DM) + lane;
#pragma unroll
      for (int j = 0; j < 4; ++j) { a2[j] = m2[64 * j]; g7[j] = gp[64 * j]; a3[j] = m3[64 * j]; a4[j] = m4[64 * j]; g8[j] = gq[64 * j]; } }
    if (g + 2 * NGW < TT) N2_LOAD(g + 2 * NGW, SET);
    if (skip) continue;
    float rstd = rsqrtf(wave_sum(s) * (1.f / DM) + NORM_EPS);
    { u32x2* xo = (u32x2*)xs_row(C, g, !with_ctx) + lane;
      s = 0.f;
#pragma unroll
      for (int j = 0; j < 4; ++j) { v[j] = v[j] + a2[j] * (o[j] * rstd * g7[j]); u32x2 w; w.x = cvtpk(v[j].x, v[j].y); w.y = cvtpk(v[j].z, v[j].w); xo[64 * j] = w;
        s += (v[j].x * v[j].x + v[j].y * v[j].y) + (v[j].z * v[j].z + v[j].w * v[j].w); } }
    rstd = rsqrtf(wave_sum(s) * (1.f / DM) + NORM_EPS);
    unsigned* to = (unsigned*)(TN + (size_t)g * DM) + lane;
    float lg[16];
#pragma unroll
    for (int e = 0; e < 16; ++e) lg[e] = 0.f;
#pragma unroll
    for (int j = 0; j < 4; ++j) { const f32x4 t = v[j] * rstd * g8[j] * (a4[j] + 1.0f) + a3[j]; to[64 * j] = pk4_fp8(t.x, t.y, t.z, t.w);
#pragma unroll
      for (int e = 0; e < 16; ++e) { const f32x4 ww = *(const LAS f32x4*)(wr + e * DM + 256 * j + 4 * lane); lg[e] += (t.x * ww.x + t.y * ww.y) + (t.z * ww.z + t.w * ww.w); if ((e & 3) == 3) asm volatile("" ::: "memory"); } }
    float mx = -1e30f;
#pragma unroll
    for (int e = 0; e < 16; ++e) { lg[e] = wave_sum(lg[e]); mx = fmaxf(mx, lg[e]); }
    float den = 0.f;
#pragma unroll
    for (int e = 0; e < 16; ++e) { lg[e] = __expf(lg[e] - mx); den += lg[e]; }
    const float inv = 1.f / den;
    float mine = 0.f;
#pragma unroll
    for (int e = 0; e < 16; ++e) mine = (lane == e) ? lg[e] * inv : mine;
    if (lane < 16) { AFF[(size_t)g * 16 + lane] = mine; SLOT[(size_t)g * 16 + lane] = -1; }
  } }
#undef N2_LOAD
  __syncthreads();
}

DI void topk_problem(const Ctx& C, int q) {
  const bool isctx = q >= 64; const int qq = q & 63, b = qq >> 4, e = qq & 15;
  const int n = isctx ? CTX : SEQ, cap = isctx ? 32 : 1024; const int g0 = b * PP + (isctx ? 0 : CTX);
  const float* AFF = (const float*)(C.ws + WS_AFF);
  int* IDX = (int*)(C.ws + WS_IDX); int* SLOT = (int*)(C.ws + WS_SLOT);
  const int obase = e * RPE + (isctx ? 4096 + b * 32 : b * 1024);
  LAS unsigned* keys = (LAS unsigned*)C.lds; LAS unsigned* hist = keys + 8192; LAS unsigned* ctl = hist + 256; LAS unsigned* grp = ctl + 16;
  if (!isctx) { unsigned kv_[16];
#pragma unroll
    for (int j = 0; j < 16; ++j) kv_[j] = __float_as_uint(AFF[(size_t)(g0 + C.tid + NTHREADS * j) * 16 + e]);
#pragma unroll
    for (int j = 0; j < 16; ++j) keys[C.tid + NTHREADS * j] = kv_[j]; }
  else for (int i = C.tid; i < n; i += NTHREADS) keys[i] = __float_as_uint(AFF[(size_t)(g0 + i) * 16 + e]);
  if (C.tid == 0) { ctl[0] = 0u; ctl[1] = (unsigned)cap; ctl[2] = 0u; ctl[3] = 0u; }
  unsigned mask = 0u;
  for (int pass = 0; pass < 4; ++pass) { const int shift = 24 - 8 * pass;
    if (C.tid < 256) hist[C.tid] = 0u;
    __syncthreads();
    const unsigned prefix = ctl[0];
    for (int i = C.tid; i < n; i += NTHREADS) { const unsigned k = keys[i]; if ((k & mask) == prefix) atomicAdd((unsigned*)&hist[(k >> shift) & 255u], 1u); }
    __syncthreads();
    if (C.tid < 16) { unsigned g_ = 0u;
#pragma unroll
      for (int j = 0; j < 16; ++j) g_ += hist[C.tid * 16 + j];
      grp[C.tid] = g_; }
    __syncthreads();
    if (C.tid < 256) { const unsigned rem = ctl[1]; unsigned sfx = 0u; const int gi = C.tid >> 4;
#pragma unroll
      for (int g2 = 0; g2 < 16; ++g2) sfx += (g2 > gi) ? grp[g2] : 0u;
#pragma unroll
      for (int j = 0; j < 16; ++j) sfx += (gi * 16 + j >= C.tid) ? hist[gi * 16 + j] : 0u;
      const unsigned nxt = sfx - hist[C.tid];
      if (sfx >= rem && nxt < rem) { ctl[0] = prefix | ((unsigned)C.tid << shift); ctl[1] = rem - nxt; } }
    mask |= 255u << shift;
    __syncthreads();
  }
  const unsigned thr = ctl[0], need_eq = ctl[1];
  for (int i = C.tid; i < n; i += NTHREADS) { const unsigned k = keys[i];
    int slot = -1;
    { const unsigned long long mgt = __builtin_amdgcn_ballot_w64(k > thr);
      if (mgt != 0ull) { unsigned base_ = 0u; if (C.lane == 0) base_ = atomicAdd((unsigned*)&ctl[2], (unsigned)__builtin_popcountll(mgt));
        base_ = __builtin_amdgcn_readfirstlane(base_);
        if (k > thr) slot = (int)(base_ + __builtin_amdgcn_mbcnt_hi((unsigned)(mgt >> 32), __builtin_amdgcn_mbcnt_lo((unsigned)mgt, 0u))); } }
    if (k > thr) {}
    else if (k == thr) { const unsigned t = atomicAdd((unsigned*)&ctl[3], 1u); if (t < need_eq) slot = cap - (int)need_eq + (int)t; }
    if (slot >= 0) { IDX[obase + slot] = g0 + i; SLOT[(size_t)(g0 + i) * 16 + e] = obase + slot; } }
  __syncthreads();
}
#define MFMA32(a, b, c) __builtin_amdgcn_mfma_f32_32x32x16_bf16((a), (b), (c), 0, 0, 0)
constexpr int AT_KROW = 208, AT_VROW = 144, AT_KBUF = 64 * AT_KROW, AT_VBUF = 64 * AT_VROW;
constexpr int AT_K0 = 0, AT_V0 = 2 * AT_KBUF, AT_OST = AT_V0 + 2 * AT_VBUF, AT_OROW = 144;
constexpr float AT_THR = 8.0f;
DI float max3f(float a, float b, float c) { float r; asm("v_max3_f32 %0, %1, %2, %3" : "=v"(r) : "v"(a), "v"(b), "v"(c)); return r; }

DI void attn_unit(const Ctx& C, int b, int h, int pq0, int nkt) {
  const bf16_t* QB = (const bf16_t*)(C.ws + WS_R2); const bf16_t* KBp = QB + (size_t)NB * NH * PP * 96; const bf16_t* VTp = KBp + (size_t)NB * NH * PP * 96;
  const bf16_t* Qh = QB + (size_t)(b * NH + h) * PP * 96; const bf16_t* Kh = KBp + (size_t)(b * NH + h) * PP * 96; const bf16_t* Vh = VTp + (size_t)(b * NH + h) * 64 * PP;
  bf16_t* MC = (bf16_t*)(C.ws + WS_R6);
  const int tid = C.tid, lane = C.lane, wave = C.wave, r32 = lane & 31, hi = lane >> 5;
  LAS unsigned char* lds = C.lds;
  bf16x8 qf[6];
  { const bf16_t* qrow = Qh + (size_t)(pq0 + wave * 32 + r32) * 96 + hi * 8;
#pragma unroll
    for (int d0 = 0; d0 < 6; ++d0) qf[d0] = *(const bf16x8*)(qrow + d0 * 16); }
  const int k0row = tid / 12, k0c = tid % 12, k1row = (tid + 512) / 12, k1c = (tid + 512) % 12;
  const unsigned k0dst = k0row * AT_KROW + k0c * 16, k1dst = k1row * AT_KROW + k1c * 16, vdst = (tid >> 3) * AT_VROW + (tid & 7) * 16;
  const bf16_t* vsrc = Vh + (size_t)(tid >> 3) * PP + (tid & 7) * 8;
  u32x4 sk0[2], sk1[2], sv[2];
#define AT_LOAD(kt, S_) do { const char* kb_ = (const char*)(Kh + (size_t)(kt) * 64 * 96); sk0[S_] = *(const u32x4*)(kb_ + tid * 16); if (tid < 256) sk1[S_] = *(const u32x4*)(kb_ + (tid + 512) * 16); sv[S_] = *(const u32x4*)(vsrc + (kt) * 64); } while (0)
#define AT_STORE(buf, S_) do { *(LAS u32x4*)(lds + AT_K0 + (buf) * AT_KBUF + k0dst) = sk0[S_]; if (tid < 256) *(LAS u32x4*)(lds + AT_K0 + (buf) * AT_KBUF + k1dst) = sk1[S_]; *(LAS u32x4*)(lds + AT_V0 + (buf) * AT_VBUF + vdst) = sv[S_]; } while (0)
  AT_LOAD(0, 0); AT_STORE(0, 0);
  AT_LOAD(1, 1); if (2 < nkt) AT_LOAD(2, 0);
  __syncthreads();
  f32x16 negm, o0, o1;
#pragma unroll
  for (int i = 0; i < 16; ++i) { negm[i] = 0.f; o0[i] = 0.f; o1[i] = 0.f; }
  float mhat = 0.f, lsum = 0.f;
  if (wave >= 4) __builtin_amdgcn_s_setprio(1);
  for (int kt2 = 0; kt2 < nkt; kt2 += 2) {
#pragma unroll
  for (int SET = 0; SET < 2; ++SET) { const int kt = kt2 + SET;
    const int buf = SET;
    const LAS unsigned char* kb = lds + AT_K0 + buf * AT_KBUF + r32 * AT_KROW + hi * 16;
    const LAS unsigned char* vb = lds + AT_V0 + buf * AT_VBUF + r32 * AT_VROW + hi * 16;
    f32x16 p0, p1;
    bf16x8 kf[12];
#pragma unroll
    for (int d0 = 0; d0 < 6; ++d0) { kf[2 * d0] = *(const LAS bf16x8*)(kb + d0 * 32); kf[2 * d0 + 1] = *(const LAS bf16x8*)(kb + 32 * AT_KROW + d0 * 32); }
#pragma unroll
    for (int d0 = 0; d0 < 6; ++d0) {
      if (d0 == 0) { p0 = MFMA32(kf[0], qf[0], negm); p1 = MFMA32(kf[1], qf[0], negm); } else { p0 = MFMA32(kf[2 * d0], qf[d0], p0); p1 = MFMA32(kf[2 * d0 + 1], qf[d0], p1); } }
    bf16x8 vf[8];
#pragma unroll
    for (int s_ = 0; s_ < 4; ++s_) { vf[2 * s_] = *(const LAS bf16x8*)(vb + s_ * 32); vf[2 * s_ + 1] = *(const LAS bf16x8*)(vb + 32 * AT_VROW + s_ * 32); }
    asm volatile("s_nop 15\n\ts_nop 7" : "+v"(p0), "+v"(p1));
    float rm;
    { float a_ = max3f(p0[0], p0[1], p1[0]), b_ = max3f(p0[2], p0[3], p1[1]); a_ = max3f(a_, p1[2], p1[3]);
#pragma unroll
      for (int r = 4; r < 16; r += 4) { a_ = max3f(a_, p0[r], p0[r + 1]); b_ = max3f(b_, p0[r + 2], p0[r + 3]); a_ = max3f(a_, p1[r], p1[r + 1]); b_ = max3f(b_, p1[r + 2], p1[r + 3]); }
      rm = max3f(a_, b_, b_); }
    rm = half_max(rm);
    if (kt == 0 || __any(rm > AT_THR)) {
      const float dl = (kt == 0) ? rm : fmaxf(rm, 0.f);
      mhat += dl; const float f = (kt == 0) ? 1.f : __builtin_amdgcn_exp2f(-dl); lsum *= f;
#pragma unroll
      for (int i = 0; i < 16; ++i) { p0[i] -= dl; p1[i] -= dl; o0[i] *= f; o1[i] *= f; negm[i] = -mhat; }
    }
    float ps = 0.f;
#pragma unroll
    for (int i = 0; i < 16; ++i) { p0[i] = __builtin_amdgcn_exp2f(p0[i]); p1[i] = __builtin_amdgcn_exp2f(p1[i]); ps += p0[i] + p1[i]; }
    lsum += ps;
    u32x4 w0, w1, w2, w3;
    w0 = (u32x4){cvtpk(p0[0], p0[1]), cvtpk(p0[2], p0[3]), cvtpk(p0[4], p0[5]), cvtpk(p0[6], p0[7])};
    w1 = (u32x4){cvtpk(p0[8], p0[9]), cvtpk(p0[10], p0[11]), cvtpk(p0[12], p0[13]), cvtpk(p0[14], p0[15])};
    w2 = (u32x4){cvtpk(p1[0], p1[1]), cvtpk(p1[2], p1[3]), cvtpk(p1[4], p1[5]), cvtpk(p1[6], p1[7])};
    w3 = (u32x4){cvtpk(p1[8], p1[9]), cvtpk(p1[10], p1[11]), cvtpk(p1[12], p1[13]), cvtpk(p1[14], p1[15])};
    const bf16x8 pf0 = __builtin_bit_cast(bf16x8, w0), pf1 = __builtin_bit_cast(bf16x8, w1), pf2 = __builtin_bit_cast(bf16x8, w2), pf3 = __builtin_bit_cast(bf16x8, w3);
#define AT_PV(s, pf) do { o0 = MFMA32(vf[2 * (s)], pf, o0); o1 = MFMA32(vf[2 * (s) + 1], pf, o1); } while (0)
    AT_PV(0, pf0); AT_PV(1, pf1); AT_PV(2, pf2); AT_PV(3, pf3);
#undef AT_PV
    if (kt + 1 < nkt) { AT_STORE(buf ^ 1, SET ^ 1); if (kt + 3 < nkt) AT_LOAD(kt + 3, SET ^ 1); }
    __syncthreads();
  } }
#undef AT_LOAD
#undef AT_STORE
  __builtin_amdgcn_s_setprio(0);
  lsum = half_sum(lsum);
  const float inv = 1.f / lsum;
  LAS bf16_t* stg = (LAS bf16_t*)(lds + AT_OST + wave * 32 * AT_OROW);
#pragma unroll
  for (int i = 0; i < 16; ++i) { const int d = (i & 3) + 8 * (i >> 2) + 4 * hi;
    stg[r32 * (AT_OROW / 2) + d] = f2bf(o0[i] * inv); stg[r32 * (AT_OROW / 2) + 32 + d] = f2bf(o1[i] * inv); }
  asm volatile("s_waitcnt lgkmcnt(0)" ::: "memory");
#pragma unroll
  for (int i = 0; i < 4; ++i) { const int piece = i * 64 + lane, row = piece >> 3, c = piece & 7;
    const u32x4 v = *(const LAS u32x4*)((const LAS unsigned char*)stg + row * AT_OROW + c * 16);
    *(u32x4*)(MC + (size_t)(b * PP + pq0 + wave * 32 + row) * DM + 384 + h * 64 + c * 8) = v; }
  __syncthreads();
}

constexpr int SC_CH = 32;
DI int scan_pos(int s, int d) { return d == 0 ? s : (s < CTX ? CTX - 1 - s : (PP - 1) - (s - CTX)); }
DI void scan_unit(const Ctx& C, int l, int unit) {
  const int chain = unit >> 1, half = unit & 1;
  const int b = chain / 12, h = (chain >> 1) % 6, d = chain & 1;
  const bf16_t* U = (const bf16_t*)(C.ws + WS_R1);
  const bf16_t* EW = (const bf16_t*)(C.ws + WS_R3); const bf16_t* AS = EW + (size_t)TT * 768;
  bf16_t* Y = (bf16_t*)(C.ws + WS_R5) + (size_t)d * TT * 384;
  const float* cw = inp(C, 12) + (size_t)l * 3 * 1152; const float* k_k = inp(C, 18) + l * 384; const float* k_a = inp(C, 19) + l * 384;
  const int lane = C.lane, wave = C.wave;
  LAS float* opsb = (LAS float*)C.lds;
  LAS float* ybuf = opsb + 2 * SC_CH * 384;
  constexpr int NCH = PP / SC_CH;
  if (wave >= 4) {
    const int pw = wave - 4;
    const int c = h * 64 + lane;
    const float cwr0 = cw[c], cwr1 = cw[1152 + c], cwr2 = cw[2304 + c];
    const float cwk0 = cw[384 + c], cwk1 = cw[1152 + 384 + c], cwk2 = cw[2304 + 384 + c];
    const float cwv0 = cw[768 + c], cwv1 = cw[1152 + 768 + c], cwv2 = cw[2304 + 768 + c];
    const float kkc = k_k[c], kac = k_a[c];
    for (int chunk = -1; chunk < NCH; ++chunk) {
      if (chunk >= 1) { const int cb = (chunk - 1) & 1;
#pragma unroll
        for (int i = 0; i < 4; ++i) { const int sl = pw * 8 + 2 * i + (lane >> 5), rw = lane & 31; const int p = scan_pos((chunk - 1) * SC_CH + sl, d);
          Y[(size_t)(b * PP + p) * 384 + h * 64 + half * 32 + rw] = f2bf(ybuf[(cb * SC_CH + sl) * 32 + rw]); } }
      if (chunk + 1 < NCH) { const int nb = (chunk + 1) & 1; const int s0 = (chunk + 1) * SC_CH;
#pragma unroll
        for (int hf = 0; hf < 2; ++hf) {
          unsigned short ur[4][3], uk[4][3], uv[4][3], uew[4], uas[4]; float ml[4], mr[4];
#pragma unroll
          for (int i = 0; i < 4; ++i) { const int sl = pw * 8 + hf * 4 + i; const int p = scan_pos(s0 + sl, d); const int g = b * PP + p;
            const bool hasl = (p != 0 && p != CTX), hasr = (p != CTX - 1 && p != PP - 1);
            ml[i] = hasl ? 1.f : 0.f; mr[i] = hasr ? 1.f : 0.f;
            const bf16_t* u0 = U + (size_t)g * UW + c; const bf16_t* ul = hasl ? u0 - UW : u0; const bf16_t* urr = hasr ? u0 + UW : u0;
            ur[i][0] = ul[0]; ur[i][1] = u0[0]; ur[i][2] = urr[0];
            uk[i][0] = ul[384]; uk[i][1] = u0[384]; uk[i][2] = urr[384];
            uv[i][0] = ul[768]; uv[i][1] = u0[768]; uv[i][2] = urr[768];
            uew[i] = EW[(size_t)g * 768 + d * 384 + c]; uas[i] = AS[(size_t)g * 768 + d * 384 + c]; }
#pragma unroll
          for (int i = 0; i < 4; ++i) { const int sl = pw * 8 + hf * 4 + i;
            const float r = bf2f(ur[i][1]) * cwr1 + ml[i] * bf2f(ur[i][0]) * cwr0 + mr[i] * bf2f(ur[i][2]) * cwr2;
            const float k = bf2f(uk[i][1]) * cwk1 + ml[i] * bf2f(uk[i][0]) * cwk0 + mr[i] * bf2f(uk[i][2]) * cwk2;
            const float v = bf2f(uv[i][1]) * cwv1 + ml[i] * bf2f(uv[i][0]) * cwv0 + mr[i] * bf2f(uv[i][2]) * cwv2;
            const float kr = k * kkc; const float nrm = sqrtf(wave_sum(kr * kr)); const float kk = kr / fmaxf(nrm, 1e-12f);
            const float ew = bf2f(uew[i]), a = bf2f(uas[i]);
            const float w = __expf(-ew); const float kd = k * (1.f + (a - 1.f) * kac);
            LAS float* o = opsb + (nb * SC_CH + sl) * 384 + lane;
            o[0] = r; o[64] = w; o[128] = kd; o[192] = v; o[256] = -kk; o[320] = kk * a; }
        } }
      __syncthreads();
    }
    { const int cb = (NCH - 1) & 1;
#pragma unroll
      for (int i = 0; i < 4; ++i) { const int sl = pw * 8 + 2 * i + (lane >> 5), rw = lane & 31; const int p = scan_pos((NCH - 1) * SC_CH + sl, d);
        Y[(size_t)(b * PP + p) * 384 + h * 64 + half * 32 + rw] = f2bf(ybuf[(cb * SC_CH + sl) * 32 + rw]); } }
  } else {
    const int rowl = wave * 8 + (lane >> 3), cg = lane & 7;
    const int vrow = half * 32 + rowl;
    f32x2 S[4];
#pragma unroll
    for (int j = 0; j < 4; ++j) S[j] = (f32x2){0.f, 0.f};
    __syncthreads();
    for (int chunk = 0; chunk < NCH; ++chunk) {
      const LAS float* ob = opsb + (chunk & 1) * SC_CH * 384;
      LAS float* yb = ybuf + (chunk & 1) * SC_CH * 32;
#define SC_LOADOPS(R0, R1, W0, W1, K0, K1, A0, A1, B0, B1, VV, slx) do { const LAS float* o_ = ob + (slx) * 384 + cg * 8; \
        R0 = *(const LAS f32x4*)(o_); R1 = *(const LAS f32x4*)(o_ + 4); W0 = *(const LAS f32x4*)(o_ + 64); W1 = *(const LAS f32x4*)(o_ + 68); \
        K0 = *(const LAS f32x4*)(o_ + 128); K1 = *(const LAS f32x4*)(o_ + 132); A0 = *(const LAS f32x4*)(o_ + 256); A1 = *(const LAS f32x4*)(o_ + 260); \
        B0 = *(const LAS f32x4*)(o_ + 320); B1 = *(const LAS f32x4*)(o_ + 324); VV = ob[(slx) * 384 + 192 + vrow]; } while (0)
#define SC_STEP(r0, r1, w0, w1, k0, k1, a0, a1, b0, b1, vv, YOUT) do { \
        f32x2 t = S[0] * (f32x2){a0.x, a0.y} + S[1] * (f32x2){a0.z, a0.w}; t = t + S[2] * (f32x2){a1.x, a1.y}; t = t + S[3] * (f32x2){a1.z, a1.w}; \
        float sa = t.x + t.y; \
        sa = dpp_add<0xB1>(sa); sa = dpp_add<0x4E>(sa); sa = dpp_add<0x141>(sa); \
        const f32x2 sa2 = (f32x2){sa, sa}, vv2 = (f32x2){vv, vv}; \
        S[0] = S[0] * (f32x2){w0.x, w0.y} + (sa2 * (f32x2){b0.x, b0.y} + vv2 * (f32x2){k0.x, k0.y}); \
        S[1] = S[1] * (f32x2){w0.z, w0.w} + (sa2 * (f32x2){b0.z, b0.w} + vv2 * (f32x2){k0.z, k0.w}); \
        S[2] = S[2] * (f32x2){w1.x, w1.y} + (sa2 * (f32x2){b1.x, b1.y} + vv2 * (f32x2){k1.x, k1.y}); \
        S[3] = S[3] * (f32x2){w1.z, w1.w} + (sa2 * (f32x2){b1.z, b1.w} + vv2 * (f32x2){k1.z, k1.w}); \
        f32x2 yy = S[0] * (f32x2){r0.x, r0.y} + S[1] * (f32x2){r0.z, r0.w}; yy = yy + S[2] * (f32x2){r1.x, r1.y}; yy = yy + S[3] * (f32x2){r1.z, r1.w}; \
        float y = yy.x + yy.y; \
        y = dpp_add<0xB1>(y); y = dpp_add<0x4E>(y); y = dpp_add<0x141>(y); YOUT = y; } while (0)
      f32x4 pr0, pr1, pw0, pw1, pk0, pk1, pa0, pa1, pb0, pb1; float pv;
      f32x4 qr0, qr1, qw0, qw1, qk0, qk1, qa0, qa1, qb0, qb1; float qv;
      SC_LOADOPS(pr0, pr1, pw0, pw1, pk0, pk1, pa0, pa1, pb0, pb1, pv, 0);
#pragma unroll 1
      for (int sg = 0; sg < SC_CH / 8; ++sg) {
        float ykeep = 0.f;
#pragma unroll
        for (int j = 0; j < 8; j += 2) { const int sl = sg * 8 + j; float y0, y1;
          SC_LOADOPS(qr0, qr1, qw0, qw1, qk0, qk1, qa0, qa1, qb0, qb1, qv, sl + 1);
          SC_STEP(pr0, pr1, pw0, pw1, pk0, pk1, pa0, pa1, pb0, pb1, pv, y0);
          SC_LOADOPS(pr0, pr1, pw0, pw1, pk0, pk1, pa0, pa1, pb0, pb1, pv, (sl + 2) & (SC_CH - 1));
          SC_STEP(qr0, qr1, qw0, qw1, qk0, qk1, qa0, qa1, qb0, qb1, qv, y1);
          ykeep = (cg == j) ? y0 : ykeep; ykeep = (cg == j + 1) ? y1 : ykeep; }
        yb[(sg * 8 + cg) * 32 + rowl] = ykeep;
      }
#undef SC_LOADOPS
#undef SC_STEP
      __syncthreads();
    }
  }
  __syncthreads();
}

DI void fft_unit(const Ctx& C, int seq, bool isctx) {
  const int N = isctx ? CTX : SEQ, logN = isctx ? 8 : 13, off = isctx ? 0 : CTX;
  const f32x2* src = (const f32x2*)(C.ws + WS_R4) + (size_t)seq * PP + off;
  const f32x2* TW = (const f32x2*)(C.ws + WS_TW);
  bf16_t* MC = (bf16_t*)(C.ws + WS_R6);
  LAS f32x2* x = (LAS f32x2*)C.lds;
  const int tid = C.tid;
  LAS f32x2* twl = x + N;
  const int twmul = SEQ / N;
  for (int i = tid; i < N; i += NTHREADS) x[i] = src[i];
  for (int i = tid; i < N / 2; i += NTHREADS) twl[i] = TW[i * twmul];
  __syncthreads();
  for (int s = 0; s < logN; ++s) { const int hb = logN - 1 - s, hh = 1 << hb;
    for (int j = tid; j < N / 2; j += NTHREADS) { const int blk = j >> hb, i = j & (hh - 1); const int i0 = (blk << (hb + 1)) + i, i1 = i0 + hh;
      const f32x2 a = x[i0], bb = x[i1]; const f32x2 tw = twl[i << s];
      const float dr = a.x - bb.x, di = a.y - bb.y;
      x[i0] = (f32x2){a.x + bb.x, a.y + bb.y}; x[i1] = (f32x2){dr * tw.x - di * tw.y, dr * tw.y + di * tw.x}; }
    __syncthreads(); }
  const float scale = rsqrtf(64.0f * (float)N);
  const int b = seq / 132, grp = (seq / 33) & 3, k2 = seq % 33;
  for (int pi = tid; pi < N; pi += NTHREADS) { const int k1 = (int)(__brev((unsigned)pi) >> (32 - logN));
    const bf16_t val = f2bf(x[pi].x * scale);
    MC[(size_t)(b * PP + off + k1) * DM + 768 + grp * 64 + k2] = val;
    if (k2 >= 1 && k2 <= 31) MC[(size_t)(b * PP + off + ((N - k1) & (N - 1))) * DM + 768 + grp * 64 + 64 - k2] = val; }
  __syncthreads();
}

constexpr int CK_ROW = 144, CK_SLOT = 64 * CK_ROW;
template <int N> struct IC_ { static constexpr int value = N; };
DI void ck_mma(f32x16& acc, const LAS unsigned char* A, int arow0, const LAS unsigned char* B, int brow0, int r32, int hi) {
  const LAS unsigned char* ap = A + (arow0 + r32) * CK_ROW + hi * 16; const LAS unsigned char* bp = B + (brow0 + r32) * CK_ROW + hi * 16;
#pragma unroll
  for (int k2 = 0; k2 < 4; k2 += 2) {
    const bf16x8 a0 = *(const LAS bf16x8*)(ap + k2 * 32), b0 = *(const LAS bf16x8*)(bp + k2 * 32), a1 = *(const LAS bf16x8*)(ap + k2 * 32 + 32), b1 = *(const LAS bf16x8*)(bp + k2 * 32 + 32);
    __builtin_amdgcn_sched_barrier(0);
    acc = MFMA32(a0, b0, acc); acc = MFMA32(a1, b1, acc); }
}
typedef short v4i16_t __attribute__((ext_vector_type(4)));
DI void ck_mma_trA(f32x16& acc, const LAS unsigned char* T, int arow0, const LAS unsigned char* B, int brow0, int lane, int r32, int hi) {
  const int q = (lane & 15) >> 2, p = lane & 3, blk = (lane >> 4) & 1;
  const LAS unsigned char* tp = T + (8 * hi + q) * CK_ROW + (arow0 + 16 * blk) * 2 + 8 * p; const LAS unsigned char* bp = B + (brow0 + r32) * CK_ROW + hi * 16;
#pragma unroll
  for (int kk = 0; kk < 4; ++kk) {
    const v4i16_t lo = __builtin_amdgcn_ds_read_tr16_b64_v4i16((LAS v4i16_t*)(tp + kk * 16 * CK_ROW)), hi4 = __builtin_amdgcn_ds_read_tr16_b64_v4i16((LAS v4i16_t*)(tp + kk * 16 * CK_ROW + 4 * CK_ROW));
    const bf16x8 a = (bf16x8){lo[0], lo[1], lo[2], lo[3], hi4[0], hi4[1], hi4[2], hi4[3]};
    acc = MFMA32(a, *(const LAS bf16x8*)(bp + kk * 32), acc); }
}
DI void ck_store(const f32x16& acc, LAS unsigned char* Out, int arow0, int brow0, int r32, int hi) {
  LAS unsigned char* op = Out + (brow0 + r32) * CK_ROW + (arow0 + 4 * hi) * 2;
#pragma unroll
  for (int g = 0; g < 4; ++g) { u32x2 w; w.x = cvtpk(acc[4 * g], acc[4 * g + 1]); w.y = cvtpk(acc[4 * g + 2], acc[4 * g + 3]); *(LAS u32x2*)(op + g * 16) = w; }
}
#ifndef PROF_TID
#define PROF_TID 0
#endif
#ifndef PROF_CHAIN
#define PROF_CHAIN 0
#endif
#ifndef PROF_LAYER
#define PROF_LAYER 0
#endif
#ifdef PROF_SEL
#define PROF_T0(k) if (PROF_SEL == (k) && C.tid == PROF_TID) *(LAS unsigned long long*)(C.lds + 147456 - 128) = __builtin_amdgcn_s_memrealtime();
#define PROF_T1(k) if (PROF_SEL == (k) && chain == PROF_CHAIN && l == 0 && C.tid == PROF_TID) atomicAdd((unsigned*)(C.ws + WS_CTL) + 1024, (unsigned)(__builtin_amdgcn_s_memrealtime() - *(LAS unsigned long long*)(C.lds + 147456 - 128)));
#else
#define PROF_T0(k)
#define PROF_T1(k)
#endif
DI void scan_chain(const Ctx& C, int l, int chain) {
  PROF_T0(1)
#ifdef PROF_SEL
  if ((PROF_SEL == 8 || PROF_SEL == 13) && C.tid == 0) *(LAS unsigned long long*)(C.lds + 147456 - 128) = __builtin_amdgcn_s_memrealtime();
  if ((PROF_SEL == 10 || PROF_SEL == 11) && C.tid == 0) *(LAS unsigned*)(C.lds + 147456 - 112) = 0u;
#endif
  const int b = chain / 12, h = (chain >> 1) % 6, d = chain & 1;
  const bf16_t* U = (const bf16_t*)(C.ws + WS_R1) + (size_t)TT * HW2;
  const float* INV = (const float*)(C.ws + WS_INV);
  const bf16_t* EW = (const bf16_t*)(C.ws + WS_R3); const bf16_t* AS = EW + (size_t)TT * 768;
  bf16_t* Y = (bf16_t*)(C.ws + WS_R5) + (size_t)d * TT * 384;
  const float* cw = inp(C, 12) + (size_t)l * 3 * 1152; const float* k_k = inp(C, 18) + l * 384; const float* k_a = inp(C, 19) + l * 384;
  const int lane = C.lane, wave = C.wave, r32 = lane & 31, hi = lane >> 5;
  LAS unsigned char* L = C.lds;
#define SLOT(n) (L + (n) * CK_SLOT)
  LAS unsigned char* const sAT = SLOT(0); LAS unsigned char* const sRT = SLOT(1); LAS unsigned char* const sBT = SLOT(2); LAS unsigned char* const sKT = SLOT(3);
  LAS unsigned char* const sVT = SLOT(4); LAS unsigned char* const sBH = SLOT(5); LAS unsigned char* const sKH = SLOT(6); LAS unsigned char* const sSB = SLOT(7);
  LAS unsigned char* const sP0 = SLOT(8); LAS unsigned char* const sP0T = SLOT(9); LAS unsigned char* const sAAK = SLOT(10); LAS unsigned char* const sARB = SLOT(11);
  LAS unsigned char* const sARK = SLOT(12); LAS unsigned char* const sXa = SLOT(13); LAS unsigned char* const sXb = SLOT(14);
  LAS float* gamC = (LAS float*)SLOT(15); LAS float* wtot = gamC + 64;
  const int t4 = wave & 3, arow0 = (t4 >> 1) * 32, brow0 = (t4 & 1) * 32;
  const int hw = lane >> 5, q2 = (lane & 31) * 2, c0 = h * 64 + q2;
  LAS float* kconst = gamC + 64 + 16 * 64;
  if (C.tid < 64) { kconst[C.tid] = k_k[h * 64 + C.tid]; kconst[64 + C.tid] = k_a[h * 64 + C.tid]; }
  __syncthreads();
#define UNP(u_) ((f32x2){bflo(u_), bfhi(u_)})
  f32x16 xacc, sacc;
#pragma unroll
  for (int i = 0; i < 16; ++i) { xacc[i] = 0.f; sacc[i] = 0.f; }
  unsigned pr[2][4], pk[2][4], pv[2][4], pew[2][4], pas[2][4]; float pin[2][4];
#define CK_PREFETCH(S_, ci) do { const int p0w_ = scan_pos((ci) * 64 + wave * 8, d); const int sg_ = d == 0 ? 1 : -1; const int p0h_ = p0w_ + sg_ * 4 * hw; \
    _Pragma("unroll") for (int j = 0; j < 4; ++j) { const int g_ = b * PP + p0h_ + sg_ * j; const bf16_t* u_ = U + ((size_t)g_ * HW2 + c0); \
      pr[S_][j] = *(const unsigned*)(u_); pk[S_][j] = *(const unsigned*)(u_ + 384); pv[S_][j] = *(const unsigned*)(u_ + 768); \
      const size_t o_ = (size_t)g_ * 768 + d * 384 + c0; pew[S_][j] = *(const unsigned*)(EW + o_); pas[S_][j] = *(const unsigned*)(AS + o_); pin[S_][j] = INV[(size_t)g_ * 6 + h]; } } while (0)
  CK_PREFETCH(0, 0); CK_PREFETCH(1, 1);
  for (int ci2 = 0; ci2 < PP / 64; ci2 += 2) {
#pragma unroll
  for (int SET = 0; SET < 2; ++SET) { const int ci = ci2 + SET;
    PROF_T0(2)
    PROF_T0(6)
    PROF_T0(12)
#ifdef PROF_SEL
    unsigned long long q0_ = 0; if (PROF_SEL == 10 && C.tid == 0) q0_ = __builtin_amdgcn_s_memrealtime();
#endif
    if (wave < 4) ck_store(sacc, sSB, arow0, brow0, r32, hi);
    f32x2 fr[4], fkd[4], fv[4], fkk[4], fal[4], flg[4];
    { f32x2 run = (f32x2){0.f, 0.f}; const f32x2 kkc = *(const LAS f32x2*)(kconst + q2), kac = *(const LAS f32x2*)(kconst + 64 + q2);
#pragma unroll
      for (int j = 0; j < 4; ++j) {
        const f32x2 k = UNP(pk[SET][j]); const f32x2 al = UNP(pas[SET][j]);
        run = run - UNP(pew[SET][j]);
        fr[j] = UNP(pr[SET][j]); fkd[j] = k * ((al - 1.f) * kac + 1.f); fv[j] = UNP(pv[SET][j]); fkk[j] = (k * kkc) * pin[SET][j]; fal[j] = al; flg[j] = run; }
      *(LAS f32x2*)(wtot + (wave * 2 + hw) * 64 + q2) = run; }
    PROF_T1(12)
    if (ci > 0) { const int s_ = C.tid >> 3, pc_ = C.tid & 7; const int p_ = scan_pos((ci - 1) * 64 + s_, d);
      *(u32x4*)(Y + (size_t)(b * PP + p_) * 384 + h * 64 + pc_ * 8) = *(const LAS u32x4*)(SLOT(8) + s_ * CK_ROW + pc_ * 16); }
    CK_PREFETCH(SET, ci + 2 < PP / 64 ? ci + 2 : ci);
    __syncthreads();
#ifdef PROF_SEL
    if (PROF_SEL == 10 && C.tid == 0) *(LAS unsigned*)(C.lds + 147456 - 112) += (unsigned)(__builtin_amdgcn_s_memrealtime() - q0_);
#endif
    PROF_T1(6)
    PROF_T0(7)
    { f32x2 off = (f32x2){0.f, 0.f}, tot = (f32x2){0.f, 0.f}; const int seg = wave * 2 + hw;
#pragma unroll
      for (int w2 = 0; w2 < 16; ++w2) { const f32x2 t = *(const LAS f32x2*)(wtot + w2 * 64 + q2); off = off + ((w2 < seg) ? t : (f32x2){0.f, 0.f}); tot = tot + t; }
      const f32x2 eTot = (f32x2){__expf(tot.x), __expf(tot.y)};
      if (wave == 0 && hw == 0) *(LAS f32x2*)(gamC + q2) = eTot;
      f32x2 eGprev = (f32x2){__expf(off.x), __expf(off.y)};
      f32x2 tv[4], tbh[4], tkh[4];
      const int s0 = wave * 8 + hw * 4;
#pragma unroll
      for (int j = 0; j < 4; ++j) { const int s = s0 + j; const f32x2 Lc = off + flg[j];
        const f32x2 eG = (f32x2){__expf(Lc.x), __expf(Lc.y)}, eGp = eGprev, eGi = (f32x2){__builtin_amdgcn_rcpf(eG.x), __builtin_amdgcn_rcpf(eG.y)}, eGc = eTot * eGi; eGprev = eG;
        const f32x2 bb = fkk[j] * fal[j];
        const f32x2 xa = fkk[j] * eGp, xr = fr[j] * eG, xb = bb * eGi, xk = fkd[j] * eGi;
        *(LAS unsigned*)(sAT + s * CK_ROW + q2 * 2) = cvtpk(-xa.x, -xa.y);
        *(LAS unsigned*)(sRT + s * CK_ROW + q2 * 2) = cvtpk(xr.x, xr.y);
        *(LAS unsigned*)(sBT + s * CK_ROW + q2 * 2) = cvtpk(xb.x, xb.y);
        *(LAS unsigned*)(sKT + s * CK_ROW + q2 * 2) = cvtpk(xk.x, xk.y);
        tv[j] = fv[j]; tbh[j] = bb * eGc; tkh[j] = fkd[j] * eGc; }
#define PK4(T, comp) ((u32x2){cvtpk(T[0].comp, T[1].comp), cvtpk(T[2].comp, T[3].comp)})
      *(LAS u32x2*)(sVT + q2 * CK_ROW + s0 * 2) = PK4(tv, x); *(LAS u32x2*)(sVT + (q2 + 1) * CK_ROW + s0 * 2) = PK4(tv, y);
      *(LAS u32x2*)(sBH + q2 * CK_ROW + s0 * 2) = PK4(tbh, x); *(LAS u32x2*)(sBH + (q2 + 1) * CK_ROW + s0 * 2) = PK4(tbh, y);
      *(LAS u32x2*)(sKH + q2 * CK_ROW + s0 * 2) = PK4(tkh, x); *(LAS u32x2*)(sKH + (q2 + 1) * CK_ROW + s0 * 2) = PK4(tkh, y);
#undef PK4
    }
    __syncthreads();
    PROF_T1(2)
    PROF_T1(7)
#ifdef PROF_SEL
    unsigned long long q1_ = 0; if (PROF_SEL == 11 && C.tid == 0) q1_ = __builtin_amdgcn_s_memrealtime();
#endif
    PROF_T0(3)
    { f32x16 z;
#pragma unroll
      for (int i = 0; i < 16; ++i) z[i] = 0.f;
      int thr = brow0 + r32 - arow0 - 4 * hi; asm volatile("" : "+v"(thr));
#define CK_CI(i) (((i) & 3) + 8 * ((i) >> 2))
      if (wave < 4) {
        f32x16 t = z, w = z;
        ck_mma(t, sBT, arow0, sAT, brow0, r32, hi);
        ck_mma(w, sBT, arow0, sRT, brow0, r32, hi);
#pragma unroll
        for (int i = 0; i < 16; ++i) { t[i] = CK_CI(i) < thr ? t[i] : 0.f; w[i] = CK_CI(i) <= thr ? w[i] : 0.f; }
        ck_store(t, sP0, arow0, brow0, r32, hi); ck_store(w, sARB, arow0, brow0, r32, hi);
      } else {
        f32x16 t = z, u = z;
        ck_mma(t, sKT, arow0, sAT, brow0, r32, hi);
        ck_mma(u, sKT, arow0, sRT, brow0, r32, hi);
#pragma unroll
        for (int i = 0; i < 16; ++i) { t[i] = CK_CI(i) < thr ? t[i] : 0.f; u[i] = CK_CI(i) <= thr ? u[i] : 0.f; }
        ck_store(t, sAAK, arow0, brow0, r32, hi); ck_store(u, sARK, arow0, brow0, r32, hi);
      }
#undef CK_CI
    }
    __syncthreads();
    PROF_T1(3)
    PROF_T0(4)
#define CK_SQUARE(Pin, Pout) do { f32x16 t_; _Pragma("unroll") for (int i = 0; i < 16; ++i) t_[i] = 0.f; \
      ck_mma_trA(t_, Pin, arow0, Pin, brow0, lane, r32, hi);            \
      ck_store(t_, Pout, arow0, brow0, r32, hi); } while (0)
#define CK_XSTEP(Pj, Xin, Xout) do { ck_mma(xacc, Pj, arow0, Xin, brow0, r32, hi); ck_store(xacc, Xout, arow0, brow0, r32, hi); } while (0)
    if (wave < 4) CK_SQUARE(sP0, SLOT(2));
    else {
#pragma unroll
      for (int i = 0; i < 16; ++i) xacc[i] = 0.f;
      ck_mma(xacc, sAT, arow0, sSB, brow0, r32, hi); ck_mma(xacc, sAAK, arow0, sVT, brow0, r32, hi); ck_store(xacc, sXa, arow0, brow0, r32, hi); }
    __syncthreads();
    if (wave < 4) CK_SQUARE(SLOT(2), SLOT(0)); else CK_XSTEP(sP0, sXa, sXb);
    __syncthreads();
    if (wave < 4) CK_SQUARE(SLOT(0), SLOT(8)); else CK_XSTEP(SLOT(2), sXb, sXa);
    __syncthreads();
    if (wave < 4) CK_SQUARE(SLOT(8), SLOT(2)); else CK_XSTEP(SLOT(0), sXa, sXb);
    __syncthreads();
    if (wave < 4) CK_SQUARE(SLOT(2), SLOT(0)); else CK_XSTEP(SLOT(8), sXb, sXa);
    __syncthreads();
    f32x16 yacc;
    if (wave >= 4) CK_XSTEP(SLOT(2), sXa, sXb);
    else {
#pragma unroll
      for (int i = 0; i < 16; ++i) yacc[i] = 0.f;
      ck_mma(yacc, sSB, arow0, sRT, brow0, r32, hi); ck_mma(yacc, sVT, arow0, sARK, brow0, r32, hi); }
    __syncthreads();
    if (wave >= 4) CK_XSTEP(SLOT(0), sXb, sXa);
    else {
#pragma unroll
      for (int i = 0; i < 16; ++i) sacc[i] *= gamC[arow0 + (i & 3) + 8 * (i >> 2) + 4 * hi];
      ck_mma(sacc, sKH, arow0, sVT, brow0, r32, hi); }
    __syncthreads();
    PROF_T1(4)
    PROF_T0(5)
    if (wave < 4) {
      ck_mma(yacc, sXa, arow0, sARB, brow0, r32, hi); ck_mma(sacc, sBH, arow0, sXa, brow0, r32, hi);
      ck_store(yacc, SLOT(8), arow0, brow0, r32, hi);
    }
    __syncthreads();
    PROF_T1(5)
#ifdef PROF_SEL
    if (PROF_SEL == 11 && C.tid == 0) *(LAS unsigned*)(C.lds + 147456 - 112) += (unsigned)(__builtin_amdgcn_s_memrealtime() - q1_);
#endif
  } }
  PROF_T1(1)
#ifdef PROF_SEL
  if ((PROF_SEL == 10 || PROF_SEL == 11) && l == PROF_LAYER && C.tid == 0) atomicMax((unsigned*)(C.ws + WS_CTL) + 1024, *(LAS unsigned*)(C.lds + 147456 - 112));
  if (PROF_SEL == 13 && l == PROF_LAYER && C.tid == 0) atomicMax((unsigned*)(C.ws + WS_CTL) + 1025, (((unsigned)(__builtin_amdgcn_s_memrealtime() - *(LAS unsigned long long*)(C.lds + 147456 - 128))) << 6) | (unsigned)chain);
  if (PROF_SEL == 8 && C.tid == 0) atomicMax((unsigned*)(C.ws + WS_CTL) + 1024, (unsigned)(__builtin_amdgcn_s_memrealtime() - *(LAS unsigned long long*)(C.lds + 147456 - 128)));
#endif
  { const int s_ = C.tid >> 3, pc_ = C.tid & 7; const int p_ = scan_pos((PP / 64 - 1) * 64 + s_, d);
    *(u32x4*)(Y + (size_t)(b * PP + p_) * 384 + h * 64 + pc_ * 8) = *(const LAS u32x4*)(SLOT(8) + s_ * CK_ROW + pc_ * 16); }
  __syncthreads();
#undef SLOT
#undef UNP
#undef CK_PREFETCH
#undef CK_SQUARE
#undef CK_XSTEP
}
DI void mix_phase(const Ctx& C0, int l, bool with_ctx, int rep = 0) {
  unsigned* ctr = (unsigned*)(C0.ws + WS_CTL) + 64 * (1 + l + 2 * rep);
  LAS int* slot = (LAS int*)(C0.lds + 147456 - 64);
    const int n_scan = 0;
#ifdef REP_ATT
  const int n_att = 1536;
#else
  const int n_att = 768;
#endif
  const int n_attc = with_ctx ? 24 : 0, n_fft = 528, n_fftc = with_ctx ? 528 : 0;
  const int total = n_scan + n_att + n_attc + n_fft + n_fftc;
#ifndef CHAIN_XCDS
#define CHAIN_XCDS 4
#endif
  { const int x = C0.bid % 8, r = C0.bid / 8; const int per = 48 / CHAIN_XCDS;
    const bool xcd_map = (C0.G % 8 == 0) && (C0.G / 8 >= per);
    if (xcd_map && x < CHAIN_XCDS && r < per) { Ctx C = C0; { int t_ = C0.tid; asm volatile("" : "+v"(t_)); C.tid = t_; C.lane = t_ & 63; C.wave = __builtin_amdgcn_readfirstlane(t_ >> 6); }
      scan_chain(C, l, x * per + r); }
    else if (!xcd_map && C0.bid < 48) { scan_chain(C0, l, C0.bid); } }
  for (;;) {
    __syncthreads();
    if (C0.tid == 0) *slot = (int)atomicAdd(ctr, 1u);
    __syncthreads();
    int it = __builtin_amdgcn_readfirstlane(*slot);
    if (it >= total) break;
    Ctx C = C0; { int t_ = C0.tid; asm volatile("" : "+v"(t_)); C.tid = t_; C.lane = t_ & 63; C.wave = __builtin_amdgcn_readfirstlane(t_ >> 6); GAS unsigned char* w_ = (GAS unsigned char*)C0.ws; asm volatile("" : "+s"(w_), "+s"(it)); C.ws = (unsigned char*)w_; }
    if (it < n_scan) { scan_chain(C, l, it); continue; } it -= n_scan;
    if (it < n_att) { const int bh = (it % 768) / 32, qb = it % 32; attn_unit(C, bh / NH, bh % NH, CTX + qb * 256, PP / 64); continue; } it -= n_att;
    if (it < n_attc) { attn_unit(C, it / NH, it % NH, 0, CTX / 64); continue; } it -= n_attc;
    if (it < n_fft) { fft_unit(C, it, false); continue; } it -= n_fft;
    fft_unit(C, it, true);
  }
  if (l == 0) { unsigned* ctr2 = (unsigned*)(C0.ws + WS_CTL) + 64 * 12;
    for (;;) { __syncthreads(); if (C0.tid == 0) *slot = (int)atomicAdd(ctr2, 1u); __syncthreads();
      const int vb = __builtin_amdgcn_readfirstlane(*slot); if (vb >= 1024) break;
      phase0(C0, 1, vb, 1024); __syncthreads(); } }
  convert_experts(C0, l);
}
#define XB_TMO      128
#define XB_XCNT(j)  (256  + 64 * (j))
#define XB_XSUB(j)  (1280 + 64 * (j))
#define XB_XGEN(j)  (2304 + 64 * (j))
#define XB_TOP      3328
#define XB_TOPGEN   3392
#define XCD_BAR_WORDS 3456
#define XB_SPIN_CAP (1u << 18)

__device__ __forceinline__ unsigned xb_ld(unsigned* p)              { return __hip_atomic_load(p, __ATOMIC_RELAXED, __HIP_MEMORY_SCOPE_AGENT); }
__device__ __forceinline__ unsigned xb_add(unsigned* p, unsigned v) { return __hip_atomic_fetch_add(p, v, __ATOMIC_RELAXED, __HIP_MEMORY_SCOPE_AGENT); }
__device__ __forceinline__ unsigned xb_xcc_id() { return (unsigned)__builtin_amdgcn_s_getreg((3 << 11) | 20) & 0xFu; }
#define XB_SPIN(cond, bar) do { unsigned _sp = 0; while (cond) { __builtin_amdgcn_s_sleep(1); \
    if ((++_sp & 255u) == 0u) { if (xb_ld(&(bar)[XB_TMO])) break; if (_sp > XB_SPIN_CAP) { atomicAdd(&(bar)[XB_TMO], 1u); break; } } } } while (0)

struct XcdBarrier {
    unsigned* bar; unsigned x;
    volatile LAS unsigned* st;
};

__device__ __forceinline__ XcdBarrier xcd_barrier_post(unsigned* bar, volatile LAS unsigned* st) {
    XcdBarrier b; b.bar = bar; b.x = xb_xcc_id(); b.st = st;
    if (threadIdx.x == 0) (void)xb_add(&bar[XB_XCNT(b.x)], 1u);
    return b;
}
__device__ __forceinline__ void xcd_barrier_complete(unsigned* bar, unsigned x, unsigned& nloc, unsigned& nx) {
    const unsigned G = gridDim.x * gridDim.y * gridDim.z;
    unsigned sum, cnt, mine, sp = 0u;
    for (;;) {
        sum = 0u; cnt = 0u; mine = 0u;
#pragma unroll
        for (unsigned j = 0; j < 16; ++j) { const unsigned c = xb_ld(&bar[XB_XCNT(j)]); sum += c; cnt += (c > 0u) ? 1u : 0u; mine = (j == x) ? c : mine; }
        if (sum == G) break;
        __builtin_amdgcn_s_sleep(1);
        if ((++sp & 255u) == 0u) { if (xb_ld(&bar[XB_TMO])) break; if (sp > XB_SPIN_CAP) { atomicAdd(&bar[XB_TMO], 1u); break; } }
    }
    nloc = mine > 0u ? mine : 1u; nx = cnt > 0u ? cnt : 1u;
}

__device__ __forceinline__ void xcd_barrier(const XcdBarrier& b, const bool leader  ) {
    asm volatile("s_waitcnt vmcnt(0)" ::: "memory");
    __syncthreads();
    if (leader) {
        unsigned* bar = b.bar;
        __builtin_amdgcn_s_waitcnt(0);
        unsigned nloc = b.st[0], nx = b.st[1];
        if (nloc == 0u) { xcd_barrier_complete(bar, b.x, nloc, nx); b.st[0] = nloc; b.st[1] = nx; }
        const unsigned old = xb_add(&bar[XB_XSUB(b.x)], 1u);
        const unsigned gen = old / nloc;
        if (old + 1u == (gen + 1u) * nloc) {
            __builtin_amdgcn_fence(__ATOMIC_RELEASE, "agent");
            asm volatile("s_waitcnt vmcnt(0)" ::: "memory");
            const unsigned og = xb_add(&bar[XB_TOP], 1u);
            const unsigned tg = og / nx;
            if (og + 1u == (tg + 1u) * nx) xb_add(&bar[XB_TOPGEN], 1u);
            else XB_SPIN(xb_ld(&bar[XB_TOPGEN]) == tg, bar);
            __builtin_amdgcn_fence(__ATOMIC_ACQUIRE, "agent");
            xb_add(&bar[XB_XGEN(b.x)], 1u);
            asm volatile("s_waitcnt vmcnt(0)" ::: "memory");
        } else {
            XB_SPIN(xb_ld(&bar[XB_XGEN(b.x)]) == gen, bar);
            __builtin_amdgcn_fence(__ATOMIC_ACQUIRE, "agent");
            asm volatile("s_waitcnt vmcnt(0)" ::: "memory");
        }
    }
    __syncthreads();
}

constexpr int LDS_BYTES = 147456;
#ifndef REP_PHASE
#define REP_PHASE 0
#endif
#define NREP(k) ((REP_PHASE == (k)) ? 2 : 1)

#ifdef PROF_SEL
#define TPH0(k) unsigned long long tph_##k = 0; if (PROF_SEL == 100 + (k)) tph_##k = __builtin_amdgcn_s_memrealtime();
#define TPH1(k) if (PROF_SEL == 100 + (k) && C.bid == 0 && C.tid == 0) atomicAdd((unsigned*)(P.ws + WS_CTL) + 1024, (unsigned)(__builtin_amdgcn_s_memrealtime() - tph_##k));
#else
#define TPH0(k)
#define TPH1(k)
#endif
__global__ void __launch_bounds__(NTHREADS, 2) mk_fwd(Params P) {
  extern __shared__ __attribute__((aligned(16))) unsigned char lds_raw[];
  cg::grid_group grid = cg::this_grid();
  Ctx C; unsigned char* ws;
  const int wave0_ = __builtin_amdgcn_readfirstlane((int)threadIdx.x >> 6);
#define PH() do { const __attribute__((address_space(4))) char* kp_ = (const __attribute__((address_space(4))) char*)__builtin_amdgcn_kernarg_segment_ptr(); asm volatile("" : "+s"(kp_)); \
    unsigned m_ = ~0u; asm volatile("" : "+s"(m_)); int t_ = wave0_ * 64 + (int)__builtin_amdgcn_mbcnt_hi(m_, __builtin_amdgcn_mbcnt_lo(m_, 0u)); asm volatile("" : "+v"(t_));     \
    C.in = (const __attribute__((address_space(4))) cfptr*)kp_; C.out = (float*)(GAS float*)*(float* const __attribute__((address_space(4)))*)(kp_ + 256); C.ws = (unsigned char*)(GAS unsigned char*)*(unsigned char* const __attribute__((address_space(4)))*)(kp_ + 264); ws = C.ws; \
    C.lds = (LAS unsigned char*)lds_raw; C.ldsg = lds_raw; C.tid = t_; C.lane = t_ & 63; C.wave = __builtin_amdgcn_readfirstlane(t_ >> 6); int g_ = gridDim.x, b_ = blockIdx.x; asm volatile("" : "+s"(g_), "+s"(b_)); C.G = g_; C.bid = b_; } while (0)
#define R1 ((bf16_t*)(ws + WS_R1))
#define R2 ((bf16_t*)(ws + WS_R2))
#define R3 ((bf16_t*)(ws + WS_R3))
#define QB R2
#define KB (R2 + (size_t)NB * NH * PP * 96)
#define VT (R2 + (size_t)2 * NB * NH * PP * 96)
#define EW R3
#define AS (R3 + (size_t)TT * 768)
#define GG (R3 + (size_t)2 * TT * 768)
#define rq ((float*)(ws + WS_RSTD))
#define rkv (((float*)(ws + WS_RSTD)) + TT)
#define IDX ((int*)(ws + WS_IDX))

  { volatile LAS unsigned* xst = (volatile LAS unsigned*)((LAS unsigned char*)lds_raw + LDS_BYTES - 32);
    if (threadIdx.x == 0) { xst[0] = 0u; xst[1] = 0u; } }
  __syncthreads();
  (void)xcd_barrier_post((unsigned*)(P.ws + WS_CTL) + 4096, (volatile LAS unsigned*)((LAS unsigned char*)lds_raw + LDS_BYTES - 32));
#define GSYNC() do { XcdBarrier xb_; xb_.bar = (unsigned*)(C.ws + WS_CTL) + 4096; xb_.x = xb_xcc_id(); xb_.st = (volatile LAS unsigned*)((LAS unsigned char*)lds_raw + LDS_BYTES - 32); xcd_barrier(xb_, C.tid == 0); } while (0)
  { TPH0(12) for (int rep = 0; rep < NREP(12); ++rep) { PH(); phase0(C, 0, C.bid, C.G);
  grid.sync(); } TPH1(12) }
  PH(); phase0b(C, 0);
  GSYNC();
  for (int l = 0; l < 2; ++l) {
    const bool last = (l == 1);
    { TPH0(1) PH(); if (l == 0) norm_pass(C, 0, 0, 0); else norm_pass(C, 1, 1, 0);
    GSYNC(); TPH1(1) }
    { TPH0(2) for (int rep = 0; rep < NREP(2); ++rep) { PH(); { pg8::Gemm g{R2, (const bf16_t*)(ws + WS_WIN) + (size_t)l * UW * DM, DM, DM}; pg8::StaticOrder S; S.init(TT, UW, C.G, C.bid);
      EpiU E{R1, R1 + (size_t)TT * HW2}; pg8::gemm_phase(C.lds, C.tid, g, S, E); }
    GSYNC(); } TPH1(2) }
    { TPH0(3) for (int rep = 0; rep < NREP(3); ++rep) { PH(); prep_a(C, l);
    GSYNC(); } TPH1(3) }
    { TPH0(4) for (int rep = 0; rep < NREP(4); ++rep) { PH(); { pg8::Gemm g{R1 + (size_t)TT * HW2, (const bf16_t*)(ws + WS_WLW) + (size_t)l * 1536 * 128, HW2, 128}; pg8::StaticOrder S; S.init(TT, 1536, C.G, C.bid);
      EpiLW E{EW, AS, inp(C, 13) + l * 768, inp(C, 15) + l * 768}; pg8::gemm_phase(C.lds, C.tid, g, S, E); }
    PH(); { pg8::Gemm g{R1 + (size_t)TT * HW2 + 128, (const bf16_t*)(ws + WS_WG) + (size_t)l * 512 * 256, HW2, 256}; pg8::StaticOrder S; S.init(TT, 512, C.G, (C.bid + 24) % C.G);
      EpiG E{GG}; pg8::gemm_phase(C.lds, C.tid, g, S, E); }
    PH(); { pg8::Gemm g{R1 + (size_t)TT * HW2 + 384, (const bf16_t*)(ws + WS_WQ) + (size_t)l * 768 * 256, HW2, 256}; pg8::StaticOrder S; S.init(TT, 768, C.G, (C.bid + 32) % C.G);
      EpiQ E{QB, rq, (const float*)(ws + WS_ROPE)}; pg8::gemm_phase(C.lds, C.tid, g, S, E); }
    PH(); { pg8::Gemm g{R1 + (size_t)TT * HW2 + 640, (const bf16_t*)(ws + WS_WKV) + (size_t)l * 768 * 128, HW2, 128}; pg8::StaticOrder S; S.init(TT, 768, C.G, (C.bid + 176) % C.G);
      EpiKV E{KB, VT, rkv}; pg8::gemm_phase(C.lds, C.tid, g, S, E); }
    GSYNC(); } TPH1(4) }
    { TPH0(14) PH(); conv_pass(C, l);
    GSYNC(); TPH1(14) }
    { TPH0(5) for (int rep = 0; rep < NREP(5); ++rep) { PH(); mix_phase(C, l, !last, rep);
    GSYNC(); } TPH1(5) }
    { TPH0(6) for (int rep = 0; rep < NREP(6); ++rep) { PH(); post_pass(C, l, !last);
    GSYNC(); } TPH1(6) }
    { TPH0(7) for (int rep = 0; rep < NREP(7); ++rep) { PH(); { pg8::Gemm g{(const bf16_t*)(ws + WS_R6), (const bf16_t*)(ws + WS_WOUT) + (size_t)l * DM * DM, DM, DM}; EpiPlain E{R1, DM};
      if (!last) { pg8::StaticOrder S; S.init(TT, DM, C.G, C.bid); pg8::gemm_phase(C.lds, C.tid, g, S, E); }
      else { LatentOrder S; S.init(DM, C.G, C.bid); pg8::gemm_phase(C.lds, C.tid, g, S, E); } }
    GSYNC(); } TPH1(7) }
    { TPH0(8) PH(); n2_pass(C, l, !last);
    GSYNC(); TPH1(8) }
    { TPH0(9) for (int rep = 0; rep < NREP(9); ++rep) { PH(); { const int nprob = last ? 64 : 128;
      { TPH0(20) if (C.bid < nprob) topk_problem(C, C.bid); TPH1(20) }
      const int gt = C.bid * NTHREADS + C.tid, NGT = C.G * NTHREADS;
      for (int i = gt; i < NEXP * 256; i += NGT) { const int e = i >> 8, r = i & 255; const int row = e * RPE + 4096 + r; if (last || r >= 128) IDX[row] = 0; }
      if (!last) phase0b(C, 1); }
    GSYNC(); } TPH1(9) }
    { TPH0(10) for (int rep = 0; rep < NREP(10); ++rep) { PH(); { pg8::Gemm g{R2, (const bf16_t*)((const unsigned char*)C.out + WEXP_OFF), DM / 2, DM / 2}; MoeOrder<true> S;       S.init(last ? 16 : 17, 8, C.G, C.bid, IDX);
      EpiMoe1 E{(unsigned char*)(ws + WS_HID)}; pg8::gemm_phase(C.lds, C.tid, g, S, E); }
    GSYNC(); } TPH1(10) }
    { TPH0(11) for (int rep = 0; rep < NREP(11); ++rep) { PH(); { pg8::Gemm g{(const bf16_t*)(ws + WS_HID), (const bf16_t*)((const unsigned char*)C.out + WEXP_OFF + (size_t)NEXP * 2048 * 1024), DM / 2, DM / 2}; MoeOrder<false> S; S.init(last ? 16 : 17, 4, C.G, C.bid, IDX);
      EpiMoe2 E{R1}; pg8::gemm_phase(C.lds, C.tid, g, S, E); }
    GSYNC(); } TPH1(11) }
  }
#ifdef EXTRA_SYNCS
  for (int i_ = 0; i_ < EXTRA_SYNCS; ++i_) GSYNC();
#endif
  { TPH0(13) PH(); norm_pass(C, 2, 0, 1); TPH1(13) }
#ifdef PROF_SEL
  GSYNC();
  PH(); if (C.bid == 0 && C.tid == 0) { unsigned ticks = __hip_atomic_load((unsigned*)(P.ws + WS_CTL) + 1024, __ATOMIC_RELAXED, __HIP_MEMORY_SCOPE_AGENT) * PROF_MUL;
    if (PROF_SEL == 13) ticks = (__hip_atomic_load((unsigned*)(P.ws + WS_CTL) + 1025, __ATOMIC_RELAXED, __HIP_MEMORY_SCOPE_AGENT) & 63u) * 2000u;
    const unsigned long long t0 = __builtin_amdgcn_s_memrealtime(); while (__builtin_amdgcn_s_memrealtime() - t0 < ticks) __builtin_amdgcn_s_sleep(4); }
#endif
}

extern "C" void kernel_launch(void* const* d_in, const int* in_sizes, int n_in, void* d_out, int out_size, void* d_ws, size_t ws_size, hipStream_t stream) {
  static int grid = 0;
  if (grid == 0) {
    int dev = 0, cus = 0, per_cu = 0;
    if (n_in != 32 || out_size != NB * SEQ * DM || ws_size < WS_END) { fprintf(stderr, "kernel_launch: unexpected shapes (n_in %d out %d ws %zu)\n", n_in, out_size, ws_size); grid = -1; return; }
    (void)hipGetDevice(&dev);
    (void)hipDeviceGetAttribute(&cus, hipDeviceAttributeMultiprocessorCount, dev);
    (void)hipFuncSetAttribute((const void*)mk_fwd, hipFuncAttributeMaxDynamicSharedMemorySize, LDS_BYTES);
    (void)hipOccupancyMaxActiveBlocksPerMultiprocessor(&per_cu, (const void*)mk_fwd, NTHREADS, LDS_BYTES);
    if (per_cu < 1) { fprintf(stderr, "kernel_launch: occupancy query reports %d blocks per CU\n", per_cu); grid = -1; return; }
    grid = cus;
  }
  if (grid < 0) return;
  (void)hipMemsetAsync((char*)d_ws + WS_CTL, 0, 32768, stream);
  Params p{};
  for (int i = 0; i < 32; ++i) p.in[i] = (const float*)d_in[i];
  p.out = (float*)d_out; p.ws = (unsigned char*)d_ws;
  void* args[] = {&p};
  hipError_t e = hipLaunchCooperativeKernel((const void*)mk_fwd, dim3(grid), dim3(NTHREADS), args, LDS_BYTES, stream);
  if (e != hipSuccess) fprintf(stderr, "cooperative launch failed: %s (grid %d)\n", hipGetErrorString(e), grid);
}
```
